# Optimizing an MI355X kernel written in HIP

```python
import math
import jax, jax.numpy as jnp
from jax import lax
import numpy as np

D_MODEL = 1024
BATCH = 2
SEQ = 8192
DEPTH = 1

N_HEADS_A = 8
HEAD_DIM = 64
WIDTH_A = N_HEADS_A * HEAD_DIM
IDX_HEADS = 8
IDX_DIM = 64
TOPK_MAX = 256
N_HEADS_B = 8
WIDTH_B = N_HEADS_B * HEAD_DIM
N_BUCKETS = 32
MAX_DISTANCE = 128
PEER_HEADS = 8
N_KEYS = 128
N_EXPERTS = N_KEYS * N_KEYS
PEER_QDIM = 256
PEER_HALF = PEER_QDIM // 2
PEER_TOPK = 16
Q_BLOCK = 128
TOK_CHUNK = 128
EPS = 1e-6
IN_SPLIT_SIZES = (WIDTH_A, WIDTH_A, WIDTH_A,
                  IDX_HEADS * IDX_DIM, IDX_DIM, IDX_HEADS,
                  WIDTH_B, WIDTH_B, WIDTH_B,
                  D_MODEL, D_MODEL)
IN_WIDTH = 3 * WIDTH_A + IDX_HEADS * IDX_DIM + IDX_DIM + IDX_HEADS + 3 * WIDTH_B + 2 * D_MODEL

kernel_name = "hybrid_dsa_stickbreak_peer_block"


def rmsnorm(x, g):
    xf = x.astype(jnp.float32)
    y = xf * lax.rsqrt(jnp.mean(xf * xf, axis=-1, keepdims=True) + EPS)
    return (y * g.astype(jnp.float32)).astype(x.dtype)


def modulate(h, shift, scale):
    return h * (1 + scale[:, None, :]) + shift[:, None, :]


def t5_bucket(n):
    max_exact = N_BUCKETS // 2
    nf = jnp.maximum(n, 1).astype(jnp.float32)
    large = max_exact + (jnp.log(nf / max_exact) / math.log(MAX_DISTANCE / max_exact)
                         * (N_BUCKETS - max_exact)).astype(jnp.int32)
    large = jnp.minimum(large, N_BUCKETS - 1)
    return jnp.where(n < max_exact, n, large)


def to_blocks(a, nblk):
    b = a.shape[0]
    return a.reshape(b, nblk, Q_BLOCK, *a.shape[2:]).swapaxes(0, 1)


def dsa_attention(q, k, v, qi, ki, wi, rel_bias):
    b, s, h, dh = q.shape
    topk = min(TOPK_MAX, s // 4)
    nblk = s // Q_BLOCK
    key_pos = jnp.arange(s)
    idx_scale = (IDX_DIM ** -0.5) * (IDX_HEADS ** -0.5)

    def one_block(args):
        blk, qb, qib, wib = args
        q_pos = blk * Q_BLOCK + jnp.arange(Q_BLOCK)
        rel = jax.nn.relu(jnp.einsum('bthd,bsd->bths', qib, ki))
        score = jnp.einsum('bths,bth->bts', rel, wib).astype(jnp.float32) * idx_scale
        causal = key_pos[None, :] <= q_pos[:, None]
        score = jnp.where(causal[None], score, -jnp.inf)
        top_score, idx = lax.top_k(score, topk)
        valid = jnp.isfinite(top_score)
        kg = jax.vmap(lambda kk, ii: kk[ii])(k, idx)
        vg = jax.vmap(lambda vv, ii: vv[ii])(v, idx)
        logits = jnp.einsum('bthd,btkhd->bhtk', qb, kg).astype(jnp.float32) * (dh ** -0.5)
        bias = rel_bias[t5_bucket(q_pos[None, :, None] - idx)].astype(jnp.float32)
        logits = logits + jnp.moveaxis(bias, -1, 1)
        logits = jnp.where(valid[:, None], logits, -jnp.inf)
        p = jax.nn.softmax(logits, axis=-1).astype(v.dtype)
        return jnp.einsum('bhtk,btkhd->bthd', p, vg)

    out = lax.map(one_block, (jnp.arange(nblk), to_blocks(q, nblk), to_blocks(qi, nblk), to_blocks(wi, nblk)))
    return out.swapaxes(0, 1).reshape(b, s, h * dh)


def stick_breaking_attention(q, k, v):
    b, s, h, dh = q.shape
    nblk = s // Q_BLOCK
    key_pos = jnp.arange(s)

    def one_block(args):
        blk, qb = args
        q_pos = blk * Q_BLOCK + jnp.arange(Q_BLOCK)
        z = jnp.einsum('bthd,bshd->bhts', qb, k).astype(jnp.float32) * (dh ** -0.5)
        strict = (key_pos[None, :] < q_pos[:, None])[None, None]
        log_beta = jax.nn.log_sigmoid(z)
        log_one_minus = jnp.where(strict, log_beta - z, 0.0)
        suffix = lax.cumsum(log_one_minus, axis=3, reverse=True) - log_one_minus
        a = jnp.where(strict, jnp.exp(log_beta + suffix), 0.0).astype(v.dtype)
        return jnp.einsum('bhts,bshd->bthd', a, v)

    out = lax.map(one_block, (jnp.arange(nblk), to_blocks(q, nblk)))
    return out.swapaxes(0, 1).reshape(b, s, h * dh)


def peer_ffn(h, w_q, sub_keys, u, v):
    t, d = h.shape
    qh = (h @ w_q).reshape(t, PEER_HEADS, 2, PEER_HALF)
    s = jnp.einsum('thcd,hcnd->thcn', qh, sub_keys).astype(jnp.float32)
    s1, i1 = lax.top_k(s[:, :, 0], PEER_TOPK)
    s2, i2 = lax.top_k(s[:, :, 1], PEER_TOPK)
    cand = (s1[..., :, None] + s2[..., None, :]).reshape(t, PEER_HEADS, PEER_TOPK * PEER_TOPK)
    cand_idx = (i1[..., :, None] * N_KEYS + i2[..., None, :]).reshape(t, PEER_HEADS, PEER_TOPK * PEER_TOPK)
    top_s, pos = lax.top_k(cand, PEER_TOPK)
    eidx = jnp.take_along_axis(cand_idx, pos, axis=-1)
    g = jax.nn.softmax(top_s, axis=-1)
    nchunk = t // TOK_CHUNK

    def one_chunk(args):
        hc, ec, gc = args
        pre = jnp.einsum('cd,chkd->chk', hc, u[ec]).astype(jnp.float32)
        coef = (gc * jax.nn.gelu(pre, approximate=False)).astype(h.dtype)
        return jnp.einsum('chk,chkd->cd', coef, v[ec])

    out = lax.map(one_chunk, (h.reshape(nchunk, TOK_CHUNK, d),
                              eidx.reshape(nchunk, TOK_CHUNK, PEER_HEADS, PEER_TOPK),
                              g.reshape(nchunk, TOK_CHUNK, PEER_HEADS, PEER_TOPK)))
    return out.reshape(t, d)


def setup_inputs(seed: int = 0) -> dict:
    key = jax.random.key(seed)
    ks = jax.random.split(key, 20)
    D = D_MODEL
    nrm = jax.random.normal
    x = nrm(ks[0], (BATCH, SEQ, D), jnp.float32)
    c = nrm(ks[1], (BATCH, D), jnp.float32)
    w_ada = nrm(ks[2], (DEPTH, D, 6 * D), jnp.float32) * (0.5 * D ** -0.5)
    b_ada = nrm(ks[3], (DEPTH, 6 * D), jnp.float32) * 0.01
    norm1_g = 1.0 + 0.05 * nrm(ks[4], (DEPTH, D), jnp.float32)
    norm2_g = 1.0 + 0.05 * nrm(ks[5], (DEPTH, D), jnp.float32)
    w_in = nrm(ks[6], (DEPTH, D, IN_WIDTH), jnp.float32) * D ** -0.5
    rel_bias = nrm(ks[7], (N_BUCKETS, N_HEADS_A), jnp.float32) * 0.5
    w_proj_a = nrm(ks[8], (DEPTH, WIDTH_A, D), jnp.float32) * WIDTH_A ** -0.5
    w_proj_b = nrm(ks[9], (DEPTH, WIDTH_B, D), jnp.float32) * WIDTH_B ** -0.5
    w_out = nrm(ks[10], (DEPTH, D, D), jnp.float32) * D ** -0.5
    peer_wq = nrm(ks[11], (DEPTH, D, PEER_HEADS * PEER_QDIM), jnp.float32) * D ** -0.5
    peer_sub_keys = nrm(ks[12], (DEPTH, PEER_HEADS, 2, N_KEYS, PEER_HALF), jnp.float32) * PEER_HALF ** -0.5
    peer_u = nrm(ks[13], (DEPTH, N_EXPERTS, D), jnp.float32) * D ** -0.5
    peer_v = nrm(ks[14], (DEPTH, N_EXPERTS, D), jnp.float32) * PEER_HEADS ** -0.5
    final_g = 1.0 + 0.05 * nrm(ks[15], (D,), jnp.float32)
    return {"x": x, "c": c, "w_ada": w_ada, "b_ada": b_ada, "norm1_g": norm1_g, "norm2_g": norm2_g,
            "w_in": w_in, "rel_bias": rel_bias, "w_proj_a": w_proj_a, "w_proj_b": w_proj_b,
            "w_out": w_out, "peer_wq": peer_wq, "peer_sub_keys": peer_sub_keys, "peer_u": peer_u,
            "peer_v": peer_v, "final_g": final_g}


def reference(x, c, w_ada, b_ada, norm1_g, norm2_g, w_in, rel_bias, w_proj_a, w_proj_b, w_out,
              peer_wq, peer_sub_keys, peer_u, peer_v, final_g):
    b, s, d = x.shape
    offsets = []
    acc = 0
    for size in IN_SPLIT_SIZES[:-1]:
        acc += size
        offsets.append(acc)
    cond = jax.nn.silu(c)
    for l in range(DEPTH):
        mod = (cond @ w_ada[l] + b_ada[l]).reshape(b, 6, d)
        shift1, scale1, gate1, shift2, scale2, gate2 = [mod[:, i] for i in range(6)]

        hn = modulate(rmsnorm(x, norm1_g[l]), shift1, scale1)
        proj = hn @ w_in[l]
        qa, ka, va, qi, ki, wi, qb, kb, vb, ga, gb = jnp.split(proj, offsets, axis=-1)
        hd = (b, s, -1, HEAD_DIM)
        ya = dsa_attention(qa.reshape(hd), ka.reshape(hd), va.reshape(hd),
                           qi.reshape(b, s, IDX_HEADS, IDX_DIM), ki, wi, rel_bias)
        yb = stick_breaking_attention(qb.reshape(hd), kb.reshape(hd), vb.reshape(hd))
        merged = jax.nn.sigmoid(ga) * (ya @ w_proj_a[l]) + jax.nn.sigmoid(gb) * (yb @ w_proj_b[l])
        x = x + gate1[:, None, :] * (merged @ w_out[l])

        hn2 = modulate(rmsnorm(x, norm2_g[l]), shift2, scale2)
        f = peer_ffn(hn2.reshape(b * s, d), peer_wq[l], peer_sub_keys[l], peer_u[l], peer_v[l]).reshape(b, s, d)
        x = x + gate2[:, None, :] * f
    return rmsnorm(x, final_g)
```

```cpp
#include <hip/hip_runtime.h>
#include <stdint.h>
#include <math.h>
#include <string.h>

typedef unsigned short bf16;
constexpr int D = 1024, NB = 2, S = 8192, T = NB * S;
constexpr int INW = 5704;
constexpr int OFF_QA = 0, OFF_KA = 512, OFF_VA = 1024, OFF_QI = 1536, OFF_KI = 2048, OFF_WI = 2112, OFF_QB = 2120, OFF_KB = 2632, OFF_VB = 3144, OFF_GA = 3656, OFF_GB = 4680;
constexpr int PW = 3656;
constexpr int TOPK = 256;
constexpr float EPS = 1e-6f;
constexpr size_t MiB = 1u << 20;

__device__ __forceinline__ bf16 f2bf(float f) { unsigned u = __float_as_uint(f); return (bf16)((u + 0x7fffu + ((u >> 16) & 1u)) >> 16); }
__device__ __forceinline__ float bf2f(bf16 h) { return __uint_as_float(((unsigned)h) << 16); }

__device__ __forceinline__ float wave_sum(float v) {
#pragma unroll
    for (int o = 1; o < 64; o <<= 1) v += __shfl_xor(v, o);
    return v;
}
template <int NT> __device__ __forceinline__ float block_sum(float v, float* red) {
    v = wave_sum(v);
    __syncthreads();
    if ((threadIdx.x & 63) == 0) red[threadIdx.x >> 6] = v;
    __syncthreads();
    float s = 0.f;
#pragma unroll
    for (int i = 0; i < NT / 64; ++i) s += red[i];
    return s;
}

__global__ void k_mod(const float* __restrict__ c, const float* __restrict__ w_ada, const float* __restrict__ b_ada, float* __restrict__ mod) {
    __shared__ float sc[2][1024];
    for (int i = threadIdx.x; i < 2048; i += 256) { float v = c[i]; sc[i >> 10][i & 1023] = v / (1.f + expf(-v)); }
    __syncthreads();
    const int j = blockIdx.x * 256 + threadIdx.x;
    float a0 = b_ada[j], a1 = a0;
    for (int k = 0; k < 1024; ++k) { const float w = w_ada[(size_t)k * 6144 + j]; a0 += sc[0][k] * w; a1 += sc[1][k] * w; }
    mod[j] = a0; mod[6144 + j] = a1;
}

__global__ void k_norm_mod(const float* __restrict__ x, const float* __restrict__ g, const float* __restrict__ mod, int shift_i, int scale_i, float* __restrict__ out) {
    __shared__ float red[4];
    const int t = blockIdx.x, b = t / S, i = threadIdx.x;
    const float4 v = ((const float4*)(x + (size_t)t * D))[i];
    float ss = v.x * v.x + v.y * v.y + v.z * v.z + v.w * v.w;
    ss = block_sum<256>(ss, red);
    const float r = rsqrtf(ss * (1.f / D) + EPS);
    const float4 gg = ((const float4*)g)[i];
    const float4 sh = ((const float4*)(mod + b * 6144 + shift_i * D))[i];
    const float4 sc = ((const float4*)(mod + b * 6144 + scale_i * D))[i];
    float4 o;
    o.x = v.x * r * gg.x * (1.f + sc.x) + sh.x; o.y = v.y * r * gg.y * (1.f + sc.y) + sh.y;
    o.z = v.z * r * gg.z * (1.f + sc.z) + sh.z; o.w = v.w * r * gg.w * (1.f + sc.w) + sh.w;
    ((float4*)(out + (size_t)t * D))[i] = o;
}

enum { EPI_BF16 = 0, EPI_SIGMOID = 1, EPI_MUL_INPLACE = 2, EPI_MULADD = 3, EPI_RESID_GATE = 4, EPI_F32 = 5 };
struct GemmArgs { const float* A; const float* Bm; void* C; const float* aux; const float* aux2; int lda, ldb, M, N, K, ldc; };
template <int EPI> __global__ void __launch_bounds__(256) k_gemm(GemmArgs g) {
    __shared__ float As[16][68];
    __shared__ float Bs[16][68];
    const int tid = threadIdx.x, tx = tid & 15, ty = tid >> 4;
    const int m0 = blockIdx.y * 64, n0 = blockIdx.x * 64;
    float acc[4][4];
#pragma unroll
    for (int i = 0; i < 4; ++i)
#pragma unroll
        for (int j = 0; j < 4; ++j) acc[i][j] = 0.f;
    for (int k0 = 0; k0 < g.K; k0 += 16) {
#pragma unroll
        for (int i = 0; i < 4; ++i) { const int e = tid + 256 * i, r = e >> 4, kk = e & 15; As[kk][r] = g.A[(size_t)(m0 + r) * g.lda + k0 + kk]; }
#pragma unroll
        for (int i = 0; i < 4; ++i) { const int e = tid + 256 * i, kk = e >> 6, cc = e & 63; const int n = n0 + cc; Bs[kk][cc] = (n < g.N) ? g.Bm[(size_t)(k0 + kk) * g.ldb + n] : 0.f; }
        __syncthreads();
#pragma unroll
        for (int kk = 0; kk < 16; ++kk) {
            float a[4], b[4];
#pragma unroll
            for (int i = 0; i < 4; ++i) a[i] = As[kk][ty * 4 + i];
#pragma unroll
            for (int j = 0; j < 4; ++j) b[j] = Bs[kk][tx * 4 + j];
#pragma unroll
            for (int i = 0; i < 4; ++i)
#pragma unroll
                for (int j = 0; j < 4; ++j) acc[i][j] += a[i] * b[j];
        }
        __syncthreads();
    }
#pragma unroll
    for (int i = 0; i < 4; ++i) {
        const int m = m0 + ty * 4 + i;
#pragma unroll
        for (int j = 0; j < 4; ++j) {
            const int n = n0 + tx * 4 + j;
            if (n >= g.N) continue;
            const size_t o = (size_t)m * g.ldc + n;
            const float v = acc[i][j];
            if (EPI == EPI_BF16) ((bf16*)g.C)[o] = f2bf(v);
            else if (EPI == EPI_SIGMOID) ((float*)g.C)[o] = 1.f / (1.f + expf(-v));
            else if (EPI == EPI_MUL_INPLACE) ((float*)g.C)[o] *= v;
            else if (EPI == EPI_MULADD) ((float*)g.C)[o] += g.aux[o] * v;
            else if (EPI == EPI_RESID_GATE) ((float*)g.C)[o] = g.aux[o] + g.aux2[(m / S) * 6144 + n] * v;
            else ((float*)g.C)[o] = v;
        }
    }
}

__device__ __forceinline__ unsigned f2ord(float f) { unsigned u = __float_as_uint(f); return (u & 0x80000000u) ? ~u : (u | 0x80000000u); }
__global__ void __launch_bounds__(256) k_index_topk(const bf16* __restrict__ proj, int* __restrict__ sel, int* __restrict__ nsel) {
    __shared__ float qs[512];
    __shared__ float w8[8];
    __shared__ unsigned keys[S];
    __shared__ unsigned hist[256];
    __shared__ unsigned sh_prefix, sh_need, sh_cnt, sh_eqcnt;
    const int t = blockIdx.x, b = t / S, tl = t % S, tid = threadIdx.x;
    const int n = tl + 1;
    if (n <= TOPK) {
        for (int i = tid; i < n; i += 256) sel[(size_t)t * TOPK + i] = i;
        if (tid == 0) nsel[t] = n;
        return;
    }
    const bf16* prow = proj + (size_t)t * PW;
    for (int i = tid; i < 512; i += 256) qs[i] = bf2f(prow[OFF_QI + i]);
    if (tid < 8) w8[tid] = bf2f(prow[OFF_WI + tid]);
    __syncthreads();
    const float idx_scale = 0.125f * 0.35355339059327373f;
    for (int s = tid; s < n; s += 256) {
        const bf16* kr = proj + (size_t)(b * S + s) * PW + OFF_KI;
        float k[64];
#pragma unroll
        for (int d = 0; d < 64; ++d) k[d] = bf2f(kr[d]);
        float score = 0.f;
#pragma unroll
        for (int h = 0; h < 8; ++h) {
            float dot = 0.f;
#pragma unroll
            for (int d = 0; d < 64; ++d) dot += qs[h * 64 + d] * k[d];
            score += w8[h] * fmaxf(dot, 0.f);
        }
        score *= idx_scale;
        if (score == 0.f) score = 0.f;
        keys[s] = f2ord(score);
    }
    __syncthreads();
    unsigned prefix = 0, need = TOPK;
    for (int pass = 0; pass < 4; ++pass) {
        const int shift = 24 - 8 * pass;
        hist[tid] = 0;
        __syncthreads();
        const unsigned himask = (pass == 0) ? 0u : (0xFFFFFFFFu << (shift + 8));
        for (int s = tid; s < n; s += 256) { const unsigned k = keys[s]; if ((k & himask) == (prefix & himask)) atomicAdd(&hist[(k >> shift) & 255u], 1u); }
        __syncthreads();
        if (tid == 0) {
            unsigned cum = 0; int bin = 255;
            for (; bin >= 0; --bin) { if (cum + hist[bin] >= need) break; cum += hist[bin]; }
            sh_prefix = prefix | ((unsigned)bin << shift); sh_need = need - cum; sh_eqcnt = hist[bin]; sh_cnt = 0;
        }
        __syncthreads();
        prefix = sh_prefix; need = sh_need;
        __syncthreads();
    }
    const unsigned tau = prefix, eqcnt = sh_eqcnt;
    for (int s = tid; s < n; s += 256) { if (keys[s] > tau) { const unsigned p = atomicAdd(&sh_cnt, 1u); sel[(size_t)t * TOPK + p] = s; } }
    __syncthreads();
    if (eqcnt == need) {
        for (int s = tid; s < n; s += 256) { if (keys[s] == tau) { const unsigned p = atomicAdd(&sh_cnt, 1u); sel[(size_t)t * TOPK + p] = s; } }
    } else if (tid == 0) {
        unsigned p = sh_cnt, left = need;
        for (int s = 0; s < n && left > 0; ++s) if (keys[s] == tau) { sel[(size_t)t * TOPK + p] = s; ++p; --left; }
    }
    if (tid == 0) nsel[t] = TOPK;
}

__device__ __forceinline__ int t5_bucket(int n) {
    if (n < 16) return n;
    int large = 16 + (int)(logf((float)n * (1.f / 16.f)) / 2.0794415416798357f * 16.f);
    return large < 31 ? large : 31;
}
__global__ void __launch_bounds__(256) k_dsa_attn(const bf16* __restrict__ proj, const int* __restrict__ sel, const int* __restrict__ nsel, const float* __restrict__ rel_bias, float* __restrict__ ya) {
    __shared__ float qs[512];
    __shared__ float lg[8][TOPK];
    __shared__ int sidx[TOPK];
    const int t = blockIdx.x, b = t / S, tl = t % S, tid = threadIdx.x;
    const int nv = nsel[t];
    const bf16* prow = proj + (size_t)t * PW;
    for (int i = tid; i < 512; i += 256) qs[i] = bf2f(prow[OFF_QA + i]);
    __syncthreads();
    if (tid < nv) {
        const int s = sel[(size_t)t * TOPK + tid];
        sidx[tid] = s;
        const bf16* kr = proj + (size_t)(b * S + s) * PW + OFF_KA;
        const int bk = t5_bucket(tl - s);
#pragma unroll 1
        for (int h = 0; h < 8; ++h) {
            float dot = 0.f;
#pragma unroll
            for (int d = 0; d < 64; ++d) dot += qs[h * 64 + d] * bf2f(kr[h * 64 + d]);
            lg[h][tid] = dot * 0.125f + rel_bias[bk * 8 + h];
        }
    } else {
        sidx[tid] = 0;
#pragma unroll
        for (int h = 0; h < 8; ++h) lg[h][tid] = -INFINITY;
    }
    __syncthreads();
    {
        const int w = tid >> 6, lane = tid & 63;
        for (int hh = 0; hh < 2; ++hh) {
            const int h = w * 2 + hh;
            float v[4]; float m = -INFINITY;
#pragma unroll
            for (int i = 0; i < 4; ++i) { v[i] = lg[h][lane + 64 * i]; m = fmaxf(m, v[i]); }
#pragma unroll
            for (int o = 1; o < 64; o <<= 1) m = fmaxf(m, __shfl_xor(m, o));
            float sum = 0.f;
#pragma unroll
            for (int i = 0; i < 4; ++i) { v[i] = expf(v[i] - m); sum += v[i]; }
            sum = wave_sum(sum);
            const float inv = 1.f / sum;
#pragma unroll
            for (int i = 0; i < 4; ++i) lg[h][lane + 64 * i] = v[i] * inv;
        }
    }
    __syncthreads();
    for (int o = tid; o < 512; o += 256) {
        const int h = o >> 6;
        float acc = 0.f;
        for (int j = 0; j < nv; ++j) acc += lg[h][j] * bf2f(proj[(size_t)(b * S + sidx[j]) * PW + OFF_VA + o]);
        ya[(size_t)t * 512 + o] = acc;
    }
}

__device__ __forceinline__ float softplus(float x) { return fmaxf(x, 0.f) + log1pf(expf(-fabsf(x))); }
__global__ void __launch_bounds__(64) k_stick(const bf16* __restrict__ proj, float* __restrict__ yb) {
    __shared__ float qs[64];
    __shared__ float As[64];
    const int t = blockIdx.x >> 3, h = blockIdx.x & 7, b = t / S, tl = t % S, lane = threadIdx.x;
    qs[lane] = bf2f(proj[(size_t)t * PW + OFF_QB + h * 64 + lane]);
    __syncthreads();
    float acc = 0.f, carry = 0.f;
    for (int base = tl - 1; base >= 0; base -= 64) {
        const int s = base - lane;
        const bool valid = s >= 0;
        float z = 0.f;
        if (valid) {
            const bf16* kr = proj + (size_t)(b * S + s) * PW + OFF_KB + h * 64;
#pragma unroll
            for (int d = 0; d < 64; ++d) z += qs[d] * bf2f(kr[d]);
            z *= 0.125f;
        }
        const float lb = -softplus(-z);
        const float l1m = valid ? -softplus(z) : 0.f;
        float incl = l1m;
#pragma unroll
        for (int o = 1; o < 64; o <<= 1) { const float n = __shfl_up(incl, o); if (lane >= o) incl += n; }
        const float suffix = carry + (incl - l1m);
        As[lane] = valid ? expf(lb + suffix) : 0.f;
        carry += __shfl(incl, 63);
        __syncthreads();
        const int cnt = base + 1 < 64 ? base + 1 : 64;
        for (int j = 0; j < cnt; ++j) acc += As[j] * bf2f(proj[(size_t)(b * S + base - j) * PW + OFF_VB + h * 64 + lane]);
        __syncthreads();
        if (carry < -120.f) break;
    }
    yb[(size_t)t * 512 + h * 64 + lane] = acc;
}

__device__ __forceinline__ void wave_argmax(float& v, int& i) {
#pragma unroll
    for (int o = 1; o < 64; o <<= 1) {
        const float ov = __shfl_xor(v, o); const int oi = __shfl_xor(i, o);
        if (ov > v || (ov == v && oi < i)) { v = ov; i = oi; }
    }
}
__global__ void __launch_bounds__(512) k_peer_select(const float* __restrict__ qh, const float* __restrict__ sk, int* __restrict__ eidx, float* __restrict__ gate) {
    __shared__ float qs[2048];
    __shared__ float tv[8][2][16];
    __shared__ int ti[8][2][16];
    const int t = blockIdx.x, tid = threadIdx.x, h = tid >> 6, lane = tid & 63;
    for (int i = tid; i < 2048; i += 512) qs[i] = qh[(size_t)t * 2048 + i];
    __syncthreads();
    for (int c = 0; c < 2; ++c) {
        float sv[2];
        for (int r = 0; r < 2; ++r) {
            const int n = lane + 64 * r;
            const float* kr = sk + ((size_t)(h * 2 + c) * 128 + n) * 128;
            const float* q = qs + h * 256 + c * 128;
            float dot = 0.f;
            for (int d = 0; d < 128; ++d) dot += q[d] * kr[d];
            sv[r] = dot;
        }
        for (int r = 0; r < 16; ++r) {
            float bv; int bi;
            if (sv[0] >= sv[1]) { bv = sv[0]; bi = lane; } else { bv = sv[1]; bi = lane + 64; }
            wave_argmax(bv, bi);
            if (lane == 0) { tv[h][c][r] = bv; ti[h][c][r] = bi; }
            if (bi == lane) sv[0] = -INFINITY;
            if (bi == lane + 64) sv[1] = -INFINITY;
        }
    }
    __syncthreads();
    float cv[4];
#pragma unroll
    for (int r = 0; r < 4; ++r) { const int ci = lane + 64 * r; cv[r] = tv[h][0][ci >> 4] + tv[h][1][ci & 15]; }
    float top_s = 0.f; int top_e = 0;
    for (int r = 0; r < 16; ++r) {
        float bv = cv[0]; int bi = lane;
#pragma unroll
        for (int q = 1; q < 4; ++q) if (cv[q] > bv) { bv = cv[q]; bi = lane + 64 * q; }
        wave_argmax(bv, bi);
        if (lane == r) { top_s = bv; top_e = ti[h][0][bi >> 4] * 128 + ti[h][1][bi & 15]; }
#pragma unroll
        for (int q = 0; q < 4; ++q) if (bi == lane + 64 * q) cv[q] = -INFINITY;
    }
    const float mx = __shfl(top_s, 0);
    float e = (lane < 16) ? expf(top_s - mx) : 0.f;
    const float sum = wave_sum(e);
    if (lane < 16) { eidx[(size_t)t * 128 + h * 16 + lane] = top_e; gate[(size_t)t * 128 + h * 16 + lane] = e / sum; }
}

__global__ void __launch_bounds__(256) k_peer_ffn(const float* __restrict__ hn2, const int* __restrict__ eidx, const float* __restrict__ gate, const float* __restrict__ pu, const float* __restrict__ pv,
                                                  const float* __restrict__ mod, const float* __restrict__ fg, float* __restrict__ xio) {
    __shared__ float coef[128];
    __shared__ int es[128];
    __shared__ float red[4];
    const int t = blockIdx.x, b = t / S, tid = threadIdx.x, w = tid >> 6, lane = tid & 63;
    if (tid < 128) es[tid] = eidx[(size_t)t * 128 + tid];
    __syncthreads();
    float4 hv[4];
#pragma unroll
    for (int i = 0; i < 4; ++i) hv[i] = ((const float4*)(hn2 + (size_t)t * D))[lane + 64 * i];
    for (int jj = 0; jj < 32; ++jj) {
        const int j = w * 32 + jj;
        const float4* ur = (const float4*)(pu + (size_t)es[j] * D);
        float dot = 0.f;
#pragma unroll
        for (int i = 0; i < 4; ++i) { const float4 u = ur[lane + 64 * i]; dot += u.x * hv[i].x + u.y * hv[i].y + u.z * hv[i].z + u.w * hv[i].w; }
        dot = wave_sum(dot);
        if (lane == 0) coef[j] = gate[(size_t)t * 128 + j] * 0.5f * dot * (1.f + erff(dot * 0.70710678118654752f));
    }
    __syncthreads();
    float4 acc = {0.f, 0.f, 0.f, 0.f};
    for (int j = 0; j < 128; ++j) {
        const float4 v = ((const float4*)(pv + (size_t)es[j] * D))[tid];
        const float cf = coef[j];
        acc.x += cf * v.x; acc.y += cf * v.y; acc.z += cf * v.z; acc.w += cf * v.w;
    }
    const float4 g2 = ((const float4*)(mod + b * 6144 + 5 * D))[tid];
    float4 x = ((const float4*)(xio + (size_t)t * D))[tid];
    x.x += g2.x * acc.x; x.y += g2.y * acc.y; x.z += g2.z * acc.z; x.w += g2.w * acc.w;
    float ss = x.x * x.x + x.y * x.y + x.z * x.z + x.w * x.w;
    ss = block_sum<256>(ss, red);
    const float r = rsqrtf(ss * (1.f / D) + EPS);
    const float4 gg = ((const float4*)fg)[tid];
    float4 o; o.x = x.x * r * gg.x; o.y = x.y * r * gg.y; o.z = x.z * r * gg.z; o.w = x.w * r * gg.w;
    ((float4*)(xio + (size_t)t * D))[tid] = o;
}

template <int EPI> static void launch_gemm(hipStream_t st, const float* A, int lda, const float* Bm, int ldb, int M, int N, int K, void* C, int ldc, const float* aux, const float* aux2) {
    GemmArgs g; memset(&g, 0, sizeof(g)); g.A = A; g.Bm = Bm; g.C = C; g.aux = aux; g.aux2 = aux2; g.lda = lda; g.ldb = ldb; g.M = M; g.N = N; g.K = K; g.ldc = ldc;
    hipLaunchKernelGGL(k_gemm<EPI>, dim3((N + 63) / 64, M / 64), dim3(256), 0, st, g);
}

extern "C" void kernel_launch(void* const* d_in, const int* in_sizes, int n_in, void* d_out, int out_size, void* d_ws, size_t ws_size, hipStream_t stream) {
    const float* x = (const float*)d_in[0];
    const float* c = (const float*)d_in[1];
    const float* w_ada = (const float*)d_in[2];
    const float* b_ada = (const float*)d_in[3];
    const float* g1 = (const float*)d_in[4];
    const float* g2 = (const float*)d_in[5];
    const float* w_in = (const float*)d_in[6];
    const float* rel_bias = (const float*)d_in[7];
    const float* wpa = (const float*)d_in[8];
    const float* wpb = (const float*)d_in[9];
    const float* wout = (const float*)d_in[10];
    const float* wq = (const float*)d_in[11];
    const float* sk = (const float*)d_in[12];
    const float* pu = (const float*)d_in[13];
    const float* pv = (const float*)d_in[14];
    const float* fg = (const float*)d_in[15];
    float* out = (float*)d_out;
    unsigned char* ws = (unsigned char*)d_ws;
    if (ws_size < 256 * MiB) return;
    float* mod = (float*)(ws + 0);
    bf16* proj = (bf16*)(ws + 1 * MiB);
    int* sel = (int*)(ws + 116 * MiB);
    int* nsel = (int*)(ws + 512 * 1024);
    float* ya = (float*)(ws + 132 * MiB);
    float* yb = (float*)(ws + 164 * MiB);
    float* GA = (float*)(ws + 1 * MiB);
    float* GB = (float*)(ws + 65 * MiB);
    float* hn = out;
    float* hn2 = (float*)(ws + 1 * MiB);
    float* qh = (float*)(ws + 65 * MiB);
    int* eidx = (int*)(ws + 196 * MiB);
    float* gate = (float*)(ws + 204 * MiB);

    hipLaunchKernelGGL(k_mod, dim3(24), dim3(256), 0, stream, c, w_ada, b_ada, mod);
    hipLaunchKernelGGL(k_norm_mod, dim3(T), dim3(256), 0, stream, x, g1, mod, 0, 1, hn);
    launch_gemm<EPI_BF16>(stream, hn, D, w_in, INW, T, PW, D, proj, PW, nullptr, nullptr);
    hipLaunchKernelGGL(k_index_topk, dim3(T), dim3(256), 0, stream, proj, sel, nsel);
    hipLaunchKernelGGL(k_dsa_attn, dim3(T), dim3(256), 0, stream, proj, sel, nsel, rel_bias, ya);
    hipLaunchKernelGGL(k_stick, dim3(T * 8), dim3(64), 0, stream, proj, yb);
    launch_gemm<EPI_SIGMOID>(stream, hn, D, w_in + OFF_GA, INW, T, D, D, GA, D, nullptr, nullptr);
    launch_gemm<EPI_MUL_INPLACE>(stream, ya, 512, wpa, D, T, D, 512, GA, D, nullptr, nullptr);
    launch_gemm<EPI_SIGMOID>(stream, hn, D, w_in + OFF_GB, INW, T, D, D, GB, D, nullptr, nullptr);
    launch_gemm<EPI_MULADD>(stream, yb, 512, wpb, D, T, D, 512, GA, D, GB, nullptr);
    launch_gemm<EPI_RESID_GATE>(stream, GA, D, wout, D, T, D, D, out, D, x, mod + 2 * D);
    hipLaunchKernelGGL(k_norm_mod, dim3(T), dim3(256), 0, stream, (const float*)out, g2, mod, 3, 4, hn2);
    launch_gemm<EPI_F32>(stream, hn2, D, wq, 2048, T, 2048, D, qh, 2048, nullptr, nullptr);
    hipLaunchKernelGGL(k_peer_select, dim3(T), dim3(512), 0, stream, (const float*)qh, sk, eidx, gate);
    hipLaunchKernelGGL(k_peer_ffn, dim3(T), dim3(256), 0, stream, (const float*)hn2, (const int*)eidx, (const float*)gate, pu, pv, (const float*)mod, fg, out);
}
```

```cpp
#include <hip/hip_runtime.h>
#include <stdint.h>
#include <math.h>
#include <string.h>
#include <stdio.h>

typedef unsigned short bf16;
constexpr int D = 1024, NB = 2, S = 8192, T = NB * S;
constexpr int INW = 5704;
constexpr int OFF_QA = 0, OFF_VA = 512, OFF_QI = 1024, OFF_QB = 1536, OFF_VB = 2048;
constexpr int PW = 2560;
constexpr int NPROJ = 3840 + 2048;
constexpr int GW = 2048;
constexpr int TOPK = 256;
constexpr float EPS = 1e-6f;
constexpr size_t MiB = 1u << 20;
constexpr int NTHR = 512, NWAVES = 8;
constexpr int LDS_BYTES = 147456;

#define LAS __attribute__((address_space(3)))

__device__ __forceinline__ bf16 f2bf(float f) { unsigned u = __float_as_uint(f); return (bf16)((u + 0x7fffu + ((u >> 16) & 1u)) >> 16); }
__device__ __forceinline__ float bf2f(bf16 h) { return __uint_as_float(((unsigned)h) << 16); }
typedef __bf16 bf16x2_hw __attribute__((ext_vector_type(2)));
__device__ __forceinline__ unsigned pk2(float lo, float hi) { bf16x2_hw v; v[0] = (__bf16)lo; v[1] = (__bf16)hi; return __builtin_bit_cast(unsigned, v); }

__device__ __forceinline__ float wave_sum(float v) {
#pragma unroll
    for (int o = 1; o < 64; o <<= 1) v += __shfl_xor(v, o);
    return v;
}
__device__ __forceinline__ float block_sum(float v, float* red) {
    v = wave_sum(v);
    __syncthreads();
    if ((threadIdx.x & 63) == 0) red[threadIdx.x >> 6] = v;
    __syncthreads();
    float s = 0.f;
#pragma unroll
    for (int i = 0; i < NWAVES; ++i) s += red[i];
    return s;
}
typedef float f32x4_t __attribute__((ext_vector_type(4)));
#define XB_TMO      128
#define XB_XCNT(j)  (256  + 64 * (j))
#define XB_XSUB(j)  (1280 + 64 * (j))
#define XB_XGEN(j)  (2304 + 64 * (j))
#define XB_TOP      3328
#define XB_TOPGEN   3392
#define XCD_BAR_WORDS 3456
#define XB_SPIN_CAP (1u << 22)

__device__ __forceinline__ unsigned xb_ld(unsigned* p)              { return __hip_atomic_load(p, __ATOMIC_RELAXED, __HIP_MEMORY_SCOPE_AGENT); }
__device__ __forceinline__ unsigned xb_add(unsigned* p, unsigned v) { return __hip_atomic_fetch_add(p, v, __ATOMIC_RELAXED, __HIP_MEMORY_SCOPE_AGENT); }
__device__ __forceinline__ unsigned xb_xcc_id() { return (unsigned)__builtin_amdgcn_s_getreg((3 << 11) | 20) & 0xFu; }
#define XB_SPIN(cond, bar) do { unsigned _sp = 0; while (cond) { __builtin_amdgcn_s_sleep(1); \
    if ((++_sp & 255u) == 0u) { if (xb_ld(&(bar)[XB_TMO])) break; if (_sp > XB_SPIN_CAP) { atomicAdd(&(bar)[XB_TMO], 1u); break; } } } } while (0)

struct XcdBarrier {
    unsigned* bar; unsigned x;
    volatile LAS unsigned* st;
};

__device__ __forceinline__ XcdBarrier xcd_barrier_post(unsigned* bar, volatile LAS unsigned* st) {
    XcdBarrier b; b.bar = bar; b.x = xb_xcc_id(); b.st = st;
    if (threadIdx.x == 0) (void)xb_add(&bar[XB_XCNT(b.x)], 1u);
    return b;
}
__device__ __forceinline__ void xcd_barrier_complete(unsigned* bar, unsigned x, unsigned& nloc, unsigned& nx) {
    const unsigned G = gridDim.x * gridDim.y * gridDim.z;
    unsigned sum, cnt, mine, sp = 0u;
    for (;;) {
        sum = 0u; cnt = 0u; mine = 0u;
#pragma unroll
        for (unsigned j = 0; j < 16; ++j) { const unsigned c = xb_ld(&bar[XB_XCNT(j)]); sum += c; cnt += (c > 0u) ? 1u : 0u; mine = (j == x) ? c : mine; }
        if (sum == G) break;
        __builtin_amdgcn_s_sleep(1);
        if ((++sp & 255u) == 0u) { if (xb_ld(&bar[XB_TMO])) break; if (sp > XB_SPIN_CAP) { atomicAdd(&bar[XB_TMO], 1u); break; } }
    }
    nloc = mine > 0u ? mine : 1u; nx = cnt > 0u ? cnt : 1u;
}

__device__ __forceinline__ void xcd_barrier(const XcdBarrier& b) {
    asm volatile("s_waitcnt vmcnt(0)" ::: "memory");
    __syncthreads();
    if (threadIdx.x == 0) {
        unsigned* bar = b.bar;
        __builtin_amdgcn_s_waitcnt(0);
        unsigned nloc = b.st[0], nx = b.st[1];
        if (nloc == 0u) { xcd_barrier_complete(bar, b.x, nloc, nx); b.st[0] = nloc; b.st[1] = nx; }
        const unsigned old = xb_add(&bar[XB_XSUB(b.x)], 1u);
        const unsigned gen = old / nloc;
        if (old + 1u == (gen + 1u) * nloc) {
            __builtin_amdgcn_fence(__ATOMIC_RELEASE, "agent");
            asm volatile("s_waitcnt vmcnt(0)" ::: "memory");
            const unsigned og = xb_add(&bar[XB_TOP], 1u);
            const unsigned tg = og / nx;
            if (og + 1u == (tg + 1u) * nx) xb_add(&bar[XB_TOPGEN], 1u);
            else XB_SPIN(xb_ld(&bar[XB_TOPGEN]) == tg, bar);
            __builtin_amdgcn_fence(__ATOMIC_ACQUIRE, "agent");
            xb_add(&bar[XB_XGEN(b.x)], 1u);
            asm volatile("s_waitcnt vmcnt(0)" ::: "memory");
        } else {
            XB_SPIN(xb_ld(&bar[XB_XGEN(b.x)]) == gen, bar);
            __builtin_amdgcn_fence(__ATOMIC_ACQUIRE, "agent");
            asm volatile("s_waitcnt vmcnt(0)" ::: "memory");
        }
    }
    __syncthreads();
}


namespace pg8 {
#define PG8_LAS __attribute__((address_space(3)))
typedef unsigned short bf16_t;
typedef short bf16x8 __attribute__((ext_vector_type(8)));
typedef float f32x4 __attribute__((ext_vector_type(4)));
typedef unsigned u32x4 __attribute__((ext_vector_type(4)));
constexpr int BM = 256, BK = 64, HALF = 128, HTB = HALF * BK * 2  , STAGE_BYTES = 8 * HTB, NXCD = 8, WGM = 8;

__host__ __device__ __forceinline__ int lds_byte(int r, int c) { const int st = (r >> 4) * 2 + (c >> 5), rr = r & 15, cc = c & 31, ob = rr * 64 + cc * 2; return st * 1024 + (ob ^ (((ob >> 9) & 1) << 5)); }
__host__ __device__ __forceinline__ void stage_rc(int b, int& R, int& C) { const int st = b / 1024, sb = b % 1024, swz = sb ^ (((sb >> 9) & 1) << 5); R = (st >> 1) * 16 + swz / 64; C = (st & 1) * 32 + (swz % 64) / 2; }
__host__ __device__ __forceinline__ int perm32(int rho) { const int n = rho >> 4, i = rho & 15; return 8 * (i >> 2) + 4 * n + (i & 3); }

struct Unit { int pm, pn; };
struct Gemm { const bf16_t* A; const bf16_t* Bt; int M, N, K, lda, ldb; };

struct StaticOrder {
    int nM, nN, nwg, G, c;
    __host__ __device__ void init(int M, int N, int G_, int c_) { nM = M / BM; nN = N / BM; nwg = nM * nN; G = G_; c = c_; }
    __host__ __device__ bool next(int i, Unit& u) const {
        const long L = (long)i * G + c; if (L >= nwg) return false;
        int wgid = (int)L; { const int q = nwg / NXCD, r = nwg % NXCD, xcd = wgid % NXCD, off = wgid / NXCD; wgid = (xcd < r ? xcd * (q + 1) : r * (q + 1) + (xcd - r) * q) + off; }
        const int nig = WGM * nN, gid = wgid / nig, fm = gid * WGM, gsz = (nM - fm) < WGM ? (nM - fm) : WGM;
        u.pm = fm + ((wgid % nig) % gsz); u.pn = (wgid % nig) / gsz; return true;
    }
    __device__ __forceinline__ void a_ready(const Unit&) const {}
    __device__ __forceinline__ void done(const Unit&) const {}
};
__device__ __forceinline__ unsigned cvt_pk_bf16(float lo, float hi) { return ::pk2(lo, hi); }
template <class Epi, class Sched, bool ALIGN_EPI = false, bool SP2 = false>
__device__ __forceinline__ void gemm_phase(PG8_LAS unsigned char* lds, const Gemm g, const Sched& S, const Epi& E) {
    int tid_ = threadIdx.x; asm volatile("" : "+v"(tid_));
    const int tid = tid_, wid = __builtin_amdgcn_readfirstlane(tid >> 6), lane = tid & 63, wr = wid >> 2, wc = wid & 3, fr = lane & 15, fq = lane >> 4;
    const int K = g.K, nt = K / BK;
    unsigned voffA[2], voffB[2];
#pragma unroll
    for (int i = 0; i < 2; ++i) { int R, C; stage_rc(tid * 16 + i * 8192, R, C); const int Rb = Epi::PERM ? ((R & ~31) + perm32(R & 31)) : R;
        voffA[i] = (unsigned)(R * g.lda + C) * 2u; voffB[i] = (unsigned)(Rb * g.ldb + C) * 2u; }
    const size_t kstep = (size_t)(BK * 2);
    const size_t hstepA = (size_t)HALF * g.lda * 2, hstepB = (size_t)HALF * g.ldb * 2;
    const size_t tstepA = 2 * hstepA, tstepB = 2 * hstepB;
    const unsigned ldsw = (unsigned)wid * 1024u;
    const int aoff = lds_byte(wr * 64 + fr, fq * 8), boff = lds_byte(wc * 32 + fr, fq * 8);
#define PG8_SA(b, h) (((b) * 2 + (h)) * HTB)
#define PG8_SB(b, h) ((4 + (b) * 2 + (h)) * HTB)
#define PG8_STAGE(bufoff, gbase, voff) do { _Pragma("unroll") for (int _i = 0; _i < 2; ++_i) \
        __builtin_amdgcn_global_load_lds((const unsigned*)((const char*)(gbase) + (voff)[_i]), (PG8_LAS unsigned*)(lds + (bufoff) + ldsw + _i * 8192), 16, 0, 0); } while (0)
#define PG8_LDA(dst, b, h) do { _Pragma("unroll") for (int m = 0; m < 4; ++m) _Pragma("unroll") for (int k = 0; k < 2; ++k) dst[m][k] = *(const PG8_LAS bf16x8*)(lds + PG8_SA(b, h) + aoff + m * 2048 + k * 1024); } while (0)
#define PG8_LDB(dst, b, h) do { _Pragma("unroll") for (int n = 0; n < 2; ++n) _Pragma("unroll") for (int k = 0; k < 2; ++k) dst[n][k] = *(const PG8_LAS bf16x8*)(lds + PG8_SB(b, h) + boff + n * 2048 + k * 1024); } while (0)
#define PG8_MMA(ai, bj, At, Bt) do { __builtin_amdgcn_s_setprio(1); _Pragma("unroll") for (int m = 0; m < 4; ++m) _Pragma("unroll") for (int n = 0; n < 2; ++n) _Pragma("unroll") for (int k = 0; k < 2; ++k) \
        acc[ai][bj][m][n] = __builtin_amdgcn_mfma_f32_16x16x32_bf16(Bt[n][k], At[m][k], acc[ai][bj][m][n], 0, 0, 0); __builtin_amdgcn_s_setprio(0); } while (0)
#define PG8_WAIT_V(n) asm volatile("s_waitcnt vmcnt(" #n ")" ::: "memory")
#define PG8_WAIT_L(n) asm volatile("s_waitcnt lgkmcnt(" #n ")" ::: "memory")
#define PG8_BAR __builtin_amdgcn_s_barrier()
#define PG8_SCHED __builtin_amdgcn_sched_barrier(0)
    Unit cur, nxt; int ui = 0;
    if (!S.next(0, cur)) return;
    f32x4 acc[2][2][4][2];
#pragma unroll
    for (int a = 0; a < 2; ++a)
#pragma unroll
        for (int b = 0; b < 2; ++b)
#pragma unroll
            for (int m = 0; m < 4; ++m)
#pragma unroll
                for (int n = 0; n < 2; ++n) acc[a][b][m][n] = (f32x4){0.f, 0.f, 0.f, 0.f};
    bf16x8 At[4][2], B0[2][2], B1[2][2];
    const char* cA = (const char*)g.A + (size_t)cur.pm * tstepA; const char* cB = (const char*)g.Bt + (size_t)cur.pn * tstepB;
    S.a_ready(cur);
    if constexpr (SP2) {
        PG8_STAGE(PG8_SB(0, 0), cB, voffB); PG8_STAGE(PG8_SB(0, 1), cB + hstepB, voffB); PG8_STAGE(PG8_SA(0, 0), cA, voffA); PG8_STAGE(PG8_SA(0, 1), cA + hstepA, voffA);
        if (wr == 1) PG8_BAR;
        PG8_WAIT_V(2); PG8_BAR;
        PG8_STAGE(PG8_SB(1, 0), cB + kstep, voffB); PG8_STAGE(PG8_SA(1, 0), cA + kstep, voffA); PG8_STAGE(PG8_SB(1, 1), cB + hstepB + kstep, voffB);
        PG8_WAIT_V(6); PG8_BAR;
    } else {
        PG8_STAGE(PG8_SB(0, 0), cB, voffB); PG8_STAGE(PG8_SA(0, 0), cA, voffA); PG8_STAGE(PG8_SB(0, 1), cB + hstepB, voffB); PG8_STAGE(PG8_SA(0, 1), cA + hstepA, voffA);
        if (wr == 1) PG8_BAR;
        PG8_WAIT_V(4); PG8_BAR;
        PG8_STAGE(PG8_SB(1, 0), cB + kstep, voffB); PG8_STAGE(PG8_SA(1, 0), cA + kstep, voffA); PG8_STAGE(PG8_SB(1, 1), cB + hstepB + kstep, voffB);
        PG8_WAIT_V(6); PG8_BAR;
    }
    for (;;) {
        const bool has_next = S.next(ui + 1, nxt);
        const char* nA = has_next ? (const char*)g.A + (size_t)nxt.pm * tstepA : cA; const char* nB = has_next ? (const char*)g.Bt + (size_t)nxt.pn * tstepB : cB;
        for (int t = 0; t < nt; t += 2) {
            const bool last = (t == nt - 2);
            const char* a1 = cA + (size_t)(t + 1) * kstep;
            const char* a2 = last ? nA : cA + (size_t)(t + 2) * kstep; const char* b2 = last ? nB : cB + (size_t)(t + 2) * kstep;
            const char* a3 = a2 + kstep; const char* b3 = b2 + kstep;
            if (last && has_next) S.a_ready(nxt);
            if constexpr (SP2) {
            PG8_LDB(B0, 0, 0); PG8_LDB(B1, 0, 1); PG8_SCHED; PG8_LDA(At, 0, 0); PG8_STAGE(PG8_SA(1, 1), a1 + hstepA, voffA);
            PG8_WAIT_V(8); PG8_WAIT_L(0); PG8_BAR; PG8_MMA(0, 0, At, B0); PG8_MMA(0, 1, At, B1); PG8_BAR; PG8_SCHED;
            PG8_LDA(At, 0, 1); PG8_STAGE(PG8_SB(0, 0), b2, voffB); PG8_STAGE(PG8_SB(0, 1), b2 + hstepB, voffB); PG8_STAGE(PG8_SA(0, 0), a2, voffA);
            PG8_WAIT_V(8); PG8_WAIT_L(0); PG8_BAR; PG8_MMA(1, 0, At, B0); PG8_MMA(1, 1, At, B1); PG8_BAR; PG8_SCHED;
            PG8_LDB(B0, 1, 0); PG8_LDB(B1, 1, 1); PG8_SCHED; PG8_LDA(At, 1, 0); PG8_STAGE(PG8_SA(0, 1), a2 + hstepA, voffA);
            PG8_WAIT_V(8); PG8_WAIT_L(0); PG8_BAR; PG8_MMA(0, 0, At, B0); PG8_MMA(0, 1, At, B1); PG8_BAR; PG8_SCHED;
            PG8_LDA(At, 1, 1); PG8_STAGE(PG8_SB(1, 0), b3, voffB); PG8_STAGE(PG8_SB(1, 1), b3 + hstepB, voffB); PG8_STAGE(PG8_SA(1, 0), a3, voffA);
            PG8_WAIT_V(8); PG8_WAIT_L(0); PG8_BAR; PG8_MMA(1, 0, At, B0); PG8_MMA(1, 1, At, B1); PG8_BAR; PG8_SCHED;
            } else {
            PG8_LDB(B0, 0, 0); PG8_SCHED; PG8_LDA(At, 0, 0); PG8_STAGE(PG8_SA(1, 1), a1 + hstepA, voffA);
            PG8_WAIT_L(8); PG8_BAR; PG8_WAIT_L(0); PG8_MMA(0, 0, At, B0); PG8_BAR; PG8_SCHED;
            PG8_LDB(B1, 0, 1); PG8_STAGE(PG8_SB(0, 0), b2, voffB);
            PG8_BAR; PG8_WAIT_L(0); PG8_MMA(0, 1, At, B1); PG8_BAR;
            PG8_LDA(At, 0, 1); PG8_STAGE(PG8_SA(0, 0), a2, voffA);
            PG8_BAR; PG8_WAIT_L(0); PG8_MMA(1, 0, At, B0); PG8_BAR; PG8_SCHED;
            PG8_STAGE(PG8_SB(0, 1), b2 + hstepB, voffB);
            PG8_WAIT_V(6); PG8_BAR; PG8_MMA(1, 1, At, B1); PG8_BAR;
            PG8_LDB(B0, 1, 0); PG8_SCHED; PG8_LDA(At, 1, 0); PG8_STAGE(PG8_SA(0, 1), a2 + hstepA, voffA);
            PG8_WAIT_L(8); PG8_BAR; PG8_WAIT_L(0); PG8_MMA(0, 0, At, B0); PG8_BAR; PG8_SCHED;
            PG8_LDB(B1, 1, 1); PG8_STAGE(PG8_SB(1, 0), b3, voffB);
            PG8_BAR; PG8_WAIT_L(0); PG8_MMA(0, 1, At, B1); PG8_BAR;
            PG8_LDA(At, 1, 1); PG8_STAGE(PG8_SA(1, 0), a3, voffA);
            PG8_BAR; PG8_WAIT_L(0); PG8_MMA(1, 0, At, B0); PG8_BAR; PG8_SCHED;
            PG8_STAGE(PG8_SB(1, 1), b3 + hstepB, voffB);
            PG8_WAIT_V(6); PG8_BAR; PG8_MMA(1, 1, At, B1); PG8_BAR;
            }
        }
        if constexpr (ALIGN_EPI) { if (wr == 0) PG8_BAR; }
        if constexpr (!Epi::AFTER_DRAIN) { E(acc, cur, wr, wc, fr, fq); S.done(cur); }
        if (!has_next) break;
#pragma unroll
        for (int a = 0; a < 2; ++a)
#pragma unroll
            for (int b = 0; b < 2; ++b)
#pragma unroll
                for (int m = 0; m < 4; ++m)
#pragma unroll
                    for (int n = 0; n < 2; ++n) acc[a][b][m][n] = (f32x4){0.f, 0.f, 0.f, 0.f};
        cur = nxt; cA = nA; cB = nB; ++ui;
        if constexpr (ALIGN_EPI) { if (wr == 1) PG8_BAR; }
    }
    PG8_WAIT_V(0);
    if constexpr (!ALIGN_EPI) { if (wr == 0) PG8_BAR; }
    PG8_BAR;
    if constexpr (Epi::AFTER_DRAIN) { E.fused(acc, cur, wr, wc, fr, fq, lds, wid, lane); S.done(cur); }
#undef PG8_SA
#undef PG8_SB
#undef PG8_STAGE
#undef PG8_LDA
#undef PG8_LDB
#undef PG8_MMA
#undef PG8_WAIT_V
#undef PG8_WAIT_L
#undef PG8_BAR
#undef PG8_SCHED
}
}

namespace pg8 {
__device__ __forceinline__ float sigmoidf_(float v) { return 1.f / (1.f + __expf(-v)); }
__device__ __forceinline__ void unpack8(const u32x4 w, float (&f)[8]) {
    f[0] = __uint_as_float(w.x << 16); f[1] = __uint_as_float(w.x & 0xffff0000u); f[2] = __uint_as_float(w.y << 16); f[3] = __uint_as_float(w.y & 0xffff0000u);
    f[4] = __uint_as_float(w.z << 16); f[5] = __uint_as_float(w.z & 0xffff0000u); f[6] = __uint_as_float(w.w << 16); f[7] = __uint_as_float(w.w & 0xffff0000u);
}
template <int MODE> struct EpiX {
    static constexpr bool PERM = true, AFTER_DRAIN = false;
    bf16_t* O; bf16_t* G; const float* xres; const float* gate; float* outf; int ldc; int pad; bf16_t* KCa; bf16_t* KCb; bf16_t* KI; bf16_t* WI;
    __device__ __forceinline__ void operator()(const f32x4 (&acc)[2][2][4][2], const Unit& u, int wr, int wc, int fr, int fq) const {
        const int row0 = u.pm * BM + wr * 64 + fr;
        int colt = u.pn * BM; bf16_t* base = O; int ld = ldc; bool sig = false;
        if (MODE == 1) { if (u.pn >= 15) { colt -= 15 * BM; base = G; ld = GW; sig = true; }
            else if (u.pn >= 10) {
#pragma unroll
                for (int ai = 0; ai < 2; ++ai)
#pragma unroll
                    for (int m = 0; m < 4; ++m) {
                        const int row = row0 + ai * HALF + m * 16, bb = row / S, ss = row % S;
#pragma unroll
                        for (int bj = 0; bj < 2; ++bj) {
                            const int c = wc * 32 + 8 * fq + bj * HALF;
                            const f32x4 v0 = acc[ai][bj][m][0], v1 = acc[ai][bj][m][1];
                            u32x4 w; w.x = cvt_pk_bf16(v0[0], v0[1]); w.y = cvt_pk_bf16(v0[2], v0[3]); w.z = cvt_pk_bf16(v1[0], v1[1]); w.w = cvt_pk_bf16(v1[2], v1[3]);
                            if (u.pn < 14) { const int cc = ((u.pn - 10) & 1) * BM + c; bf16_t* kc = (u.pn < 12) ? KCa : KCb;
                                *(u32x4*)(kc + ((size_t)(bb * 8 + (cc >> 6)) * S + ss) * 64 + (cc & 63)) = w; }
                            else if (c < 64) *(u32x4*)(KI + (size_t)row * 64 + c) = w;
                            else if (c == 64) *(u32x4*)(WI + (size_t)row * 8) = w;
                        }
                    }
                return;
            } }
        if (MODE == 2 || MODE == 3) { base = G; ld = GW; }
        const int col0 = colt + wc * 32 + 8 * fq;
#pragma unroll
        for (int ai = 0; ai < 2; ++ai)
#pragma unroll
            for (int m = 0; m < 4; ++m) {
                const int row = row0 + ai * HALF + m * 16;
#pragma unroll
                for (int bj = 0; bj < 2; ++bj) {
                    const int col = col0 + bj * HALF;
                    f32x4 v0 = acc[ai][bj][m][0], v1 = acc[ai][bj][m][1];
                    if (MODE == 4) {
                        const size_t o = (size_t)row * 1024 + col;
                        const f32x4 x0 = __builtin_nontemporal_load((const f32x4*)(xres + o)), x1 = __builtin_nontemporal_load((const f32x4*)(xres + o + 4));
                        const float* gp = gate + (row / S) * 6144 + col;
                        const f32x4 g0 = *(const f32x4*)gp, g1 = *(const f32x4*)(gp + 4);
                        *(f32x4*)(outf + o) = x0 + g0 * v0; *(f32x4*)(outf + o + 4) = x1 + g1 * v1;
                    } else {
                        bf16_t* pp = base + (size_t)row * ld + col;
                        if (MODE == 1) { if (sig) {
#pragma unroll
                            for (int e = 0; e < 4; ++e) { v0[e] = sigmoidf_(v0[e]); v1[e] = sigmoidf_(v1[e]); } } }
                        if (MODE == 2) { float t[8]; unpack8(*(const u32x4*)pp, t);
#pragma unroll
                            for (int e = 0; e < 4; ++e) { v0[e] *= t[e]; v1[e] *= t[4 + e]; } }
                        if (MODE == 3) { float t[8], gg[8]; unpack8(*(const u32x4*)pp, t); unpack8(*(const u32x4*)(pp + 1024), gg);
#pragma unroll
                            for (int e = 0; e < 4; ++e) { v0[e] = t[e] + gg[e] * v0[e]; v1[e] = t[4 + e] + gg[4 + e] * v1[e]; } }
                        u32x4 w; w.x = cvt_pk_bf16(v0[0], v0[1]); w.y = cvt_pk_bf16(v0[2], v0[3]); w.z = cvt_pk_bf16(v1[0], v1[1]); w.w = cvt_pk_bf16(v1[2], v1[3]);
                        *(u32x4*)pp = w;
                    }
                }
            }
    }
};
}
struct Params {
    const float *x, *c, *w_ada, *b_ada, *g1, *g2, *w_in, *rel_bias, *wpa, *wpb, *wout, *wq, *sk, *pu, *pv, *fg;
    float* out; unsigned char* ws;
};
__device__ __forceinline__ int opaque_tid() { int t = threadIdx.x; asm volatile("" : "+v"(t)); return t; }
typedef unsigned v4u __attribute__((ext_vector_type(4)));
#define LDS_WAIT() asm volatile("s_waitcnt lgkmcnt(0)" ::: "memory")

constexpr size_t WS_BAR = 0;
constexpr size_t CTL_ZERO_BYTES = 16384;
constexpr size_t WS_MOD = 64 * 1024;
constexpr size_t WS_WIN = 1 * MiB;
constexpr size_t WS_WPA = 13 * MiB, WS_WPB = 14 * MiB;
constexpr size_t WS_WOUT = 15 * MiB;
constexpr size_t WS_WQ = 17 * MiB;
constexpr size_t WS_PROJ = 22 * MiB;
constexpr size_t WS_KCA = 102 * MiB, WS_KCB = 118 * MiB;
constexpr size_t WS_KI = 134 * MiB, WS_WI = 136 * MiB;
constexpr size_t WS_G = 142 * MiB;
constexpr size_t WS_YA = 206 * MiB, WS_YB = 222 * MiB;
constexpr size_t WS_HN2 = 22 * MiB;
constexpr size_t WS_QH = 54 * MiB;
constexpr size_t WS_SKB = 21 * MiB;
constexpr size_t WS_EIDX = 118 * MiB;
constexpr size_t WS_GATE = 122 * MiB;
constexpr size_t WS_TAB = 130 * MiB;
constexpr size_t WS_SCALES = 162 * MiB;
constexpr size_t WS_VT = 238 * MiB;
constexpr size_t WS_NEED = 254 * MiB;
constexpr int LDS_SC_OFF = 7 * 16384 + 8448;

__device__ __forceinline__ void ph_mod(const Params& p, float* mod, float* sc) {
    float* part = sc + 2048;
    const int tid = threadIdx.x, kk = tid >> 3, cc = tid & 7;
    for (int i = tid; i < 2048; i += NTHR) { float v = p.c[i]; sc[i] = v / (1.f + expf(-v)); }
    __syncthreads();
    for (int unit = blockIdx.x; unit < 6144 / 24; unit += gridDim.x) {
        const int col = unit * 24 + 3 * cc;
        float a[2][3] = {{0.f, 0.f, 0.f}, {0.f, 0.f, 0.f}};
#pragma unroll 4
        for (int k = kk; k < 1024; k += 64) {
            const float* w = p.w_ada + (size_t)k * 6144 + col;
            const float w0 = __builtin_nontemporal_load(w), w1 = __builtin_nontemporal_load(w + 1), w2 = __builtin_nontemporal_load(w + 2), s0 = sc[k], s1 = sc[1024 + k];
            a[0][0] += s0 * w0; a[0][1] += s0 * w1; a[0][2] += s0 * w2; a[1][0] += s1 * w0; a[1][1] += s1 * w1; a[1][2] += s1 * w2;
        }
#pragma unroll
        for (int b = 0; b < 2; ++b)
#pragma unroll
            for (int j = 0; j < 3; ++j) part[kk * 48 + b * 24 + 3 * cc + j] = a[b][j];
        __syncthreads();
        if (tid < 48) { float s = 0.f; for (int q = 0; q < 64; ++q) s += part[q * 48 + tid]; const int b = tid / 24, j = unit * 24 + tid % 24; mod[b * 6144 + j] = s + p.b_ada[j]; }
        __syncthreads();
    }
}

template <class CM> __device__ __forceinline__ void transpose_item(const float* W, int ldw, int K, bf16* WT, LAS float* scr, int item, int nblk, int lane, const CM& cm) {
    const int kb = item / nblk, nb = item % nblk, k0 = 64 * kb, n0 = 32 * nb;
    const int sc = cm(n0 + (lane & 31));
#pragma unroll 8
    for (int i = 0; i < 32; ++i) { const int kk = 2 * i + (lane >> 5); scr[kk * 33 + (lane & 31)] = (sc >= 0) ? __builtin_nontemporal_load(W + (size_t)(k0 + kk) * ldw + sc) : 0.f; }
    LDS_WAIT(); asm volatile("" ::: "memory");
    const int c = lane & 7;
#pragma unroll
    for (int j = 0; j < 4; ++j) { const int n = (lane >> 3) + 8 * j; const LAS float* s = scr + (8 * c) * 33 + n;
        v4u o; o.x = pk2(s[0 * 33], s[1 * 33]); o.y = pk2(s[2 * 33], s[3 * 33]); o.z = pk2(s[4 * 33], s[5 * 33]); o.w = pk2(s[6 * 33], s[7 * 33]);
        *(v4u*)(WT + (size_t)(n0 + n) * K + k0 + 8 * c) = o; }
    LDS_WAIT(); asm volatile("" ::: "memory");
}
struct CmIdent { __device__ __forceinline__ int operator()(int n) const { return n; } };
struct CmWin {
    __device__ __forceinline__ int operator()(int n) const {
        if (n < 512) return n;
        if (n < 1024) return 1024 + (n - 512);
        if (n < 1536) return 1536 + (n - 1024);
        if (n < 2048) return 2120 + (n - 1536);
        if (n < 2560) return 3144 + (n - 2048);
        if (n < 3072) return 512 + (n - 2560);
        if (n < 3584) return 2632 + (n - 3072);
        if (n < 3648) return 2048 + (n - 3584);
        if (n < 3656) return 2112 + (n - 3648);
        if (n < 3840) return -1;
        return 3656 + (n - 3840);
    }
};
__device__ __forceinline__ void ph_weights(const Params& p, LAS unsigned char* lds) {
    unsigned char* ws = p.ws;
    const int wave = __builtin_amdgcn_readfirstlane(threadIdx.x >> 6), lane = threadIdx.x & 63;
    LAS float* scr = (LAS float*)(lds + wave * 16384);
    const int gw = blockIdx.x * NWAVES + wave, NGW = gridDim.x * NWAVES;
    constexpr int I_IN = 16 * (NPROJ / 32), I_PA = 8 * 32, I_PB = 8 * 32, I_OUT = 16 * 32, I_Q = 16 * 64;
    constexpr int NITEMS = I_IN + I_PA + I_PB + I_OUT + I_Q;
    for (int it = gw; it < NITEMS; it += NGW) {
        int r = it;
        if (r < I_IN) { transpose_item(p.w_in, INW, 1024, (bf16*)(ws + WS_WIN), scr, r, NPROJ / 32, lane, CmWin()); continue; } r -= I_IN;
        if (r < I_PA) { transpose_item(p.wpa, 1024, 512, (bf16*)(ws + WS_WPA), scr, r, 32, lane, CmIdent()); continue; } r -= I_PA;
        if (r < I_PB) { transpose_item(p.wpb, 1024, 512, (bf16*)(ws + WS_WPB), scr, r, 32, lane, CmIdent()); continue; } r -= I_PB;
        if (r < I_OUT) { transpose_item(p.wout, 1024, 1024, (bf16*)(ws + WS_WOUT), scr, r, 32, lane, CmIdent()); continue; } r -= I_OUT;
        transpose_item(p.wq, 2048, 1024, (bf16*)(ws + WS_WQ), scr, r, 64, lane, CmIdent());
    }
    for (int i = gw * 64 + lane; i < 8 * 2 * 128 * 128 / 4; i += NGW * 64) {
        const float4 v = ((const float4*)p.sk)[i]; uint2 w; w.x = pk2(v.x, v.y); w.y = pk2(v.z, v.w); ((uint2*)(ws + WS_SKB))[i] = w;
    }
}

template <bool NT> __device__ __forceinline__ void ph_norm(const float* src, const float* g, const float* mod, int shift_i, int scale_i, bf16* dst) {
    const int lane = threadIdx.x & 63, gw = blockIdx.x * NWAVES + __builtin_amdgcn_readfirstlane(threadIdx.x >> 6), ngw = gridDim.x * NWAVES;
    for (int t = gw; t < T; t += ngw) {
        const int b = t / S;
        float4 v[4]; float ss = 0.f;
#pragma unroll
        for (int i = 0; i < 4; ++i) { const f32x4_t t_ = NT ? __builtin_nontemporal_load((const f32x4_t*)(src + (size_t)t * D) + lane + 64 * i) : *((const f32x4_t*)(src + (size_t)t * D) + lane + 64 * i); v[i] = make_float4(t_.x, t_.y, t_.z, t_.w); ss += v[i].x * v[i].x + v[i].y * v[i].y + v[i].z * v[i].z + v[i].w * v[i].w; }
        ss = wave_sum(ss);
        const float r = rsqrtf(ss * (1.f / D) + EPS);
#pragma unroll
        for (int i = 0; i < 4; ++i) {
            const float4 gg = ((const float4*)g)[lane + 64 * i];
            const float4 sh = ((const float4*)(mod + b * 6144 + shift_i * D))[lane + 64 * i];
            const float4 sc = ((const float4*)(mod + b * 6144 + scale_i * D))[lane + 64 * i];
            float4 o;
            o.x = v[i].x * r * gg.x * (1.f + sc.x) + sh.x; o.y = v[i].y * r * gg.y * (1.f + sc.y) + sh.y;
            o.z = v[i].z * r * gg.z * (1.f + sc.z) + sh.z; o.w = v[i].w * r * gg.w * (1.f + sc.w) + sh.w;
            uint2 w; w.x = pk2(o.x, o.y); w.y = pk2(o.z, o.w);
            ((uint2*)(dst + (size_t)t * D))[lane + 64 * i] = w;
        }
    }
}
__device__ __forceinline__ unsigned f2ord(float f) { unsigned u = __float_as_uint(f); return (u & 0x80000000u) ? ~u : (u | 0x80000000u); }
__device__ __forceinline__ int t5_bucket(int n) {
    if (n < 16) return n;
    int large = 16 + (int)(logf((float)n * (1.f / 16.f)) / 2.0794415416798357f * 16.f);
    return large < 31 ? large : 31;
}

typedef short bf16x8_t __attribute__((ext_vector_type(8)));
template <int CTRL> __device__ __forceinline__ unsigned dppu(unsigned x) { return (unsigned)__builtin_amdgcn_mov_dpp((int)x, CTRL, 0xf, 0xf, true); }
template <int CTRL> __device__ __forceinline__ float dppf(float x) { return __builtin_bit_cast(float, __builtin_amdgcn_mov_dpp(__builtin_bit_cast(int, x), CTRL, 0xf, 0xf, true)); }
__device__ __forceinline__ unsigned row_max_u(unsigned x) { x = max(x, dppu<0xB1>(x)); x = max(x, dppu<0x4E>(x)); x = max(x, dppu<0x141>(x)); x = max(x, dppu<0x128>(x)); return x; }
__device__ __forceinline__ float row_max_f(float x) { x = fmaxf(x, dppf<0xB1>(x)); x = fmaxf(x, dppf<0x4E>(x)); x = fmaxf(x, dppf<0x141>(x)); x = fmaxf(x, dppf<0x128>(x)); return x; }
__device__ __forceinline__ float row_sum_f(float x) { x += dppf<0xB1>(x); x += dppf<0x4E>(x); x += dppf<0x141>(x); x += dppf<0x128>(x); return x; }
__device__ __forceinline__ float ord2f(unsigned k) { return __uint_as_float((k & 0x80000000u) ? (k & 0x7fffffffu) : ~k); }
__device__ __forceinline__ unsigned max3u(unsigned a, unsigned b, unsigned c) { return max(max(a, b), c); }

__device__ __forceinline__ void ph_quant(const Params& p, unsigned char* tab, float* scales) {
    const int lane = threadIdx.x & 63, gw = blockIdx.x * NWAVES + __builtin_amdgcn_readfirstlane(threadIdx.x >> 6), ngw = gridDim.x * NWAVES;
    for (int r = gw; r < 32768; r += ngw) {
        const float* src = (r < 16384) ? p.pu + (size_t)r * D : p.pv + (size_t)(r - 16384) * D;
        float4 v[4]; float am = 0.f;
#pragma unroll
        for (int i = 0; i < 4; ++i) { const f32x4_t t_ = __builtin_nontemporal_load((const f32x4_t*)src + lane + 64 * i); v[i] = make_float4(t_.x, t_.y, t_.z, t_.w);     am = fmaxf(am, fmaxf(fmaxf(fabsf(v[i].x), fabsf(v[i].y)), fmaxf(fabsf(v[i].z), fabsf(v[i].w)))); }
#pragma unroll
        for (int o = 1; o < 64; o <<= 1) am = fmaxf(am, __shfl_xor(am, o));
        const float inv = am > 0.f ? 127.f / am : 0.f;
        uint4 w; unsigned* wp = (unsigned*)&w;
#pragma unroll
        for (int i = 0; i < 4; ++i) {
            const int q0 = (int)rintf(v[i].x * inv) + 128, q1 = (int)rintf(v[i].y * inv) + 128, q2 = (int)rintf(v[i].z * inv) + 128, q3 = (int)rintf(v[i].w * inv) + 128;
            wp[i] = (unsigned)q0 | ((unsigned)q1 << 8) | ((unsigned)q2 << 16) | ((unsigned)q3 << 24);
        }
        ((uint4*)(tab + (size_t)r * 1024))[lane] = w;
        if (lane == 0) scales[r] = am * (1.f / 127.f);
    }
}

#define CE_DESC(x, y) do { const unsigned hi_ = max(x, y), lo_ = min(x, y); x = hi_; y = lo_; } while (0)
__device__ __forceinline__ int hull_ab(int c) {
    int a = 0, base = 0; bool done = false;
#pragma unroll
    for (int aa = 0; aa < 16; ++aa) { const int nb = 16 / (aa + 1); if (!done) { if (c >= base + nb) { base += nb; a = aa + 1; } else done = true; } }
    return (c < 50) ? ((a << 4) | (c - base)) : -1;
}
__device__ __forceinline__ void ph_peer_select(const bf16* qh, const bf16* skb, unsigned short* eidx, float* gate) {
    const int tid = opaque_tid();
    const int lane = tid & 63, fr = lane & 15, fq = lane >> 4;
    const int gw = blockIdx.x * NWAVES + __builtin_amdgcn_readfirstlane(tid >> 6), ngw = gridDim.x * NWAVES;
    int hab[4];
#pragma unroll
    for (int s = 0; s < 4; ++s) hab[s] = hull_ab(16 * s + fr);
    for (int unit = gw; unit < (T / 16) * 2; unit += ngw) {
        const int t0 = (unit >> 1) * 16, hh = unit & 1;
#pragma unroll 1
        for (int hi = 0; hi < 4; ++hi) {
            const int h = hh * 4 + hi;
            unsigned win[2][4];
#pragma unroll
            for (int c = 0; c < 2; ++c) {
                f32x4_t acc[8];
#pragma unroll
                for (int nt = 0; nt < 8; ++nt) acc[nt] = (f32x4_t){0.f, 0.f, 0.f, 0.f};
                const bf16* qrow = qh + (size_t)(t0 + fr) * 2048 + h * 256 + c * 128 + 8 * fq;
                bf16x8_t a[4];
#pragma unroll
                for (int ks = 0; ks < 4; ++ks) a[ks] = *(const bf16x8_t*)(qrow + 32 * ks);
                const bf16* kb = skb + ((size_t)(h * 2 + c) * 128 + fr) * 128 + 8 * fq;
#pragma unroll
                for (int nt = 0; nt < 8; ++nt)
#pragma unroll
                    for (int ks = 0; ks < 4; ++ks) { const bf16x8_t b = *(const bf16x8_t*)(kb + (size_t)nt * 16 * 128 + 32 * ks); acc[nt] = __builtin_amdgcn_mfma_f32_16x16x32_bf16(a[ks], b, acc[nt], 0, 0, 0); }
                unsigned pk[8][4];
#pragma unroll
                for (int nt = 0; nt < 8; ++nt)
#pragma unroll
                    for (int i = 0; i < 4; ++i) pk[nt][i] = (f2ord(acc[nt][i]) & ~127u) | (127u - (unsigned)(16 * nt + fr));
#pragma unroll
                for (int i = 0; i < 4; ++i) {
                    CE_DESC(pk[0][i], pk[1][i]); CE_DESC(pk[2][i], pk[3][i]); CE_DESC(pk[4][i], pk[5][i]); CE_DESC(pk[6][i], pk[7][i]);
                    CE_DESC(pk[0][i], pk[2][i]); CE_DESC(pk[1][i], pk[3][i]); CE_DESC(pk[4][i], pk[6][i]); CE_DESC(pk[5][i], pk[7][i]);
                    CE_DESC(pk[1][i], pk[2][i]); CE_DESC(pk[5][i], pk[6][i]);
                    CE_DESC(pk[0][i], pk[4][i]); CE_DESC(pk[1][i], pk[5][i]); CE_DESC(pk[2][i], pk[6][i]); CE_DESC(pk[3][i], pk[7][i]);
                    CE_DESC(pk[2][i], pk[4][i]); CE_DESC(pk[3][i], pk[5][i]);
                    CE_DESC(pk[1][i], pk[2][i]); CE_DESC(pk[3][i], pk[4][i]); CE_DESC(pk[5][i], pk[6][i]);
                }
#pragma unroll
                for (int r = 0; r < 16; ++r)
#pragma unroll
                    for (int i = 0; i < 4; ++i) {
                        const unsigned m = row_max_u(pk[0][i]);
                        if (fr == r) win[c][i] = m;
                        const bool w = pk[0][i] == m;
#pragma unroll
                        for (int nt = 0; nt < 7; ++nt) pk[nt][i] = w ? pk[nt + 1][i] : pk[nt][i];
                        pk[7][i] = w ? 0u : pk[7][i];
                    }
            }
#pragma unroll
            for (int i = 0; i < 4; ++i) {
                unsigned ck[4];
#pragma unroll
                for (int s = 0; s < 4; ++s) {
                    const int ab = hab[s] < 0 ? 0 : hab[s];
                    const unsigned wa = (unsigned)__shfl((int)win[0][i], (lane & 48) + (ab >> 4)), wb = (unsigned)__shfl((int)win[1][i], (lane & 48) + (ab & 15));
                    const float v = ord2f(wa & ~127u) + ord2f(wb & ~127u);
                    ck[s] = hab[s] < 0 ? 0u : ((f2ord(v) & ~255u) | (255u - (unsigned)ab));
                }
                unsigned mywin = 0u;
#pragma unroll
                for (int r = 0; r < 16; ++r) {
                    unsigned m = max(max(ck[0], ck[1]), max(ck[2], ck[3]));
                    m = row_max_u(m);
                    if (fr == r) mywin = m;
#pragma unroll
                    for (int s = 0; s < 4; ++s) ck[s] = (ck[s] == m) ? 0u : ck[s];
                }
                const unsigned ci = 255u - (mywin & 255u);
                const unsigned w0 = (unsigned)__shfl((int)win[0][i], (lane & 48) + (int)(ci >> 4)), w1 = (unsigned)__shfl((int)win[1][i], (lane & 48) + (int)(ci & 15u));
                const int e = (int)(127u - (w0 & 127u)) * 128 + (int)(127u - (w1 & 127u));
                const float s = ord2f(w0 & ~127u) + ord2f(w1 & ~127u);
                const float mx = row_max_f(s);
                const float ex = __expf(s - mx);
                const float sum = row_sum_f(ex);
                const int t = t0 + 4 * fq + i;
                eidx[(size_t)t * 128 + h * 16 + fr] = (unsigned short)e;
                gate[(size_t)t * 128 + h * 16 + fr] = ex / sum;
            }
        }
    }
}

__device__ __forceinline__ float wave_total_dpp(float x) {
    x = row_sum_f(x);
    return __builtin_bit_cast(float, __builtin_amdgcn_readlane(__builtin_bit_cast(int, x), 0)) + __builtin_bit_cast(float, __builtin_amdgcn_readlane(__builtin_bit_cast(int, x), 16)) +
           __builtin_bit_cast(float, __builtin_amdgcn_readlane(__builtin_bit_cast(int, x), 32)) + __builtin_bit_cast(float, __builtin_amdgcn_readlane(__builtin_bit_cast(int, x), 48));
}
__device__ __forceinline__ float gelu_erf(float x) { return 0.5f * x * (1.f + erff(x * 0.70710678118654752f)); }
__device__ __forceinline__ void ph_peer_gather(const Params& p, const bf16* hn2, const unsigned short* eidx, const float* gate, const unsigned char* tab, const float* scales, const float* mod, const float* xin, float* xout) {
    const int tid = opaque_tid();
    const int lane = tid & 63, gw = blockIdx.x * NWAVES + __builtin_amdgcn_readfirstlane(tid >> 6), ngw = gridDim.x * NWAVES;
    const unsigned char* utab = tab; const unsigned char* vtab = tab + (size_t)16384 * 1024;
    for (int t = gw; t < T; t += ngw) {
        const int b = t / S;
        float hv[16]; float hs = 0.f;
#pragma unroll
        for (int i = 0; i < 4; ++i) { const uint2 w = ((const uint2*)(hn2 + (size_t)t * D))[lane + 64 * i];
            hv[4 * i + 0] = __uint_as_float(w.x << 16); hv[4 * i + 1] = __uint_as_float(w.x & 0xffff0000u); hv[4 * i + 2] = __uint_as_float(w.y << 16); hv[4 * i + 3] = __uint_as_float(w.y & 0xffff0000u);
            hs += (hv[4 * i] + hv[4 * i + 1]) + (hv[4 * i + 2] + hv[4 * i + 3]); }
        hs = wave_total_dpp(hs);
        const int e0 = eidx[(size_t)t * 128 + lane], e1 = eidx[(size_t)t * 128 + 64 + lane];
        const float g0 = gate[(size_t)t * 128 + lane], g1 = gate[(size_t)t * 128 + 64 + lane];
        float pre0 = 0.f, pre1 = 0.f;
#pragma unroll
        for (int half = 0; half < 2; ++half) {
            const int ev = half ? e1 : e0;
            float pre = 0.f;
#pragma unroll 8
            for (int j = 0; j < 64; ++j) {
                const int e = __builtin_amdgcn_readlane(ev, j);
                const uint4 w = ((const uint4*)(utab + (size_t)e * 1024))[lane];
                const unsigned ww[4] = {w.x, w.y, w.z, w.w};
                float d = 0.f;
#pragma unroll
                for (int i = 0; i < 4; ++i) {
                    d += hv[4 * i + 0] * (float)(ww[i] & 0xffu); d += hv[4 * i + 1] * (float)((ww[i] >> 8) & 0xffu);
                    d += hv[4 * i + 2] * (float)((ww[i] >> 16) & 0xffu); d += hv[4 * i + 3] * (float)(ww[i] >> 24);
                }
                d = wave_total_dpp(d);
                pre = (lane == j) ? d : pre;
            }
            if (half) pre1 = pre; else pre0 = pre;
        }
        const float c0 = g0 * gelu_erf(scales[e0] * (pre0 - 128.f * hs)) * scales[16384 + e0];
        const float c1 = g1 * gelu_erf(scales[e1] * (pre1 - 128.f * hs)) * scales[16384 + e1];
        const float corr = 128.f * wave_total_dpp(c0 + c1);
        float acc[16];
#pragma unroll
        for (int i = 0; i < 16; ++i) acc[i] = 0.f;
#pragma unroll
        for (int half = 0; half < 2; ++half) {
            const int ev = half ? e1 : e0; const float cv = half ? c1 : c0;
#pragma unroll 8
            for (int j = 0; j < 64; ++j) {
                const int e = __builtin_amdgcn_readlane(ev, j);
                const float cf = __builtin_bit_cast(float, __builtin_amdgcn_readlane(__builtin_bit_cast(int, cv), j));
                const uint4 w = ((const uint4*)(vtab + (size_t)e * 1024))[lane];
                const unsigned ww[4] = {w.x, w.y, w.z, w.w};
#pragma unroll
                for (int i = 0; i < 4; ++i) {
                    acc[4 * i + 0] += cf * (float)(ww[i] & 0xffu); acc[4 * i + 1] += cf * (float)((ww[i] >> 8) & 0xffu);
                    acc[4 * i + 2] += cf * (float)((ww[i] >> 16) & 0xffu); acc[4 * i + 3] += cf * (float)(ww[i] >> 24);
                }
            }
        }
        float xv[16]; float ss = 0.f;
#pragma unroll
        for (int i = 0; i < 4; ++i) {
            const float4 g2 = ((const float4*)(mod + b * 6144 + 5 * D))[lane + 64 * i];
            const float4 x = ((const float4*)(xin + (size_t)t * D))[lane + 64 * i];
            xv[4 * i + 0] = x.x + g2.x * (acc[4 * i + 0] - corr); xv[4 * i + 1] = x.y + g2.y * (acc[4 * i + 1] - corr);
            xv[4 * i + 2] = x.z + g2.z * (acc[4 * i + 2] - corr); xv[4 * i + 3] = x.w + g2.w * (acc[4 * i + 3] - corr);
            ss += (xv[4 * i] * xv[4 * i] + xv[4 * i + 1] * xv[4 * i + 1]) + (xv[4 * i + 2] * xv[4 * i + 2] + xv[4 * i + 3] * xv[4 * i + 3]);
        }
        ss = wave_total_dpp(ss);
        const float r = rsqrtf(ss * (1.f / D) + EPS);
#pragma unroll
        for (int i = 0; i < 4; ++i) {
            const float4 gg = ((const float4*)p.fg)[lane + 64 * i];
            float4 o; o.x = xv[4 * i + 0] * r * gg.x; o.y = xv[4 * i + 1] * r * gg.y; o.z = xv[4 * i + 2] * r * gg.z; o.w = xv[4 * i + 3] * r * gg.w;
            ((float4*)(xout + (size_t)t * D))[lane + 64 * i] = o;
        }
    }
}

__device__ __forceinline__ void ph_vt(const bf16* proj, int voff, bf16* VT) {
    const int lane = threadIdx.x & 63, gw = blockIdx.x * NWAVES + __builtin_amdgcn_readfirstlane(threadIdx.x >> 6), ngw = gridDim.x * NWAVES;
    for (int u = gw; u < NB * 8 * (S / 64); u += ngw) {
        const int sb = u & 127, h = (u >> 7) & 7, b = u >> 10;
        const bf16* src = proj + (size_t)(b * S + sb * 64) * PW + voff + h * 64 + lane;
        bf16* dst = VT + (((size_t)(b * 8 + h) * (S / 32) + 2 * sb) * 64 + lane) * 32;
        unsigned short e[64];
#pragma unroll
        for (int j = 0; j < 64; ++j) e[j] = src[(size_t)j * PW];
#pragma unroll
        for (int blk = 0; blk < 2; ++blk)
#pragma unroll
            for (int q4 = 0; q4 < 4; ++q4) {
                const int a = 32 * blk + 4 * q4, c = a + 16;
                v4u o; o.x = e[a] | ((unsigned)e[a + 1] << 16); o.y = e[a + 2] | ((unsigned)e[a + 3] << 16); o.z = e[c] | ((unsigned)e[c + 1] << 16); o.w = e[c + 2] | ((unsigned)e[c + 3] << 16);
                *(v4u*)(dst + blk * 64 * 32 + 8 * q4) = o;
            }
    }
}
__device__ __forceinline__ void ph_stick2(const bf16* proj, const bf16* KC, const bf16* VT, bf16* yb) {
    const int tid = opaque_tid();
    const int lane = tid & 63, fr = lane & 15, fq = lane >> 4;
    const int gw = blockIdx.x * NWAVES + __builtin_amdgcn_readfirstlane(tid >> 6), ngw = gridDim.x * NWAVES;
    for (int u = gw; u < (T / 16) * 8; u += ngw) {
        const int h = (u >> 3) & 7, t0 = ((((u >> 6) << 3) | (u & 7))) * 16, b = t0 / S, tl0 = t0 % S;
        const int qpos = tl0 + fr;
        bf16x8_t bq[2];
        { const bf16* qrow = proj + (size_t)(t0 + fr) * PW + OFF_QB + 64 * h + 8 * fq; bq[0] = *(const bf16x8_t*)qrow; bq[1] = *(const bf16x8_t*)(qrow + 32); }
        f32x4_t acc[4];
#pragma unroll
        for (int dt = 0; dt < 4; ++dt) acc[dt] = (f32x4_t){0.f, 0.f, 0.f, 0.f};
        float carry = 0.f;
        const bf16* vtb = VT + ((size_t)(b * 8 + h) * (S / 32) * 64 + fr) * 32 + 8 * fq;
        const bf16* kbase = KC + ((size_t)(b * 8 + h) * S + fr) * 64 + 8 * fq;
        int kb = (tl0 + 15) >> 5;
        bf16x8_t nk[2][2]; v4u nv[4];
#pragma unroll
        for (int tile = 0; tile < 2; ++tile) { const bf16* kr = kbase + (size_t)(32 * kb + 16 * tile) * 64; nk[tile][0] = *(const bf16x8_t*)kr; nk[tile][1] = *(const bf16x8_t*)(kr + 32); }
#pragma unroll
        for (int dt = 0; dt < 4; ++dt) { const bf16* vr = vtb + (size_t)kb * 2048 + (16 * dt) * 32; nv[dt] = *(const v4u*)vr; }
        for (; kb >= 0; --kb) {
            bf16x8_t ck[2][2]; v4u cv[4];
#pragma unroll
            for (int tile = 0; tile < 2; ++tile) { ck[tile][0] = nk[tile][0]; ck[tile][1] = nk[tile][1]; }
#pragma unroll
            for (int dt = 0; dt < 4; ++dt) cv[dt] = nv[dt];
            { const int kbn = kb > 0 ? kb - 1 : 0;
#pragma unroll
              for (int tile = 0; tile < 2; ++tile) { const bf16* kr = kbase + (size_t)(32 * kbn + 16 * tile) * 64; nk[tile][0] = *(const bf16x8_t*)kr; nk[tile][1] = *(const bf16x8_t*)(kr + 32); }
#pragma unroll
              for (int dt = 0; dt < 4; ++dt) { const bf16* vr = vtb + (size_t)kbn * 2048 + (16 * dt) * 32; nv[dt] = *(const v4u*)vr; } }
            unsigned pw[4] = {0u, 0u, 0u, 0u};
#pragma unroll
            for (int tile = 1; tile >= 0; --tile) {
                const int k0 = 32 * kb + 16 * tile;
                if (k0 > tl0 + 14) continue;
                f32x4_t st = (f32x4_t){0.f, 0.f, 0.f, 0.f};
                st = __builtin_amdgcn_mfma_f32_16x16x32_bf16(ck[tile][0], bq[0], st, 0, 0, 0);
                st = __builtin_amdgcn_mfma_f32_16x16x32_bf16(ck[tile][1], bq[1], st, 0, 0, 0);
                float lb[4], l1m[4];
#pragma unroll
                for (int i = 0; i < 4; ++i) {
                    const float z = st[i] * 0.18033688011112042f;
                    const bool valid = (k0 + 4 * fq + i) < qpos;
                    const float sp = fmaxf(-z, 0.f) + __builtin_amdgcn_logf(1.f + __builtin_amdgcn_exp2f(-fabsf(z)));
                    lb[i] = valid ? -sp : -INFINITY;
                    l1m[i] = valid ? (-sp - z) : 0.f;
                }
                const float e2 = l1m[3], e1 = e2 + l1m[2], e0 = e1 + l1m[1], gsum = e0 + l1m[0];
                const float a1 = __shfl(gsum, (lane + 16) & 63), a2 = __shfl(gsum, (lane + 32) & 63), a3 = __shfl(gsum, (lane + 48) & 63);
                const float above = (fq < 3 ? a1 : 0.f) + (fq < 2 ? a2 : 0.f) + (fq < 1 ? a3 : 0.f);
                const float base = carry + above;
                const float w0 = __builtin_amdgcn_exp2f(lb[0] + base + e0), w1 = __builtin_amdgcn_exp2f(lb[1] + base + e1), w2 = __builtin_amdgcn_exp2f(lb[2] + base + e2), w3 = __builtin_amdgcn_exp2f(lb[3] + base);
                carry += (gsum + a1) + (a2 + a3);
                pw[2 * tile] = pk2(w0, w1); pw[2 * tile + 1] = pk2(w2, w3);
            }
            bf16x8_t pb;
            { v4u t; t.x = pw[0]; t.y = pw[1]; t.z = pw[2]; t.w = pw[3]; pb = __builtin_bit_cast(bf16x8_t, t); }
#pragma unroll
            for (int dt = 0; dt < 4; ++dt) {
                acc[dt] = __builtin_amdgcn_mfma_f32_16x16x32_bf16(__builtin_bit_cast(bf16x8_t, cv[dt]), pb, acc[dt], 0, 0, 0);
            }
            if (__all(carry < -173.2f)) break;
        }
#pragma unroll
        for (int dt = 0; dt < 4; ++dt) {
            uint2 o; o.x = pk2(acc[dt][0], acc[dt][1]); o.y = pk2(acc[dt][2], acc[dt][3]);
            *(uint2*)(yb + (size_t)(t0 + fr) * 512 + 64 * h + 16 * dt + 4 * fq) = o;
        }
    }
}

constexpr int IQB = 32, ICAPN = 704, ICAP = 705  , ITRIG = ICAPN - 128, ILOW = 352;
constexpr int LDS_IKEY = 0, LDS_IIDX = IQB * ICAP * 4, LDS_ICNT = ((LDS_IIDX + IQB * ICAP * 2 + 15) / 16) * 16, LDS_ITHR = LDS_ICNT + IQB * 4, LDS_IROW = LDS_ITHR + IQB * 4;
static_assert(LDS_IROW + NWAVES * 1024 <= LDS_BYTES - 16, "indexer LDS map");
__device__ __forceinline__ int wave_count(bool pred) { return __popcll(__ballot(pred)); }
template <int NE> __device__ __forceinline__ void index_load(LAS unsigned* keyb, LAS unsigned short* idxb, int q, int n, int lane, unsigned (&kv)[NE], unsigned (&iv)[NE]) {
#pragma unroll
    for (int j = 0; j < NE; ++j) { const int pos = lane + 64 * j; const bool in = pos < n; kv[j] = in ? keyb[q * ICAP + pos] : 0u; iv[j] = in ? (unsigned)idxb[q * ICAP + pos] : 0xFFFFu; }
}
template <int NE> __device__ __forceinline__ int index_count_ge(const unsigned (&kv)[NE], unsigned c) {
    int k = 0;
#pragma unroll
    for (int j = 0; j < NE; ++j) k += __popcll(__builtin_amdgcn_uicmp(kv[j], c, 35));
    return k;
}
template <int NE> __device__ __forceinline__ unsigned index_kth(const unsigned (&kv)[NE], int need) {
    unsigned tau = 0u;
#pragma unroll 1
    for (int bit = 31; bit >= 0; --bit) { const unsigned c = tau | (1u << bit); if (index_count_ge<NE>(kv, c) >= need) tau = c; }
    return tau;
}
__device__ __forceinline__ void index_cut(LAS unsigned* keyb, LAS unsigned short* idxb, LAS unsigned* cnt, LAS unsigned* thr, int q, int lane) {
    const int n = (int)cnt[q];
    if (n <= TOPK) return;
    unsigned kv[11], iv[11];
    index_load<11>(keyb, idxb, q, n, lane, kv, iv);
    unsigned smp[1]; smp[0] = keyb[q * ICAP + ((lane * n) >> 6)];
    int r = (64 * TOPK + n - 1) / n + 6; unsigned p = 0u; int c = n;
#pragma unroll 1
    for (;;) {
        if (r > 64) { p = index_kth<11>(kv, TOPK); c = index_count_ge<11>(kv, p); break; }
        p = index_kth<1>(smp, r); c = index_count_ge<11>(kv, p);
        if (c >= TOPK) break;
        r += 6;
    }
    unsigned tau = p - 1u, iota = 0xFFFFu;
    if (c > 448) {
        tau = index_kth<11>(kv, TOPK);
        int ngt = 0, neq = 0;
#pragma unroll
        for (int j = 0; j < 11; ++j) { ngt += __popcll(__builtin_amdgcn_uicmp(kv[j], tau, 34)); neq += __popcll(__builtin_amdgcn_uicmp(kv[j], tau, 32)); }
        const int need = TOPK - ngt;
        if (neq > need) {
            unsigned x = 0u;
#pragma unroll 1
            for (int bit = 15; bit >= 0; --bit) {
                const unsigned cc = x | (1u << bit);
                int k = 0;
#pragma unroll
                for (int j = 0; j < 11; ++j) k += wave_count(kv[j] == tau && iv[j] < cc);
                if (k < need) x = cc;
            }
            iota = x;
        }
    }
    int base = 0;
    const unsigned long long lt = (1ull << lane) - 1ull;
#pragma unroll
    for (int j = 0; j < 11; ++j) {
        const bool keep = kv[j] > tau || (kv[j] == tau && iv[j] <= iota);
        const unsigned long long m = __ballot(keep);
        const int pos = base + __popcll(m & lt);
        if (keep) { keyb[q * ICAP + pos] = kv[j]; idxb[q * ICAP + pos] = (unsigned short)iv[j]; }
        base += __popcll(m);
    }
    if (lane == 0) { cnt[q] = (unsigned)base; thr[q] = tau; }
    asm volatile("s_waitcnt lgkmcnt(0)" ::: "memory");
}
template <int NE> __device__ __forceinline__ void index_bits(LAS unsigned* keyb, LAS unsigned short* idxb, int q, int n, int lane) {
    unsigned kv[NE], iv[NE];
    index_load<NE>(keyb, idxb, q, n, lane, kv, iv);
    unsigned tau = 0u, iota = 0xFFFFu;
    if (n > TOPK) {
        tau = index_kth<NE>(kv, TOPK);
        int ngt = 0, neq = 0;
#pragma unroll
        for (int j = 0; j < NE; ++j) { ngt += __popcll(__builtin_amdgcn_uicmp(kv[j], tau, 34)); neq += __popcll(__builtin_amdgcn_uicmp(kv[j], tau, 32)); }
        const int need = TOPK - ngt;
        if (neq > need) {
            unsigned x = 0u;
#pragma unroll 1
            for (int bit = 15; bit >= 0; --bit) {
                const unsigned c = x | (1u << bit);
                int k = 0;
#pragma unroll
                for (int j = 0; j < NE; ++j) k += wave_count(kv[j] == tau && iv[j] < c);
                if (k < need) x = c;
            }
            iota = x;
        }
    }
    LAS unsigned* rowl = keyb + q * ICAP;
    asm volatile("s_waitcnt lgkmcnt(0)" ::: "memory");
#pragma unroll
    for (int i = 0; i < 4; ++i) rowl[lane + 64 * i] = 0u;
    asm volatile("s_waitcnt lgkmcnt(0)" ::: "memory");
#pragma unroll
    for (int j = 0; j < NE; ++j) {
        const bool keep = (n > TOPK) ? (kv[j] > tau || (kv[j] == tau && iv[j] <= iota)) : (lane + 64 * j < n);
        if (keep) (void)__hip_atomic_fetch_or(rowl + (iv[j] >> 5), 1u << (iv[j] & 31u), __ATOMIC_RELAXED, __HIP_MEMORY_SCOPE_WORKGROUP);
    }
    asm volatile("s_waitcnt lgkmcnt(0)" ::: "memory");
}
__device__ __forceinline__ void index_final(LAS unsigned* keyb, LAS unsigned short* idxb, LAS unsigned* cnt, LAS unsigned* thr, int q, int lane) {
    if ((int)cnt[q] > 384) index_cut(keyb, idxb, cnt, thr, q, lane);
    const int n = (int)cnt[q];
    if (n <= 384) index_bits<6>(keyb, idxb, q, n, lane); else if (n <= 448) index_bits<7>(keyb, idxb, q, n, lane); else index_bits<11>(keyb, idxb, q, n, lane);
}
template <int ABL> __device__ __forceinline__ void ph_dsa_index(const bf16* proj, const bf16* KI, const bf16* WI, unsigned* selbits, LAS unsigned char* lds) {
    LAS unsigned* keyb = (LAS unsigned*)(lds + LDS_IKEY); LAS unsigned short* idxb = (LAS unsigned short*)(lds + LDS_IIDX);
    LAS unsigned* cnt = (LAS unsigned*)(lds + LDS_ICNT); LAS unsigned* thr = (LAS unsigned*)(lds + LDS_ITHR);
    const int tid = opaque_tid(), wave = __builtin_amdgcn_readfirstlane(tid >> 6), lane = tid & 63, fr = lane & 15, fq = lane >> 4;
    LAS unsigned* rowl = (LAS unsigned*)(lds + LDS_IROW + wave * 1024);
    constexpr int NQB = S / IQB;
    for (int pr = blockIdx.x; pr < NB * NQB / 2; pr += gridDim.x) {
        const int b = pr / (NQB / 2), pp = pr % (NQB / 2);
#pragma unroll 1
        for (int ui = 0; ui < 2; ++ui) {
            const int qb = ui ? pp : (NQB - 1 - pp);
            const int q0 = qb * IQB, t0 = b * S + q0;
            __syncthreads();
            if (tid < IQB) { cnt[tid] = 0u; thr[tid] = 0u; }
            bf16x8_t bqf[2][8][2]; unsigned wvp[2][4];
#pragma unroll
            for (int qg = 0; qg < 2; ++qg) {
                const bf16* qrow = proj + (size_t)(t0 + 16 * qg + fr) * PW;
#pragma unroll
                for (int h = 0; h < 8; ++h) { bqf[qg][h][0] = *(const bf16x8_t*)(qrow + OFF_QI + 64 * h + 8 * fq); bqf[qg][h][1] = *(const bf16x8_t*)(qrow + OFF_QI + 64 * h + 8 * fq + 32); }
                { const uint4 w4 = *(const uint4*)(WI + (size_t)(t0 + 16 * qg + fr) * 8); wvp[qg][0] = w4.x; wvp[qg][1] = w4.y; wvp[qg][2] = w4.z; wvp[qg][3] = w4.w; }
            }
            const int ntiles = (q0 + IQB - 1) / 128 + 1;
            const bf16* kwave = KI + (size_t)(b * S + 16 * wave + fr) * 64 + 8 * fq;
            bf16x8_t ak0 = *(const bf16x8_t*)kwave, ak1 = *(const bf16x8_t*)(kwave + 32);
#pragma unroll 1
            for (int kt = 0; kt < ntiles; ++kt) {
                asm volatile("s_waitcnt lgkmcnt(0)" ::: "memory"); __builtin_amdgcn_s_barrier(); asm volatile("" ::: "memory");
                if (__any((int)cnt[lane & 31] > ITRIG)) {
#pragma unroll 1
                    for (int qq = 0; qq < 4; ++qq) { const int q = 4 * wave + qq; if ((int)cnt[q] > ILOW) { if (ABL == 2) { if (lane == 0) cnt[q] = 256u; } else index_cut(keyb, idxb, cnt, thr, q, lane); } }
                    asm volatile("s_waitcnt lgkmcnt(0)" ::: "memory"); __builtin_amdgcn_s_barrier(); asm volatile("" ::: "memory");
                }
                const unsigned th0 = thr[fr], th1 = thr[16 + fr];
                const int k0 = 128 * kt + 16 * wave;
                const bf16x8_t a0 = ak0, a1 = ak1;
                { const bf16* kn = kwave + (size_t)(128 * ((kt + 1 < ntiles) ? kt + 1 : kt)) * 64; ak0 = *(const bf16x8_t*)kn; ak1 = *(const bf16x8_t*)(kn + 32); }
#pragma unroll
                for (int qg = 0; qg < 2; ++qg) {
                    float sc[4] = {0.f, 0.f, 0.f, 0.f};
#pragma unroll
                    for (int h = 0; h < 8; ++h) {
                        f32x4_t a = (f32x4_t){0.f, 0.f, 0.f, 0.f};
                        a = __builtin_amdgcn_mfma_f32_16x16x32_bf16(a0, bqf[qg][h][0], a, 0, 0, 0);
                        a = __builtin_amdgcn_mfma_f32_16x16x32_bf16(a1, bqf[qg][h][1], a, 0, 0, 0);
                        const float wh = (h & 1) ? __uint_as_float(wvp[qg][h >> 1] & 0xffff0000u) : __uint_as_float(wvp[qg][h >> 1] << 16);
#pragma unroll
                        for (int i = 0; i < 4; ++i) { sc[i] += wh * __builtin_amdgcn_fmed3f(a[i], 0.f, __builtin_inff()); asm("" : "+v"(sc[i])); }
                    }
                    const int qi = 16 * qg + fr, qpos = q0 + qi;
                    const unsigned th = qg ? th1 : th0;
                    unsigned keyv[4], slot[4]; bool prd[4];
#pragma unroll
                    for (int i = 0; i < 4; ++i) {
                        float s = sc[i]; if (s == 0.f) s = 0.f;
                        keyv[i] = f2ord(s);
                        prd[i] = (ABL != 1) && (k0 + 4 * fq + i <= qpos) && (keyv[i] > th);
                    }
#pragma unroll
                    for (int i = 0; i < 4; ++i) slot[i] = prd[i] ? __hip_atomic_fetch_add(cnt + qi, 1u, __ATOMIC_RELAXED, __HIP_MEMORY_SCOPE_WORKGROUP) : 0u;
#pragma unroll
                    for (int i = 0; i < 4; ++i) if (prd[i]) { keyb[qi * ICAP + slot[i]] = keyv[i]; idxb[qi * ICAP + slot[i]] = (unsigned short)(k0 + 4 * fq + i); }
                }
            }
            __syncthreads();
#pragma unroll 1
            for (int qq = 0; qq < (ABL == 0 ? 4 : 0); ++qq) { const int q = 4 * wave + qq; index_final(keyb, idxb, cnt, thr, q, lane); }
            if (ABL == 0) {
                __syncthreads();
                unsigned* dst = selbits + ((size_t)(b * (S / 32) + qb) * 128) * 64;
                for (int idx = tid; idx < 128 * 32; idx += NTHR) { const int kt = idx >> 5, qq = idx & 31;
                    uint2 w; w.x = keyb[qq * ICAP + 2 * kt]; w.y = keyb[qq * ICAP + 2 * kt + 1];
                    *(uint2*)(dst + (size_t)idx * 2) = w; }
            }
        }
    }
    __syncthreads();
}

constexpr int AQB = 256, AKT = 64, AROW = 144;
constexpr int LDS_AK = 0, LDS_AV = AKT * AROW, LDS_ABUF = 2 * AKT * AROW, LDS_ABLUT = 2 * LDS_ABUF;
__device__ __forceinline__ float bfi_f(unsigned mask, unsigned a, unsigned b) { unsigned r_; asm("v_bfi_b32 %0, %1, %2, %3" : "=v"(r_) : "v"(mask), "v"(a), "v"(b)); return __uint_as_float(r_); }
template <bool NEAR> __device__ __forceinline__ void attn_tile(LAS unsigned char* buf, LAS float* blut, const bf16x8_t (&bq)[2][2], const uint2 cb0, const uint2 cb1, int qw, int k0, int fr, int fq,
                                                               const bf16x8_t ones, f32x4_t (&acc)[2][4], f32x4_t (&accl)[2], float (&mrun)[2]) {
    const float cfar = blut[128];
    const unsigned ninf = 0xff800000u;
    bf16x8_t kf[4][2];
#pragma unroll
    for (int tile = 0; tile < 4; ++tile)
#pragma unroll
        for (int ks = 0; ks < 2; ++ks) kf[tile][ks] = *(const LAS bf16x8_t*)(buf + LDS_AK + (16 * tile + fr) * AROW + (8 * fq + 32 * ks) * 2);
    f32x4_t sx[2][4];
#pragma unroll
    for (int qg = 0; qg < 2; ++qg)
#pragma unroll
        for (int tile = 0; tile < 4; ++tile) { sx[qg][tile] = (f32x4_t){0.f, 0.f, 0.f, 0.f};
            sx[qg][tile] = __builtin_amdgcn_mfma_f32_16x16x32_bf16(kf[tile][0], bq[qg][0], sx[qg][tile], 0, 0, 0); sx[qg][tile] = __builtin_amdgcn_mfma_f32_16x16x32_bf16(kf[tile][1], bq[qg][1], sx[qg][tile], 0, 0, 0); }
    float x[2][16]; float mt[2];
#pragma unroll
    for (int qg = 0; qg < 2; ++qg) {
        const uint2 cb = qg ? cb1 : cb0;
        const int dist0 = (qw + 16 * qg + fr) - (k0 + 4 * fq);
        const float mref = (mrun[qg] == -INFINITY) ? 0.f : mrun[qg];
        const float cfm = cfar - mref;
#pragma unroll
        for (int tile = 0; tile < 4; ++tile) {
            const int nib = (int)(((tile & 2) ? cb.y : cb.x) >> (16 * (tile & 1) + 4 * fq));
#pragma unroll
            for (int i = 0; i < 4; ++i) {
                const unsigned t = (unsigned)__builtin_amdgcn_sbfe(nib, i, 1);
                float bias = cfm;
                if (NEAR) { int n = dist0 - (16 * tile + i); n = n < 0 ? 0 : (n > 128 ? 128 : n); bias = blut[n] - mref; }
                x[qg][4 * tile + i] = __builtin_fmaf(sx[qg][tile][i], 0.18033688011112042f, bfi_f(t, __float_as_uint(bias), ninf));
                asm("" : "+v"(x[qg][4 * tile + i]));
            }
        }
        float m8 = fmaxf(fmaxf(fmaxf(x[qg][0], x[qg][1]), fmaxf(x[qg][2], x[qg][3])), fmaxf(fmaxf(x[qg][4], x[qg][5]), fmaxf(x[qg][6], x[qg][7])));
        m8 = fmaxf(m8, fmaxf(fmaxf(fmaxf(x[qg][8], x[qg][9]), fmaxf(x[qg][10], x[qg][11])), fmaxf(fmaxf(x[qg][12], x[qg][13]), fmaxf(x[qg][14], x[qg][15]))));
        m8 = fmaxf(m8, __shfl_xor(m8, 16)); mt[qg] = fmaxf(m8, __shfl_xor(m8, 32));
    }
    const bool rc0 = (mt[0] > 24.f) || (mrun[0] == -INFINITY && mt[0] > -INFINITY), rc1 = (mt[1] > 24.f) || (mrun[1] == -INFINITY && mt[1] > -INFINITY);
    if (__any(rc0 || rc1)) {
#pragma unroll
        for (int qg = 0; qg < 2; ++qg) {
            const bool rc = qg ? rc1 : rc0;
            const float sh = rc ? mt[qg] : 0.f;
            const float f = (rc && mrun[qg] != -INFINITY) ? __builtin_amdgcn_exp2f(-sh) : 1.f;
            mrun[qg] = rc ? (((mrun[qg] == -INFINITY) ? 0.f : mrun[qg]) + sh) : mrun[qg];
            accl[qg] = accl[qg] * f;
#pragma unroll
            for (int dt = 0; dt < 4; ++dt) acc[qg][dt] = acc[qg][dt] * f;
#pragma unroll
            for (int e = 0; e < 16; ++e) x[qg][e] -= sh;
        }
    }
#pragma unroll
    for (int blk = 0; blk < 2; ++blk) {
        bf16x8_t vf[4];
#pragma unroll
        for (int dt = 0; dt < 4; ++dt) vf[dt] = *(const LAS bf16x8_t*)(buf + LDS_AV + (16 * dt + fr) * AROW + (32 * blk + 8 * fq) * 2);
#pragma unroll
        for (int qg = 0; qg < 2; ++qg) {
            v4u t;
            t.x = pk2(__builtin_amdgcn_exp2f(x[qg][8 * blk + 0]), __builtin_amdgcn_exp2f(x[qg][8 * blk + 1])); t.y = pk2(__builtin_amdgcn_exp2f(x[qg][8 * blk + 2]), __builtin_amdgcn_exp2f(x[qg][8 * blk + 3]));
            t.z = pk2(__builtin_amdgcn_exp2f(x[qg][8 * blk + 4]), __builtin_amdgcn_exp2f(x[qg][8 * blk + 5])); t.w = pk2(__builtin_amdgcn_exp2f(x[qg][8 * blk + 6]), __builtin_amdgcn_exp2f(x[qg][8 * blk + 7]));
            const bf16x8_t pb = __builtin_bit_cast(bf16x8_t, t);
            accl[qg] = __builtin_amdgcn_mfma_f32_16x16x32_bf16(ones, pb, accl[qg], 0, 0, 0);
#pragma unroll
            for (int dt = 0; dt < 4; ++dt) acc[qg][dt] = __builtin_amdgcn_mfma_f32_16x16x32_bf16(vf[dt], pb, acc[qg][dt], 0, 0, 0);
        }
    }
}
__device__ __forceinline__ void ph_dsa_attn2(const Params& p, const bf16* proj, const bf16* KC, const bf16* VTa, const unsigned* selbits, bf16* ya, LAS unsigned char* lds) {
    const int tid = opaque_tid(), wave = __builtin_amdgcn_readfirstlane(tid >> 6), lane = tid & 63, fr = lane & 15, fq = lane >> 4;
    LAS float* blut = (LAS float*)(lds + LDS_ABLUT);
    constexpr int NQBA = S / AQB;
    const int ldr = tid >> 3, ldc = tid & 7;
    for (int pr = blockIdx.x; pr < NB * 8 * NQBA / 2; pr += gridDim.x) {
        const int bh = pr / (NQBA / 2), pp = pr % (NQBA / 2), b = bh >> 3, h = bh & 7;
        __syncthreads();
        if (tid <= 128) blut[tid] = p.rel_bias[(tid >= 128 ? 31 : t5_bucket(tid)) * 8 + h] * 1.4426950408889634f;
        const bf16* kg = KC + ((size_t)(b * 8 + h) * S + ldr) * 64 + 8 * ldc;
        const bf16* vg = VTa + ((size_t)(b * 8 + h) * (S / 32) * 64 + (ldc >> 2) * 64 + ldr) * 32 + 8 * (ldc & 3);
#pragma unroll 1
        for (int ui = 0; ui < 2; ++ui) {
            const int qb = ui ? pp : (NQBA - 1 - pp);
            const int q0 = qb * AQB, qw = q0 + 32 * wave;
            const int ntiles = (q0 + AQB) / AKT;
            bf16x8_t bq[2][2];
#pragma unroll
            for (int qg = 0; qg < 2; ++qg) { const bf16* qrow = proj + (size_t)(b * S + qw + 16 * qg + fr) * PW + OFF_QA + 64 * h + 8 * fq; bq[qg][0] = *(const bf16x8_t*)qrow; bq[qg][1] = *(const bf16x8_t*)(qrow + 32); }
            const unsigned* brow0 = selbits + ((size_t)(b * (S / 32) + (qw >> 5)) * 128) * 64 + 2 * fr;
            const unsigned* brow1 = brow0 + 32;
            f32x4_t acc[2][4], accl[2]; float mrun[2];
            const bf16x8_t ones = __builtin_bit_cast(bf16x8_t, (v4u){0x3f803f80u, 0x3f803f80u, 0x3f803f80u, 0x3f803f80u});
#pragma unroll
            for (int qg = 0; qg < 2; ++qg) { mrun[qg] = -INFINITY; accl[qg] = (f32x4_t){0.f, 0.f, 0.f, 0.f};
#pragma unroll
                for (int dt = 0; dt < 4; ++dt) acc[qg][dt] = (f32x4_t){0.f, 0.f, 0.f, 0.f}; }
            __syncthreads();
            { const v4u kk = *(const v4u*)kg, vv = *(const v4u*)vg;
              *(LAS v4u*)(lds + LDS_AK + ldr * AROW + 16 * ldc) = kk; *(LAS v4u*)(lds + LDS_AV + ldr * AROW + 16 * ldc) = vv; }
            uint2 wb0 = *(const uint2*)brow0, wb1 = *(const uint2*)brow1;
            __syncthreads();
#pragma unroll 1
            for (int kt = 0; kt < ntiles; ++kt) {
                const int k0 = kt * AKT;
                LAS unsigned char* buf = lds + (kt & 1) * LDS_ABUF;
                const int ktn = (kt + 1 < ntiles) ? kt + 1 : kt;
                const uint2 cb0 = wb0, cb1 = wb1;
                const v4u nk = *(const v4u*)(kg + (size_t)(ktn * AKT) * 64), nvv = *(const v4u*)(vg + (size_t)(ktn * AKT / 32) * 2048);
                wb0 = *(const uint2*)(brow0 + 64 * ktn); wb1 = *(const uint2*)(brow1 + 64 * ktn);
                if (k0 <= qw + 31) {
                    if ((k0 + AKT - 1 + 128) > qw) attn_tile<true>(buf, blut, bq, cb0, cb1, qw, k0, fr, fq, ones, acc, accl, mrun);
                    else attn_tile<false>(buf, blut, bq, cb0, cb1, qw, k0, fr, fq, ones, acc, accl, mrun);
                }
                { LAS unsigned char* nb = lds + ((kt + 1) & 1) * LDS_ABUF;
                    *(LAS v4u*)(nb + LDS_AK + ldr * AROW + 16 * ldc) = nk; *(LAS v4u*)(nb + LDS_AV + ldr * AROW + 16 * ldc) = nvv; }
                asm volatile("s_waitcnt lgkmcnt(0)" ::: "memory"); __builtin_amdgcn_s_barrier(); asm volatile("" ::: "memory");
            }
#pragma unroll
            for (int qg = 0; qg < 2; ++qg) {
                const float inv = 1.f / accl[qg][0];
#pragma unroll
                for (int dt = 0; dt < 4; ++dt) { uint2 o; o.x = pk2(acc[qg][dt][0] * inv, acc[qg][dt][1] * inv); o.y = pk2(acc[qg][dt][2] * inv, acc[qg][dt][3] * inv);
                    *(uint2*)(ya + (size_t)(b * S + qw + 16 * qg + fr) * 512 + 64 * h + 16 * dt + 4 * fq) = o; }
            }
        }
    }
    __syncthreads();
}

__global__ void __launch_bounds__(NTHR, 2) mega_fwd(Params p) {
    extern __shared__ __attribute__((aligned(16))) unsigned char lds[];
    float* sm = (float*)lds;
    LAS unsigned char* ldsl = (LAS unsigned char*)lds;
    volatile LAS unsigned* bst = (volatile LAS unsigned*)(ldsl + LDS_BYTES - 16);
    if (threadIdx.x == 0) { bst[0] = 0u; bst[1] = 0u; bst[2] = 0u; bst[3] = 0u; }
    __syncthreads();
    XcdBarrier bar = xcd_barrier_post((unsigned*)(p.ws + WS_BAR), bst);
    unsigned char* ws = p.ws;
    float* mod = (float*)(ws + WS_MOD);
    bf16* proj = (bf16*)(ws + WS_PROJ);
    bf16* G = (bf16*)(ws + WS_G);
    bf16* ya = (bf16*)(ws + WS_YA); bf16* yb = (bf16*)(ws + WS_YB);
    bf16* hn2 = (bf16*)(ws + WS_HN2); bf16* qh = (bf16*)(ws + WS_QH);
    bf16* hn = (bf16*)p.out;
    const int G_ = gridDim.x, c_ = blockIdx.x;

    ph_mod(p, mod, (float*)(lds + LDS_SC_OFF));
    ph_weights(p, ldsl);
    xcd_barrier(bar);
    ph_norm<true>(p.x, p.g1, mod, 0, 1, hn);
    xcd_barrier(bar);
    {
        pg8::Gemm g{hn, (const bf16*)(ws + WS_WIN), T, NPROJ, D, D, D}; pg8::StaticOrder So; So.init(T, NPROJ, G_, c_);
        pg8::EpiX<1> E{proj, G, nullptr, nullptr, nullptr, PW, 0, (bf16*)(ws + WS_KCA), (bf16*)(ws + WS_KCB), (bf16*)(ws + WS_KI), (bf16*)(ws + WS_WI)};
        pg8::gemm_phase<pg8::EpiX<1>, pg8::StaticOrder, true, true>(ldsl, g, So, E);
    }
    xcd_barrier(bar);
    unsigned* selbits = (unsigned*)((unsigned char*)p.out + 32 * MiB); bf16* VTa = (bf16*)p.out;
    ph_vt(proj, OFF_VB, (bf16*)(ws + WS_VT));
    ph_vt(proj, OFF_VA, VTa);
    ph_dsa_index<0>(proj, (const bf16*)(ws + WS_KI), (const bf16*)(ws + WS_WI), selbits, ldsl);
    xcd_barrier(bar);
    ph_dsa_attn2(p, proj, (const bf16*)(ws + WS_KCA), VTa, selbits, ya, ldsl);
    ph_stick2(proj, (const bf16*)(ws + WS_KCB), (const bf16*)(ws + WS_VT), yb);
    xcd_barrier(bar);
    {
        pg8::Gemm g{ya, (const bf16*)(ws + WS_WPA), T, D, 512, 512, 512}; pg8::StaticOrder So; So.init(T, D, G_, c_);
        pg8::EpiX<2> E{nullptr, G, nullptr, nullptr, nullptr, 0, 0, nullptr, nullptr, nullptr, nullptr};
        pg8::gemm_phase<pg8::EpiX<2>, pg8::StaticOrder, true, true>(ldsl, g, So, E);
    }
    {
        pg8::Gemm g{yb, (const bf16*)(ws + WS_WPB), T, D, 512, 512, 512}; pg8::StaticOrder So; So.init(T, D, G_, c_);
        pg8::EpiX<3> E{nullptr, G, nullptr, nullptr, nullptr, 0, 0, nullptr, nullptr, nullptr, nullptr};
        pg8::gemm_phase<pg8::EpiX<3>, pg8::StaticOrder, true, true>(ldsl, g, So, E);
    }
    xcd_barrier(bar);
    {
        pg8::Gemm g{G, (const bf16*)(ws + WS_WOUT), T, D, D, GW, D}; pg8::StaticOrder So; So.init(T, D, G_, c_);
        pg8::EpiX<4> E{nullptr, nullptr, p.x, mod + 2 * D, p.out, 0, 0, nullptr, nullptr, nullptr, nullptr};
        pg8::gemm_phase<pg8::EpiX<4>, pg8::StaticOrder, true, true>(ldsl, g, So, E);
    }
    xcd_barrier(bar);
    ph_norm<false>(p.out, p.g2, mod, 3, 4, hn2);
    ph_quant(p, ws + WS_TAB, (float*)(ws + WS_SCALES));
    xcd_barrier(bar);
    {
        pg8::Gemm g{hn2, (const bf16*)(ws + WS_WQ), T, 2048, D, D, D}; pg8::StaticOrder So; So.init(T, 2048, G_, c_);
        pg8::EpiX<0> E{qh, nullptr, nullptr, nullptr, nullptr, 2048, 0, nullptr, nullptr, nullptr, nullptr};
        pg8::gemm_phase<pg8::EpiX<0>, pg8::StaticOrder, true, true>(ldsl, g, So, E);
    }
    xcd_barrier(bar);
    ph_peer_select(qh, (const bf16*)(ws + WS_SKB), (unsigned short*)(ws + WS_EIDX), (float*)(ws + WS_GATE));
    xcd_barrier(bar);
    ph_peer_gather(p, hn2, (const unsigned short*)(ws + WS_EIDX), (const float*)(ws + WS_GATE), ws + WS_TAB, (const float*)(ws + WS_SCALES), mod, p.out, p.out);
}

extern "C" void kernel_launch(void* const* d_in, const int* in_sizes, int n_in, void* d_out, int out_size, void* d_ws, size_t ws_size, hipStream_t stream) {
    static int grid = 0;
    if (grid == 0) {
        if (n_in != 16 || out_size != T * D || ws_size < WS_NEED) { fprintf(stderr, "kernel_launch: unexpected shapes (n_in %d out %d ws %zu)\n", n_in, out_size, ws_size); grid = -1; return; }
        int dev = 0, cus = 0, per_cu = 0;
        if (hipGetDevice(&dev) != hipSuccess || hipDeviceGetAttribute(&cus, hipDeviceAttributeMultiprocessorCount, dev) != hipSuccess) { grid = -1; return; }
        if (hipFuncSetAttribute((const void*)mega_fwd, hipFuncAttributeMaxDynamicSharedMemorySize, LDS_BYTES) != hipSuccess) { fprintf(stderr, "kernel_launch: hipFuncSetAttribute failed\n"); grid = -1; return; }
        if (hipOccupancyMaxActiveBlocksPerMultiprocessor(&per_cu, (const void*)mega_fwd, NTHR, LDS_BYTES) != hipSuccess || per_cu < 1) { fprintf(stderr, "kernel_launch: occupancy query says %d\n", per_cu); per_cu = 1; }
        (void)hipGetLastError();
        grid = cus;
    }
    if (grid < 0) return;
    (void)hipMemsetAsync((char*)d_ws + WS_BAR, 0, CTL_ZERO_BYTES, stream);
    Params p; memset(&p, 0, sizeof(p));
    p.x = (const float*)d_in[0]; p.c = (const float*)d_in[1]; p.w_ada = (const float*)d_in[2]; p.b_ada = (const float*)d_in[3];
    p.g1 = (const float*)d_in[4]; p.g2 = (const float*)d_in[5]; p.w_in = (const float*)d_in[6]; p.rel_bias = (const float*)d_in[7];
    p.wpa = (const float*)d_in[8]; p.wpb = (const float*)d_in[9]; p.wout = (const float*)d_in[10]; p.wq = (const float*)d_in[11];
    p.sk = (const float*)d_in[12]; p.pu = (const float*)d_in[13]; p.pv = (const float*)d_in[14]; p.fg = (const float*)d_in[15];
    p.out = (float*)d_out; p.ws = (unsigned char*)d_ws;
    hipLaunchKernelGGL(mega_fwd, dim3(grid), dim3(NTHR), LDS_BYTES, stream, p);
}
```

```cpp
#include <hip/hip_runtime.h>
#include <stdint.h>
#include <math.h>
#include <string.h>
#include <stdio.h>

typedef unsigned short bf16;
constexpr int D = 1024, NB = 2, S = 8192, T = NB * S;
constexpr int INW = 5704;
constexpr int OFF_QA = 0, OFF_VA = 512, OFF_QI = 1024, OFF_QB = 1536, OFF_VB = 2048;
constexpr int PW = 2560;
constexpr int NPROJ = 3840 + 2048;
constexpr int GW = 2048;
constexpr int TOPK = 256;
constexpr float EPS = 1e-6f;
constexpr size_t MiB = 1u << 20;
constexpr int NTHR = 512, NWAVES = 8;
constexpr int LDS_BYTES = 147456;

#define LAS __attribute__((address_space(3)))

__device__ __forceinline__ bf16 f2bf(float f) { unsigned u = __float_as_uint(f); return (bf16)((u + 0x7fffu + ((u >> 16) & 1u)) >> 16); }
__device__ __forceinline__ float bf2f(bf16 h) { return __uint_as_float(((unsigned)h) << 16); }
typedef __bf16 bf16x2_hw __attribute__((ext_vector_type(2)));
__device__ __forceinline__ unsigned pk2(float lo, float hi) { bf16x2_hw v; v[0] = (__bf16)lo; v[1] = (__bf16)hi; return __builtin_bit_cast(unsigned, v); }

__device__ __forceinline__ float wave_sum(float v) {
#pragma unroll
    for (int o = 1; o < 64; o <<= 1) v += __shfl_xor(v, o);
    return v;
}
__device__ __forceinline__ float block_sum(float v, float* red) {
    v = wave_sum(v);
    __syncthreads();
    if ((threadIdx.x & 63) == 0) red[threadIdx.x >> 6] = v;
    __syncthreads();
    float s = 0.f;
#pragma unroll
    for (int i = 0; i < NWAVES; ++i) s += red[i];
    return s;
}
typedef float f32x4_t __attribute__((ext_vector_type(4)));
#define XB_TMO      128
#define XB_XCNT(j)  (256  + 64 * (j))
#define XB_XSUB(j)  (1280 + 64 * (j))
#define XB_XGEN(j)  (2304 + 64 * (j))
#define XB_TOP      3328
#define XB_TOPGEN   3392
#define XCD_BAR_WORDS 3456
#define XB_SPIN_CAP (1u << 22)

__device__ __forceinline__ unsigned xb_ld(unsigned* p)              { return __hip_atomic_load(p, __ATOMIC_RELAXED, __HIP_MEMORY_SCOPE_AGENT); }
__device__ __forceinline__ unsigned xb_add(unsigned* p, unsigned v) { return __hip_atomic_fetch_add(p, v, __ATOMIC_RELAXED, __HIP_MEMORY_SCOPE_AGENT); }
__device__ __forceinline__ unsigned xb_xcc_id() { return (unsigned)__builtin_amdgcn_s_getreg((3 << 11) | 20) & 0xFu; }
#define XB_SPIN(cond, bar) do { unsigned _sp = 0; while (cond) { __builtin_amdgcn_s_sleep(1); \
    if ((++_sp & 255u) == 0u) { if (xb_ld(&(bar)[XB_TMO])) break; if (_sp > XB_SPIN_CAP) { atomicAdd(&(bar)[XB_TMO], 1u); break; } } } } while (0)

struct XcdBarrier {
    unsigned* bar; unsigned x;
    volatile LAS unsigned* st;
};

__device__ __forceinline__ XcdBarrier xcd_barrier_post(unsigned* bar, volatile LAS unsigned* st) {
    XcdBarrier b; b.bar = bar; b.x = xb_xcc_id(); b.st = st;
    if (threadIdx.x == 0) (void)xb_add(&bar[XB_XCNT(b.x)], 1u);
    return b;
}
__device__ __forceinline__ void xcd_barrier_complete(unsigned* bar, unsigned x, unsigned& nloc, unsigned& nx) {
    const unsigned G = gridDim.x * gridDim.y * gridDim.z;
    unsigned sum, cnt, mine, sp = 0u;
    for (;;) {
        sum = 0u; cnt = 0u; mine = 0u;
#pragma unroll
        for (unsigned j = 0; j < 16; ++j) { const unsigned c = xb_ld(&bar[XB_XCNT(j)]); sum += c; cnt += (c > 0u) ? 1u : 0u; mine = (j == x) ? c : mine; }
        if (sum == G) break;
        __builtin_amdgcn_s_sleep(1);
        if ((++sp & 255u) == 0u) { if (xb_ld(&bar[XB_TMO])) break; if (sp > XB_SPIN_CAP) { atomicAdd(&bar[XB_TMO], 1u); break; } }
    }
    nloc = mine > 0u ? mine : 1u; nx = cnt > 0u ? cnt : 1u;
}

__device__ __forceinline__ void xcd_barrier(const XcdBarrier& b) {
    asm volatile("s_waitcnt vmcnt(0)" ::: "memory");
    __syncthreads();
    if (threadIdx.x == 0) {
        unsigned* bar = b.bar;
        __builtin_amdgcn_s_waitcnt(0);
        unsigned nloc = b.st[0], nx = b.st[1];
        if (nloc == 0u) { xcd_barrier_complete(bar, b.x, nloc, nx); b.st[0] = nloc; b.st[1] = nx; }
        const unsigned old = xb_add(&bar[XB_XSUB(b.x)], 1u);
        const unsigned gen = old / nloc;
        if (old + 1u == (gen + 1u) * nloc) {
            __builtin_amdgcn_fence(__ATOMIC_RELEASE, "agent");
            asm volatile("s_waitcnt vmcnt(0)" ::: "memory");
            const unsigned og = xb_add(&bar[XB_TOP], 1u);
            const unsigned tg = og / nx;
            if (og + 1u == (tg + 1u) * nx) xb_add(&bar[XB_TOPGEN], 1u);
            else XB_SPIN(xb_ld(&bar[XB_TOPGEN]) == tg, bar);
            __builtin_amdgcn_fence(__ATOMIC_ACQUIRE, "agent");
            xb_add(&bar[XB_XGEN(b.x)], 1u);
            asm volatile("s_waitcnt vmcnt(0)" ::: "memory");
        } else {
            XB_SPIN(xb_ld(&bar[XB_XGEN(b.x)]) == gen, bar);
            __builtin_amdgcn_fence(__ATOMIC_ACQUIRE, "agent");
            asm volatile("s_waitcnt vmcnt(0)" ::: "memory");
        }
    }
    __syncthreads();
}


namespace pg8 {
#define PG8_LAS __attribute__((address_space(3)))
typedef unsigned short bf16_t;
typedef short bf16x8 __attribute__((ext_vector_type(8)));
typedef float f32x4 __attribute__((ext_vector_type(4)));
typedef unsigned u32x4 __attribute__((ext_vector_type(4)));
constexpr int BM = 256, BK = 64, HALF = 128, HTB = HALF * BK * 2  , STAGE_BYTES = 8 * HTB, NXCD = 8, WGM = 8;

__host__ __device__ __forceinline__ int lds_byte(int r, int c) { const int st = (r >> 4) * 2 + (c >> 5), rr = r & 15, cc = c & 31, ob = rr * 64 + cc * 2; return st * 1024 + (ob ^ (((ob >> 9) & 1) << 5)); }
__host__ __device__ __forceinline__ void stage_rc(int b, int& R, int& C) { const int st = b / 1024, sb = b % 1024, swz = sb ^ (((sb >> 9) & 1) << 5); R = (st >> 1) * 16 + swz / 64; C = (st & 1) * 32 + (swz % 64) / 2; }
__host__ __device__ __forceinline__ int perm32(int rho) { const int n = rho >> 4, i = rho & 15; return 8 * (i >> 2) + 4 * n + (i & 3); }

struct Unit { int pm, pn; };
struct Gemm { const bf16_t* A; const bf16_t* Bt; int M, N, K, lda, ldb; };

struct StaticOrder {
    int nM, nN, nwg, G, c;
    __host__ __device__ void init(int M, int N, int G_, int c_) { nM = M / BM; nN = N / BM; nwg = nM * nN; G = G_; c = c_; }
    __host__ __device__ bool next(int i, Unit& u) const {
        const long L = (long)i * G + c; if (L >= nwg) return false;
        int wgid = (int)L; { const int q = nwg / NXCD, r = nwg % NXCD, xcd = wgid % NXCD, off = wgid / NXCD; wgid = (xcd < r ? xcd * (q + 1) : r * (q + 1) + (xcd - r) * q) + off; }
        const int nig = WGM * nN, gid = wgid / nig, fm = gid * WGM, gsz = (nM - fm) < WGM ? (nM - fm) : WGM;
        u.pm = fm + ((wgid % nig) % gsz); u.pn = (wgid % nig) / gsz; return true;
    }
    __device__ __forceinline__ void a_ready(const Unit&) const {}
    __device__ __forceinline__ void done(const Unit&) const {}
};
__device__ __forceinline__ unsigned cvt_pk_bf16(float lo, float hi) { return ::pk2(lo, hi); }
template <class Epi, class Sched, bool ALIGN_EPI = false, bool SP2 = false>
__device__ __forceinline__ void gemm_phase(PG8_LAS unsigned char* lds, const Gemm g, const Sched& S, const Epi& E) {
    int tid_ = threadIdx.x; asm volatile("" : "+v"(tid_));
    const int tid = tid_, wid = __builtin_amdgcn_readfirstlane(tid >> 6), lane = tid & 63, wr = wid >> 2, wc = wid & 3, fr = lane & 15, fq = lane >> 4;
    const int K = g.K, nt = K / BK;
    unsigned voffA[2], voffB[2];
#pragma unroll
    for (int i = 0; i < 2; ++i) { int R, C; stage_rc(tid * 16 + i * 8192, R, C); const int Rb = Epi::PERM ? ((R & ~31) + perm32(R & 31)) : R;
        voffA[i] = (unsigned)(R * g.lda + C) * 2u; voffB[i] = (unsigned)(Rb * g.ldb + C) * 2u; }
    const size_t kstep = (size_t)(BK * 2);
    const size_t hstepA = (size_t)HALF * g.lda * 2, hstepB = (size_t)HALF * g.ldb * 2;
    const size_t tstepA = 2 * hstepA, tstepB = 2 * hstepB;
    const unsigned ldsw = (unsigned)wid * 1024u;
    const int aoff = lds_byte(wr * 64 + fr, fq * 8), boff = lds_byte(wc * 32 + fr, fq * 8);
#define PG8_SA(b, h) (((b) * 2 + (h)) * HTB)
#define PG8_SB(b, h) ((4 + (b) * 2 + (h)) * HTB)
#define PG8_STAGE(bufoff, gbase, voff) do { _Pragma("unroll") for (int _i = 0; _i < 2; ++_i) \
        __builtin_amdgcn_global_load_lds((const unsigned*)((const char*)(gbase) + (voff)[_i]), (PG8_LAS unsigned*)(lds + (bufoff) + ldsw + _i * 8192), 16, 0, 0); } while (0)
#define PG8_LDA(dst, b, h) do { _Pragma("unroll") for (int m = 0; m < 4; ++m) _Pragma("unroll") for (int k = 0; k < 2; ++k) dst[m][k] = *(const PG8_LAS bf16x8*)(lds + PG8_SA(b, h) + aoff + m * 2048 + k * 1024); } while (0)
#define PG8_LDB(dst, b, h) do { _Pragma("unroll") for (int n = 0; n < 2; ++n) _Pragma("unroll") for (int k = 0; k < 2; ++k) dst[n][k] = *(const PG8_LAS bf16x8*)(lds + PG8_SB(b, h) + boff + n * 2048 + k * 1024); } while (0)
#define PG8_MMA(ai, bj, At, Bt) do { __builtin_amdgcn_s_setprio(1); _Pragma("unroll") for (int m = 0; m < 4; ++m) _Pragma("unroll") for (int n = 0; n < 2; ++n) _Pragma("unroll") for (int k = 0; k < 2; ++k) \
        acc[ai][bj][m][n] = __builtin_amdgcn_mfma_f32_16x16x32_bf16(Bt[n][k], At[m][k], acc[ai][bj][m][n], 0, 0, 0); __builtin_amdgcn_s_setprio(0); } while (0)
#define PG8_WAIT_V(n) asm volatile("s_waitcnt vmcnt(" #n ")" ::: "memory")
#define PG8_WAIT_L(n) asm volatile("s_waitcnt lgkmcnt(" #n ")" ::: "memory")
#define PG8_BAR __builtin_amdgcn_s_barrier()
#define PG8_SCHED __builtin_amdgcn_sched_barrier(0)
    Unit cur, nxt; int ui = 0;
    if (!S.next(0, cur)) return;
    f32x4 acc[2][2][4][2];
#pragma unroll
    for (int a = 0; a < 2; ++a)
#pragma unroll
        for (int b = 0; b < 2; ++b)
#pragma unroll
            for (int m = 0; m < 4; ++m)
#pragma unroll
                for (int n = 0; n < 2; ++n) acc[a][b][m][n] = (f32x4){0.f, 0.f, 0.f, 0.f};
    bf16x8 At[4][2], B0[2][2], B1[2][2];
    const char* cA = (const char*)g.A + (size_t)cur.pm * tstepA; const char* cB = (const char*)g.Bt + (size_t)cur.pn * tstepB;
    S.a_ready(cur);
    if constexpr (SP2) {
        PG8_STAGE(PG8_SB(0, 0), cB, voffB); PG8_STAGE(PG8_SB(0, 1), cB + hstepB, voffB); PG8_STAGE(PG8_SA(0, 0), cA, voffA); PG8_STAGE(PG8_SA(0, 1), cA + hstepA, voffA);
        if (wr == 1) PG8_BAR;
        PG8_WAIT_V(2); PG8_BAR;
        PG8_STAGE(PG8_SB(1, 0), cB + kstep, voffB); PG8_STAGE(PG8_SA(1, 0), cA + kstep, voffA); PG8_STAGE(PG8_SB(1, 1), cB + hstepB + kstep, voffB);
        PG8_WAIT_V(6); PG8_BAR;
    } else {
        PG8_STAGE(PG8_SB(0, 0), cB, voffB); PG8_STAGE(PG8_SA(0, 0), cA, voffA); PG8_STAGE(PG8_SB(0, 1), cB + hstepB, voffB); PG8_STAGE(PG8_SA(0, 1), cA + hstepA, voffA);
        if (wr == 1) PG8_BAR;
        PG8_WAIT_V(4); PG8_BAR;
        PG8_STAGE(PG8_SB(1, 0), cB + kstep, voffB); PG8_STAGE(PG8_SA(1, 0), cA + kstep, voffA); PG8_STAGE(PG8_SB(1, 1), cB + hstepB + kstep, voffB);
        PG8_WAIT_V(6); PG8_BAR;
    }
    for (;;) {
        const bool has_next = S.next(ui + 1, nxt);
        const char* nA = has_next ? (const char*)g.A + (size_t)nxt.pm * tstepA : cA; const char* nB = has_next ? (const char*)g.Bt + (size_t)nxt.pn * tstepB : cB;
        for (int t = 0; t < nt; t += 2) {
            const bool last = (t == nt - 2);
            const char* a1 = cA + (size_t)(t + 1) * kstep;
            const char* a2 = last ? nA : cA + (size_t)(t + 2) * kstep; const char* b2 = last ? nB : cB + (size_t)(t + 2) * kstep;
            const char* a3 = a2 + kstep; const char* b3 = b2 + kstep;
            if (last && has_next) S.a_ready(nxt);
            if constexpr (SP2) {
            PG8_LDB(B0, 0, 0); PG8_LDB(B1, 0, 1); PG8_SCHED; PG8_LDA(At, 0, 0); PG8_STAGE(PG8_SA(1, 1), a1 + hstepA, voffA);
            PG8_WAIT_V(8); PG8_WAIT_L(0); PG8_BAR; PG8_MMA(0, 0, At, B0); PG8_MMA(0, 1, At, B1); PG8_BAR; PG8_SCHED;
            PG8_LDA(At, 0, 1); PG8_STAGE(PG8_SB(0, 0), b2, voffB); PG8_STAGE(PG8_SB(0, 1), b2 + hstepB, voffB); PG8_STAGE(PG8_SA(0, 0), a2, voffA);
            PG8_WAIT_V(8); PG8_WAIT_L(0); PG8_BAR; PG8_MMA(1, 0, At, B0); PG8_MMA(1, 1, At, B1); PG8_BAR; PG8_SCHED;
            PG8_LDB(B0, 1, 0); PG8_LDB(B1, 1, 1); PG8_SCHED; PG8_LDA(At, 1, 0); PG8_STAGE(PG8_SA(0, 1), a2 + hstepA, voffA);
            PG8_WAIT_V(8); PG8_WAIT_L(0); PG8_BAR; PG8_MMA(0, 0, At, B0); PG8_MMA(0, 1, At, B1); PG8_BAR; PG8_SCHED;
            PG8_LDA(At, 1, 1); PG8_STAGE(PG8_SB(1, 0), b3, voffB); PG8_STAGE(PG8_SB(1, 1), b3 + hstepB, voffB); PG8_STAGE(PG8_SA(1, 0), a3, voffA);
            PG8_WAIT_V(8); PG8_WAIT_L(0); PG8_BAR; PG8_MMA(1, 0, At, B0); PG8_MMA(1, 1, At, B1); PG8_BAR; PG8_SCHED;
            } else {
            PG8_LDB(B0, 0, 0); PG8_SCHED; PG8_LDA(At, 0, 0); PG8_STAGE(PG8_SA(1, 1), a1 + hstepA, voffA);
            PG8_WAIT_L(8); PG8_BAR; PG8_WAIT_L(0); PG8_MMA(0, 0, At, B0); PG8_BAR; PG8_SCHED;
            PG8_LDB(B1, 0, 1); PG8_STAGE(PG8_SB(0, 0), b2, voffB);
            PG8_BAR; PG8_WAIT_L(0); PG8_MMA(0, 1, At, B1); PG8_BAR;
            PG8_LDA(At, 0, 1); PG8_STAGE(PG8_SA(0, 0), a2, voffA);
            PG8_BAR; PG8_WAIT_L(0); PG8_MMA(1, 0, At, B0); PG8_BAR; PG8_SCHED;
            PG8_STAGE(PG8_SB(0, 1), b2 + hstepB, voffB);
            PG8_WAIT_V(6); PG8_BAR; PG8_MMA(1, 1, At, B1); PG8_BAR;
            PG8_LDB(B0, 1, 0); PG8_SCHED; PG8_LDA(At, 1, 0); PG8_STAGE(PG8_SA(0, 1), a2 + hstepA, voffA);
            PG8_WAIT_L(8); PG8_BAR; PG8_WAIT_L(0); PG8_MMA(0, 0, At, B0); PG8_BAR; PG8_SCHED;
            PG8_LDB(B1, 1, 1); PG8_STAGE(PG8_SB(1, 0), b3, voffB);
            PG8_BAR; PG8_WAIT_L(0); PG8_MMA(0, 1, At, B1); PG8_BAR;
            PG8_LDA(At, 1, 1); PG8_STAGE(PG8_SA(1, 0), a3, voffA);
            PG8_BAR; PG8_WAIT_L(0); PG8_MMA(1, 0, At, B0); PG8_BAR; PG8_SCHED;
            PG8_STAGE(PG8_SB(1, 1), b3 + hstepB, voffB);
            PG8_WAIT_V(6); PG8_BAR; PG8_MMA(1, 1, At, B1); PG8_BAR;
            }
        }
        if constexpr (ALIGN_EPI) { if (wr == 0) PG8_BAR; }
        if constexpr (!Epi::AFTER_DRAIN) { E(acc, cur, wr, wc, fr, fq); S.done(cur); }
        if (!has_next) break;
#pragma unroll
        for (int a = 0; a < 2; ++a)
#pragma unroll
            for (int b = 0; b < 2; ++b)
#pragma unroll
                for (int m = 0; m < 4; ++m)
#pragma unroll
                    for (int n = 0; n < 2; ++n) acc[a][b][m][n] = (f32x4){0.f, 0.f, 0.f, 0.f};
        cur = nxt; cA = nA; cB = nB; ++ui;
        if constexpr (ALIGN_EPI) { if (wr == 1) PG8_BAR; }
    }
    PG8_WAIT_V(0);
    if constexpr (!ALIGN_EPI) { if (wr == 0) PG8_BAR; }
    PG8_BAR;
    if constexpr (Epi::AFTER_DRAIN) { E.fused(acc, cur, wr, wc, fr, fq, lds, wid, lane); S.done(cur); }
#undef PG8_SA
#undef PG8_SB
#undef PG8_STAGE
#undef PG8_LDA
#undef PG8_LDB
#undef PG8_MMA
#undef PG8_WAIT_V
#undef PG8_WAIT_L
#undef PG8_BAR
#undef PG8_SCHED
}
}

namespace pg8 {
__device__ __forceinline__ float sigmoidf_(float v) { return 1.f / (1.f + __expf(-v)); }
__device__ __forceinline__ void unpack8(const u32x4 w, float (&f)[8]) {
    f[0] = __uint_as_float(w.x << 16); f[1] = __uint_as_float(w.x & 0xffff0000u); f[2] = __uint_as_float(w.y << 16); f[3] = __uint_as_float(w.y & 0xffff0000u);
    f[4] = __uint_as_float(w.z << 16); f[5] = __uint_as_float(w.z & 0xffff0000u); f[6] = __uint_as_float(w.w << 16); f[7] = __uint_as_float(w.w & 0xffff0000u);
}
template <int MODE> struct EpiX {
    static constexpr bool PERM = true, AFTER_DRAIN = false;
    bf16_t* O; bf16_t* G; const float* xres; const float* gate; float* outf; int ldc; int pad; bf16_t* KCa; bf16_t* KCb; bf16_t* KI; bf16_t* WI;
    __device__ __forceinline__ void operator()(const f32x4 (&acc)[2][2][4][2], const Unit& u, int wr, int wc, int fr, int fq) const {
        const int row0 = u.pm * BM + wr * 64 + fr;
        int colt = u.pn * BM; bf16_t* base = O; int ld = ldc; bool sig = false;
        if (MODE == 1) { if (u.pn >= 15) { colt -= 15 * BM; base = G; ld = GW; sig = true; }
            else if (u.pn >= 10) {
#pragma unroll
                for (int ai = 0; ai < 2; ++ai)
#pragma unroll
                    for (int m = 0; m < 4; ++m) {
                        const int row = row0 + ai * HALF + m * 16, bb = row / S, ss = row % S;
#pragma unroll
                        for (int bj = 0; bj < 2; ++bj) {
                            const int c = wc * 32 + 8 * fq + bj * HALF;
                            const f32x4 v0 = acc[ai][bj][m][0], v1 = acc[ai][bj][m][1];
                            u32x4 w; w.x = cvt_pk_bf16(v0[0], v0[1]); w.y = cvt_pk_bf16(v0[2], v0[3]); w.z = cvt_pk_bf16(v1[0], v1[1]); w.w = cvt_pk_bf16(v1[2], v1[3]);
                            if (u.pn < 14) { const int cc = ((u.pn - 10) & 1) * BM + c; bf16_t* kc = (u.pn < 12) ? KCa : KCb;
                                *(u32x4*)(kc + ((size_t)(bb * 8 + (cc >> 6)) * S + ss) * 64 + (cc & 63)) = w; }
                            else if (c < 64) *(u32x4*)(KI + (size_t)row * 64 + c) = w;
                            else if (c == 64) *(u32x4*)(WI + (size_t)row * 8) = w;
                        }
                    }
                return;
            } }
        if (MODE == 2 || MODE == 3) { base = G; ld = GW; }
        const int col0 = colt + wc * 32 + 8 * fq;
#pragma unroll
        for (int ai = 0; ai < 2; ++ai)
#pragma unroll
            for (int m = 0; m < 4; ++m) {
                const int row = row0 + ai * HALF + m * 16;
#pragma unroll
                for (int bj = 0; bj < 2; ++bj) {
                    const int col = col0 + bj * HALF;
                    f32x4 v0 = acc[ai][bj][m][0], v1 = acc[ai][bj][m][1];
                    if (MODE == 4) {
                        const size_t o = (size_t)row * 1024 + col;
                        const f32x4 x0 = __builtin_nontemporal_load((const f32x4*)(xres + o)), x1 = __builtin_nontemporal_load((const f32x4*)(xres + o + 4));
                        const float* gp = gate + (row / S) * 6144 + col;
                        const f32x4 g0 = *(const f32x4*)gp, g1 = *(const f32x4*)(gp + 4);
                        *(f32x4*)(outf + o) = x0 + g0 * v0; *(f32x4*)(outf + o + 4) = x1 + g1 * v1;
                    } else {
                        bf16_t* pp = base + (size_t)row * ld + col;
                        if (MODE == 1) { if (sig) {
#pragma unroll
                            for (int e = 0; e < 4; ++e) { v0[e] = sigmoidf_(v0[e]); v1[e] = sigmoidf_(v1[e]); } } }
                        if (MODE == 2) { float t[8]; unpack8(*(const u32x4*)pp, t);
#pragma unroll
                            for (int e = 0; e < 4; ++e) { v0[e] *= t[e]; v1[e] *= t[4 + e]; } }
                        if (MODE == 3) { float t[8], gg[8]; unpack8(*(const u32x4*)pp, t); unpack8(*(const u32x4*)(pp + 1024), gg);
#pragma unroll
                            for (int e = 0; e < 4; ++e) { v0[e] = t[e] + gg[e] * v0[e]; v1[e] = t[4 + e] + gg[4 + e] * v1[e]; } }
                        u32x4 w; w.x = cvt_pk_bf16(v0[0], v0[1]); w.y = cvt_pk_bf16(v0[2], v0[3]); w.z = cvt_pk_bf16(v1[0], v1[1]); w.w = cvt_pk_bf16(v1[2], v1[3]);
                        *(u32x4*)pp = w;
                    }
                }
            }
    }
};
}
struct Params {
    const float *x, *c, *w_ada, *b_ada, *g1, *g2, *w_in, *rel_bias, *wpa, *wpb, *wout, *wq, *sk, *pu, *pv, *fg;
    float* out; unsigned char* ws;
};
__device__ __forceinline__ int opaque_tid() { int t = threadIdx.x; asm volatile("" : "+v"(t)); return t; }
typedef unsigned v4u __attribute__((ext_vector_type(4)));
#define LDS_WAIT() asm volatile("s_waitcnt lgkmcnt(0)" ::: "memory")

constexpr size_t WS_BAR = 0;
constexpr size_t CTL_ZERO_BYTES = 16384;
constexpr size_t WS_MOD = 64 * 1024;
constexpr size_t WS_WIN = 1 * MiB;
constexpr size_t WS_WPA = 13 * MiB, WS_WPB = 14 * MiB;
constexpr size_t WS_WOUT = 15 * MiB;
constexpr size_t WS_WQ = 17 * MiB;
constexpr size_t WS_PROJ = 22 * MiB;
constexpr size_t WS_KCA = 102 * MiB, WS_KCB = 118 * MiB;
constexpr size_t WS_KI = 134 * MiB, WS_WI = 136 * MiB;
constexpr size_t WS_G = 142 * MiB;
constexpr size_t WS_YA = 206 * MiB, WS_YB = 222 * MiB;
constexpr size_t WS_HN2 = 22 * MiB;
constexpr size_t WS_QH = 54 * MiB;
constexpr size_t WS_SKB = 21 * MiB;
constexpr size_t WS_EIDX = 118 * MiB;
constexpr size_t WS_GATE = 122 * MiB;
constexpr size_t WS_TAB = 130 * MiB;
constexpr size_t WS_SCALES = 162 * MiB;
constexpr size_t WS_VT = 238 * MiB;
constexpr size_t WS_NEED = 254 * MiB;
constexpr int LDS_SC_OFF = 7 * 16384 + 8448;

__device__ __forceinline__ void ph_mod(const Params& p, float* mod, float* sc) {
    float* part = sc + 2048;
    const int tid = threadIdx.x, kk = tid >> 3, cc = tid & 7;
    for (int i = tid; i < 2048; i += NTHR) { float v = p.c[i]; sc[i] = v / (1.f + expf(-v)); }
    __syncthreads();
    for (int unit = blockIdx.x; unit < 6144 / 24; unit += gridDim.x) {
        const int col = unit * 24 + 3 * cc;
        float a[2][3] = {{0.f, 0.f, 0.f}, {0.f, 0.f, 0.f}};
#pragma unroll 4
        for (int k = kk; k < 1024; k += 64) {
            const float* w = p.w_ada + (size_t)k * 6144 + col;
            const float w0 = __builtin_nontemporal_load(w), w1 = __builtin_nontemporal_load(w + 1), w2 = __builtin_nontemporal_load(w + 2), s0 = sc[k], s1 = sc[1024 + k];
            a[0][0] += s0 * w0; a[0][1] += s0 * w1; a[0][2] += s0 * w2; a[1][0] += s1 * w0; a[1][1] += s1 * w1; a[1][2] += s1 * w2;
        }
#pragma unroll
        for (int b = 0; b < 2; ++b)
#pragma unroll
            for (int j = 0; j < 3; ++j) part[kk * 48 + b * 24 + 3 * cc + j] = a[b][j];
        __syncthreads();
        if (tid < 48) { float s = 0.f; for (int q = 0; q < 64; ++q) s += part[q * 48 + tid]; const int b = tid / 24, j = unit * 24 + tid % 24; mod[b * 6144 + j] = s + p.b_ada[j]; }
        __syncthreads();
    }
}

template <class CM> __device__ __forceinline__ void transpose_item(const float* W, int ldw, int K, bf16* WT, LAS float* scr, int item, int nblk, int lane, const CM& cm) {
    const int kb = item / nblk, nb = item % nblk, k0 = 64 * kb, n0 = 32 * nb;
    const int sc = cm(n0 + (lane & 31));
#pragma unroll 8
    for (int i = 0; i < 32; ++i) { const int kk = 2 * i + (lane >> 5); scr[kk * 33 + (lane & 31)] = (sc >= 0) ? __builtin_nontemporal_load(W + (size_t)(k0 + kk) * ldw + sc) : 0.f; }
    LDS_WAIT(); asm volatile("" ::: "memory");
    const int c = lane & 7;
#pragma unroll
    for (int j = 0; j < 4; ++j) { const int n = (lane >> 3) + 8 * j; const LAS float* s = scr + (8 * c) * 33 + n;
        v4u o; o.x = pk2(s[0 * 33], s[1 * 33]); o.y = pk2(s[2 * 33], s[3 * 33]); o.z = pk2(s[4 * 33], s[5 * 33]); o.w = pk2(s[6 * 33], s[7 * 33]);
        *(v4u*)(WT + (size_t)(n0 + n) * K + k0 + 8 * c) = o; }
    LDS_WAIT(); asm volatile("" ::: "memory");
}
struct CmIdent { __device__ __forceinline__ int operator()(int n) const { return n; } };
struct CmWin {
    __device__ __forceinline__ int operator()(int n) const {
        if (n < 512) return n;
        if (n < 1024) return 1024 + (n - 512);
        if (n < 1536) return 1536 + (n - 1024);
        if (n < 2048) return 2120 + (n - 1536);
        if (n < 2560) return 3144 + (n - 2048);
        if (n < 3072) return 512 + (n - 2560);
        if (n < 3584) return 2632 + (n - 3072);
        if (n < 3648) return 2048 + (n - 3584);
        if (n < 3656) return 2112 + (n - 3648);
        if (n < 3840) return -1;
        return 3656 + (n - 3840);
    }
};
__device__ __forceinline__ void ph_weights(const Params& p, LAS unsigned char* lds) {
    unsigned char* ws = p.ws;
    const int wave = __builtin_amdgcn_readfirstlane(threadIdx.x >> 6), lane = threadIdx.x & 63;
    LAS float* scr = (LAS float*)(lds + wave * 16384);
    const int gw = blockIdx.x * NWAVES + wave, NGW = gridDim.x * NWAVES;
    constexpr int I_IN = 16 * (NPROJ / 32), I_PA = 8 * 32, I_PB = 8 * 32, I_OUT = 16 * 32, I_Q = 16 * 64;
    constexpr int NITEMS = I_IN + I_PA + I_PB + I_OUT + I_Q;
    for (int it = gw; it < NITEMS; it += NGW) {
        int r = it;
        if (r < I_IN) { transpose_item(p.w_in, INW, 1024, (bf16*)(ws + WS_WIN), scr, r, NPROJ / 32, lane, CmWin()); continue; } r -= I_IN;
        if (r < I_PA) { transpose_item(p.wpa, 1024, 512, (bf16*)(ws + WS_WPA), scr, r, 32, lane, CmIdent()); continue; } r -= I_PA;
        if (r < I_PB) { transpose_item(p.wpb, 1024, 512, (bf16*)(ws + WS_WPB), scr, r, 32, lane, CmIdent()); continue; } r -= I_PB;
        if (r < I_OUT) { transpose_item(p.wout, 1024, 1024, (bf16*)(ws + WS_WOUT), scr, r, 32, lane, CmIdent()); continue; } r -= I_OUT;
        transpose_item(p.wq, 2048, 1024, (bf16*)(ws + WS_WQ), scr, r, 64, lane, CmIdent());
    }
    for (int i = gw * 64 + lane; i < 8 * 2 * 128 * 128 / 4; i += NGW * 64) {
        const float4 v = ((const float4*)p.sk)[i]; uint2 w; w.x = pk2(v.x, v.y); w.y = pk2(v.z, v.w); ((uint2*)(ws + WS_SKB))[i] = w;
    }
}

template <bool NT> __device__ __forceinline__ void ph_norm(const float* src, const float* g, const float* mod, int shift_i, int scale_i, bf16* dst) {
    const int lane = threadIdx.x & 63, gw = blockIdx.x * NWAVES + __builtin_amdgcn_readfirstlane(threadIdx.x >> 6), ngw = gridDim.x * NWAVES;
    for (int t = gw; t < T; t += ngw) {
        const int b = t / S;
        float4 v[4]; float ss = 0.f;
#pragma unroll
        for (int i = 0; i < 4; ++i) { const f32x4_t t_ = NT ? __builtin_nontemporal_load((const f32x4_t*)(src + (size_t)t * D) + lane + 64 * i) : *((const f32x4_t*)(src + (size_t)t * D) + lane + 64 * i); v[i] = make_float4(t_.x, t_.y, t_.z, t_.w); ss += v[i].x * v[i].x + v[i].y * v[i].y + v[i].z * v[i].z + v[i].w * v[i].w; }
        ss = wave_sum(ss);
        const float r = rsqrtf(ss * (1.f / D) + EPS);
#pragma unroll
        for (int i = 0; i < 4; ++i) {
            const float4 gg = ((const float4*)g)[lane + 64 * i];
            const float4 sh = ((const float4*)(mod + b * 6144 + shift_i * D))[lane + 64 * i];
            const float4 sc = ((const float4*)(mod + b * 6144 + scale_i * D))[lane + 64 * i];
            float4 o;
            o.x = v[i].x * r * gg.x * (1.f + sc.x) + sh.x; o.y = v[i].y * r * gg.y * (1.f + sc.y) + sh.y;
            o.z = v[i].z * r * gg.z * (1.f + sc.z) + sh.z; o.w = v[i].w * r * gg.w * (1.f + sc.w) + sh.w;
            uint2 w; w.x = pk2(o.x, o.y); w.y = pk2(o.z, o.w);
            ((uint2*)(dst + (size_t)t * D))[lane + 64 * i] = w;
        }
    }
}
__device__ __forceinline__ unsigned f2ord(float f) { unsigned u = __float_as_uint(f); return (u & 0x80000000u) ? ~u : (u | 0x80000000u); }
__device__ __forceinline__ int t5_bucket(int n) {
    if (n < 16) return n;
    int large = 16 + (int)(logf((float)n * (1.f / 16.f)) / 2.0794415416798357f * 16.f);
    return large < 31 ? large : 31;
}

typedef short bf16x8_t __attribute__((ext_vector_type(8)));
template <int CTRL> __device__ __forceinline__ unsigned dppu(unsigned x) { return (unsigned)__builtin_amdgcn_mov_dpp((int)x, CTRL, 0xf, 0xf, true); }
template <int CTRL> __device__ __forceinline__ float dppf(float x) { return __builtin_bit_cast(float, __builtin_amdgcn_mov_dpp(__builtin_bit_cast(int, x), CTRL, 0xf, 0xf, true)); }
__device__ __forceinline__ unsigned row_max_u(unsigned x) { x = max(x, dppu<0xB1>(x)); x = max(x, dppu<0x4E>(x)); x = max(x, dppu<0x141>(x)); x = max(x, dppu<0x128>(x)); return x; }
__device__ __forceinline__ float row_max_f(float x) { x = fmaxf(x, dppf<0xB1>(x)); x = fmaxf(x, dppf<0x4E>(x)); x = fmaxf(x, dppf<0x141>(x)); x = fmaxf(x, dppf<0x128>(x)); return x; }
__device__ __forceinline__ float row_sum_f(float x) { x += dppf<0xB1>(x); x += dppf<0x4E>(x); x += dppf<0x141>(x); x += dppf<0x128>(x); return x; }
__device__ __forceinline__ float ord2f(unsigned k) { return __uint_as_float((k & 0x80000000u) ? (k & 0x7fffffffu) : ~k); }
__device__ __forceinline__ unsigned max3u(unsigned a, unsigned b, unsigned c) { return max(max(a, b), c); }

__device__ __forceinline__ void ph_quant(const Params& p, unsigned char* tab, float* scales) {
    const int lane = threadIdx.x & 63, gw = blockIdx.x * NWAVES + __builtin_amdgcn_readfirstlane(threadIdx.x >> 6), ngw = gridDim.x * NWAVES;
    for (int r = gw; r < 32768; r += ngw) {
        const float* src = (r < 16384) ? p.pu + (size_t)r * D : p.pv + (size_t)(r - 16384) * D;
        float4 v[4]; float am = 0.f;
#pragma unroll
        for (int i = 0; i < 4; ++i) { const f32x4_t t_ = __builtin_nontemporal_load((const f32x4_t*)src + lane + 64 * i); v[i] = make_float4(t_.x, t_.y, t_.z, t_.w);     am = fmaxf(am, fmaxf(fmaxf(fabsf(v[i].x), fabsf(v[i].y)), fmaxf(fabsf(v[i].z), fabsf(v[i].w)))); }
#pragma unroll
        for (int o = 1; o < 64; o <<= 1) am = fmaxf(am, __shfl_xor(am, o));
        const float inv = am > 0.f ? 127.f / am : 0.f;
        uint4 w; unsigned* wp = (unsigned*)&w;
#pragma unroll
        for (int i = 0; i < 4; ++i) {
            const int q0 = (int)rintf(v[i].x * inv) + 128, q1 = (int)rintf(v[i].y * inv) + 128, q2 = (int)rintf(v[i].z * inv) + 128, q3 = (int)rintf(v[i].w * inv) + 128;
            wp[i] = (unsigned)q0 | ((unsigned)q1 << 8) | ((unsigned)q2 << 16) | ((unsigned)q3 << 24);
        }
        ((uint4*)(tab + (size_t)r * 1024))[lane] = w;
        if (lane == 0) scales[r] = am * (1.f / 127.f);
    }
}

#define CE_DESC(x, y) do { const unsigned hi_ = max(x, y), lo_ = min(x, y); x = hi_; y = lo_; } while (0)
__device__ __forceinline__ int hull_ab(int c) {
    int a = 0, base = 0; bool done = false;
#pragma unroll
    for (int aa = 0; aa < 16; ++aa) { const int nb = 16 / (aa + 1); if (!done) { if (c >= base + nb) { base += nb; a = aa + 1; } else done = true; } }
    return (c < 50) ? ((a << 4) | (c - base)) : -1;
}
__device__ __forceinline__ void ph_peer_select(const bf16* qh, const bf16* skb, unsigned short* eidx, float* gate) {
    const int tid = opaque_tid();
    const int lane = tid & 63, fr = lane & 15, fq = lane >> 4;
    const int gw = blockIdx.x * NWAVES + __builtin_amdgcn_readfirstlane(tid >> 6), ngw = gridDim.x * NWAVES;
    int hab[4];
#pragma unroll
    for (int s = 0; s < 4; ++s) hab[s] = hull_ab(16 * s + fr);
    for (int unit = gw; unit < (T / 16) * 2; unit += ngw) {
        const int t0 = (unit >> 1) * 16, hh = unit & 1;
#pragma unroll 1
        for (int hi = 0; hi < 4; ++hi) {
            const int h = hh * 4 + hi;
            unsigned win[2][4];
#pragma unroll
            for (int c = 0; c < 2; ++c) {
                f32x4_t acc[8];
#pragma unroll
                for (int nt = 0; nt < 8; ++nt) acc[nt] = (f32x4_t){0.f, 0.f, 0.f, 0.f};
                const bf16* qrow = qh + (size_t)(t0 + fr) * 2048 + h * 256 + c * 128 + 8 * fq;
                bf16x8_t a[4];
#pragma unroll
                for (int ks = 0; ks < 4; ++ks) a[ks] = *(const bf16x8_t*)(qrow + 32 * ks);
                const bf16* kb = skb + ((size_t)(h * 2 + c) * 128 + fr) * 128 + 8 * fq;
#pragma unroll
                for (int nt = 0; nt < 8; ++nt)
#pragma unroll
                    for (int ks = 0; ks < 4; ++ks) { const bf16x8_t b = *(const bf16x8_t*)(kb + (size_t)nt * 16 * 128 + 32 * ks); acc[nt] = __builtin_amdgcn_mfma_f32_16x16x32_bf16(a[ks], b, acc[nt], 0, 0, 0); }
                unsigned pk[8][4];
#pragma unroll
                for (int nt = 0; nt < 8; ++nt)
#pragma unroll
                    for (int i = 0; i < 4; ++i) pk[nt][i] = (f2ord(acc[nt][i]) & ~127u) | (127u - (unsigned)(16 * nt + fr));
#pragma unroll
                for (int i = 0; i < 4; ++i) {
                    CE_DESC(pk[0][i], pk[1][i]); CE_DESC(pk[2][i], pk[3][i]); CE_DESC(pk[4][i], pk[5][i]); CE_DESC(pk[6][i], pk[7][i]);
                    CE_DESC(pk[0][i], pk[2][i]); CE_DESC(pk[1][i], pk[3][i]); CE_DESC(pk[4][i], pk[6][i]); CE_DESC(pk[5][i], pk[7][i]);
                    CE_DESC(pk[1][i], pk[2][i]); CE_DESC(pk[5][i], pk[6][i]);
                    CE_DESC(pk[0][i], pk[4][i]); CE_DESC(pk[1][i], pk[5][i]); CE_DESC(pk[2][i], pk[6][i]); CE_DESC(pk[3][i], pk[7][i]);
                    CE_DESC(pk[2][i], pk[4][i]); CE_DESC(pk[3][i], pk[5][i]);
                    CE_DESC(pk[1][i], pk[2][i]); CE_DESC(pk[3][i], pk[4][i]); CE_DESC(pk[5][i], pk[6][i]);
                }
#pragma unroll
                for (int r = 0; r < 16; ++r)
#pragma unroll
                    for (int i = 0; i < 4; ++i) {
                        const unsigned m = row_max_u(pk[0][i]);
                        if (fr == r) win[c][i] = m;
                        const bool w = pk[0][i] == m;
#pragma unroll
                        for (int nt = 0; nt < 7; ++nt) pk[nt][i] = w ? pk[nt + 1][i] : pk[nt][i];
                        pk[7][i] = w ? 0u : pk[7][i];
                    }
            }
#pragma unroll
            for (int i = 0; i < 4; ++i) {
                unsigned ck[4];
#pragma unroll
                for (int s = 0; s < 4; ++s) {
                    const int ab = hab[s] < 0 ? 0 : hab[s];
                    const unsigned wa = (unsigned)__shfl((int)win[0][i], (lane & 48) + (ab >> 4)), wb = (unsigned)__shfl((int)win[1][i], (lane & 48) + (ab & 15));
                    const float v = ord2f(wa & ~127u) + ord2f(wb & ~127u);
                    ck[s] = hab[s] < 0 ? 0u : ((f2ord(v) & ~255u) | (255u - (unsigned)ab));
                }
                unsigned mywin = 0u;
#pragma unroll
                for (int r = 0; r < 16; ++r) {
                    unsigned m = max(max(ck[0], ck[1]), max(ck[2], ck[3]));
                    m = row_max_u(m);
                    if (fr == r) mywin = m;
#pragma unroll
                    for (int s = 0; s < 4; ++s) ck[s] = (ck[s] == m) ? 0u : ck[s];
                }
                const unsigned ci = 255u - (mywin & 255u);
                const unsigned w0 = (unsigned)__shfl((int)win[0][i], (lane & 48) + (int)(ci >> 4)), w1 = (unsigned)__shfl((int)win[1][i], (lane & 48) + (int)(ci & 15u));
                const int e = (int)(127u - (w0 & 127u)) * 128 + (int)(127u - (w1 & 127u));
                const float s = ord2f(w0 & ~127u) + ord2f(w1 & ~127u);
                const float mx = row_max_f(s);
                const float ex = __expf(s - mx);
                const float sum = row_sum_f(ex);
                const int t = t0 + 4 * fq + i;
                eidx[(size_t)t * 128 + h * 16 + fr] = (unsigned short)e;
                gate[(size_t)t * 128 + h * 16 + fr] = ex / sum;
            }
        }
    }
}

__device__ __forceinline__ float wave_total_dpp(float x) {
    x = row_sum_f(x);
    return __builtin_bit_cast(float, __builtin_amdgcn_readlane(__builtin_bit_cast(int, x), 0)) + __builtin_bit_cast(float, __builtin_amdgcn_readlane(__builtin_bit_cast(int, x), 16)) +
           __builtin_bit_cast(float, __builtin_amdgcn_readlane(__builtin_bit_cast(int, x), 32)) + __builtin_bit_cast(float, __builtin_amdgcn_readlane(__builtin_bit_cast(int, x), 48));
}
__device__ __forceinline__ float gelu_erf(float x) { return 0.5f * x * (1.f + erff(x * 0.70710678118654752f)); }
__device__ __forceinline__ void ph_peer_gather(const Params& p, const bf16* hn2, const unsigned short* eidx, const float* gate, const unsigned char* tab, const float* scales, const float* mod, const float* xin, float* xout) {
    const int tid = opaque_tid();
    const int lane = tid & 63, gw = blockIdx.x * NWAVES + __builtin_amdgcn_readfirstlane(tid >> 6), ngw = gridDim.x * NWAVES;
    const unsigned char* utab = tab; const unsigned char* vtab = tab + (size_t)16384 * 1024;
    for (int t = gw; t < T; t += ngw) {
        const int b = t / S;
        float hv[16]; float hs = 0.f;
#pragma unroll
        for (int i = 0; i < 4; ++i) { const uint2 w = ((const uint2*)(hn2 + (size_t)t * D))[lane + 64 * i];
            hv[4 * i + 0] = __uint_as_float(w.x << 16); hv[4 * i + 1] = __uint_as_float(w.x & 0xffff0000u); hv[4 * i + 2] = __uint_as_float(w.y << 16); hv[4 * i + 3] = __uint_as_float(w.y & 0xffff0000u);
            hs += (hv[4 * i] + hv[4 * i + 1]) + (hv[4 * i + 2] + hv[4 * i + 3]); }
        hs = wave_total_dpp(hs);
        const int e0 = eidx[(size_t)t * 128 + lane], e1 = eidx[(size_t)t * 128 + 64 + lane];
        const float g0 = gate[(size_t)t * 128 + lane], g1 = gate[(size_t)t * 128 + 64 + lane];
        float pre0 = 0.f, pre1 = 0.f;
#pragma unroll
        for (int half = 0; half < 2; ++half) {
            const int ev = half ? e1 : e0;
            float pre = 0.f;
#pragma unroll 8
            for (int j = 0; j < 64; ++j) {
                const int e = __builtin_amdgcn_readlane(ev, j);
                const uint4 w = ((const uint4*)(utab + (size_t)e * 1024))[lane];
                const unsigned ww[4] = {w.x, w.y, w.z, w.w};
                float d = 0.f;
#pragma unroll
                for (int i = 0; i < 4; ++i) {
                    d += hv[4 * i + 0] * (float)(ww[i] & 0xffu); d += hv[4 * i + 1] * (float)((ww[i] >> 8) & 0xffu);
                    d += hv[4 * i + 2] * (float)((ww[i] >> 16) & 0xffu); d += hv[4 * i + 3] * (float)(ww[i] >> 24);
                }
                d = wave_total_dpp(d);
                pre = (lane == j) ? d : pre;
            }
            if (half) pre1 = pre; else pre0 = pre;
        }
        const float c0 = g0 * gelu_erf(scales[e0] * (pre0 - 128.f * hs)) * scales[16384 + e0];
        const float c1 = g1 * gelu_erf(scales[e1] * (pre1 - 128.f * hs)) * scales[16384 + e1];
        const float corr = 128.f * wave_total_dpp(c0 + c1);
        float acc[16];
#pragma unroll
        for (int i = 0; i < 16; ++i) acc[i] = 0.f;
#pragma unroll
        for (int half = 0; half < 2; ++half) {
            const int ev = half ? e1 : e0; const float cv = half ? c1 : c0;
#pragma unroll 8
            for (int j = 0; j < 64; ++j) {
                const int e = __builtin_amdgcn_readlane(ev, j);
                const float cf = __builtin_bit_cast(float, __builtin_amdgcn_readlane(__builtin_bit_cast(int, cv), j));
                const uint4 w = ((const uint4*)(vtab + (size_t)e * 1024))[lane];
                const unsigned ww[4] = {w.x, w.y, w.z, w.w};
#pragma unroll
                for (int i = 0; i < 4; ++i) {
                    acc[4 * i + 0] += cf * (float)(ww[i] & 0xffu); acc[4 * i + 1] += cf * (float)((ww[i] >> 8) & 0xffu);
                    acc[4 * i + 2] += cf * (float)((ww[i] >> 16) & 0xffu); acc[4 * i + 3] += cf * (float)(ww[i] >> 24);
                }
            }
        }
        float xv[16]; float ss = 0.f;
#pragma unroll
        for (int i = 0; i < 4; ++i) {
            const float4 g2 = ((const float4*)(mod + b * 6144 + 5 * D))[lane + 64 * i];
            const float4 x = ((const float4*)(xin + (size_t)t * D))[lane + 64 * i];
            xv[4 * i + 0] = x.x + g2.x * (acc[4 * i + 0] - corr); xv[4 * i + 1] = x.y + g2.y * (acc[4 * i + 1] - corr);
            xv[4 * i + 2] = x.z + g2.z * (acc[4 * i + 2] - corr); xv[4 * i + 3] = x.w + g2.w * (acc[4 * i + 3] - corr);
            ss += (xv[4 * i] * xv[4 * i] + xv[4 * i + 1] * xv[4 * i + 1]) + (xv[4 * i + 2] * xv[4 * i + 2] + xv[4 * i + 3] * xv[4 * i + 3]);
        }
        ss = wave_total_dpp(ss);
        const float r = rsqrtf(ss * (1.f / D) + EPS);
#pragma unroll
        for (int i = 0; i < 4; ++i) {
            const float4 gg = ((const float4*)p.fg)[lane + 64 * i];
            float4 o; o.x = xv[4 * i + 0] * r * gg.x; o.y = xv[4 * i + 1] * r * gg.y; o.z = xv[4 * i + 2] * r * gg.z; o.w = xv[4 * i + 3] * r * gg.w;
            ((float4*)(xout + (size_t)t * D))[lane + 64 * i] = o;
        }
    }
}

__device__ __forceinline__ void ph_vt(const bf16* proj, int voff, bf16* VT) {
    const int lane = threadIdx.x & 63, gw = blockIdx.x * NWAVES + __builtin_amdgcn_readfirstlane(threadIdx.x >> 6), ngw = gridDim.x * NWAVES;
    for (int u = gw; u < NB * 8 * (S / 64); u += ngw) {
        const int sb = u & 127, h = (u >> 7) & 7, b = u >> 10;
        const bf16* src = proj + (size_t)(b * S + sb * 64) * PW + voff + h * 64 + lane;
        bf16* dst = VT + (((size_t)(b * 8 + h) * (S / 32) + 2 * sb) * 64 + lane) * 32;
        unsigned short e[64];
#pragma unroll
        for (int j = 0; j < 64; ++j) e[j] = src[(size_t)j * PW];
#pragma unroll
        for (int blk = 0; blk < 2; ++blk)
#pragma unroll
            for (int q4 = 0; q4 < 4; ++q4) {
                const int a = 32 * blk + 4 * q4, c = a + 16;
                v4u o; o.x = e[a] | ((unsigned)e[a + 1] << 16); o.y = e[a + 2] | ((unsigned)e[a + 3] << 16); o.z = e[c] | ((unsigned)e[c + 1] << 16); o.w = e[c + 2] | ((unsigned)e[c + 3] << 16);
                *(v4u*)(dst + blk * 64 * 32 + 8 * q4) = o;
            }
    }
}
__device__ __forceinline__ void ph_stick2(const bf16* proj, const bf16* KC, const bf16* VT, bf16* yb) {
    const int tid = opaque_tid();
    const int lane = tid & 63, fr = lane & 15, fq = lane >> 4;
    const int gw = blockIdx.x * NWAVES + __builtin_amdgcn_readfirstlane(tid >> 6), ngw = gridDim.x * NWAVES;
    for (int u = gw; u < (T / 16) * 8; u += ngw) {
        const int h = (u >> 3) & 7, t0 = ((((u >> 6) << 3) | (u & 7))) * 16, b = t0 / S, tl0 = t0 % S;
        const int qpos = tl0 + fr;
        bf16x8_t bq[2];
        { const bf16* qrow = proj + (size_t)(t0 + fr) * PW + OFF_QB + 64 * h + 8 * fq; bq[0] = *(const bf16x8_t*)qrow; bq[1] = *(const bf16x8_t*)(qrow + 32); }
        f32x4_t acc[4];
#pragma unroll
        for (int dt = 0; dt < 4; ++dt) acc[dt] = (f32x4_t){0.f, 0.f, 0.f, 0.f};
        float carry = 0.f;
        const bf16* vtb = VT + ((size_t)(b * 8 + h) * (S / 32) * 64 + fr) * 32 + 8 * fq;
        const bf16* kbase = KC + ((size_t)(b * 8 + h) * S + fr) * 64 + 8 * fq;
        int kb = (tl0 + 15) >> 5;
        bf16x8_t nk[2][2]; v4u nv[4];
#pragma unroll
        for (int tile = 0; tile < 2; ++tile) { const bf16* kr = kbase + (size_t)(32 * kb + 16 * tile) * 64; nk[tile][0] = *(const bf16x8_t*)kr; nk[tile][1] = *(const bf16x8_t*)(kr + 32); }
#pragma unroll
        for (int dt = 0; dt < 4; ++dt) { const bf16* vr = vtb + (size_t)kb * 2048 + (16 * dt) * 32; nv[dt] = *(const v4u*)vr; }
        for (; kb >= 0; --kb) {
            bf16x8_t ck[2][2]; v4u cv[4];
#pragma unroll
            for (int tile = 0; tile < 2; ++tile) { ck[tile][0] = nk[tile][0]; ck[tile][1] = nk[tile][1]; }
#pragma unroll
            for (int dt = 0; dt < 4; ++dt) cv[dt] = nv[dt];
            { const int kbn = kb > 0 ? kb - 1 : 0;
#pragma unroll
              for (int tile = 0; tile < 2; ++tile) { const bf16* kr = kbase + (size_t)(32 * kbn + 16 * tile) * 64; nk[tile][0] = *(const bf16x8_t*)kr; nk[tile][1] = *(const bf16x8_t*)(kr + 32); }
#pragma unroll
              for (int dt = 0; dt < 4; ++dt) { const bf16* vr = vtb + (size_t)kbn * 2048 + (16 * dt) * 32; nv[dt] = *(const v4u*)vr; } }
            unsigned pw[4] = {0u, 0u, 0u, 0u};
#pragma unroll
            for (int tile = 1; tile >= 0; --tile) {
                const int k0 = 32 * kb + 16 * tile;
                if (k0 > tl0 + 14) continue;
                f32x4_t st = (f32x4_t){0.f, 0.f, 0.f, 0.f};
                st = __builtin_amdgcn_mfma_f32_16x16x32_bf16(ck[tile][0], bq[0], st, 0, 0, 0);
                st = __builtin_amdgcn_mfma_f32_16x16x32_bf16(ck[tile][1], bq[1], st, 0, 0, 0);
                float lb[4], l1m[4];
#pragma unroll
                for (int i = 0; i < 4; ++i) {
                    const float z = st[i] * 0.18033688011112042f;
                    const bool valid = (k0 + 4 * fq + i) < qpos;
                    const float sp = fmaxf(-z, 0.f) + __builtin_amdgcn_logf(1.f + __builtin_amdgcn_exp2f(-fabsf(z)));
                    lb[i] = valid ? -sp : -INFINITY;
                    l1m[i] = valid ? (-sp - z) : 0.f;
                }
                const float e2 = l1m[3], e1 = e2 + l1m[2], e0 = e1 + l1m[1], gsum = e0 + l1m[0];
                const float a1 = __shfl(gsum, (lane + 16) & 63), a2 = __shfl(gsum, (lane + 32) & 63), a3 = __shfl(gsum, (lane + 48) & 63);
                const float above = (fq < 3 ? a1 : 0.f) + (fq < 2 ? a2 : 0.f) + (fq < 1 ? a3 : 0.f);
                const float base = carry + above;
                const float w0 = __builtin_amdgcn_exp2f(lb[0] + base + e0), w1 = __builtin_amdgcn_exp2f(lb[1] + base + e1), w2 = __builtin_amdgcn_exp2f(lb[2] + base + e2), w3 = __builtin_amdgcn_exp2f(lb[3] + base);
                carry += (gsum + a1) + (a2 + a3);
                pw[2 * tile] = pk2(w0, w1); pw[2 * tile + 1] = pk2(w2, w3);
            }
            bf16x8_t pb;
            { v4u t; t.x = pw[0]; t.y = pw[1]; t.z = pw[2]; t.w = pw[3]; pb = __builtin_bit_cast(bf16x8_t, t); }
#pragma unroll
            for (int dt = 0; dt < 4; ++dt) {
                acc[dt] = __builtin_amdgcn_mfma_f32_16x16x32_bf16(__builtin_bit_cast(bf16x8_t, cv[dt]), pb, acc[dt], 0, 0, 0);
            }
            if (__all(carry < -173.2f)) break;
        }
#pragma unroll
        for (int dt = 0; dt < 4; ++dt) {
            uint2 o; o.x = pk2(acc[dt][0], acc[dt][1]); o.y = pk2(acc[dt][2], acc[dt][3]);
            *(uint2*)(yb + (size_t)(t0 + fr) * 512 + 64 * h + 16 * dt + 4 * fq) = o;
        }
    }
}

constexpr int IQB = 32, ICAPN = 704, ICAP = 705  , ITRIG = ICAPN - 128, ILOW = 352;
constexpr int LDS_IKEY = 0, LDS_IIDX = IQB * ICAP * 4, LDS_ICNT = ((LDS_IIDX + IQB * ICAP * 2 + 15) / 16) * 16, LDS_ITHR = LDS_ICNT + IQB * 4, LDS_IROW = LDS_ITHR + IQB * 4;
static_assert(LDS_IROW + NWAVES * 1024 <= LDS_BYTES - 16, "indexer LDS map");
__device__ __forceinline__ int wave_count(bool pred) { return __popcll(__ballot(pred)); }
__device__ __forceinline__ int index_keep(int nseen, int ntot) {
    const float f = (float)nseen / (float)ntot, a = (float)(ntot - nseen) / (float)nseen;
    const float s = 2.25f * sqrtf(a) + sqrtf(5.0625f * a + 256.f);
    return (int)ceilf(fmaxf(s * s, 272.f) * f);
}
template <int NE> __device__ __forceinline__ void index_load(LAS unsigned* keyb, LAS unsigned short* idxb, int q, int n, int lane, unsigned (&kv)[NE], unsigned (&iv)[NE]) {
#pragma unroll
    for (int j = 0; j < NE; ++j) { const int pos = lane + 64 * j; const bool in = pos < n; kv[j] = in ? keyb[q * ICAP + pos] : 0u; iv[j] = in ? (unsigned)idxb[q * ICAP + pos] : 0xFFFFu; }
}
template <int NE> __device__ __forceinline__ int index_count_ge(const unsigned (&kv)[NE], unsigned c) {
    int k = 0;
#pragma unroll
    for (int j = 0; j < NE; ++j) k += __popcll(__builtin_amdgcn_uicmp(kv[j], c, 35));
    return k;
}
template <int NE> __device__ __forceinline__ unsigned index_kth(const unsigned (&kv)[NE], int need) {
    unsigned tau = 0u;
#pragma unroll 1
    for (int bit = 31; bit >= 0; --bit) { const unsigned c = tau | (1u << bit); if (index_count_ge<NE>(kv, c) >= need) tau = c; }
    return tau;
}
template <int NE> __device__ __forceinline__ unsigned index_kth_range(const unsigned (&kv)[NE], int lo, int hi, int& cout) {
    unsigned tau = 0u;
#pragma unroll 1
    for (int bit = 31; bit >= 0; --bit) {
        const unsigned c = tau | (1u << bit); const int cc = index_count_ge<NE>(kv, c);
        if (cc >= lo) { tau = c; cout = cc; if (cc <= hi) break; }
    }
    return tau;
}
__device__ __forceinline__ void index_cut(LAS unsigned* keyb, LAS unsigned short* idxb, LAS unsigned* cnt, LAS unsigned* thr, int q, int lane, int K) {
    const int n = (int)cnt[q];
    if (n <= K) return;
    unsigned kv[11], iv[11];
    index_load<11>(keyb, idxb, q, n, lane, kv, iv);
    int c = n;
    const unsigned p = index_kth_range<11>(kv, K, K + (K >> 3), c);
    unsigned tau = p - 1u, iota = 0xFFFFu;
    if (c > 448 || p == 0u) {
        tau = index_kth<11>(kv, TOPK);
        int ngt = 0, neq = 0;
#pragma unroll
        for (int j = 0; j < 11; ++j) { ngt += __popcll(__builtin_amdgcn_uicmp(kv[j], tau, 34)); neq += __popcll(__builtin_amdgcn_uicmp(kv[j], tau, 32)); }
        const int need = TOPK - ngt;
        if (neq > need) {
            unsigned x = 0u;
#pragma unroll 1
            for (int bit = 15; bit >= 0; --bit) {
                const unsigned cc = x | (1u << bit);
                int k = 0;
#pragma unroll
                for (int j = 0; j < 11; ++j) k += wave_count(kv[j] == tau && iv[j] < cc);
                if (k < need) x = cc;
            }
            iota = x;
        }
    }
    int base = 0;
    const unsigned long long lt = (1ull << lane) - 1ull;
#pragma unroll
    for (int j = 0; j < 11; ++j) {
        const bool keep = kv[j] > tau || (kv[j] == tau && iv[j] <= iota);
        const unsigned long long m = __ballot(keep);
        const int pos = base + __popcll(m & lt);
        if (keep) { keyb[q * ICAP + pos] = kv[j]; idxb[q * ICAP + pos] = (unsigned short)iv[j]; }
        base += __popcll(m);
    }
    if (lane == 0) { cnt[q] = (unsigned)base; thr[q] = tau; }
    asm volatile("s_waitcnt lgkmcnt(0)" ::: "memory");
}
template <int NE> __device__ __forceinline__ void index_bits(LAS unsigned* keyb, LAS unsigned short* idxb, int q, int n, int lane) {
    unsigned kv[NE], iv[NE];
    index_load<NE>(keyb, idxb, q, n, lane, kv, iv);
    unsigned tau = 0u, iota = 0xFFFFu;
    if (n > TOPK) {
        int cdummy = 0; tau = index_kth_range<NE>(kv, TOPK, TOPK, cdummy);
        int ngt = 0, neq = 0;
#pragma unroll
        for (int j = 0; j < NE; ++j) { ngt += __popcll(__builtin_amdgcn_uicmp(kv[j], tau, 34)); neq += __popcll(__builtin_amdgcn_uicmp(kv[j], tau, 32)); }
        const int need = TOPK - ngt;
        if (neq > need) {
            unsigned x = 0u;
#pragma unroll 1
            for (int bit = 15; bit >= 0; --bit) {
                const unsigned c = x | (1u << bit);
                int k = 0;
#pragma unroll
                for (int j = 0; j < NE; ++j) k += wave_count(kv[j] == tau && iv[j] < c);
                if (k < need) x = c;
            }
            iota = x;
        }
    }
    LAS unsigned* rowl = keyb + q * ICAP;
    asm volatile("s_waitcnt lgkmcnt(0)" ::: "memory");
#pragma unroll
    for (int i = 0; i < 4; ++i) rowl[lane + 64 * i] = 0u;
    asm volatile("s_waitcnt lgkmcnt(0)" ::: "memory");
#pragma unroll
    for (int j = 0; j < NE; ++j) {
        const bool keep = (n > TOPK) ? (kv[j] > tau || (kv[j] == tau && iv[j] <= iota)) : (lane + 64 * j < n);
        if (keep) (void)__hip_atomic_fetch_or(rowl + (iv[j] >> 5), 1u << (iv[j] & 31u), __ATOMIC_RELAXED, __HIP_MEMORY_SCOPE_WORKGROUP);
    }
    asm volatile("s_waitcnt lgkmcnt(0)" ::: "memory");
}
__device__ __forceinline__ void index_final(LAS unsigned* keyb, LAS unsigned short* idxb, LAS unsigned* cnt, int q, int lane) {
    const int n = (int)cnt[q];
    if (n <= 384) index_bits<6>(keyb, idxb, q, n, lane); else if (n <= 448) index_bits<7>(keyb, idxb, q, n, lane); else if (n <= 576) index_bits<9>(keyb, idxb, q, n, lane); else index_bits<11>(keyb, idxb, q, n, lane);
}
template <int ABL> __device__ __forceinline__ void ph_dsa_index(const bf16* proj, const bf16* KI, const bf16* WI, unsigned* selbits, LAS unsigned char* lds) {
    LAS unsigned* keyb = (LAS unsigned*)(lds + LDS_IKEY); LAS unsigned short* idxb = (LAS unsigned short*)(lds + LDS_IIDX);
    LAS unsigned* cnt = (LAS unsigned*)(lds + LDS_ICNT); LAS unsigned* thr = (LAS unsigned*)(lds + LDS_ITHR);
    const int tid = opaque_tid(), wave = __builtin_amdgcn_readfirstlane(tid >> 6), lane = tid & 63, fr = lane & 15, fq = lane >> 4;
    LAS unsigned* rowl = (LAS unsigned*)(lds + LDS_IROW + wave * 1024);
    constexpr int NQB = S / IQB;
    for (int pr = blockIdx.x; pr < NB * NQB / 2; pr += gridDim.x) {
        const int b = pr / (NQB / 2), pp = pr % (NQB / 2);
#pragma unroll 1
        for (int ui = 0; ui < 2; ++ui) {
            const int qb = ui ? pp : (NQB - 1 - pp);
            const int q0 = qb * IQB, t0 = b * S + q0;
            bf16x8_t bqf[2][8][2]; unsigned wvp[2][4];
#pragma unroll
            for (int qg = 0; qg < 2; ++qg) {
                const bf16* qrow = proj + (size_t)(t0 + 16 * qg + fr) * PW;
#pragma unroll
                for (int h = 0; h < 8; ++h) { bqf[qg][h][0] = *(const bf16x8_t*)(qrow + OFF_QI + 64 * h + 8 * fq); bqf[qg][h][1] = *(const bf16x8_t*)(qrow + OFF_QI + 64 * h + 8 * fq + 32); }
                { const uint4 w4 = *(const uint4*)(WI + (size_t)(t0 + 16 * qg + fr) * 8); wvp[qg][0] = w4.x; wvp[qg][1] = w4.y; wvp[qg][2] = w4.z; wvp[qg][3] = w4.w; }
            }
            const int ntiles = (q0 + IQB - 1) / 128 + 1;
            const bf16* kwave = KI + (size_t)(b * S + 16 * wave + fr) * 64 + 8 * fq;
#pragma unroll 1
            for (int cons = 0; cons < 2; ++cons) {
            __syncthreads();
            if (tid < IQB) { cnt[tid] = 0u; thr[tid] = 0u; }
            bf16x8_t ak0 = *(const bf16x8_t*)kwave, ak1 = *(const bf16x8_t*)(kwave + 32);
#pragma unroll 1
            for (int kt = 0; kt < ntiles; ++kt) {
                asm volatile("s_waitcnt lgkmcnt(0)" ::: "memory"); __builtin_amdgcn_s_barrier(); asm volatile("" ::: "memory");
                if (__any((int)cnt[lane & 31] > ITRIG)) {
#pragma unroll 1
                    for (int qq = 0; qq < 4; ++qq) { const int q = 4 * wave + qq; if ((int)cnt[q] > ILOW) { if (ABL == 2) { if (lane == 0) cnt[q] = 256u; } else {
                        const int ntot = q0 + q + 1, nseen = min(128 * kt, ntot);
                        const int K = cons ? TOPK : __builtin_amdgcn_readfirstlane(max(index_keep(nseen, ntot), 32));
                        index_cut(keyb, idxb, cnt, thr, q, lane, K); } } }
                    asm volatile("s_waitcnt lgkmcnt(0)" ::: "memory"); __builtin_amdgcn_s_barrier(); asm volatile("" ::: "memory");
                }
                const unsigned th0 = thr[fr], th1 = thr[16 + fr];
                const int k0 = 128 * kt + 16 * wave;
                const bf16x8_t a0 = ak0, a1 = ak1;
                { const bf16* kn = kwave + (size_t)(128 * ((kt + 1 < ntiles) ? kt + 1 : kt)) * 64; ak0 = *(const bf16x8_t*)kn; ak1 = *(const bf16x8_t*)(kn + 32); }
#pragma unroll
                for (int qg = 0; qg < 2; ++qg) {
                    float sc[4] = {0.f, 0.f, 0.f, 0.f};
#pragma unroll
                    for (int h = 0; h < 8; ++h) {
                        f32x4_t a = (f32x4_t){0.f, 0.f, 0.f, 0.f};
                        a = __builtin_amdgcn_mfma_f32_16x16x32_bf16(a0, bqf[qg][h][0], a, 0, 0, 0);
                        a = __builtin_amdgcn_mfma_f32_16x16x32_bf16(a1, bqf[qg][h][1], a, 0, 0, 0);
                        const float wh = (h & 1) ? __uint_as_float(wvp[qg][h >> 1] & 0xffff0000u) : __uint_as_float(wvp[qg][h >> 1] << 16);
#pragma unroll
                        for (int i = 0; i < 4; ++i) { sc[i] += wh * __builtin_amdgcn_fmed3f(a[i], 0.f, __builtin_inff()); asm("" : "+v"(sc[i])); }
                    }
                    const int qi = 16 * qg + fr, qpos = q0 + qi;
                    const unsigned th = qg ? th1 : th0;
                    unsigned keyv[4], slot[4]; bool prd[4];
#pragma unroll
                    for (int i = 0; i < 4; ++i) {
                        float s = sc[i]; if (s == 0.f) s = 0.f;
                        keyv[i] = f2ord(s);
                        prd[i] = (ABL != 1) && (k0 + 4 * fq + i <= qpos) && (keyv[i] > th);
                    }
#pragma unroll
                    for (int i = 0; i < 4; ++i) slot[i] = prd[i] ? __hip_atomic_fetch_add(cnt + qi, 1u, __ATOMIC_RELAXED, __HIP_MEMORY_SCOPE_WORKGROUP) : 0u;
#pragma unroll
                    for (int i = 0; i < 4; ++i) if (prd[i]) { keyb[qi * ICAP + slot[i]] = keyv[i]; idxb[qi * ICAP + slot[i]] = (unsigned short)(k0 + 4 * fq + i); }
                }
            }
            __syncthreads();
            if (!__any((int)cnt[lane & 31] < min(TOPK, q0 + (lane & 31) + 1))) break;
            }
#pragma unroll 1
            for (int qq = 0; qq < (ABL == 0 ? 4 : 0); ++qq) { const int q = 4 * wave + qq; index_final(keyb, idxb, cnt, q, lane); }
            if (ABL == 0) {
                __syncthreads();
                unsigned* dst = selbits + ((size_t)(b * (S / 32) + qb) * 128) * 64;
                for (int idx = tid; idx < 128 * 32; idx += NTHR) { const int kt = idx >> 5, qq = idx & 31;
                    uint2 w; w.x = keyb[qq * ICAP + 2 * kt]; w.y = keyb[qq * ICAP + 2 * kt + 1];
                    *(uint2*)(dst + (size_t)idx * 2) = w; }
            }
        }
    }
    __syncthreads();
}

constexpr int AQB = 256, AKT = 64, AROW = 144;
constexpr int LDS_AK = 0, LDS_AV = AKT * AROW, LDS_ABUF = 2 * AKT * AROW, LDS_ABLUT = 2 * LDS_ABUF;
__device__ __forceinline__ float bfi_f(unsigned mask, unsigned a, unsigned b) { unsigned r_; asm("v_bfi_b32 %0, %1, %2, %3" : "=v"(r_) : "v"(mask), "v"(a), "v"(b)); return __uint_as_float(r_); }
template <bool NEAR> __device__ __forceinline__ void attn_tile(LAS unsigned char* buf, LAS float* blut, const bf16x8_t (&bq)[2][2], const uint2 cb0, const uint2 cb1, int qw, int k0, int fr, int fq,
                                                               const bf16x8_t ones, f32x4_t (&acc)[2][4], f32x4_t (&accl)[2], float (&mrun)[2]) {
    const float cfar = blut[128];
    const unsigned ninf = 0xff800000u;
    bf16x8_t kf[4][2];
#pragma unroll
    for (int tile = 0; tile < 4; ++tile)
#pragma unroll
        for (int ks = 0; ks < 2; ++ks) kf[tile][ks] = *(const LAS bf16x8_t*)(buf + LDS_AK + (16 * tile + fr) * AROW + (8 * fq + 32 * ks) * 2);
    f32x4_t sx[2][4];
#pragma unroll
    for (int qg = 0; qg < 2; ++qg)
#pragma unroll
        for (int tile = 0; tile < 4; ++tile) { sx[qg][tile] = (f32x4_t){0.f, 0.f, 0.f, 0.f};
            sx[qg][tile] = __builtin_amdgcn_mfma_f32_16x16x32_bf16(kf[tile][0], bq[qg][0], sx[qg][tile], 0, 0, 0); sx[qg][tile] = __builtin_amdgcn_mfma_f32_16x16x32_bf16(kf[tile][1], bq[qg][1], sx[qg][tile], 0, 0, 0); }
    float x[2][16]; float mt[2];
#pragma unroll
    for (int qg = 0; qg < 2; ++qg) {
        const uint2 cb = qg ? cb1 : cb0;
        const int dist0 = (qw + 16 * qg + fr) - (k0 + 4 * fq);
        const float mref = (mrun[qg] == -INFINITY) ? 0.f : mrun[qg];
        const float cfm = cfar - mref;
#pragma unroll
        for (int tile = 0; tile < 4; ++tile) {
            const int nib = (int)(((tile & 2) ? cb.y : cb.x) >> (16 * (tile & 1) + 4 * fq));
#pragma unroll
            for (int i = 0; i < 4; ++i) {
                const unsigned t = (unsigned)__builtin_amdgcn_sbfe(nib, i, 1);
                float bias = cfm;
                if (NEAR) { int n = dist0 - (16 * tile + i); n = n < 0 ? 0 : (n > 128 ? 128 : n); bias = blut[n] - mref; }
                x[qg][4 * tile + i] = __builtin_fmaf(sx[qg][tile][i], 0.18033688011112042f, bfi_f(t, __float_as_uint(bias), ninf));
                asm("" : "+v"(x[qg][4 * tile + i]));
            }
        }
        float m8 = fmaxf(fmaxf(fmaxf(x[qg][0], x[qg][1]), fmaxf(x[qg][2], x[qg][3])), fmaxf(fmaxf(x[qg][4], x[qg][5]), fmaxf(x[qg][6], x[qg][7])));
        m8 = fmaxf(m8, fmaxf(fmaxf(fmaxf(x[qg][8], x[qg][9]), fmaxf(x[qg][10], x[qg][11])), fmaxf(fmaxf(x[qg][12], x[qg][13]), fmaxf(x[qg][14], x[qg][15]))));
        m8 = fmaxf(m8, __shfl_xor(m8, 16)); mt[qg] = fmaxf(m8, __shfl_xor(m8, 32));
    }
    const bool rc0 = (mt[0] > 24.f) || (mrun[0] == -INFINITY && mt[0] > -INFINITY), rc1 = (mt[1] > 24.f) || (mrun[1] == -INFINITY && mt[1] > -INFINITY);
    if (__any(rc0 || rc1)) {
#pragma unroll
        for (int qg = 0; qg < 2; ++qg) {
            const bool rc = qg ? rc1 : rc0;
            const float sh = rc ? mt[qg] : 0.f;
            const float f = (rc && mrun[qg] != -INFINITY) ? __builtin_amdgcn_exp2f(-sh) : 1.f;
            mrun[qg] = rc ? (((mrun[qg] == -INFINITY) ? 0.f : mrun[qg]) + sh) : mrun[qg];
            accl[qg] = accl[qg] * f;
#pragma unroll
            for (int dt = 0; dt < 4; ++dt) acc[qg][dt] = acc[qg][dt] * f;
#pragma unroll
            for (int e = 0; e < 16; ++e) x[qg][e] -= sh;
        }
    }
#pragma unroll
    for (int blk = 0; blk < 2; ++blk) {
        bf16x8_t vf[4];
#pragma unroll
        for (int dt = 0; dt < 4; ++dt) vf[dt] = *(const LAS bf16x8_t*)(buf + LDS_AV + (16 * dt + fr) * AROW + (32 * blk + 8 * fq) * 2);
#pragma unroll
        for (int qg = 0; qg < 2; ++qg) {
            v4u t;
            t.x = pk2(__builtin_amdgcn_exp2f(x[qg][8 * blk + 0]), __builtin_amdgcn_exp2f(x[qg][8 * blk + 1])); t.y = pk2(__builtin_amdgcn_exp2f(x[qg][8 * blk + 2]), __builtin_amdgcn_exp2f(x[qg][8 * blk + 3]));
            t.z = pk2(__builtin_amdgcn_exp2f(x[qg][8 * blk + 4]), __builtin_amdgcn_exp2f(x[qg][8 * blk + 5])); t.w = pk2(__builtin_amdgcn_exp2f(x[qg][8 * blk + 6]), __builtin_amdgcn_exp2f(x[qg][8 * blk + 7]));
            const bf16x8_t pb = __builtin_bit_cast(bf16x8_t, t);
            accl[qg] = __builtin_amdgcn_mfma_f32_16x16x32_bf16(ones, pb, accl[qg], 0, 0, 0);
#pragma unroll
            for (int dt = 0; dt < 4; ++dt) acc[qg][dt] = __builtin_amdgcn_mfma_f32_16x16x32_bf16(vf[dt], pb, acc[qg][dt], 0, 0, 0);
        }
    }
}
__device__ __forceinline__ void ph_dsa_attn2(const Params& p, const bf16* proj, const bf16* KC, const bf16* VTa, const unsigned* selbits, bf16* ya, LAS unsigned char* lds) {
    const int tid = opaque_tid(), wave = __builtin_amdgcn_readfirstlane(tid >> 6), lane = tid & 63, fr = lane & 15, fq = lane >> 4;
    LAS float* blut = (LAS float*)(lds + LDS_ABLUT);
    constexpr int NQBA = S / AQB;
    const int ldr = tid >> 3, ldc = tid & 7;
    for (int pr = blockIdx.x; pr < NB * 8 * NQBA / 2; pr += gridDim.x) {
        const int bh = pr / (NQBA / 2), pp = pr % (NQBA / 2), b = bh >> 3, h = bh & 7;
        __syncthreads();
        if (tid <= 128) blut[tid] = p.rel_bias[(tid >= 128 ? 31 : t5_bucket(tid)) * 8 + h] * 1.4426950408889634f;
        const bf16* kg = KC + ((size_t)(b * 8 + h) * S + ldr) * 64 + 8 * ldc;
        const bf16* vg = VTa + ((size_t)(b * 8 + h) * (S / 32) * 64 + (ldc >> 2) * 64 + ldr) * 32 + 8 * (ldc & 3);
#pragma unroll 1
        for (int ui = 0; ui < 2; ++ui) {
            const int qb = ui ? pp : (NQBA - 1 - pp);
            const int q0 = qb * AQB, qw = q0 + 32 * wave;
            const int ntiles = (q0 + AQB) / AKT;
            bf16x8_t bq[2][2];
#pragma unroll
            for (int qg = 0; qg < 2; ++qg) { const bf16* qrow = proj + (size_t)(b * S + qw + 16 * qg + fr) * PW + OFF_QA + 64 * h + 8 * fq; bq[qg][0] = *(const bf16x8_t*)qrow; bq[qg][1] = *(const bf16x8_t*)(qrow + 32); }
            const unsigned* brow0 = selbits + ((size_t)(b * (S / 32) + (qw >> 5)) * 128) * 64 + 2 * fr;
            const unsigned* brow1 = brow0 + 32;
            f32x4_t acc[2][4], accl[2]; float mrun[2];
            const bf16x8_t ones = __builtin_bit_cast(bf16x8_t, (v4u){0x3f803f80u, 0x3f803f80u, 0x3f803f80u, 0x3f803f80u});
#pragma unroll
            for (int qg = 0; qg < 2; ++qg) { mrun[qg] = -INFINITY; accl[qg] = (f32x4_t){0.f, 0.f, 0.f, 0.f};
#pragma unroll
                for (int dt = 0; dt < 4; ++dt) acc[qg][dt] = (f32x4_t){0.f, 0.f, 0.f, 0.f}; }
            __syncthreads();
            { const v4u kk = *(const v4u*)kg, vv = *(const v4u*)vg;
              *(LAS v4u*)(lds + LDS_AK + ldr * AROW + 16 * ldc) = kk; *(LAS v4u*)(lds + LDS_AV + ldr * AROW + 16 * ldc) = vv; }
            uint2 wb0 = *(const uint2*)brow0, wb1 = *(const uint2*)brow1;
            __syncthreads();
#pragma unroll 1
            for (int kt = 0; kt < ntiles; ++kt) {
                const int k0 = kt * AKT;
                LAS unsigned char* buf = lds + (kt & 1) * LDS_ABUF;
                const int ktn = (kt + 1 < ntiles) ? kt + 1 : kt;
                const uint2 cb0 = wb0, cb1 = wb1;
                const v4u nk = *(const v4u*)(kg + (size_t)(ktn * AKT) * 64), nvv = *(const v4u*)(vg + (size_t)(ktn * AKT / 32) * 2048);
                wb0 = *(const uint2*)(brow0 + 64 * ktn); wb1 = *(const uint2*)(brow1 + 64 * ktn);
                if (k0 <= qw + 31) {
                    if ((k0 + AKT - 1 + 128) > qw) attn_tile<true>(buf, blut, bq, cb0, cb1, qw, k0, fr, fq, ones, acc, accl, mrun);
                    else attn_tile<false>(buf, blut, bq, cb0, cb1, qw, k0, fr, fq, ones, acc, accl, mrun);
                }
                { LAS unsigned char* nb = lds + ((kt + 1) & 1) * LDS_ABUF;
                    *(LAS v4u*)(nb + LDS_AK + ldr * AROW + 16 * ldc) = nk; *(LAS v4u*)(nb + LDS_AV + ldr * AROW + 16 * ldc) = nvv; }
                asm volatile("s_waitcnt lgkmcnt(0)" ::: "memory"); __builtin_amdgcn_s_barrier(); asm volatile("" ::: "memory");
            }
#pragma unroll
            for (int qg = 0; qg < 2; ++qg) {
                const float inv = 1.f / accl[qg][0];
#pragma unroll
                for (int dt = 0; dt < 4; ++dt) { uint2 o; o.x = pk2(acc[qg][dt][0] * inv, acc[qg][dt][1] * inv); o.y = pk2(acc[qg][dt][2] * inv, acc[qg][dt][3] * inv);
                    *(uint2*)(ya + (size_t)(b * S + qw + 16 * qg + fr) * 512 + 64 * h + 16 * dt + 4 * fq) = o; }
            }
        }
    }
    __syncthreads();
}

__global__ void __launch_bounds__(NTHR, 2) mega_fwd(Params p) {
    extern __shared__ __attribute__((aligned(16))) unsigned char lds[];
    float* sm = (float*)lds;
    LAS unsigned char* ldsl = (LAS unsigned char*)lds;
    volatile LAS unsigned* bst = (volatile LAS unsigned*)(ldsl + LDS_BYTES - 16);
    if (threadIdx.x == 0) { bst[0] = 0u; bst[1] = 0u; bst[2] = 0u; bst[3] = 0u; }
    __syncthreads();
    XcdBarrier bar = xcd_barrier_post((unsigned*)(p.ws + WS_BAR), bst);
    unsigned char* ws = p.ws;
    float* mod = (float*)(ws + WS_MOD);
    bf16* proj = (bf16*)(ws + WS_PROJ);
    bf16* G = (bf16*)(ws + WS_G);
    bf16* ya = (bf16*)(ws + WS_YA); bf16* yb = (bf16*)(ws + WS_YB);
    bf16* hn2 = (bf16*)(ws + WS_HN2); bf16* qh = (bf16*)(ws + WS_QH);
    bf16* hn = (bf16*)p.out;
    const int G_ = gridDim.x, c_ = blockIdx.x;

    ph_mod(p, mod, (float*)(lds + LDS_SC_OFF));
    ph_weights(p, ldsl);
    xcd_barrier(bar);
    ph_norm<true>(p.x, p.g1, mod, 0, 1, hn);
    xcd_barrier(bar);
    {
        pg8::Gemm g{hn, (const bf16*)(ws + WS_WIN), T, NPROJ, D, D, D}; pg8::StaticOrder So; So.init(T, NPROJ, G_, c_);
        pg8::EpiX<1> E{proj, G, nullptr, nullptr, nullptr, PW, 0, (bf16*)(ws + WS_KCA), (bf16*)(ws + WS_KCB), (bf16*)(ws + WS_KI), (bf16*)(ws + WS_WI)};
        pg8::gemm_phase<pg8::EpiX<1>, pg8::StaticOrder, true, true>(ldsl, g, So, E);
    }
    xcd_barrier(bar);
    unsigned* selbits = (unsigned*)((unsigned char*)p.out + 32 * MiB); bf16* VTa = (bf16*)p.out;
    ph_vt(proj, OFF_VB, (bf16*)(ws + WS_VT));
    ph_vt(proj, OFF_VA, VTa);
    ph_dsa_index<0>(proj, (const bf16*)(ws + WS_KI), (const bf16*)(ws + WS_WI), selbits, ldsl);
    xcd_barrier(bar);
    ph_dsa_attn2(p, proj, (const bf16*)(ws + WS_KCA), VTa, selbits, ya, ldsl);
    ph_stick2(proj, (const bf16*)(ws + WS_KCB), (const bf16*)(ws + WS_VT), yb);
    xcd_barrier(bar);
    {
        pg8::Gemm g{ya, (const bf16*)(ws + WS_WPA), T, D, 512, 512, 512}; pg8::StaticOrder So; So.init(T, D, G_, c_);
        pg8::EpiX<2> E{nullptr, G, nullptr, nullptr, nullptr, 0, 0, nullptr, nullptr, nullptr, nullptr};
        pg8::gemm_phase<pg8::EpiX<2>, pg8::StaticOrder, true, true>(ldsl, g, So, E);
    }
    {
        pg8::Gemm g{yb, (const bf16*)(ws + WS_WPB), T, D, 512, 512, 512}; pg8::StaticOrder So; So.init(T, D, G_, c_);
        pg8::EpiX<3> E{nullptr, G, nullptr, nullptr, nullptr, 0, 0, nullptr, nullptr, nullptr, nullptr};
        pg8::gemm_phase<pg8::EpiX<3>, pg8::StaticOrder, true, true>(ldsl, g, So, E);
    }
    xcd_barrier(bar);
    {
        pg8::Gemm g{G, (const bf16*)(ws + WS_WOUT), T, D, D, GW, D}; pg8::StaticOrder So; So.init(T, D, G_, c_);
        pg8::EpiX<4> E{nullptr, nullptr, p.x, mod + 2 * D, p.out, 0, 0, nullptr, nullptr, nullptr, nullptr};
        pg8::gemm_phase<pg8::EpiX<4>, pg8::StaticOrder, true, true>(ldsl, g, So, E);
    }
    xcd_barrier(bar);
    ph_norm<false>(p.out, p.g2, mod, 3, 4, hn2);
    ph_quant(p, ws + WS_TAB, (float*)(ws + WS_SCALES));
    xcd_barrier(bar);
    {
        pg8::Gemm g{hn2, (const bf16*)(ws + WS_WQ), T, 2048, D, D, D}; pg8::StaticOrder So; So.init(T, 2048, G_, c_);
        pg8::EpiX<0> E{qh, nullptr, nullptr, nullptr, nullptr, 2048, 0, nullptr, nullptr, nullptr, nullptr};
        pg8::gemm_phase<pg8::EpiX<0>, pg8::StaticOrder, true, true>(ldsl, g, So, E);
    }
    xcd_barrier(bar);
    ph_peer_select(qh, (const bf16*)(ws + WS_SKB), (unsigned short*)(ws + WS_EIDX), (float*)(ws + WS_GATE));
    xcd_barrier(bar);
    ph_peer_gather(p, hn2, (const unsigned short*)(ws + WS_EIDX), (const float*)(ws + WS_GATE), ws + WS_TAB, (const float*)(ws + WS_SCALES), mod, p.out, p.out);
}

extern "C" void kernel_launch(void* const* d_in, const int* in_sizes, int n_in, void* d_out, int out_size, void* d_ws, size_t ws_size, hipStream_t stream) {
    static int grid = 0;
    if (grid == 0) {
        if (n_in != 16 || out_size != T * D || ws_size < WS_NEED) { fprintf(stderr, "kernel_launch: unexpected shapes (n_in %d out %d ws %zu)\n", n_in, out_size, ws_size); grid = -1; return; }
        int dev = 0, cus = 0, per_cu = 0;
        if (hipGetDevice(&dev) != hipSuccess || hipDeviceGetAttribute(&cus, hipDeviceAttributeMultiprocessorCount, dev) != hipSuccess) { grid = -1; return; }
        if (hipFuncSetAttribute((const void*)mega_fwd, hipFuncAttributeMaxDynamicSharedMemorySize, LDS_BYTES) != hipSuccess) { fprintf(stderr, "kernel_launch: hipFuncSetAttribute failed\n"); grid = -1; return; }
        if (hipOccupancyMaxActiveBlocksPerMultiprocessor(&per_cu, (const void*)mega_fwd, NTHR, LDS_BYTES) != hipSuccess || per_cu < 1) { fprintf(stderr, "kernel_launch: occupancy query says %d\n", per_cu); per_cu = 1; }
        (void)hipGetLastError();
        grid = cus;
    }
    if (grid < 0) return;
    (void)hipMemsetAsync((char*)d_ws + WS_BAR, 0, CTL_ZERO_BYTES, stream);
    Params p; memset(&p, 0, sizeof(p));
    p.x = (const float*)d_in[0]; p.c = (const float*)d_in[1]; p.w_ada = (const float*)d_in[2]; p.b_ada = (const float*)d_in[3];
    p.g1 = (const float*)d_in[4]; p.g2 = (const float*)d_in[5]; p.w_in = (const float*)d_in[6]; p.rel_bias = (const float*)d_in[7];
    p.wpa = (const float*)d_in[8]; p.wpb = (const float*)d_in[9]; p.wout = (const float*)d_in[10]; p.wq = (const float*)d_in[11];
    p.sk = (const float*)d_in[12]; p.pu = (const float*)d_in[13]; p.pv = (const float*)d_in[14]; p.fg = (const float*)d_in[15];
    p.out = (float*)d_out; p.ws = (unsigned char*)d_ws;
    hipLaunchKernelGGL(mega_fwd, dim3(grid), dim3(NTHR), LDS_BYTES, stream, p);
}
```

```cpp
#include <hip/hip_runtime.h>
#include <stdint.h>
#include <math.h>
#include <string.h>
#include <stdio.h>

typedef unsigned short bf16;
constexpr int D = 1024, NB = 2, S = 8192, T = NB * S;
constexpr int INW = 5704;
constexpr int OFF_QA = 0, OFF_VA = 512, OFF_QI = 1024, OFF_QB = 1536, OFF_VB = 2048;
constexpr int PW = 2560;
constexpr int NPROJ = 3840 + 2048;
constexpr int GW = 2048;
constexpr int TOPK = 256;
constexpr float EPS = 1e-6f;
constexpr size_t MiB = 1u << 20;
constexpr int NTHR = 512, NWAVES = 8;
constexpr int LDS_BYTES = 147456;

#define LAS __attribute__((address_space(3)))

__device__ __forceinline__ bf16 f2bf(float f) { unsigned u = __float_as_uint(f); return (bf16)((u + 0x7fffu + ((u >> 16) & 1u)) >> 16); }
__device__ __forceinline__ float bf2f(bf16 h) { return __uint_as_float(((unsigned)h) << 16); }
typedef __bf16 bf16x2_hw __attribute__((ext_vector_type(2)));
__device__ __forceinline__ unsigned pk2(float lo, float hi) { bf16x2_hw v; v[0] = (__bf16)lo; v[1] = (__bf16)hi; return __builtin_bit_cast(unsigned, v); }

__device__ __forceinline__ float wave_sum(float v) {
#pragma unroll
    for (int o = 1; o < 64; o <<= 1) v += __shfl_xor(v, o);
    return v;
}
__device__ __forceinline__ float block_sum(float v, float* red) {
    v = wave_sum(v);
    __syncthreads();
    if ((threadIdx.x & 63) == 0) red[threadIdx.x >> 6] = v;
    __syncthreads();
    float s = 0.f;
#pragma unroll
    for (int i = 0; i < NWAVES; ++i) s += red[i];
    return s;
}
typedef float f32x4_t __attribute__((ext_vector_type(4)));
#define XB_TMO      128
#define XB_XCNT(j)  (256  + 64 * (j))
#define XB_XSUB(j)  (1280 + 64 * (j))
#define XB_XGEN(j)  (2304 + 64 * (j))
#define XB_TOP      3328
#define XB_TOPGEN   3392
#define XCD_BAR_WORDS 3456
#define XB_SPIN_CAP (1u << 22)

__device__ __forceinline__ unsigned xb_ld(unsigned* p)              { return __hip_atomic_load(p, __ATOMIC_RELAXED, __HIP_MEMORY_SCOPE_AGENT); }
__device__ __forceinline__ unsigned xb_add(unsigned* p, unsigned v) { return __hip_atomic_fetch_add(p, v, __ATOMIC_RELAXED, __HIP_MEMORY_SCOPE_AGENT); }
__device__ __forceinline__ unsigned xb_xcc_id() { return (unsigned)__builtin_amdgcn_s_getreg((3 << 11) | 20) & 0xFu; }
#define XB_SPIN(cond, bar) do { unsigned _sp = 0; while (cond) { __builtin_amdgcn_s_sleep(1); \
    if ((++_sp & 255u) == 0u) { if (xb_ld(&(bar)[XB_TMO])) break; if (_sp > XB_SPIN_CAP) { atomicAdd(&(bar)[XB_TMO], 1u); break; } } } } while (0)

struct XcdBarrier {
    unsigned* bar; unsigned x;
    volatile LAS unsigned* st;
};

__device__ __forceinline__ XcdBarrier xcd_barrier_post(unsigned* bar, volatile LAS unsigned* st) {
    XcdBarrier b; b.bar = bar; b.x = xb_xcc_id(); b.st = st;
    if (threadIdx.x == 0) (void)xb_add(&bar[XB_XCNT(b.x)], 1u);
    return b;
}
__device__ __forceinline__ void xcd_barrier_complete(unsigned* bar, unsigned x, unsigned& nloc, unsigned& nx) {
    const unsigned G = gridDim.x * gridDim.y * gridDim.z;
    unsigned sum, cnt, mine, sp = 0u;
    for (;;) {
        sum = 0u; cnt = 0u; mine = 0u;
#pragma unroll
        for (unsigned j = 0; j < 16; ++j) { const unsigned c = xb_ld(&bar[XB_XCNT(j)]); sum += c; cnt += (c > 0u) ? 1u : 0u; mine = (j == x) ? c : mine; }
        if (sum == G) break;
        __builtin_amdgcn_s_sleep(1);
        if ((++sp & 255u) == 0u) { if (xb_ld(&bar[XB_TMO])) break; if (sp > XB_SPIN_CAP) { atomicAdd(&bar[XB_TMO], 1u); break; } }
    }
    nloc = mine > 0u ? mine : 1u; nx = cnt > 0u ? cnt : 1u;
}

__device__ __forceinline__ void xcd_barrier(const XcdBarrier& b) {
    asm volatile("s_waitcnt vmcnt(0)" ::: "memory");
    __syncthreads();
    if (threadIdx.x == 0) {
        unsigned* bar = b.bar;
        __builtin_amdgcn_s_waitcnt(0);
        unsigned nloc = b.st[0], nx = b.st[1];
        if (nloc == 0u) { xcd_barrier_complete(bar, b.x, nloc, nx); b.st[0] = nloc; b.st[1] = nx; }
        const unsigned old = xb_add(&bar[XB_XSUB(b.x)], 1u);
        const unsigned gen = old / nloc;
        if (old + 1u == (gen + 1u) * nloc) {
            __builtin_amdgcn_fence(__ATOMIC_RELEASE, "agent");
            asm volatile("s_waitcnt vmcnt(0)" ::: "memory");
            const unsigned og = xb_add(&bar[XB_TOP], 1u);
            const unsigned tg = og / nx;
            if (og + 1u == (tg + 1u) * nx) xb_add(&bar[XB_TOPGEN], 1u);
            else XB_SPIN(xb_ld(&bar[XB_TOPGEN]) == tg, bar);
            __builtin_amdgcn_fence(__ATOMIC_ACQUIRE, "agent");
            xb_add(&bar[XB_XGEN(b.x)], 1u);
            asm volatile("s_waitcnt vmcnt(0)" ::: "memory");
        } else {
            XB_SPIN(xb_ld(&bar[XB_XGEN(b.x)]) == gen, bar);
            __builtin_amdgcn_fence(__ATOMIC_ACQUIRE, "agent");
            asm volatile("s_waitcnt vmcnt(0)" ::: "memory");
        }
    }
    __syncthreads();
}


namespace pg8 {
#define PG8_LAS __attribute__((address_space(3)))
typedef unsigned short bf16_t;
typedef short bf16x8 __attribute__((ext_vector_type(8)));
typedef float f32x4 __attribute__((ext_vector_type(4)));
typedef unsigned u32x4 __attribute__((ext_vector_type(4)));
constexpr int BM = 256, BK = 64, HALF = 128, HTB = HALF * BK * 2  , STAGE_BYTES = 8 * HTB, NXCD = 8, WGM = 8;

__host__ __device__ __forceinline__ int lds_byte(int r, int c) { const int st = (r >> 4) * 2 + (c >> 5), rr = r & 15, cc = c & 31, ob = rr * 64 + cc * 2; return st * 1024 + (ob ^ (((ob >> 9) & 1) << 5)); }
__host__ __device__ __forceinline__ void stage_rc(int b, int& R, int& C) { const int st = b / 1024, sb = b % 1024, swz = sb ^ (((sb >> 9) & 1) << 5); R = (st >> 1) * 16 + swz / 64; C = (st & 1) * 32 + (swz % 64) / 2; }
__host__ __device__ __forceinline__ int perm32(int rho) { const int n = rho >> 4, i = rho & 15; return 8 * (i >> 2) + 4 * n + (i & 3); }

struct Unit { int pm, pn; };
struct Gemm { const bf16_t* A; const bf16_t* Bt; int M, N, K, lda, ldb; };

struct StaticOrder {
    int nM, nN, nwg, G, c;
    __host__ __device__ void init(int M, int N, int G_, int c_) { nM = M / BM; nN = N / BM; nwg = nM * nN; G = G_; c = c_; }
    __host__ __device__ bool next(int i, Unit& u) const {
        const long L = (long)i * G + c; if (L >= nwg) return false;
        int wgid = (int)L; { const int q = nwg / NXCD, r = nwg % NXCD, xcd = wgid % NXCD, off = wgid / NXCD; wgid = (xcd < r ? xcd * (q + 1) : r * (q + 1) + (xcd - r) * q) + off; }
        const int nig = WGM * nN, gid = wgid / nig, fm = gid * WGM, gsz = (nM - fm) < WGM ? (nM - fm) : WGM;
        u.pm = fm + ((wgid % nig) % gsz); u.pn = (wgid % nig) / gsz; return true;
    }
    __device__ __forceinline__ void a_ready(const Unit&) const {}
    __device__ __forceinline__ void done(const Unit&) const {}
};
__device__ __forceinline__ unsigned cvt_pk_bf16(float lo, float hi) { return ::pk2(lo, hi); }
template <class Epi, class Sched, bool ALIGN_EPI = false, bool SP2 = false>
__device__ __forceinline__ void gemm_phase(PG8_LAS unsigned char* lds, const Gemm g, const Sched& S, const Epi& E) {
    int tid_ = threadIdx.x; asm volatile("" : "+v"(tid_));
    const int tid = tid_, wid = __builtin_amdgcn_readfirstlane(tid >> 6), lane = tid & 63, wr = wid >> 2, wc = wid & 3, fr = lane & 15, fq = lane >> 4;
    const int K = g.K, nt = K / BK;
    unsigned voffA[2], voffB[2];
#pragma unroll
    for (int i = 0; i < 2; ++i) { int R, C; stage_rc(tid * 16 + i * 8192, R, C); const int Rb = Epi::PERM ? ((R & ~31) + perm32(R & 31)) : R;
        voffA[i] = (unsigned)(R * g.lda + C) * 2u; voffB[i] = (unsigned)(Rb * g.ldb + C) * 2u; }
    const size_t kstep = (size_t)(BK * 2);
    const size_t hstepA = (size_t)HALF * g.lda * 2, hstepB = (size_t)HALF * g.ldb * 2;
    const size_t tstepA = 2 * hstepA, tstepB = 2 * hstepB;
    const unsigned ldsw = (unsigned)wid * 1024u;
    const int aoff = lds_byte(wr * 64 + fr, fq * 8), boff = lds_byte(wc * 32 + fr, fq * 8);
#define PG8_SA(b, h) (((b) * 2 + (h)) * HTB)
#define PG8_SB(b, h) ((4 + (b) * 2 + (h)) * HTB)
#define PG8_STAGE(bufoff, gbase, voff) do { _Pragma("unroll") for (int _i = 0; _i < 2; ++_i) \
        __builtin_amdgcn_global_load_lds((const unsigned*)((const char*)(gbase) + (voff)[_i]), (PG8_LAS unsigned*)(lds + (bufoff) + ldsw + _i * 8192), 16, 0, 0); } while (0)
#define PG8_LDA(dst, b, h) do { _Pragma("unroll") for (int m = 0; m < 4; ++m) _Pragma("unroll") for (int k = 0; k < 2; ++k) dst[m][k] = *(const PG8_LAS bf16x8*)(lds + PG8_SA(b, h) + aoff + m * 2048 + k * 1024); } while (0)
#define PG8_LDB(dst, b, h) do { _Pragma("unroll") for (int n = 0; n < 2; ++n) _Pragma("unroll") for (int k = 0; k < 2; ++k) dst[n][k] = *(const PG8_LAS bf16x8*)(lds + PG8_SB(b, h) + boff + n * 2048 + k * 1024); } while (0)
#define PG8_MMA(ai, bj, At, Bt) do { __builtin_amdgcn_s_setprio(1); _Pragma("unroll") for (int m = 0; m < 4; ++m) _Pragma("unroll") for (int n = 0; n < 2; ++n) _Pragma("unroll") for (int k = 0; k < 2; ++k) \
        acc[ai][bj][m][n] = __builtin_amdgcn_mfma_f32_16x16x32_bf16(Bt[n][k], At[m][k], acc[ai][bj][m][n], 0, 0, 0); __builtin_amdgcn_s_setprio(0); } while (0)
#define PG8_WAIT_V(n) asm volatile("s_waitcnt vmcnt(" #n ")" ::: "memory")
#define PG8_WAIT_L(n) asm volatile("s_waitcnt lgkmcnt(" #n ")" ::: "memory")
#define PG8_BAR __builtin_amdgcn_s_barrier()
#define PG8_SCHED __builtin_amdgcn_sched_barrier(0)
    Unit cur, nxt; int ui = 0;
    if (!S.next(0, cur)) return;
    f32x4 acc[2][2][4][2];
#pragma unroll
    for (int a = 0; a < 2; ++a)
#pragma unroll
        for (int b = 0; b < 2; ++b)
#pragma unroll
            for (int m = 0; m < 4; ++m)
#pragma unroll
                for (int n = 0; n < 2; ++n) acc[a][b][m][n] = (f32x4){0.f, 0.f, 0.f, 0.f};
    bf16x8 At[4][2], B0[2][2], B1[2][2];
    const char* cA = (const char*)g.A + (size_t)cur.pm * tstepA; const char* cB = (const char*)g.Bt + (size_t)cur.pn * tstepB;
    S.a_ready(cur);
    if constexpr (SP2) {
        PG8_STAGE(PG8_SB(0, 0), cB, voffB); PG8_STAGE(PG8_SB(0, 1), cB + hstepB, voffB); PG8_STAGE(PG8_SA(0, 0), cA, voffA); PG8_STAGE(PG8_SA(0, 1), cA + hstepA, voffA);
        if (wr == 1) PG8_BAR;
        PG8_WAIT_V(2); PG8_BAR;
        PG8_STAGE(PG8_SB(1, 0), cB + kstep, voffB); PG8_STAGE(PG8_SA(1, 0), cA + kstep, voffA); PG8_STAGE(PG8_SB(1, 1), cB + hstepB + kstep, voffB);
        PG8_WAIT_V(6); PG8_BAR;
    } else {
        PG8_STAGE(PG8_SB(0, 0), cB, voffB); PG8_STAGE(PG8_SA(0, 0), cA, voffA); PG8_STAGE(PG8_SB(0, 1), cB + hstepB, voffB); PG8_STAGE(PG8_SA(0, 1), cA + hstepA, voffA);
        if (wr == 1) PG8_BAR;
        PG8_WAIT_V(4); PG8_BAR;
        PG8_STAGE(PG8_SB(1, 0), cB + kstep, voffB); PG8_STAGE(PG8_SA(1, 0), cA + kstep, voffA); PG8_STAGE(PG8_SB(1, 1), cB + hstepB + kstep, voffB);
        PG8_WAIT_V(6); PG8_BAR;
    }
    for (;;) {
        const bool has_next = S.next(ui + 1, nxt);
        const char* nA = has_next ? (const char*)g.A + (size_t)nxt.pm * tstepA : cA; const char* nB = has_next ? (const char*)g.Bt + (size_t)nxt.pn * tstepB : cB;
        for (int t = 0; t < nt; t += 2) {
            const bool last = (t == nt - 2);
            const char* a1 = cA + (size_t)(t + 1) * kstep;
            const char* a2 = last ? nA : cA + (size_t)(t + 2) * kstep; const char* b2 = last ? nB : cB + (size_t)(t + 2) * kstep;
            const char* a3 = a2 + kstep; const char* b3 = b2 + kstep;
            if (last && has_next) S.a_ready(nxt);
            if constexpr (SP2) {
            PG8_LDB(B0, 0, 0); PG8_LDB(B1, 0, 1); PG8_SCHED; PG8_LDA(At, 0, 0); PG8_STAGE(PG8_SA(1, 1), a1 + hstepA, voffA);
            PG8_WAIT_V(8); PG8_WAIT_L(0); PG8_BAR; PG8_MMA(0, 0, At, B0); PG8_MMA(0, 1, At, B1); PG8_BAR; PG8_SCHED;
            PG8_LDA(At, 0, 1); PG8_STAGE(PG8_SB(0, 0), b2, voffB); PG8_STAGE(PG8_SB(0, 1), b2 + hstepB, voffB); PG8_STAGE(PG8_SA(0, 0), a2, voffA);
            PG8_WAIT_V(8); PG8_WAIT_L(0); PG8_BAR; PG8_MMA(1, 0, At, B0); PG8_MMA(1, 1, At, B1); PG8_BAR; PG8_SCHED;
            PG8_LDB(B0, 1, 0); PG8_LDB(B1, 1, 1); PG8_SCHED; PG8_LDA(At, 1, 0); PG8_STAGE(PG8_SA(0, 1), a2 + hstepA, voffA);
            PG8_WAIT_V(8); PG8_WAIT_L(0); PG8_BAR; PG8_MMA(0, 0, At, B0); PG8_MMA(0, 1, At, B1); PG8_BAR; PG8_SCHED;
            PG8_LDA(At, 1, 1); PG8_STAGE(PG8_SB(1, 0), b3, voffB); PG8_STAGE(PG8_SB(1, 1), b3 + hstepB, voffB); PG8_STAGE(PG8_SA(1, 0), a3, voffA);
            PG8_WAIT_V(8); PG8_WAIT_L(0); PG8_BAR; PG8_MMA(1, 0, At, B0); PG8_MMA(1, 1, At, B1); PG8_BAR; PG8_SCHED;
            } else {
            PG8_LDB(B0, 0, 0); PG8_SCHED; PG8_LDA(At, 0, 0); PG8_STAGE(PG8_SA(1, 1), a1 + hstepA, voffA);
            PG8_WAIT_L(8); PG8_BAR; PG8_WAIT_L(0); PG8_MMA(0, 0, At, B0); PG8_BAR; PG8_SCHED;
            PG8_LDB(B1, 0, 1); PG8_STAGE(PG8_SB(0, 0), b2, voffB);
            PG8_BAR; PG8_WAIT_L(0); PG8_MMA(0, 1, At, B1); PG8_BAR;
            PG8_LDA(At, 0, 1); PG8_STAGE(PG8_SA(0, 0), a2, voffA);
            PG8_BAR; PG8_WAIT_L(0); PG8_MMA(1, 0, At, B0); PG8_BAR; PG8_SCHED;
            PG8_STAGE(PG8_SB(0, 1), b2 + hstepB, voffB);
            PG8_WAIT_V(6); PG8_BAR; PG8_MMA(1, 1, At, B1); PG8_BAR;
            PG8_LDB(B0, 1, 0); PG8_SCHED; PG8_LDA(At, 1, 0); PG8_STAGE(PG8_SA(0, 1), a2 + hstepA, voffA);
            PG8_WAIT_L(8); PG8_BAR; PG8_WAIT_L(0); PG8_MMA(0, 0, At, B0); PG8_BAR; PG8_SCHED;
            PG8_LDB(B1, 1, 1); PG8_STAGE(PG8_SB(1, 0), b3, voffB);
            PG8_BAR; PG8_WAIT_L(0); PG8_MMA(0, 1, At, B1); PG8_BAR;
            PG8_LDA(At, 1, 1); PG8_STAGE(PG8_SA(1, 0), a3, voffA);
            PG8_BAR; PG8_WAIT_L(0); PG8_MMA(1, 0, At, B0); PG8_BAR; PG8_SCHED;
            PG8_STAGE(PG8_SB(1, 1), b3 + hstepB, voffB);
            PG8_WAIT_V(6); PG8_BAR; PG8_MMA(1, 1, At, B1); PG8_BAR;
            }
        }
        if constexpr (ALIGN_EPI) { if (wr == 0) PG8_BAR; }
        if constexpr (!Epi::AFTER_DRAIN) { E(acc, cur, wr, wc, fr, fq); S.done(cur); }
        if (!has_next) break;
#pragma unroll
        for (int a = 0; a < 2; ++a)
#pragma unroll
            for (int b = 0; b < 2; ++b)
#pragma unroll
                for (int m = 0; m < 4; ++m)
#pragma unroll
                    for (int n = 0; n < 2; ++n) acc[a][b][m][n] = (f32x4){0.f, 0.f, 0.f, 0.f};
        cur = nxt; cA = nA; cB = nB; ++ui;
        if constexpr (ALIGN_EPI) { if (wr == 1) PG8_BAR; }
    }
    PG8_WAIT_V(0);
    if constexpr (!ALIGN_EPI) { if (wr == 0) PG8_BAR; }
    PG8_BAR;
    if constexpr (Epi::AFTER_DRAIN) { E.fused(acc, cur, wr, wc, fr, fq, lds, wid, lane); S.done(cur); }
#undef PG8_SA
#undef PG8_SB
#undef PG8_STAGE
#undef PG8_LDA
#undef PG8_LDB
#undef PG8_MMA
#undef PG8_WAIT_V
#undef PG8_WAIT_L
#undef PG8_BAR
#undef PG8_SCHED
}
}

namespace pg8 {
__device__ __forceinline__ float sigmoidf_(float v) { return 1.f / (1.f + __expf(-v)); }
__device__ __forceinline__ void unpack8(const u32x4 w, float (&f)[8]) {
    f[0] = __uint_as_float(w.x << 16); f[1] = __uint_as_float(w.x & 0xffff0000u); f[2] = __uint_as_float(w.y << 16); f[3] = __uint_as_float(w.y & 0xffff0000u);
    f[4] = __uint_as_float(w.z << 16); f[5] = __uint_as_float(w.z & 0xffff0000u); f[6] = __uint_as_float(w.w << 16); f[7] = __uint_as_float(w.w & 0xffff0000u);
}
template <int MODE> struct EpiX {
    static constexpr bool PERM = true, AFTER_DRAIN = false;
    bf16_t* O; bf16_t* G; const float* xres; const float* gate; float* outf; int ldc; int pad; bf16_t* KCa; bf16_t* KCb; bf16_t* KI; bf16_t* WI;
    __device__ __forceinline__ void operator()(const f32x4 (&acc)[2][2][4][2], const Unit& u, int wr, int wc, int fr, int fq) const {
        const int row0 = u.pm * BM + wr * 64 + fr;
        int colt = u.pn * BM; bf16_t* base = O; int ld = ldc; bool sig = false;
        if (MODE == 1) { if (u.pn >= 15) { colt -= 15 * BM; base = G; ld = GW; sig = true; }
            else if (u.pn >= 10) {
#pragma unroll
                for (int ai = 0; ai < 2; ++ai)
#pragma unroll
                    for (int m = 0; m < 4; ++m) {
                        const int row = row0 + ai * HALF + m * 16, bb = row / S, ss = row % S;
#pragma unroll
                        for (int bj = 0; bj < 2; ++bj) {
                            const int c = wc * 32 + 8 * fq + bj * HALF;
                            const f32x4 v0 = acc[ai][bj][m][0], v1 = acc[ai][bj][m][1];
                            u32x4 w; w.x = cvt_pk_bf16(v0[0], v0[1]); w.y = cvt_pk_bf16(v0[2], v0[3]); w.z = cvt_pk_bf16(v1[0], v1[1]); w.w = cvt_pk_bf16(v1[2], v1[3]);
                            if (u.pn < 14) { const int cc = ((u.pn - 10) & 1) * BM + c; bf16_t* kc = (u.pn < 12) ? KCa : KCb;
                                *(u32x4*)(kc + ((size_t)(bb * 8 + (cc >> 6)) * S + ss) * 64 + (cc & 63)) = w; }
                            else if (c < 64) *(u32x4*)(KI + (size_t)row * 64 + c) = w;
                            else if (c == 64) *(u32x4*)(WI + (size_t)row * 8) = w;
                        }
                    }
                return;
            } }
        if (MODE == 2 || MODE == 3) { base = G; ld = GW; }
        const int col0 = colt + wc * 32 + 8 * fq;
#pragma unroll
        for (int ai = 0; ai < 2; ++ai)
#pragma unroll
            for (int m = 0; m < 4; ++m) {
                const int row = row0 + ai * HALF + m * 16;
#pragma unroll
                for (int bj = 0; bj < 2; ++bj) {
                    const int col = col0 + bj * HALF;
                    f32x4 v0 = acc[ai][bj][m][0], v1 = acc[ai][bj][m][1];
                    if (MODE == 4) {
                        const size_t o = (size_t)row * 1024 + col;
                        const f32x4 x0 = __builtin_nontemporal_load((const f32x4*)(xres + o)), x1 = __builtin_nontemporal_load((const f32x4*)(xres + o + 4));
                        const float* gp = gate + (row / S) * 6144 + col;
                        const f32x4 g0 = *(const f32x4*)gp, g1 = *(const f32x4*)(gp + 4);
                        *(f32x4*)(outf + o) = x0 + g0 * v0; *(f32x4*)(outf + o + 4) = x1 + g1 * v1;
                    } else {
                        bf16_t* pp = base + (size_t)row * ld + col;
                        if (MODE == 1) { if (sig) {
#pragma unroll
                            for (int e = 0; e < 4; ++e) { v0[e] = sigmoidf_(v0[e]); v1[e] = sigmoidf_(v1[e]); } } }
                        if (MODE == 2) { float t[8]; unpack8(*(const u32x4*)pp, t);
#pragma unroll
                            for (int e = 0; e < 4; ++e) { v0[e] *= t[e]; v1[e] *= t[4 + e]; } }
                        if (MODE == 3) { float t[8], gg[8]; unpack8(*(const u32x4*)pp, t); unpack8(*(const u32x4*)(pp + 1024), gg);
#pragma unroll
                            for (int e = 0; e < 4; ++e) { v0[e] = t[e] + gg[e] * v0[e]; v1[e] = t[4 + e] + gg[4 + e] * v1[e]; } }
                        u32x4 w; w.x = cvt_pk_bf16(v0[0], v0[1]); w.y = cvt_pk_bf16(v0[2], v0[3]); w.z = cvt_pk_bf16(v1[0], v1[1]); w.w = cvt_pk_bf16(v1[2], v1[3]);
                        *(u32x4*)pp = w;
                    }
                }
            }
    }
};
}
struct Params {
    const float *x, *c, *w_ada, *b_ada, *g1, *g2, *w_in, *rel_bias, *wpa, *wpb, *wout, *wq, *sk, *pu, *pv, *fg;
    float* out; unsigned char* ws;
};
__device__ __forceinline__ int opaque_tid() { int t = threadIdx.x; asm volatile("" : "+v"(t)); return t; }
typedef unsigned v4u __attribute__((ext_vector_type(4)));
#define LDS_WAIT() asm volatile("s_waitcnt lgkmcnt(0)" ::: "memory")

constexpr size_t WS_BAR = 0;
constexpr size_t CTL_ZERO_BYTES = 16384;
constexpr size_t WS_MOD = 64 * 1024;
constexpr size_t WS_WIN = 1 * MiB;
constexpr size_t WS_WPA = 13 * MiB, WS_WPB = 14 * MiB;
constexpr size_t WS_WOUT = 15 * MiB;
constexpr size_t WS_WQ = 17 * MiB;
constexpr size_t WS_PROJ = 22 * MiB;
constexpr size_t WS_KCA = 102 * MiB, WS_KCB = 118 * MiB;
constexpr size_t WS_KI = 134 * MiB, WS_WI = 136 * MiB;
constexpr size_t WS_G = 142 * MiB;
constexpr size_t WS_YA = 206 * MiB, WS_YB = 222 * MiB;
constexpr size_t WS_HN2 = 22 * MiB;
constexpr size_t WS_QH = 54 * MiB;
constexpr size_t WS_SKB = 21 * MiB;
constexpr size_t WS_EIDX = 118 * MiB;
constexpr size_t WS_GATE = 122 * MiB;
constexpr size_t WS_TAB = 130 * MiB;
constexpr size_t WS_SCALES = 162 * MiB;
constexpr size_t WS_VT = 238 * MiB;
constexpr size_t WS_NEED = 254 * MiB;
constexpr int LDS_SC_OFF = 7 * 16384 + 8448;

__device__ __forceinline__ void ph_mod(const Params& p, float* mod, float* sc) {
    float* part = sc + 2048;
    const int tid = threadIdx.x, kk = tid >> 3, cc = tid & 7;
    for (int i = tid; i < 2048; i += NTHR) { float v = p.c[i]; sc[i] = v / (1.f + expf(-v)); }
    __syncthreads();
    for (int unit = blockIdx.x; unit < 6144 / 24; unit += gridDim.x) {
        const int col = unit * 24 + 3 * cc;
        float a[2][3] = {{0.f, 0.f, 0.f}, {0.f, 0.f, 0.f}};
#pragma unroll 4
        for (int k = kk; k < 1024; k += 64) {
            const float* w = p.w_ada + (size_t)k * 6144 + col;
            const float w0 = __builtin_nontemporal_load(w), w1 = __builtin_nontemporal_load(w + 1), w2 = __builtin_nontemporal_load(w + 2), s0 = sc[k], s1 = sc[1024 + k];
            a[0][0] += s0 * w0; a[0][1] += s0 * w1; a[0][2] += s0 * w2; a[1][0] += s1 * w0; a[1][1] += s1 * w1; a[1][2] += s1 * w2;
        }
#pragma unroll
        for (int b = 0; b < 2; ++b)
#pragma unroll
            for (int j = 0; j < 3; ++j) part[kk * 48 + b * 24 + 3 * cc + j] = a[b][j];
        __syncthreads();
        if (tid < 48) { float s = 0.f; for (int q = 0; q < 64; ++q) s += part[q * 48 + tid]; const int b = tid / 24, j = unit * 24 + tid % 24; mod[b * 6144 + j] = s + p.b_ada[j]; }
        __syncthreads();
    }
}

template <class CM> __device__ __forceinline__ void transpose_item(const float* W, int ldw, int K, bf16* WT, LAS float* scr, int item, int nblk, int lane, const CM& cm) {
    const int kb = item / nblk, nb = item % nblk, k0 = 64 * kb, n0 = 32 * nb;
    const int sc = cm(n0 + (lane & 31));
#pragma unroll 8
    for (int i = 0; i < 32; ++i) { const int kk = 2 * i + (lane >> 5); scr[kk * 33 + (lane & 31)] = (sc >= 0) ? __builtin_nontemporal_load(W + (size_t)(k0 + kk) * ldw + sc) : 0.f; }
    LDS_WAIT(); asm volatile("" ::: "memory");
    const int c = lane & 7;
#pragma unroll
    for (int j = 0; j < 4; ++j) { const int n = (lane >> 3) + 8 * j; const LAS float* s = scr + (8 * c) * 33 + n;
        v4u o; o.x = pk2(s[0 * 33], s[1 * 33]); o.y = pk2(s[2 * 33], s[3 * 33]); o.z = pk2(s[4 * 33], s[5 * 33]); o.w = pk2(s[6 * 33], s[7 * 33]);
        *(v4u*)(WT + (size_t)(n0 + n) * K + k0 + 8 * c) = o; }
    LDS_WAIT(); asm volatile("" ::: "memory");
}
struct CmIdent { __device__ __forceinline__ int operator()(int n) const { return n; } };
struct CmWin {
    __device__ __forceinline__ int operator()(int n) const {
        if (n < 512) return n;
        if (n < 1024) return 1024 + (n - 512);
        if (n < 1536) return 1536 + (n - 1024);
        if (n < 2048) return 2120 + (n - 1536);
        if (n < 2560) return 3144 + (n - 2048);
        if (n < 3072) return 512 + (n - 2560);
        if (n < 3584) return 2632 + (n - 3072);
        if (n < 3648) return 2048 + (n - 3584);
        if (n < 3656) return 2112 + (n - 3648);
        if (n < 3840) return -1;
        return 3656 + (n - 3840);
    }
};
__device__ __forceinline__ void ph_weights(const Params& p, LAS unsigned char* lds) {
    unsigned char* ws = p.ws;
    const int wave = __builtin_amdgcn_readfirstlane(threadIdx.x >> 6), lane = threadIdx.x & 63;
    LAS float* scr = (LAS float*)(lds + wave * 16384);
    const int gw = blockIdx.x * NWAVES + wave, NGW = gridDim.x * NWAVES;
    constexpr int I_IN = 16 * (NPROJ / 32), I_PA = 8 * 32, I_PB = 8 * 32, I_OUT = 16 * 32, I_Q = 16 * 64;
    constexpr int NITEMS = I_IN + I_PA + I_PB + I_OUT + I_Q;
    for (int it = gw; it < NITEMS; it += NGW) {
        int r = it;
        if (r < I_IN) { transpose_item(p.w_in, INW, 1024, (bf16*)(ws + WS_WIN), scr, r, NPROJ / 32, lane, CmWin()); continue; } r -= I_IN;
        if (r < I_PA) { transpose_item(p.wpa, 1024, 512, (bf16*)(ws + WS_WPA), scr, r, 32, lane, CmIdent()); continue; } r -= I_PA;
        if (r < I_PB) { transpose_item(p.wpb, 1024, 512, (bf16*)(ws + WS_WPB), scr, r, 32, lane, CmIdent()); continue; } r -= I_PB;
        if (r < I_OUT) { transpose_item(p.wout, 1024, 1024, (bf16*)(ws + WS_WOUT), scr, r, 32, lane, CmIdent()); continue; } r -= I_OUT;
        transpose_item(p.wq, 2048, 1024, (bf16*)(ws + WS_WQ), scr, r, 64, lane, CmIdent());
    }
    for (int i = gw * 64 + lane; i < 8 * 2 * 128 * 128 / 4; i += NGW * 64) {
        const float4 v = ((const float4*)p.sk)[i]; uint2 w; w.x = pk2(v.x, v.y); w.y = pk2(v.z, v.w); ((uint2*)(ws + WS_SKB))[i] = w;
    }
}

template <bool NT> __device__ __forceinline__ void ph_norm(const float* src, const float* g, const float* mod, int shift_i, int scale_i, bf16* dst) {
    const int lane = threadIdx.x & 63, gw = blockIdx.x * NWAVES + __builtin_amdgcn_readfirstlane(threadIdx.x >> 6), ngw = gridDim.x * NWAVES;
    for (int t = gw; t < T; t += ngw) {
        const int b = t / S;
        float4 v[4]; float ss = 0.f;
#pragma unroll
        for (int i = 0; i < 4; ++i) { const f32x4_t t_ = NT ? __builtin_nontemporal_load((const f32x4_t*)(src + (size_t)t * D) + lane + 64 * i) : *((const f32x4_t*)(src + (size_t)t * D) + lane + 64 * i); v[i] = make_float4(t_.x, t_.y, t_.z, t_.w); ss += v[i].x * v[i].x + v[i].y * v[i].y + v[i].z * v[i].z + v[i].w * v[i].w; }
        ss = wave_sum(ss);
        const float r = rsqrtf(ss * (1.f / D) + EPS);
#pragma unroll
        for (int i = 0; i < 4; ++i) {
            const float4 gg = ((const float4*)g)[lane + 64 * i];
            const float4 sh = ((const float4*)(mod + b * 6144 + shift_i * D))[lane + 64 * i];
            const float4 sc = ((const float4*)(mod + b * 6144 + scale_i * D))[lane + 64 * i];
            float4 o;
            o.x = v[i].x * r * gg.x * (1.f + sc.x) + sh.x; o.y = v[i].y * r * gg.y * (1.f + sc.y) + sh.y;
            o.z = v[i].z * r * gg.z * (1.f + sc.z) + sh.z; o.w = v[i].w * r * gg.w * (1.f + sc.w) + sh.w;
            uint2 w; w.x = pk2(o.x, o.y); w.y = pk2(o.z, o.w);
            ((uint2*)(dst + (size_t)t * D))[lane + 64 * i] = w;
        }
    }
}
__device__ __forceinline__ unsigned f2ord(float f) { unsigned u = __float_as_uint(f); return (u & 0x80000000u) ? ~u : (u | 0x80000000u); }
__device__ __forceinline__ int t5_bucket(int n) {
    if (n < 16) return n;
    int large = 16 + (int)(logf((float)n * (1.f / 16.f)) / 2.0794415416798357f * 16.f);
    return large < 31 ? large : 31;
}

typedef short bf16x8_t __attribute__((ext_vector_type(8)));
template <int CTRL> __device__ __forceinline__ unsigned dppu(unsigned x) { return (unsigned)__builtin_amdgcn_mov_dpp((int)x, CTRL, 0xf, 0xf, true); }
template <int CTRL> __device__ __forceinline__ float dppf(float x) { return __builtin_bit_cast(float, __builtin_amdgcn_mov_dpp(__builtin_bit_cast(int, x), CTRL, 0xf, 0xf, true)); }
__device__ __forceinline__ unsigned row_max_u(unsigned x) { x = max(x, dppu<0xB1>(x)); x = max(x, dppu<0x4E>(x)); x = max(x, dppu<0x141>(x)); x = max(x, dppu<0x128>(x)); return x; }
__device__ __forceinline__ float row_max_f(float x) { x = fmaxf(x, dppf<0xB1>(x)); x = fmaxf(x, dppf<0x4E>(x)); x = fmaxf(x, dppf<0x141>(x)); x = fmaxf(x, dppf<0x128>(x)); return x; }
__device__ __forceinline__ float row_sum_f(float x) { x += dppf<0xB1>(x); x += dppf<0x4E>(x); x += dppf<0x141>(x); x += dppf<0x128>(x); return x; }
__device__ __forceinline__ float ord2f(unsigned k) { return __uint_as_float((k & 0x80000000u) ? (k & 0x7fffffffu) : ~k); }
__device__ __forceinline__ unsigned max3u(unsigned a, unsigned b, unsigned c) { return max(max(a, b), c); }

__device__ __forceinline__ void ph_quant(const Params& p, unsigned char* tab, float* scales) {
    const int lane = threadIdx.x & 63, gw = blockIdx.x * NWAVES + __builtin_amdgcn_readfirstlane(threadIdx.x >> 6), ngw = gridDim.x * NWAVES;
    for (int r = gw; r < 32768; r += ngw) {
        const float* src = (r < 16384) ? p.pu + (size_t)r * D : p.pv + (size_t)(r - 16384) * D;
        float4 v[4]; float am = 0.f;
#pragma unroll
        for (int i = 0; i < 4; ++i) { const f32x4_t t_ = __builtin_nontemporal_load((const f32x4_t*)src + lane + 64 * i); v[i] = make_float4(t_.x, t_.y, t_.z, t_.w);     am = fmaxf(am, fmaxf(fmaxf(fabsf(v[i].x), fabsf(v[i].y)), fmaxf(fabsf(v[i].z), fabsf(v[i].w)))); }
#pragma unroll
        for (int o = 1; o < 64; o <<= 1) am = fmaxf(am, __shfl_xor(am, o));
        const float inv = am > 0.f ? 127.f / am : 0.f;
        uint4 w; unsigned* wp = (unsigned*)&w;
#pragma unroll
        for (int i = 0; i < 4; ++i) {
            const int q0 = (int)rintf(v[i].x * inv) + 128, q1 = (int)rintf(v[i].y * inv) + 128, q2 = (int)rintf(v[i].z * inv) + 128, q3 = (int)rintf(v[i].w * inv) + 128;
            wp[i] = (unsigned)q0 | ((unsigned)q1 << 8) | ((unsigned)q2 << 16) | ((unsigned)q3 << 24);
        }
        ((uint4*)(tab + (size_t)r * 1024))[lane] = w;
        if (lane == 0) scales[r] = am * (1.f / 127.f);
    }
}

#define CE_DESC(x, y) do { const unsigned hi_ = max(x, y), lo_ = min(x, y); x = hi_; y = lo_; } while (0)
__device__ __forceinline__ int hull_ab(int c) {
    int a = 0, base = 0; bool done = false;
#pragma unroll
    for (int aa = 0; aa < 16; ++aa) { const int nb = 16 / (aa + 1); if (!done) { if (c >= base + nb) { base += nb; a = aa + 1; } else done = true; } }
    return (c < 50) ? ((a << 4) | (c - base)) : -1;
}
__device__ __forceinline__ void ph_peer_select(const bf16* qh, const bf16* skb, unsigned short* eidx, float* gate) {
    const int tid = opaque_tid();
    const int lane = tid & 63, fr = lane & 15, fq = lane >> 4;
    const int gw = blockIdx.x * NWAVES + __builtin_amdgcn_readfirstlane(tid >> 6), ngw = gridDim.x * NWAVES;
    int hab[4];
#pragma unroll
    for (int s = 0; s < 4; ++s) hab[s] = hull_ab(16 * s + fr);
    for (int unit = gw; unit < (T / 16) * 2; unit += ngw) {
        const int t0 = (unit >> 1) * 16, hh = unit & 1;
#pragma unroll 1
        for (int hi = 0; hi < 4; ++hi) {
            const int h = hh * 4 + hi;
            unsigned win[2][4];
#pragma unroll
            for (int c = 0; c < 2; ++c) {
                f32x4_t acc[8];
#pragma unroll
                for (int nt = 0; nt < 8; ++nt) acc[nt] = (f32x4_t){0.f, 0.f, 0.f, 0.f};
                const bf16* qrow = qh + (size_t)(t0 + fr) * 2048 + h * 256 + c * 128 + 8 * fq;
                bf16x8_t a[4];
#pragma unroll
                for (int ks = 0; ks < 4; ++ks) a[ks] = *(const bf16x8_t*)(qrow + 32 * ks);
                const bf16* kb = skb + ((size_t)(h * 2 + c) * 128 + fr) * 128 + 8 * fq;
#pragma unroll
                for (int nt = 0; nt < 8; ++nt)
#pragma unroll
                    for (int ks = 0; ks < 4; ++ks) { const bf16x8_t b = *(const bf16x8_t*)(kb + (size_t)nt * 16 * 128 + 32 * ks); acc[nt] = __builtin_amdgcn_mfma_f32_16x16x32_bf16(a[ks], b, acc[nt], 0, 0, 0); }
                unsigned pk[8][4];
#pragma unroll
                for (int nt = 0; nt < 8; ++nt)
#pragma unroll
                    for (int i = 0; i < 4; ++i) pk[nt][i] = (f2ord(acc[nt][i]) & ~127u) | (127u - (unsigned)(16 * nt + fr));
#pragma unroll
                for (int i = 0; i < 4; ++i) {
                    CE_DESC(pk[0][i], pk[1][i]); CE_DESC(pk[2][i], pk[3][i]); CE_DESC(pk[4][i], pk[5][i]); CE_DESC(pk[6][i], pk[7][i]);
                    CE_DESC(pk[0][i], pk[2][i]); CE_DESC(pk[1][i], pk[3][i]); CE_DESC(pk[4][i], pk[6][i]); CE_DESC(pk[5][i], pk[7][i]);
                    CE_DESC(pk[1][i], pk[2][i]); CE_DESC(pk[5][i], pk[6][i]);
                    CE_DESC(pk[0][i], pk[4][i]); CE_DESC(pk[1][i], pk[5][i]); CE_DESC(pk[2][i], pk[6][i]); CE_DESC(pk[3][i], pk[7][i]);
                    CE_DESC(pk[2][i], pk[4][i]); CE_DESC(pk[3][i], pk[5][i]);
                    CE_DESC(pk[1][i], pk[2][i]); CE_DESC(pk[3][i], pk[4][i]); CE_DESC(pk[5][i], pk[6][i]);
                }
#pragma unroll
                for (int r = 0; r < 16; ++r)
#pragma unroll
                    for (int i = 0; i < 4; ++i) {
                        const unsigned m = row_max_u(pk[0][i]);
                        if (fr == r) win[c][i] = m;
                        const bool w = pk[0][i] == m;
#pragma unroll
                        for (int nt = 0; nt < 7; ++nt) pk[nt][i] = w ? pk[nt + 1][i] : pk[nt][i];
                        pk[7][i] = w ? 0u : pk[7][i];
                    }
            }
#pragma unroll
            for (int i = 0; i < 4; ++i) {
                unsigned ck[4];
#pragma unroll
                for (int s = 0; s < 4; ++s) {
                    const int ab = hab[s] < 0 ? 0 : hab[s];
                    const unsigned wa = (unsigned)__shfl((int)win[0][i], (lane & 48) + (ab >> 4)), wb = (unsigned)__shfl((int)win[1][i], (lane & 48) + (ab & 15));
                    const float v = ord2f(wa & ~127u) + ord2f(wb & ~127u);
                    ck[s] = hab[s] < 0 ? 0u : ((f2ord(v) & ~255u) | (255u - (unsigned)ab));
                }
                unsigned mywin = 0u;
#pragma unroll
                for (int r = 0; r < 16; ++r) {
                    unsigned m = max(max(ck[0], ck[1]), max(ck[2], ck[3]));
                    m = row_max_u(m);
                    if (fr == r) mywin = m;
#pragma unroll
                    for (int s = 0; s < 4; ++s) ck[s] = (ck[s] == m) ? 0u : ck[s];
                }
                const unsigned ci = 255u - (mywin & 255u);
                const unsigned w0 = (unsigned)__shfl((int)win[0][i], (lane & 48) + (int)(ci >> 4)), w1 = (unsigned)__shfl((int)win[1][i], (lane & 48) + (int)(ci & 15u));
                const int e = (int)(127u - (w0 & 127u)) * 128 + (int)(127u - (w1 & 127u));
                const float s = ord2f(w0 & ~127u) + ord2f(w1 & ~127u);
                const float mx = row_max_f(s);
                const float ex = __expf(s - mx);
                const float sum = row_sum_f(ex);
                const int t = t0 + 4 * fq + i;
                eidx[(size_t)t * 128 + h * 16 + fr] = (unsigned short)e;
                gate[(size_t)t * 128 + h * 16 + fr] = ex / sum;
            }
        }
    }
}

__device__ __forceinline__ float wave_total_dpp(float x) {
    x = row_sum_f(x);
    return __builtin_bit_cast(float, __builtin_amdgcn_readlane(__builtin_bit_cast(int, x), 0)) + __builtin_bit_cast(float, __builtin_amdgcn_readlane(__builtin_bit_cast(int, x), 16)) +
           __builtin_bit_cast(float, __builtin_amdgcn_readlane(__builtin_bit_cast(int, x), 32)) + __builtin_bit_cast(float, __builtin_amdgcn_readlane(__builtin_bit_cast(int, x), 48));
}
__device__ __forceinline__ float gelu_erf(float x) { return 0.5f * x * (1.f + erff(x * 0.70710678118654752f)); }
__device__ __forceinline__ void ph_peer_gather(const Params& p, const bf16* hn2, const unsigned short* eidx, const float* gate, const unsigned char* tab, const float* scales, const float* mod, const float* xin, float* xout) {
    const int tid = opaque_tid();
    const int lane = tid & 63, gw = blockIdx.x * NWAVES + __builtin_amdgcn_readfirstlane(tid >> 6), ngw = gridDim.x * NWAVES;
    const unsigned char* utab = tab; const unsigned char* vtab = tab + (size_t)16384 * 1024;
    for (int t = gw; t < T; t += ngw) {
        const int b = t / S;
        float hv[16]; float hs = 0.f;
#pragma unroll
        for (int i = 0; i < 4; ++i) { const uint2 w = ((const uint2*)(hn2 + (size_t)t * D))[lane + 64 * i];
            hv[4 * i + 0] = __uint_as_float(w.x << 16); hv[4 * i + 1] = __uint_as_float(w.x & 0xffff0000u); hv[4 * i + 2] = __uint_as_float(w.y << 16); hv[4 * i + 3] = __uint_as_float(w.y & 0xffff0000u);
            hs += (hv[4 * i] + hv[4 * i + 1]) + (hv[4 * i + 2] + hv[4 * i + 3]); }
        hs = wave_total_dpp(hs);
        const int e0 = eidx[(size_t)t * 128 + lane], e1 = eidx[(size_t)t * 128 + 64 + lane];
        const float g0 = gate[(size_t)t * 128 + lane], g1 = gate[(size_t)t * 128 + 64 + lane];
        float pre0 = 0.f, pre1 = 0.f;
#pragma unroll
        for (int half = 0; half < 2; ++half) {
            const int ev = half ? e1 : e0;
            float pre = 0.f;
#pragma unroll 8
            for (int j = 0; j < 64; ++j) {
                const int e = __builtin_amdgcn_readlane(ev, j);
                const uint4 w = ((const uint4*)(utab + (size_t)e * 1024))[lane];
                const unsigned ww[4] = {w.x, w.y, w.z, w.w};
                float d = 0.f;
#pragma unroll
                for (int i = 0; i < 4; ++i) {
                    d += hv[4 * i + 0] * (float)(ww[i] & 0xffu); d += hv[4 * i + 1] * (float)((ww[i] >> 8) & 0xffu);
                    d += hv[4 * i + 2] * (float)((ww[i] >> 16) & 0xffu); d += hv[4 * i + 3] * (float)(ww[i] >> 24);
                }
                d = wave_total_dpp(d);
                pre = (lane == j) ? d : pre;
            }
            if (half) pre1 = pre; else pre0 = pre;
        }
        const float c0 = g0 * gelu_erf(scales[e0] * (pre0 - 128.f * hs)) * scales[16384 + e0];
        const float c1 = g1 * gelu_erf(scales[e1] * (pre1 - 128.f * hs)) * scales[16384 + e1];
        const float corr = 128.f * wave_total_dpp(c0 + c1);
        float acc[16];
#pragma unroll
        for (int i = 0; i < 16; ++i) acc[i] = 0.f;
#pragma unroll
        for (int half = 0; half < 2; ++half) {
            const int ev = half ? e1 : e0; const float cv = half ? c1 : c0;
#pragma unroll 8
            for (int j = 0; j < 64; ++j) {
                const int e = __builtin_amdgcn_readlane(ev, j);
                const float cf = __builtin_bit_cast(float, __builtin_amdgcn_readlane(__builtin_bit_cast(int, cv), j));
                const uint4 w = ((const uint4*)(vtab + (size_t)e * 1024))[lane];
                const unsigned ww[4] = {w.x, w.y, w.z, w.w};
#pragma unroll
                for (int i = 0; i < 4; ++i) {
                    acc[4 * i + 0] += cf * (float)(ww[i] & 0xffu); acc[4 * i + 1] += cf * (float)((ww[i] >> 8) & 0xffu);
                    acc[4 * i + 2] += cf * (float)((ww[i] >> 16) & 0xffu); acc[4 * i + 3] += cf * (float)(ww[i] >> 24);
                }
            }
        }
        float xv[16]; float ss = 0.f;
#pragma unroll
        for (int i = 0; i < 4; ++i) {
            const float4 g2 = ((const float4*)(mod + b * 6144 + 5 * D))[lane + 64 * i];
            const float4 x = ((const float4*)(xin + (size_t)t * D))[lane + 64 * i];
            xv[4 * i + 0] = x.x + g2.x * (acc[4 * i + 0] - corr); xv[4 * i + 1] = x.y + g2.y * (acc[4 * i + 1] - corr);
            xv[4 * i + 2] = x.z + g2.z * (acc[4 * i + 2] - corr); xv[4 * i + 3] = x.w + g2.w * (acc[4 * i + 3] - corr);
            ss += (xv[4 * i] * xv[4 * i] + xv[4 * i + 1] * xv[4 * i + 1]) + (xv[4 * i + 2] * xv[4 * i + 2] + xv[4 * i + 3] * xv[4 * i + 3]);
        }
        ss = wave_total_dpp(ss);
        const float r = rsqrtf(ss * (1.f / D) + EPS);
#pragma unroll
        for (int i = 0; i < 4; ++i) {
            const float4 gg = ((const float4*)p.fg)[lane + 64 * i];
            float4 o; o.x = xv[4 * i + 0] * r * gg.x; o.y = xv[4 * i + 1] * r * gg.y; o.z = xv[4 * i + 2] * r * gg.z; o.w = xv[4 * i + 3] * r * gg.w;
            ((float4*)(xout + (size_t)t * D))[lane + 64 * i] = o;
        }
    }
}

__device__ __forceinline__ void ph_vt(const bf16* proj, int voff, bf16* VT) {
    const int lane = threadIdx.x & 63, gw = blockIdx.x * NWAVES + __builtin_amdgcn_readfirstlane(threadIdx.x >> 6), ngw = gridDim.x * NWAVES;
    for (int u = gw; u < NB * 8 * (S / 64); u += ngw) {
        const int sb = u & 127, h = (u >> 7) & 7, b = u >> 10;
        const bf16* src = proj + (size_t)(b * S + sb * 64) * PW + voff + h * 64 + lane;
        bf16* dst = VT + (((size_t)(b * 8 + h) * (S / 32) + 2 * sb) * 64 + lane) * 32;
        unsigned short e[64];
#pragma unroll
        for (int j = 0; j < 64; ++j) e[j] = src[(size_t)j * PW];
#pragma unroll
        for (int blk = 0; blk < 2; ++blk)
#pragma unroll
            for (int q4 = 0; q4 < 4; ++q4) {
                const int a = 32 * blk + 4 * q4, c = a + 16;
                v4u o; o.x = e[a] | ((unsigned)e[a + 1] << 16); o.y = e[a + 2] | ((unsigned)e[a + 3] << 16); o.z = e[c] | ((unsigned)e[c + 1] << 16); o.w = e[c + 2] | ((unsigned)e[c + 3] << 16);
                *(v4u*)(dst + blk * 64 * 32 + 8 * q4) = o;
            }
    }
}
__device__ __forceinline__ void ph_stick2(const bf16* proj, const bf16* KC, const bf16* VT, bf16* yb) {
    const int tid = opaque_tid();
    const int lane = tid & 63, fr = lane & 15, fq = lane >> 4;
    const int gw = blockIdx.x * NWAVES + __builtin_amdgcn_readfirstlane(tid >> 6), ngw = gridDim.x * NWAVES;
    for (int u = gw; u < (T / 16) * 8; u += ngw) {
        const int h = (u >> 3) & 7, t0 = ((((u >> 6) << 3) | (u & 7))) * 16, b = t0 / S, tl0 = t0 % S;
        const int qpos = tl0 + fr;
        bf16x8_t bq[2];
        { const bf16* qrow = proj + (size_t)(t0 + fr) * PW + OFF_QB + 64 * h + 8 * fq; bq[0] = *(const bf16x8_t*)qrow; bq[1] = *(const bf16x8_t*)(qrow + 32); }
        f32x4_t acc[4];
#pragma unroll
        for (int dt = 0; dt < 4; ++dt) acc[dt] = (f32x4_t){0.f, 0.f, 0.f, 0.f};
        float carry = 0.f;
        const bf16* vtb = VT + ((size_t)(b * 8 + h) * (S / 32) * 64 + fr) * 32 + 8 * fq;
        const bf16* kbase = KC + ((size_t)(b * 8 + h) * S + fr) * 64 + 8 * fq;
        int kb = (tl0 + 15) >> 5;
        bf16x8_t nk[2][2]; v4u nv[4];
#pragma unroll
        for (int tile = 0; tile < 2; ++tile) { const bf16* kr = kbase + (size_t)(32 * kb + 16 * tile) * 64; nk[tile][0] = *(const bf16x8_t*)kr; nk[tile][1] = *(const bf16x8_t*)(kr + 32); }
#pragma unroll
        for (int dt = 0; dt < 4; ++dt) { const bf16* vr = vtb + (size_t)kb * 2048 + (16 * dt) * 32; nv[dt] = *(const v4u*)vr; }
        for (; kb >= 0; --kb) {
            bf16x8_t ck[2][2]; v4u cv[4];
#pragma unroll
            for (int tile = 0; tile < 2; ++tile) { ck[tile][0] = nk[tile][0]; ck[tile][1] = nk[tile][1]; }
#pragma unroll
            for (int dt = 0; dt < 4; ++dt) cv[dt] = nv[dt];
            { const int kbn = kb > 0 ? kb - 1 : 0;
#pragma unroll
              for (int tile = 0; tile < 2; ++tile) { const bf16* kr = kbase + (size_t)(32 * kbn + 16 * tile) * 64; nk[tile][0] = *(const bf16x8_t*)kr; nk[tile][1] = *(const bf16x8_t*)(kr + 32); }
#pragma unroll
              for (int dt = 0; dt < 4; ++dt) { const bf16* vr = vtb + (size_t)kbn * 2048 + (16 * dt) * 32; nv[dt] = *(const v4u*)vr; } }
            unsigned pw[4] = {0u, 0u, 0u, 0u};
#pragma unroll
            for (int tile = 1; tile >= 0; --tile) {
                const int k0 = 32 * kb + 16 * tile;
                if (k0 > tl0 + 14) continue;
                f32x4_t st = (f32x4_t){0.f, 0.f, 0.f, 0.f};
                st = __builtin_amdgcn_mfma_f32_16x16x32_bf16(ck[tile][0], bq[0], st, 0, 0, 0);
                st = __builtin_amdgcn_mfma_f32_16x16x32_bf16(ck[tile][1], bq[1], st, 0, 0, 0);
                float lb[4], l1m[4];
#pragma unroll
                for (int i = 0; i < 4; ++i) {
                    const float z = st[i] * 0.18033688011112042f;
                    const bool valid = (k0 + 4 * fq + i) < qpos;
                    const float sp = fmaxf(-z, 0.f) + __builtin_amdgcn_logf(1.f + __builtin_amdgcn_exp2f(-fabsf(z)));
                    lb[i] = valid ? -sp : -INFINITY;
                    l1m[i] = valid ? (-sp - z) : 0.f;
                }
                const float e2 = l1m[3], e1 = e2 + l1m[2], e0 = e1 + l1m[1], gsum = e0 + l1m[0];
                const float a1 = __shfl(gsum, (lane + 16) & 63), a2 = __shfl(gsum, (lane + 32) & 63), a3 = __shfl(gsum, (lane + 48) & 63);
                const float above = (fq < 3 ? a1 : 0.f) + (fq < 2 ? a2 : 0.f) + (fq < 1 ? a3 : 0.f);
                const float base = carry + above;
                const float w0 = __builtin_amdgcn_exp2f(lb[0] + base + e0), w1 = __builtin_amdgcn_exp2f(lb[1] + base + e1), w2 = __builtin_amdgcn_exp2f(lb[2] + base + e2), w3 = __builtin_amdgcn_exp2f(lb[3] + base);
                carry += (gsum + a1) + (a2 + a3);
                pw[2 * tile] = pk2(w0, w1); pw[2 * tile + 1] = pk2(w2, w3);
            }
            bf16x8_t pb;
            { v4u t; t.x = pw[0]; t.y = pw[1]; t.z = pw[2]; t.w = pw[3]; pb = __builtin_bit_cast(bf16x8_t, t); }
#pragma unroll
            for (int dt = 0; dt < 4; ++dt) {
                acc[dt] = __builtin_amdgcn_mfma_f32_16x16x32_bf16(__builtin_bit_cast(bf16x8_t, cv[dt]), pb, acc[dt], 0, 0, 0);
            }
            if (__all(carry < -173.2f)) break;
        }
#pragma unroll
        for (int dt = 0; dt < 4; ++dt) {
            uint2 o; o.x = pk2(acc[dt][0], acc[dt][1]); o.y = pk2(acc[dt][2], acc[dt][3]);
            *(uint2*)(yb + (size_t)(t0 + fr) * 512 + 64 * h + 16 * dt + 4 * fq) = o;
        }
    }
}

constexpr int IQB = 32, ICAPN = 704, ICAP = 705  , ITRIG = ICAPN - 128, ILOW = 352;
constexpr int LDS_IKEY = 0, LDS_IIDX = IQB * ICAP * 4, LDS_ICNT = ((LDS_IIDX + IQB * ICAP * 2 + 15) / 16) * 16, LDS_ITHR = LDS_ICNT + IQB * 4, LDS_IROW = LDS_ITHR + IQB * 4;
static_assert(LDS_IROW + NWAVES * 1024 <= LDS_BYTES - 16, "indexer LDS map");
__device__ __forceinline__ int wave_count(bool pred) { return __popcll(__ballot(pred)); }
__device__ __forceinline__ int index_keep(int nseen, int ntot) {
    const float f = (float)nseen / (float)ntot, a = (float)(ntot - nseen) / (float)nseen;
    const float s = 2.25f * sqrtf(a) + sqrtf(5.0625f * a + 256.f);
    return (int)ceilf(fmaxf(s * s, 272.f) * f);
}
template <int NE> __device__ __forceinline__ void index_load(LAS unsigned* keyb, LAS unsigned short* idxb, int q, int n, int lane, unsigned (&kv)[NE], unsigned (&iv)[NE]) {
#pragma unroll
    for (int j = 0; j < NE; ++j) { const int pos = lane + 64 * j; const bool in = pos < n; kv[j] = in ? keyb[q * ICAP + pos] : 0u; iv[j] = in ? (unsigned)idxb[q * ICAP + pos] : 0xFFFFu; }
}
template <int NE> __device__ __forceinline__ int index_count_ge(const unsigned (&kv)[NE], unsigned c) {
    int k = 0;
#pragma unroll
    for (int j = 0; j < NE; ++j) k += __popcll(__builtin_amdgcn_uicmp(kv[j], c, 35));
    return k;
}
template <int NE> __device__ __forceinline__ unsigned index_kth(const unsigned (&kv)[NE], int need) {
    unsigned tau = 0u;
#pragma unroll 1
    for (int bit = 31; bit >= 0; --bit) { const unsigned c = tau | (1u << bit); if (index_count_ge<NE>(kv, c) >= need) tau = c; }
    return tau;
}
template <int NE> __device__ __forceinline__ unsigned index_kth_range(const unsigned (&kv)[NE], int lo, int hi, int& cout) {
    unsigned tau = 0u;
#pragma unroll 1
    for (int bit = 31; bit >= 0; --bit) {
        const unsigned c = tau | (1u << bit); const int cc = index_count_ge<NE>(kv, c);
        if (cc >= lo) { tau = c; cout = cc; if (cc <= hi) break; }
    }
    return tau;
}
__device__ __forceinline__ void index_cut(LAS unsigned* keyb, LAS unsigned short* idxb, LAS unsigned* cnt, LAS unsigned* thr, int q, int lane, int K) {
    const int n = (int)cnt[q];
    if (n <= K) return;
    unsigned kv[11], iv[11];
    index_load<11>(keyb, idxb, q, n, lane, kv, iv);
    int c = n;
    const unsigned p = index_kth_range<11>(kv, K, K + (K >> 3), c);
    unsigned tau = p - 1u, iota = 0xFFFFu;
    if (c > 448 || p == 0u) {
        tau = index_kth<11>(kv, TOPK);
        int ngt = 0, neq = 0;
#pragma unroll
        for (int j = 0; j < 11; ++j) { ngt += __popcll(__builtin_amdgcn_uicmp(kv[j], tau, 34)); neq += __popcll(__builtin_amdgcn_uicmp(kv[j], tau, 32)); }
        const int need = TOPK - ngt;
        if (neq > need) {
            unsigned x = 0u;
#pragma unroll 1
            for (int bit = 15; bit >= 0; --bit) {
                const unsigned cc = x | (1u << bit);
                int k = 0;
#pragma unroll
                for (int j = 0; j < 11; ++j) k += wave_count(kv[j] == tau && iv[j] < cc);
                if (k < need) x = cc;
            }
            iota = x;
        }
    }
    int base = 0;
    const unsigned long long lt = (1ull << lane) - 1ull;
#pragma unroll
    for (int j = 0; j < 11; ++j) {
        const bool keep = kv[j] > tau || (kv[j] == tau && iv[j] <= iota);
        const unsigned long long m = __ballot(keep);
        const int pos = base + __popcll(m & lt);
        if (keep) { keyb[q * ICAP + pos] = kv[j]; idxb[q * ICAP + pos] = (unsigned short)iv[j]; }
        base += __popcll(m);
    }
    if (lane == 0) { cnt[q] = (unsigned)base; thr[q] = tau; }
    asm volatile("s_waitcnt lgkmcnt(0)" ::: "memory");
}
template <int NE> __device__ __forceinline__ void index_bits(LAS unsigned* keyb, LAS unsigned short* idxb, int q, int n, int lane) {
    unsigned kv[NE], iv[NE];
    index_load<NE>(keyb, idxb, q, n, lane, kv, iv);
    unsigned tau = 0u, iota = 0xFFFFu;
    if (n > TOPK) {
        int cdummy = 0; tau = index_kth_range<NE>(kv, TOPK, TOPK, cdummy);
        int ngt = 0, neq = 0;
#pragma unroll
        for (int j = 0; j < NE; ++j) { ngt += __popcll(__builtin_amdgcn_uicmp(kv[j], tau, 34)); neq += __popcll(__builtin_amdgcn_uicmp(kv[j], tau, 32)); }
        const int need = TOPK - ngt;
        if (neq > need) {
            unsigned x = 0u;
#pragma unroll 1
            for (int bit = 15; bit >= 0; --bit) {
                const unsigned c = x | (1u << bit);
                int k = 0;
#pragma unroll
                for (int j = 0; j < NE; ++j) k += wave_count(kv[j] == tau && iv[j] < c);
                if (k < need) x = c;
            }
            iota = x;
        }
    }
    LAS unsigned* rowl = keyb + q * ICAP;
    asm volatile("s_waitcnt lgkmcnt(0)" ::: "memory");
#pragma unroll
    for (int i = 0; i < 4; ++i) rowl[lane + 64 * i] = 0u;
    asm volatile("s_waitcnt lgkmcnt(0)" ::: "memory");
#pragma unroll
    for (int j = 0; j < NE; ++j) {
        const bool keep = (n > TOPK) ? (kv[j] > tau || (kv[j] == tau && iv[j] <= iota)) : (lane + 64 * j < n);
        if (keep) (void)__hip_atomic_fetch_or(rowl + (iv[j] >> 5), 1u << (iv[j] & 31u), __ATOMIC_RELAXED, __HIP_MEMORY_SCOPE_WORKGROUP);
    }
    asm volatile("s_waitcnt lgkmcnt(0)" ::: "memory");
}
__device__ __forceinline__ void index_final(LAS unsigned* keyb, LAS unsigned short* idxb, LAS unsigned* cnt, int q, int lane) {
    const int n = (int)cnt[q];
    if (n <= 384) index_bits<6>(keyb, idxb, q, n, lane); else if (n <= 448) index_bits<7>(keyb, idxb, q, n, lane); else if (n <= 576) index_bits<9>(keyb, idxb, q, n, lane); else index_bits<11>(keyb, idxb, q, n, lane);
}
template <int ABL> __device__ __forceinline__ void ph_dsa_index(const bf16* proj, const bf16* KI, const bf16* WI, unsigned* selbits, LAS unsigned char* lds) {
    LAS unsigned* keyb = (LAS unsigned*)(lds + LDS_IKEY); LAS unsigned short* idxb = (LAS unsigned short*)(lds + LDS_IIDX);
    LAS unsigned* cnt = (LAS unsigned*)(lds + LDS_ICNT); LAS unsigned* thr = (LAS unsigned*)(lds + LDS_ITHR);
    const int tid = opaque_tid(), wave = __builtin_amdgcn_readfirstlane(tid >> 6), lane = tid & 63, fr = lane & 15, fq = lane >> 4;
    LAS unsigned* rowl = (LAS unsigned*)(lds + LDS_IROW + wave * 1024);
    constexpr int NQB = S / IQB;
    for (int pr = blockIdx.x; pr < NB * NQB / 2; pr += gridDim.x) {
        const int b = pr / (NQB / 2), pp = pr % (NQB / 2);
#pragma unroll 1
        for (int ui = 0; ui < 2; ++ui) {
            const int qb = ui ? pp : (NQB - 1 - pp);
            const int q0 = qb * IQB, t0 = b * S + q0;
            bf16x8_t bqf[2][8][2]; unsigned wvp[2][4];
#pragma unroll
            for (int qg = 0; qg < 2; ++qg) {
                const bf16* qrow = proj + (size_t)(t0 + 16 * qg + fr) * PW;
#pragma unroll
                for (int h = 0; h < 8; ++h) { bqf[qg][h][0] = *(const bf16x8_t*)(qrow + OFF_QI + 64 * h + 8 * fq); bqf[qg][h][1] = *(const bf16x8_t*)(qrow + OFF_QI + 64 * h + 8 * fq + 32); }
                { const uint4 w4 = *(const uint4*)(WI + (size_t)(t0 + 16 * qg + fr) * 8); wvp[qg][0] = w4.x; wvp[qg][1] = w4.y; wvp[qg][2] = w4.z; wvp[qg][3] = w4.w; }
            }
            const int ntiles = (q0 + IQB - 1) / 128 + 1;
            const bf16* kwave = KI + (size_t)(b * S + 16 * wave + fr) * 64 + 8 * fq;
#pragma unroll 1
            for (int cons = 0; cons < 2; ++cons) {
            __syncthreads();
            if (tid < IQB) { cnt[tid] = 0u; thr[tid] = 0u; }
            bf16x8_t ak0 = *(const bf16x8_t*)kwave, ak1 = *(const bf16x8_t*)(kwave + 32);
#pragma unroll 1
            for (int kt = 0; kt < ntiles; ++kt) {
                asm volatile("s_waitcnt lgkmcnt(0)" ::: "memory"); __builtin_amdgcn_s_barrier(); asm volatile("" ::: "memory");
                if (__any((int)cnt[lane & 31] > ITRIG)) {
#pragma unroll 1
                    for (int qq = 0; qq < 4; ++qq) { const int q = 4 * wave + qq; if ((int)cnt[q] > ILOW) { if (ABL == 2) { if (lane == 0) cnt[q] = 256u; } else {
                        const int ntot = q0 + q + 1, nseen = min(128 * kt, ntot);
                        const int K = cons ? TOPK : __builtin_amdgcn_readfirstlane(max(index_keep(nseen, ntot), 32));
                        index_cut(keyb, idxb, cnt, thr, q, lane, K); } } }
                    asm volatile("s_waitcnt lgkmcnt(0)" ::: "memory"); __builtin_amdgcn_s_barrier(); asm volatile("" ::: "memory");
                }
                const unsigned th0 = thr[fr], th1 = thr[16 + fr];
                const int k0 = 128 * kt + 16 * wave;
                const bf16x8_t a0 = ak0, a1 = ak1;
                { const bf16* kn = kwave + (size_t)(128 * ((kt + 1 < ntiles) ? kt + 1 : kt)) * 64; ak0 = *(const bf16x8_t*)kn; ak1 = *(const bf16x8_t*)(kn + 32); }
#pragma unroll
                for (int qg = 0; qg < 2; ++qg) {
                    float sc[4] = {0.f, 0.f, 0.f, 0.f};
#pragma unroll
                    for (int h = 0; h < 8; ++h) {
                        f32x4_t a = (f32x4_t){0.f, 0.f, 0.f, 0.f};
                        a = __builtin_amdgcn_mfma_f32_16x16x32_bf16(a0, bqf[qg][h][0], a, 0, 0, 0);
                        a = __builtin_amdgcn_mfma_f32_16x16x32_bf16(a1, bqf[qg][h][1], a, 0, 0, 0);
                        const float wh = (h & 1) ? __uint_as_float(wvp[qg][h >> 1] & 0xffff0000u) : __uint_as_float(wvp[qg][h >> 1] << 16);
#pragma unroll
                        for (int i = 0; i < 4; ++i) { const float af_ = a[i]; sc[i] += wh * __int_as_float(max(__float_as_int(af_), 0)); asm("" : "+v"(sc[i])); }
                    }
                    const int qi = 16 * qg + fr, qpos = q0 + qi;
                    const unsigned th = qg ? th1 : th0;
                    unsigned keyv[4], slot[4]; bool prd[4];
#pragma unroll
                    for (int i = 0; i < 4; ++i) {
                        float s = sc[i]; if (s == 0.f) s = 0.f;
                        keyv[i] = f2ord(s);
                        prd[i] = (ABL != 1) && (k0 + 4 * fq + i <= qpos) && (keyv[i] > th);
                    }
#pragma unroll
                    for (int i = 0; i < 4; ++i) slot[i] = prd[i] ? __hip_atomic_fetch_add(cnt + qi, 1u, __ATOMIC_RELAXED, __HIP_MEMORY_SCOPE_WORKGROUP) : 0u;
#pragma unroll
                    for (int i = 0; i < 4; ++i) if (prd[i]) { keyb[qi * ICAP + slot[i]] = keyv[i]; idxb[qi * ICAP + slot[i]] = (unsigned short)(k0 + 4 * fq + i); }
                }
            }
            __syncthreads();
            if (!__any((int)cnt[lane & 31] < min(TOPK, q0 + (lane & 31) + 1))) break;
            }
#pragma unroll 1
            for (int qq = 0; qq < (ABL == 0 ? 4 : 0); ++qq) { const int q = 4 * wave + qq; index_final(keyb, idxb, cnt, q, lane); }
            if (ABL == 0) {
                __syncthreads();
                unsigned* dst = selbits + ((size_t)(b * (S / 32) + qb) * 128) * 64;
                for (int idx = tid; idx < 128 * 32; idx += NTHR) { const int kt = idx >> 5, qq = idx & 31;
                    uint2 w; w.x = keyb[qq * ICAP + 2 * kt]; w.y = keyb[qq * ICAP + 2 * kt + 1];
                    *(uint2*)(dst + (size_t)idx * 2) = w; }
            }
        }
    }
    __syncthreads();
}

constexpr int AQB = 256, AKT = 64, AROW = 144;
constexpr int LDS_AK = 0, LDS_AV = AKT * AROW, LDS_ABUF = 2 * AKT * AROW, LDS_ABLUT = 2 * LDS_ABUF;
__device__ __forceinline__ float bfi_f(unsigned mask, unsigned a, unsigned b) { unsigned r_; asm("v_bfi_b32 %0, %1, %2, %3" : "=v"(r_) : "v"(mask), "v"(a), "v"(b)); return __uint_as_float(r_); }
template <bool NEAR> __device__ __forceinline__ void attn_tile(LAS unsigned char* buf, LAS float* blut, const bf16x8_t (&bq)[2][2], const uint2 cb0, const uint2 cb1, int qw, int k0, int fr, int fq,
                                                               const bf16x8_t ones, f32x4_t (&acc)[2][4], f32x4_t (&accl)[2], float (&mrun)[2]) {
    const float cfar = blut[128];
    const unsigned ninf = 0xff800000u;
    bf16x8_t kf[4][2];
#pragma unroll
    for (int tile = 0; tile < 4; ++tile)
#pragma unroll
        for (int ks = 0; ks < 2; ++ks) kf[tile][ks] = *(const LAS bf16x8_t*)(buf + LDS_AK + (16 * tile + fr) * AROW + (8 * fq + 32 * ks) * 2);
    f32x4_t sx[2][4];
#pragma unroll
    for (int qg = 0; qg < 2; ++qg)
#pragma unroll
        for (int tile = 0; tile < 4; ++tile) { sx[qg][tile] = (f32x4_t){0.f, 0.f, 0.f, 0.f};
            sx[qg][tile] = __builtin_amdgcn_mfma_f32_16x16x32_bf16(kf[tile][0], bq[qg][0], sx[qg][tile], 0, 0, 0); sx[qg][tile] = __builtin_amdgcn_mfma_f32_16x16x32_bf16(kf[tile][1], bq[qg][1], sx[qg][tile], 0, 0, 0); }
    float x[2][16]; float mt[2];
#pragma unroll
    for (int qg = 0; qg < 2; ++qg) {
        const uint2 cb = qg ? cb1 : cb0;
        const int dist0 = (qw + 16 * qg + fr) - (k0 + 4 * fq);
        const float mref = (mrun[qg] == -INFINITY) ? 0.f : mrun[qg];
        const float cfm = cfar - mref;
#pragma unroll
        for (int tile = 0; tile < 4; ++tile) {
            const int nib = (int)(((tile & 2) ? cb.y : cb.x) >> (16 * (tile & 1) + 4 * fq));
#pragma unroll
            for (int i = 0; i < 4; ++i) {
                const unsigned t = (unsigned)__builtin_amdgcn_sbfe(nib, i, 1);
                float bias = cfm;
                if (NEAR) { int n = dist0 - (16 * tile + i); n = n < 0 ? 0 : (n > 128 ? 128 : n); bias = blut[n] - mref; }
                x[qg][4 * tile + i] = __builtin_fmaf(sx[qg][tile][i], 0.18033688011112042f, bfi_f(t, __float_as_uint(bias), ninf));
                asm("" : "+v"(x[qg][4 * tile + i]));
            }
        }
        float m8 = fmaxf(fmaxf(fmaxf(x[qg][0], x[qg][1]), fmaxf(x[qg][2], x[qg][3])), fmaxf(fmaxf(x[qg][4], x[qg][5]), fmaxf(x[qg][6], x[qg][7])));
        m8 = fmaxf(m8, fmaxf(fmaxf(fmaxf(x[qg][8], x[qg][9]), fmaxf(x[qg][10], x[qg][11])), fmaxf(fmaxf(x[qg][12], x[qg][13]), fmaxf(x[qg][14], x[qg][15]))));
        m8 = fmaxf(m8, __shfl_xor(m8, 16)); mt[qg] = fmaxf(m8, __shfl_xor(m8, 32));
    }
    const bool rc0 = (mt[0] > 24.f) || (mrun[0] == -INFINITY && mt[0] > -INFINITY), rc1 = (mt[1] > 24.f) || (mrun[1] == -INFINITY && mt[1] > -INFINITY);
    if (__any(rc0 || rc1)) {
#pragma unroll
        for (int qg = 0; qg < 2; ++qg) {
            const bool rc = qg ? rc1 : rc0;
            const float sh = rc ? mt[qg] : 0.f;
            const float f = (rc && mrun[qg] != -INFINITY) ? __builtin_amdgcn_exp2f(-sh) : 1.f;
            mrun[qg] = rc ? (((mrun[qg] == -INFINITY) ? 0.f : mrun[qg]) + sh) : mrun[qg];
            accl[qg] = accl[qg] * f;
#pragma unroll
            for (int dt = 0; dt < 4; ++dt) acc[qg][dt] = acc[qg][dt] * f;
#pragma unroll
            for (int e = 0; e < 16; ++e) x[qg][e] -= sh;
        }
    }
#pragma unroll
    for (int blk = 0; blk < 2; ++blk) {
        bf16x8_t vf[4];
#pragma unroll
        for (int dt = 0; dt < 4; ++dt) vf[dt] = *(const LAS bf16x8_t*)(buf + LDS_AV + (16 * dt + fr) * AROW + (32 * blk + 8 * fq) * 2);
#pragma unroll
        for (int qg = 0; qg < 2; ++qg) {
            v4u t;
            t.x = pk2(__builtin_amdgcn_exp2f(x[qg][8 * blk + 0]), __builtin_amdgcn_exp2f(x[qg][8 * blk + 1])); t.y = pk2(__builtin_amdgcn_exp2f(x[qg][8 * blk + 2]), __builtin_amdgcn_exp2f(x[qg][8 * blk + 3]));
            t.z = pk2(__builtin_amdgcn_exp2f(x[qg][8 * blk + 4]), __builtin_amdgcn_exp2f(x[qg][8 * blk + 5])); t.w = pk2(__builtin_amdgcn_exp2f(x[qg][8 * blk + 6]), __builtin_amdgcn_exp2f(x[qg][8 * blk + 7]));
            const bf16x8_t pb = __builtin_bit_cast(bf16x8_t, t);
            accl[qg] = __builtin_amdgcn_mfma_f32_16x16x32_bf16(ones, pb, accl[qg], 0, 0, 0);
#pragma unroll
            for (int dt = 0; dt < 4; ++dt) acc[qg][dt] = __builtin_amdgcn_mfma_f32_16x16x32_bf16(vf[dt], pb, acc[qg][dt], 0, 0, 0);
        }
    }
}
__device__ __forceinline__ void ph_dsa_attn2(const Params& p, const bf16* proj, const bf16* KC, const bf16* VTa, const unsigned* selbits, bf16* ya, LAS unsigned char* lds) {
    const int tid = opaque_tid(), wave = __builtin_amdgcn_readfirstlane(tid >> 6), lane = tid & 63, fr = lane & 15, fq = lane >> 4;
    LAS float* blut = (LAS float*)(lds + LDS_ABLUT);
    constexpr int NQBA = S / AQB;
    const int ldr = tid >> 3, ldc = tid & 7;
    for (int pr = blockIdx.x; pr < NB * 8 * NQBA / 2; pr += gridDim.x) {
        const int bh = pr / (NQBA / 2), pp = pr % (NQBA / 2), b = bh >> 3, h = bh & 7;
        __syncthreads();
        if (tid <= 128) blut[tid] = p.rel_bias[(tid >= 128 ? 31 : t5_bucket(tid)) * 8 + h] * 1.4426950408889634f;
        const bf16* kg = KC + ((size_t)(b * 8 + h) * S + ldr) * 64 + 8 * ldc;
        const bf16* vg = VTa + ((size_t)(b * 8 + h) * (S / 32) * 64 + (ldc >> 2) * 64 + ldr) * 32 + 8 * (ldc & 3);
#pragma unroll 1
        for (int ui = 0; ui < 2; ++ui) {
            const int qb = ui ? pp : (NQBA - 1 - pp);
            const int q0 = qb * AQB, qw = q0 + 32 * wave;
            const int ntiles = (q0 + AQB) / AKT;
            bf16x8_t bq[2][2];
#pragma unroll
            for (int qg = 0; qg < 2; ++qg) { const bf16* qrow = proj + (size_t)(b * S + qw + 16 * qg + fr) * PW + OFF_QA + 64 * h + 8 * fq; bq[qg][0] = *(const bf16x8_t*)qrow; bq[qg][1] = *(const bf16x8_t*)(qrow + 32); }
            const unsigned* brow0 = selbits + ((size_t)(b * (S / 32) + (qw >> 5)) * 128) * 64 + 2 * fr;
            const unsigned* brow1 = brow0 + 32;
            f32x4_t acc[2][4], accl[2]; float mrun[2];
            const bf16x8_t ones = __builtin_bit_cast(bf16x8_t, (v4u){0x3f803f80u, 0x3f803f80u, 0x3f803f80u, 0x3f803f80u});
#pragma unroll
            for (int qg = 0; qg < 2; ++qg) { mrun[qg] = -INFINITY; accl[qg] = (f32x4_t){0.f, 0.f, 0.f, 0.f};
#pragma unroll
                for (int dt = 0; dt < 4; ++dt) acc[qg][dt] = (f32x4_t){0.f, 0.f, 0.f, 0.f}; }
            __syncthreads();
            { const v4u kk = *(const v4u*)kg, vv = *(const v4u*)vg;
              *(LAS v4u*)(lds + LDS_AK + ldr * AROW + 16 * ldc) = kk; *(LAS v4u*)(lds + LDS_AV + ldr * AROW + 16 * ldc) = vv; }
            uint2 wb0 = *(const uint2*)brow0, wb1 = *(const uint2*)brow1;
            __syncthreads();
#pragma unroll 1
            for (int kt = 0; kt < ntiles; ++kt) {
                const int k0 = kt * AKT;
                LAS unsigned char* buf = lds + (kt & 1) * LDS_ABUF;
                const int ktn = (kt + 1 < ntiles) ? kt + 1 : kt;
                const uint2 cb0 = wb0, cb1 = wb1;
                const v4u nk = *(const v4u*)(kg + (size_t)(ktn * AKT) * 64), nvv = *(const v4u*)(vg + (size_t)(ktn * AKT / 32) * 2048);
                wb0 = *(const uint2*)(brow0 + 64 * ktn); wb1 = *(const uint2*)(brow1 + 64 * ktn);
                if (k0 <= qw + 31) {
                    if ((k0 + AKT - 1 + 128) > qw) attn_tile<true>(buf, blut, bq, cb0, cb1, qw, k0, fr, fq, ones, acc, accl, mrun);
                    else attn_tile<false>(buf, blut, bq, cb0, cb1, qw, k0, fr, fq, ones, acc, accl, mrun);
                }
                { LAS unsigned char* nb = lds + ((kt + 1) & 1) * LDS_ABUF;
                    *(LAS v4u*)(nb + LDS_AK + ldr * AROW + 16 * ldc) = nk; *(LAS v4u*)(nb + LDS_AV + ldr * AROW + 16 * ldc) = nvv; }
                asm volatile("s_waitcnt lgkmcnt(0)" ::: "memory"); __builtin_amdgcn_s_barrier(); asm volatile("" ::: "memory");
            }
#pragma unroll
            for (int qg = 0; qg < 2; ++qg) {
                const float inv = 1.f / accl[qg][0];
#pragma unroll
                for (int dt = 0; dt < 4; ++dt) { uint2 o; o.x = pk2(acc[qg][dt][0] * inv, acc[qg][dt][1] * inv); o.y = pk2(acc[qg][dt][2] * inv, acc[qg][dt][3] * inv);
                    *(uint2*)(ya + (size_t)(b * S + qw + 16 * qg + fr) * 512 + 64 * h + 16 * dt + 4 * fq) = o; }
            }
        }
    }
    __syncthreads();
}

__global__ void __launch_bounds__(NTHR, 2) mega_fwd(Params p) {
    extern __shared__ __attribute__((aligned(16))) unsigned char lds[];
    float* sm = (float*)lds;
    LAS unsigned char* ldsl = (LAS unsigned char*)lds;
    volatile LAS unsigned* bst = (volatile LAS unsigned*)(ldsl + LDS_BYTES - 16);
    if (threadIdx.x == 0) { bst[0] = 0u; bst[1] = 0u; bst[2] = 0u; bst[3] = 0u; }
    __syncthreads();
    XcdBarrier bar = xcd_barrier_post((unsigned*)(p.ws + WS_BAR), bst);
    unsigned char* ws = p.ws;
    float* mod = (float*)(ws + WS_MOD);
    bf16* proj = (bf16*)(ws + WS_PROJ);
    bf16* G = (bf16*)(ws + WS_G);
    bf16* ya = (bf16*)(ws + WS_YA); bf16* yb = (bf16*)(ws + WS_YB);
    bf16* hn2 = (bf16*)(ws + WS_HN2); bf16* qh = (bf16*)(ws + WS_QH);
    bf16* hn = (bf16*)p.out;
    const int G_ = gridDim.x, c_ = blockIdx.x;

    ph_mod(p, mod, (float*)(lds + LDS_SC_OFF));
    ph_weights(p, ldsl);
    xcd_barrier(bar);
    ph_norm<true>(p.x, p.g1, mod, 0, 1, hn);
    xcd_barrier(bar);
    {
        pg8::Gemm g{hn, (const bf16*)(ws + WS_WIN), T, NPROJ, D, D, D}; pg8::StaticOrder So; So.init(T, NPROJ, G_, c_);
        pg8::EpiX<1> E{proj, G, nullptr, nullptr, nullptr, PW, 0, (bf16*)(ws + WS_KCA), (bf16*)(ws + WS_KCB), (bf16*)(ws + WS_KI), (bf16*)(ws + WS_WI)};
        pg8::gemm_phase<pg8::EpiX<1>, pg8::StaticOrder, true, true>(ldsl, g, So, E);
    }
    xcd_barrier(bar);
    unsigned* selbits = (unsigned*)((unsigned char*)p.out + 32 * MiB); bf16* VTa = (bf16*)p.out;
    ph_vt(proj, OFF_VB, (bf16*)(ws + WS_VT));
    ph_vt(proj, OFF_VA, VTa);
    ph_dsa_index<0>(proj, (const bf16*)(ws + WS_KI), (const bf16*)(ws + WS_WI), selbits, ldsl);
    xcd_barrier(bar);
    ph_dsa_attn2(p, proj, (const bf16*)(ws + WS_KCA), VTa, selbits, ya, ldsl);
    ph_stick2(proj, (const bf16*)(ws + WS_KCB), (const bf16*)(ws + WS_VT), yb);
    xcd_barrier(bar);
    {
        pg8::Gemm g{ya, (const bf16*)(ws + WS_WPA), T, D, 512, 512, 512}; pg8::StaticOrder So; So.init(T, D, G_, c_);
        pg8::EpiX<2> E{nullptr, G, nullptr, nullptr, nullptr, 0, 0, nullptr, nullptr, nullptr, nullptr};
        pg8::gemm_phase<pg8::EpiX<2>, pg8::StaticOrder, true, true>(ldsl, g, So, E);
    }
    {
        pg8::Gemm g{yb, (const bf16*)(ws + WS_WPB), T, D, 512, 512, 512}; pg8::StaticOrder So; So.init(T, D, G_, c_);
        pg8::EpiX<3> E{nullptr, G, nullptr, nullptr, nullptr, 0, 0, nullptr, nullptr, nullptr, nullptr};
        pg8::gemm_phase<pg8::EpiX<3>, pg8::StaticOrder, true, true>(ldsl, g, So, E);
    }
    xcd_barrier(bar);
    {
        pg8::Gemm g{G, (const bf16*)(ws + WS_WOUT), T, D, D, GW, D}; pg8::StaticOrder So; So.init(T, D, G_, c_);
        pg8::EpiX<4> E{nullptr, nullptr, p.x, mod + 2 * D, p.out, 0, 0, nullptr, nullptr, nullptr, nullptr};
        pg8::gemm_phase<pg8::EpiX<4>, pg8::StaticOrder, true, true>(ldsl, g, So, E);
    }
    xcd_barrier(bar);
    ph_norm<false>(p.out, p.g2, mod, 3, 4, hn2);
    ph_quant(p, ws + WS_TAB, (float*)(ws + WS_SCALES));
    xcd_barrier(bar);
    {
        pg8::Gemm g{hn2, (const bf16*)(ws + WS_WQ), T, 2048, D, D, D}; pg8::StaticOrder So; So.init(T, 2048, G_, c_);
        pg8::EpiX<0> E{qh, nullptr, nullptr, nullptr, nullptr, 2048, 0, nullptr, nullptr, nullptr, nullptr};
        pg8::gemm_phase<pg8::EpiX<0>, pg8::StaticOrder, true, true>(ldsl, g, So, E);
    }
    xcd_barrier(bar);
    ph_peer_select(qh, (const bf16*)(ws + WS_SKB), (unsigned short*)(ws + WS_EIDX), (float*)(ws + WS_GATE));
    xcd_barrier(bar);
    ph_peer_gather(p, hn2, (const unsigned short*)(ws + WS_EIDX), (const float*)(ws + WS_GATE), ws + WS_TAB, (const float*)(ws + WS_SCALES), mod, p.out, p.out);
}

extern "C" void kernel_launch(void* const* d_in, const int* in_sizes, int n_in, void* d_out, int out_size, void* d_ws, size_t ws_size, hipStream_t stream) {
    static int grid = 0;
    if (grid == 0) {
        if (n_in != 16 || out_size != T * D || ws_size < WS_NEED) { fprintf(stderr, "kernel_launch: unexpected shapes (n_in %d out %d ws %zu)\n", n_in, out_size, ws_size); grid = -1; return; }
        int dev = 0, cus = 0, per_cu = 0;
        if (hipGetDevice(&dev) != hipSuccess || hipDeviceGetAttribute(&cus, hipDeviceAttributeMultiprocessorCount, dev) != hipSuccess) { grid = -1; return; }
        if (hipFuncSetAttribute((const void*)mega_fwd, hipFuncAttributeMaxDynamicSharedMemorySize, LDS_BYTES) != hipSuccess) { fprintf(stderr, "kernel_launch: hipFuncSetAttribute failed\n"); grid = -1; return; }
        if (hipOccupancyMaxActiveBlocksPerMultiprocessor(&per_cu, (const void*)mega_fwd, NTHR, LDS_BYTES) != hipSuccess || per_cu < 1) { fprintf(stderr, "kernel_launch: occupancy query says %d\n", per_cu); per_cu = 1; }
        (void)hipGetLastError();
        grid = cus;
    }
    if (grid < 0) return;
    (void)hipMemsetAsync((char*)d_ws + WS_BAR, 0, CTL_ZERO_BYTES, stream);
    Params p; memset(&p, 0, sizeof(p));
    p.x = (const float*)d_in[0]; p.c = (const float*)d_in[1]; p.w_ada = (const float*)d_in[2]; p.b_ada = (const float*)d_in[3];
    p.g1 = (const float*)d_in[4]; p.g2 = (const float*)d_in[5]; p.w_in = (const float*)d_in[6]; p.rel_bias = (const float*)d_in[7];
    p.wpa = (const float*)d_in[8]; p.wpb = (const float*)d_in[9]; p.wout = (const float*)d_in[10]; p.wq = (const float*)d_in[11];
    p.sk = (const float*)d_in[12]; p.pu = (const float*)d_in[13]; p.pv = (const float*)d_in[14]; p.fg = (const float*)d_in[15];
    p.out = (float*)d_out; p.ws = (unsigned char*)d_ws;
    hipLaunchKernelGGL(mega_fwd, dim3(grid), dim3(NTHR), LDS_BYTES, stream, p);
}
```

```cpp
#include <hip/hip_runtime.h>
#include <stdint.h>
#include <math.h>
#include <string.h>
#include <stdio.h>

typedef unsigned short bf16;
constexpr int D = 1024, NB = 2, S = 8192, T = NB * S;
constexpr int INW = 5704;
constexpr int OFF_QA = 0, OFF_VA = 512, OFF_QI = 1024, OFF_QB = 1536, OFF_VB = 2048;
constexpr int PW = 2560;
constexpr int NPROJ = 3840 + 2048;
constexpr int GW = 2048;
constexpr int TOPK = 256;
constexpr float EPS = 1e-6f;
constexpr size_t MiB = 1u << 20;
constexpr int NTHR = 512, NWAVES = 8;
constexpr int LDS_BYTES = 147456;

#define LAS __attribute__((address_space(3)))

__device__ __forceinline__ bf16 f2bf(float f) { unsigned u = __float_as_uint(f); return (bf16)((u + 0x7fffu + ((u >> 16) & 1u)) >> 16); }
__device__ __forceinline__ float bf2f(bf16 h) { return __uint_as_float(((unsigned)h) << 16); }
typedef __bf16 bf16x2_hw __attribute__((ext_vector_type(2)));
__device__ __forceinline__ unsigned pk2(float lo, float hi) { bf16x2_hw v; v[0] = (__bf16)lo; v[1] = (__bf16)hi; return __builtin_bit_cast(unsigned, v); }

__device__ __forceinline__ float wave_sum(float v) {
#pragma unroll
    for (int o = 1; o < 64; o <<= 1) v += __shfl_xor(v, o);
    return v;
}
__device__ __forceinline__ float block_sum(float v, float* red) {
    v = wave_sum(v);
    __syncthreads();
    if ((threadIdx.x & 63) == 0) red[threadIdx.x >> 6] = v;
    __syncthreads();
    float s = 0.f;
#pragma unroll
    for (int i = 0; i < NWAVES; ++i) s += red[i];
    return s;
}
typedef float f32x4_t __attribute__((ext_vector_type(4)));
#define XB_TMO      128
#define XB_XCNT(j)  (256  + 64 * (j))
#define XB_XSUB(j)  (1280 + 64 * (j))
#define XB_XGEN(j)  (2304 + 64 * (j))
#define XB_TOP      3328
#define XB_TOPGEN   3392
#define XCD_BAR_WORDS 3456
#define XB_SPIN_CAP (1u << 22)

__device__ __forceinline__ unsigned xb_ld(unsigned* p)              { return __hip_atomic_load(p, __ATOMIC_RELAXED, __HIP_MEMORY_SCOPE_AGENT); }
__device__ __forceinline__ unsigned xb_add(unsigned* p, unsigned v) { return __hip_atomic_fetch_add(p, v, __ATOMIC_RELAXED, __HIP_MEMORY_SCOPE_AGENT); }
__device__ __forceinline__ unsigned xb_xcc_id() { return (unsigned)__builtin_amdgcn_s_getreg((3 << 11) | 20) & 0xFu; }
#define XB_SPIN(cond, bar) do { unsigned _sp = 0; while (cond) { __builtin_amdgcn_s_sleep(1); \
    if ((++_sp & 255u) == 0u) { if (xb_ld(&(bar)[XB_TMO])) break; if (_sp > XB_SPIN_CAP) { atomicAdd(&(bar)[XB_TMO], 1u); break; } } } } while (0)

struct XcdBarrier {
    unsigned* bar; unsigned x;
    volatile LAS unsigned* st;
};

__device__ __forceinline__ XcdBarrier xcd_barrier_post(unsigned* bar, volatile LAS unsigned* st) {
    XcdBarrier b; b.bar = bar; b.x = xb_xcc_id(); b.st = st;
    if (threadIdx.x == 0) (void)xb_add(&bar[XB_XCNT(b.x)], 1u);
    return b;
}
__device__ __forceinline__ void xcd_barrier_complete(unsigned* bar, unsigned x, unsigned& nloc, unsigned& nx) {
    const unsigned G = gridDim.x * gridDim.y * gridDim.z;
    unsigned sum, cnt, mine, sp = 0u;
    for (;;) {
        sum = 0u; cnt = 0u; mine = 0u;
#pragma unroll
        for (unsigned j = 0; j < 16; ++j) { const unsigned c = xb_ld(&bar[XB_XCNT(j)]); sum += c; cnt += (c > 0u) ? 1u : 0u; mine = (j == x) ? c : mine; }
        if (sum == G) break;
        __builtin_amdgcn_s_sleep(1);
        if ((++sp & 255u) == 0u) { if (xb_ld(&bar[XB_TMO])) break; if (sp > XB_SPIN_CAP) { atomicAdd(&bar[XB_TMO], 1u); break; } }
    }
    nloc = mine > 0u ? mine : 1u; nx = cnt > 0u ? cnt : 1u;
}

__device__ __forceinline__ void xcd_barrier(const XcdBarrier& b) {
    asm volatile("s_waitcnt vmcnt(0)" ::: "memory");
    __syncthreads();
    if (threadIdx.x == 0) {
        unsigned* bar = b.bar;
        __builtin_amdgcn_s_waitcnt(0);
        unsigned nloc = b.st[0], nx = b.st[1];
        if (nloc == 0u) { xcd_barrier_complete(bar, b.x, nloc, nx); b.st[0] = nloc; b.st[1] = nx; }
        const unsigned old = xb_add(&bar[XB_XSUB(b.x)], 1u);
        const unsigned gen = old / nloc;
        if (old + 1u == (gen + 1u) * nloc) {
            __builtin_amdgcn_fence(__ATOMIC_RELEASE, "agent");
            asm volatile("s_waitcnt vmcnt(0)" ::: "memory");
            const unsigned og = xb_add(&bar[XB_TOP], 1u);
            const unsigned tg = og / nx;
            if (og + 1u == (tg + 1u) * nx) xb_add(&bar[XB_TOPGEN], 1u);
            else XB_SPIN(xb_ld(&bar[XB_TOPGEN]) == tg, bar);
            __builtin_amdgcn_fence(__ATOMIC_ACQUIRE, "agent");
            xb_add(&bar[XB_XGEN(b.x)], 1u);
            asm volatile("s_waitcnt vmcnt(0)" ::: "memory");
        } else {
            XB_SPIN(xb_ld(&bar[XB_XGEN(b.x)]) == gen, bar);
            __builtin_amdgcn_fence(__ATOMIC_ACQUIRE, "agent");
            asm volatile("s_waitcnt vmcnt(0)" ::: "memory");
        }
    }
    __syncthreads();
}


namespace pg8 {
#define PG8_LAS __attribute__((address_space(3)))
typedef unsigned short bf16_t;
typedef short bf16x8 __attribute__((ext_vector_type(8)));
typedef float f32x4 __attribute__((ext_vector_type(4)));
typedef unsigned u32x4 __attribute__((ext_vector_type(4)));
constexpr int BM = 256, BK = 64, HALF = 128, HTB = HALF * BK * 2  , STAGE_BYTES = 8 * HTB, NXCD = 8, WGM = 8;

__host__ __device__ __forceinline__ int lds_byte(int r, int c) { const int st = (r >> 4) * 2 + (c >> 5), rr = r & 15, cc = c & 31, ob = rr * 64 + cc * 2; return st * 1024 + (ob ^ (((ob >> 9) & 1) << 5)); }
__host__ __device__ __forceinline__ void stage_rc(int b, int& R, int& C) { const int st = b / 1024, sb = b % 1024, swz = sb ^ (((sb >> 9) & 1) << 5); R = (st >> 1) * 16 + swz / 64; C = (st & 1) * 32 + (swz % 64) / 2; }
__host__ __device__ __forceinline__ int perm32(int rho) { const int n = rho >> 4, i = rho & 15; return 8 * (i >> 2) + 4 * n + (i & 3); }

struct Unit { int pm, pn; };
struct Gemm { const bf16_t* A; const bf16_t* Bt; int M, N, K, lda, ldb; };

struct StaticOrder {
    int nM, nN, nwg, G, c;
    __host__ __device__ void init(int M, int N, int G_, int c_) { nM = M / BM; nN = N / BM; nwg = nM * nN; G = G_; c = c_; }
    __host__ __device__ bool next(int i, Unit& u) const {
        const long L = (long)i * G + c; if (L >= nwg) return false;
        int wgid = (int)L; { const int q = nwg / NXCD, r = nwg % NXCD, xcd = wgid % NXCD, off = wgid / NXCD; wgid = (xcd < r ? xcd * (q + 1) : r * (q + 1) + (xcd - r) * q) + off; }
        const int nig = WGM * nN, gid = wgid / nig, fm = gid * WGM, gsz = (nM - fm) < WGM ? (nM - fm) : WGM;
        u.pm = fm + ((wgid % nig) % gsz); u.pn = (wgid % nig) / gsz; return true;
    }
    __device__ __forceinline__ void a_ready(const Unit&) const {}
    __device__ __forceinline__ void done(const Unit&) const {}
};
__device__ __forceinline__ unsigned cvt_pk_bf16(float lo, float hi) { return ::pk2(lo, hi); }
template <class Epi, class Sched, bool ALIGN_EPI = false, bool SP2 = false>
__device__ __forceinline__ void gemm_phase(PG8_LAS unsigned char* lds, const Gemm g, const Sched& S, const Epi& E) {
    int tid_ = threadIdx.x; asm volatile("" : "+v"(tid_));
    const int tid = tid_, wid = __builtin_amdgcn_readfirstlane(tid >> 6), lane = tid & 63, wr = wid >> 2, wc = wid & 3, fr = lane & 15, fq = lane >> 4;
    const int K = g.K, nt = K / BK;
    unsigned voffA[2], voffB[2];
#pragma unroll
    for (int i = 0; i < 2; ++i) { int R, C; stage_rc(tid * 16 + i * 8192, R, C); const int Rb = Epi::PERM ? ((R & ~31) + perm32(R & 31)) : R;
        voffA[i] = (unsigned)(R * g.lda + C) * 2u; voffB[i] = (unsigned)(Rb * g.ldb + C) * 2u; }
    const size_t kstep = (size_t)(BK * 2);
    const size_t hstepA = (size_t)HALF * g.lda * 2, hstepB = (size_t)HALF * g.ldb * 2;
    const size_t tstepA = 2 * hstepA, tstepB = 2 * hstepB;
    const unsigned ldsw = (unsigned)wid * 1024u;
    const int aoff = lds_byte(wr * 64 + fr, fq * 8), boff = lds_byte(wc * 32 + fr, fq * 8);
#define PG8_SA(b, h) (((b) * 2 + (h)) * HTB)
#define PG8_SB(b, h) ((4 + (b) * 2 + (h)) * HTB)
#define PG8_STAGE(bufoff, gbase, voff) do { _Pragma("unroll") for (int _i = 0; _i < 2; ++_i) \
        __builtin_amdgcn_global_load_lds((const unsigned*)((const char*)(gbase) + (voff)[_i]), (PG8_LAS unsigned*)(lds + (bufoff) + ldsw + _i * 8192), 16, 0, 0); } while (0)
#define PG8_LDA(dst, b, h) do { _Pragma("unroll") for (int m = 0; m < 4; ++m) _Pragma("unroll") for (int k = 0; k < 2; ++k) dst[m][k] = *(const PG8_LAS bf16x8*)(lds + PG8_SA(b, h) + aoff + m * 2048 + k * 1024); } while (0)
#define PG8_LDB(dst, b, h) do { _Pragma("unroll") for (int n = 0; n < 2; ++n) _Pragma("unroll") for (int k = 0; k < 2; ++k) dst[n][k] = *(const PG8_LAS bf16x8*)(lds + PG8_SB(b, h) + boff + n * 2048 + k * 1024); } while (0)
#define PG8_MMA(ai, bj, At, Bt) do { __builtin_amdgcn_s_setprio(1); _Pragma("unroll") for (int m = 0; m < 4; ++m) _Pragma("unroll") for (int n = 0; n < 2; ++n) _Pragma("unroll") for (int k = 0; k < 2; ++k) \
        acc[ai][bj][m][n] = __builtin_amdgcn_mfma_f32_16x16x32_bf16(Bt[n][k], At[m][k], acc[ai][bj][m][n], 0, 0, 0); __builtin_amdgcn_s_setprio(0); } while (0)
#define PG8_WAIT_V(n) asm volatile("s_waitcnt vmcnt(" #n ")" ::: "memory")
#define PG8_WAIT_L(n) asm volatile("s_waitcnt lgkmcnt(" #n ")" ::: "memory")
#define PG8_BAR __builtin_amdgcn_s_barrier()
#define PG8_SCHED __builtin_amdgcn_sched_barrier(0)
    Unit cur, nxt; int ui = 0;
    if (!S.next(0, cur)) return;
    f32x4 acc[2][2][4][2];
#pragma unroll
    for (int a = 0; a < 2; ++a)
#pragma unroll
        for (int b = 0; b < 2; ++b)
#pragma unroll
            for (int m = 0; m < 4; ++m)
#pragma unroll
                for (int n = 0; n < 2; ++n) acc[a][b][m][n] = (f32x4){0.f, 0.f, 0.f, 0.f};
    bf16x8 At[4][2], B0[2][2], B1[2][2];
    const char* cA = (const char*)g.A + (size_t)cur.pm * tstepA; const char* cB = (const char*)g.Bt + (size_t)cur.pn * tstepB;
    S.a_ready(cur);
    if constexpr (SP2) {
        PG8_STAGE(PG8_SB(0, 0), cB, voffB); PG8_STAGE(PG8_SB(0, 1), cB + hstepB, voffB); PG8_STAGE(PG8_SA(0, 0), cA, voffA); PG8_STAGE(PG8_SA(0, 1), cA + hstepA, voffA);
        if (wr == 1) PG8_BAR;
        PG8_WAIT_V(2); PG8_BAR;
        PG8_STAGE(PG8_SB(1, 0), cB + kstep, voffB); PG8_STAGE(PG8_SA(1, 0), cA + kstep, voffA); PG8_STAGE(PG8_SB(1, 1), cB + hstepB + kstep, voffB);
        PG8_WAIT_V(6); PG8_BAR;
    } else {
        PG8_STAGE(PG8_SB(0, 0), cB, voffB); PG8_STAGE(PG8_SA(0, 0), cA, voffA); PG8_STAGE(PG8_SB(0, 1), cB + hstepB, voffB); PG8_STAGE(PG8_SA(0, 1), cA + hstepA, voffA);
        if (wr == 1) PG8_BAR;
        PG8_WAIT_V(4); PG8_BAR;
        PG8_STAGE(PG8_SB(1, 0), cB + kstep, voffB); PG8_STAGE(PG8_SA(1, 0), cA + kstep, voffA); PG8_STAGE(PG8_SB(1, 1), cB + hstepB + kstep, voffB);
        PG8_WAIT_V(6); PG8_BAR;
    }
    for (;;) {
        const bool has_next = S.next(ui + 1, nxt);
        const char* nA = has_next ? (const char*)g.A + (size_t)nxt.pm * tstepA : cA; const char* nB = has_next ? (const char*)g.Bt + (size_t)nxt.pn * tstepB : cB;
        for (int t = 0; t < nt; t += 2) {
            const bool last = (t == nt - 2);
            const char* a1 = cA + (size_t)(t + 1) * kstep;
            const char* a2 = last ? nA : cA + (size_t)(t + 2) * kstep; const char* b2 = last ? nB : cB + (size_t)(t + 2) * kstep;
            const char* a3 = a2 + kstep; const char* b3 = b2 + kstep;
            if (last && has_next) S.a_ready(nxt);
            if constexpr (SP2) {
            PG8_LDB(B0, 0, 0); PG8_LDB(B1, 0, 1); PG8_SCHED; PG8_LDA(At, 0, 0); PG8_STAGE(PG8_SA(1, 1), a1 + hstepA, voffA);
            PG8_WAIT_V(8); PG8_WAIT_L(0); PG8_BAR; PG8_MMA(0, 0, At, B0); PG8_MMA(0, 1, At, B1); PG8_BAR; PG8_SCHED;
            PG8_LDA(At, 0, 1); PG8_STAGE(PG8_SB(0, 0), b2, voffB); PG8_STAGE(PG8_SB(0, 1), b2 + hstepB, voffB); PG8_STAGE(PG8_SA(0, 0), a2, voffA);
            PG8_WAIT_V(8); PG8_WAIT_L(0); PG8_BAR; PG8_MMA(1, 0, At, B0); PG8_MMA(1, 1, At, B1); PG8_BAR; PG8_SCHED;
            PG8_LDB(B0, 1, 0); PG8_LDB(B1, 1, 1); PG8_SCHED; PG8_LDA(At, 1, 0); PG8_STAGE(PG8_SA(0, 1), a2 + hstepA, voffA);
            PG8_WAIT_V(8); PG8_WAIT_L(0); PG8_BAR; PG8_MMA(0, 0, At, B0); PG8_MMA(0, 1, At, B1); PG8_BAR; PG8_SCHED;
            PG8_LDA(At, 1, 1); PG8_STAGE(PG8_SB(1, 0), b3, voffB); PG8_STAGE(PG8_SB(1, 1), b3 + hstepB, voffB); PG8_STAGE(PG8_SA(1, 0), a3, voffA);
            PG8_WAIT_V(8); PG8_WAIT_L(0); PG8_BAR; PG8_MMA(1, 0, At, B0); PG8_MMA(1, 1, At, B1); PG8_BAR; PG8_SCHED;
            } else {
            PG8_LDB(B0, 0, 0); PG8_SCHED; PG8_LDA(At, 0, 0); PG8_STAGE(PG8_SA(1, 1), a1 + hstepA, voffA);
            PG8_WAIT_L(8); PG8_BAR; PG8_WAIT_L(0); PG8_MMA(0, 0, At, B0); PG8_BAR; PG8_SCHED;
            PG8_LDB(B1, 0, 1); PG8_STAGE(PG8_SB(0, 0), b2, voffB);
            PG8_BAR; PG8_WAIT_L(0); PG8_MMA(0, 1, At, B1); PG8_BAR;
            PG8_LDA(At, 0, 1); PG8_STAGE(PG8_SA(0, 0), a2, voffA);
            PG8_BAR; PG8_WAIT_L(0); PG8_MMA(1, 0, At, B0); PG8_BAR; PG8_SCHED;
            PG8_STAGE(PG8_SB(0, 1), b2 + hstepB, voffB);
            PG8_WAIT_V(6); PG8_BAR; PG8_MMA(1, 1, At, B1); PG8_BAR;
            PG8_LDB(B0, 1, 0); PG8_SCHED; PG8_LDA(At, 1, 0); PG8_STAGE(PG8_SA(0, 1), a2 + hstepA, voffA);
            PG8_WAIT_L(8); PG8_BAR; PG8_WAIT_L(0); PG8_MMA(0, 0, At, B0); PG8_BAR; PG8_SCHED;
            PG8_LDB(B1, 1, 1); PG8_STAGE(PG8_SB(1, 0), b3, voffB);
            PG8_BAR; PG8_WAIT_L(0); PG8_MMA(0, 1, At, B1); PG8_BAR;
            PG8_LDA(At, 1, 1); PG8_STAGE(PG8_SA(1, 0), a3, voffA);
            PG8_BAR; PG8_WAIT_L(0); PG8_MMA(1, 0, At, B0); PG8_BAR; PG8_SCHED;
            PG8_STAGE(PG8_SB(1, 1), b3 + hstepB, voffB);
            PG8_WAIT_V(6); PG8_BAR; PG8_MMA(1, 1, At, B1); PG8_BAR;
            }
        }
        if constexpr (ALIGN_EPI) { if (wr == 0) PG8_BAR; }
        if constexpr (!Epi::AFTER_DRAIN) { E(acc, cur, wr, wc, fr, fq); S.done(cur); }
        if (!has_next) break;
#pragma unroll
        for (int a = 0; a < 2; ++a)
#pragma unroll
            for (int b = 0; b < 2; ++b)
#pragma unroll
                for (int m = 0; m < 4; ++m)
#pragma unroll
                    for (int n = 0; n < 2; ++n) acc[a][b][m][n] = (f32x4){0.f, 0.f, 0.f, 0.f};
        cur = nxt; cA = nA; cB = nB; ++ui;
        if constexpr (ALIGN_EPI) { if (wr == 1) PG8_BAR; }
    }
    PG8_WAIT_V(0);
    if constexpr (!ALIGN_EPI) { if (wr == 0) PG8_BAR; }
    PG8_BAR;
    if constexpr (Epi::AFTER_DRAIN) { E.fused(acc, cur, wr, wc, fr, fq, lds, wid, lane); S.done(cur); }
#undef PG8_SA
#undef PG8_SB
#undef PG8_STAGE
#undef PG8_LDA
#undef PG8_LDB
#undef PG8_MMA
#undef PG8_WAIT_V
#undef PG8_WAIT_L
#undef PG8_BAR
#undef PG8_SCHED
}
}

namespace pg8 {
__device__ __forceinline__ float sigmoidf_(float v) { return 1.f / (1.f + __expf(-v)); }
__device__ __forceinline__ void unpack8(const u32x4 w, float (&f)[8]) {
    f[0] = __uint_as_float(w.x << 16); f[1] = __uint_as_float(w.x & 0xffff0000u); f[2] = __uint_as_float(w.y << 16); f[3] = __uint_as_float(w.y & 0xffff0000u);
    f[4] = __uint_as_float(w.z << 16); f[5] = __uint_as_float(w.z & 0xffff0000u); f[6] = __uint_as_float(w.w << 16); f[7] = __uint_as_float(w.w & 0xffff0000u);
}
template <int MODE> struct EpiX {
    static constexpr bool PERM = true, AFTER_DRAIN = false;
    bf16_t* O; bf16_t* G; const float* xres; const float* gate; float* outf; int ldc; int pad; bf16_t* KCa; bf16_t* KCb; bf16_t* KI; bf16_t* WI;
    __device__ __forceinline__ void operator()(const f32x4 (&acc)[2][2][4][2], const Unit& u, int wr, int wc, int fr, int fq) const {
        const int row0 = u.pm * BM + wr * 64 + fr;
        int colt = u.pn * BM; bf16_t* base = O; int ld = ldc; bool sig = false;
        if (MODE == 1) { if (u.pn >= 15) { colt -= 15 * BM; base = G; ld = GW; sig = true; }
            else if (u.pn >= 10) {
#pragma unroll
                for (int ai = 0; ai < 2; ++ai)
#pragma unroll
                    for (int m = 0; m < 4; ++m) {
                        const int row = row0 + ai * HALF + m * 16, bb = row / S, ss = row % S;
#pragma unroll
                        for (int bj = 0; bj < 2; ++bj) {
                            const int c = wc * 32 + 8 * fq + bj * HALF;
                            const f32x4 v0 = acc[ai][bj][m][0], v1 = acc[ai][bj][m][1];
                            u32x4 w; w.x = cvt_pk_bf16(v0[0], v0[1]); w.y = cvt_pk_bf16(v0[2], v0[3]); w.z = cvt_pk_bf16(v1[0], v1[1]); w.w = cvt_pk_bf16(v1[2], v1[3]);
                            if (u.pn < 14) { const int cc = ((u.pn - 10) & 1) * BM + c; bf16_t* kc = (u.pn < 12) ? KCa : KCb;
                                *(u32x4*)(kc + ((size_t)(bb * 8 + (cc >> 6)) * S + ss) * 64 + (cc & 63)) = w; }
                            else if (c < 64) *(u32x4*)(KI + (size_t)row * 64 + c) = w;
                            else if (c == 64) *(u32x4*)(WI + (size_t)row * 8) = w;
                        }
                    }
                return;
            } }
        if (MODE == 2 || MODE == 3) { base = G; ld = GW; }
        const int col0 = colt + wc * 32 + 8 * fq;
#pragma unroll
        for (int ai = 0; ai < 2; ++ai)
#pragma unroll
            for (int m = 0; m < 4; ++m) {
                const int row = row0 + ai * HALF + m * 16;
#pragma unroll
                for (int bj = 0; bj < 2; ++bj) {
                    const int col = col0 + bj * HALF;
                    f32x4 v0 = acc[ai][bj][m][0], v1 = acc[ai][bj][m][1];
                    if (MODE == 4) {
                        const size_t o = (size_t)row * 1024 + col;
                        const f32x4 x0 = __builtin_nontemporal_load((const f32x4*)(xres + o)), x1 = __builtin_nontemporal_load((const f32x4*)(xres + o + 4));
                        const float* gp = gate + (row / S) * 6144 + col;
                        const f32x4 g0 = *(const f32x4*)gp, g1 = *(const f32x4*)(gp + 4);
                        *(f32x4*)(outf + o) = x0 + g0 * v0; *(f32x4*)(outf + o + 4) = x1 + g1 * v1;
                    } else {
                        bf16_t* pp = base + (size_t)row * ld + col;
                        if (MODE == 1) { if (sig) {
#pragma unroll
                            for (int e = 0; e < 4; ++e) { v0[e] = sigmoidf_(v0[e]); v1[e] = sigmoidf_(v1[e]); } } }
                        if (MODE == 2) { float t[8]; unpack8(*(const u32x4*)pp, t);
#pragma unroll
                            for (int e = 0; e < 4; ++e) { v0[e] *= t[e]; v1[e] *= t[4 + e]; } }
                        if (MODE == 3) { float t[8], gg[8]; unpack8(*(const u32x4*)pp, t); unpack8(*(const u32x4*)(pp + 1024), gg);
#pragma unroll
                            for (int e = 0; e < 4; ++e) { v0[e] = t[e] + gg[e] * v0[e]; v1[e] = t[4 + e] + gg[4 + e] * v1[e]; } }
                        u32x4 w; w.x = cvt_pk_bf16(v0[0], v0[1]); w.y = cvt_pk_bf16(v0[2], v0[3]); w.z = cvt_pk_bf16(v1[0], v1[1]); w.w = cvt_pk_bf16(v1[2], v1[3]);
                        *(u32x4*)pp = w;
                    }
                }
            }
    }
};
}
struct Params {
    const float *x, *c, *w_ada, *b_ada, *g1, *g2, *w_in, *rel_bias, *wpa, *wpb, *wout, *wq, *sk, *pu, *pv, *fg;
    float* out; unsigned char* ws;
};
__device__ __forceinline__ int opaque_tid() { int t = threadIdx.x; asm volatile("" : "+v"(t)); return t; }
typedef unsigned v4u __attribute__((ext_vector_type(4)));
#define LDS_WAIT() asm volatile("s_waitcnt lgkmcnt(0)" ::: "memory")

constexpr size_t WS_BAR = 0;
constexpr size_t CTL_ZERO_BYTES = 16384;
constexpr size_t WS_MOD = 64 * 1024;
constexpr size_t WS_WIN = 1 * MiB;
constexpr size_t WS_WPA = 13 * MiB, WS_WPB = 14 * MiB;
constexpr size_t WS_WOUT = 15 * MiB;
constexpr size_t WS_WQ = 17 * MiB;
constexpr size_t WS_PROJ = 22 * MiB;
constexpr size_t WS_KCA = 102 * MiB, WS_KCB = 118 * MiB;
constexpr size_t WS_KI = 134 * MiB, WS_WI = 136 * MiB;
constexpr size_t WS_G = 142 * MiB;
constexpr size_t WS_YA = 206 * MiB, WS_YB = 222 * MiB;
constexpr size_t WS_HN2 = 22 * MiB;
constexpr size_t WS_QH = 54 * MiB;
constexpr size_t WS_SKB = 21 * MiB;
constexpr size_t WS_EIDX = 118 * MiB;
constexpr size_t WS_GATE = 122 * MiB;
constexpr size_t WS_TAB = 130 * MiB;
constexpr size_t WS_SCALES = 162 * MiB;
constexpr size_t WS_VT = 238 * MiB;
constexpr size_t WS_NEED = 254 * MiB;
constexpr int LDS_SC_OFF = 7 * 16384 + 8448;

__device__ __forceinline__ void ph_mod(const Params& p, float* mod, float* sc) {
    float* part = sc + 2048;
    const int tid = threadIdx.x, kk = tid >> 3, cc = tid & 7;
    for (int i = tid; i < 2048; i += NTHR) { float v = p.c[i]; sc[i] = v / (1.f + expf(-v)); }
    __syncthreads();
    for (int unit = blockIdx.x; unit < 6144 / 24; unit += gridDim.x) {
        const int col = unit * 24 + 3 * cc;
        float a[2][3] = {{0.f, 0.f, 0.f}, {0.f, 0.f, 0.f}};
#pragma unroll 4
        for (int k = kk; k < 1024; k += 64) {
            const float* w = p.w_ada + (size_t)k * 6144 + col;
            const float w0 = __builtin_nontemporal_load(w), w1 = __builtin_nontemporal_load(w + 1), w2 = __builtin_nontemporal_load(w + 2), s0 = sc[k], s1 = sc[1024 + k];
            a[0][0] += s0 * w0; a[0][1] += s0 * w1; a[0][2] += s0 * w2; a[1][0] += s1 * w0; a[1][1] += s1 * w1; a[1][2] += s1 * w2;
        }
#pragma unroll
        for (int b = 0; b < 2; ++b)
#pragma unroll
            for (int j = 0; j < 3; ++j) part[kk * 48 + b * 24 + 3 * cc + j] = a[b][j];
        __syncthreads();
        if (tid < 48) { float s = 0.f; for (int q = 0; q < 64; ++q) s += part[q * 48 + tid]; const int b = tid / 24, j = unit * 24 + tid % 24; mod[b * 6144 + j] = s + p.b_ada[j]; }
        __syncthreads();
    }
}

template <class CM> __device__ __forceinline__ void transpose_item(const float* W, int ldw, int K, bf16* WT, LAS float* scr, int item, int nblk, int lane, const CM& cm) {
    const int kb = item / nblk, nb = item % nblk, k0 = 64 * kb, n0 = 32 * nb;
    const int sc = cm(n0 + (lane & 31));
#pragma unroll 8
    for (int i = 0; i < 32; ++i) { const int kk = 2 * i + (lane >> 5); scr[kk * 33 + (lane & 31)] = (sc >= 0) ? __builtin_nontemporal_load(W + (size_t)(k0 + kk) * ldw + sc) : 0.f; }
    LDS_WAIT(); asm volatile("" ::: "memory");
    const int c = lane & 7;
#pragma unroll
    for (int j = 0; j < 4; ++j) { const int n = (lane >> 3) + 8 * j; const LAS float* s = scr + (8 * c) * 33 + n;
        v4u o; o.x = pk2(s[0 * 33], s[1 * 33]); o.y = pk2(s[2 * 33], s[3 * 33]); o.z = pk2(s[4 * 33], s[5 * 33]); o.w = pk2(s[6 * 33], s[7 * 33]);
        *(v4u*)(WT + (size_t)(n0 + n) * K + k0 + 8 * c) = o; }
    LDS_WAIT(); asm volatile("" ::: "memory");
}
struct CmIdent { __device__ __forceinline__ int operator()(int n) const { return n; } };
struct CmWin {
    __device__ __forceinline__ int operator()(int n) const {
        if (n < 512) return n;
        if (n < 1024) return 1024 + (n - 512);
        if (n < 1536) return 1536 + (n - 1024);
        if (n < 2048) return 2120 + (n - 1536);
        if (n < 2560) return 3144 + (n - 2048);
        if (n < 3072) return 512 + (n - 2560);
        if (n < 3584) return 2632 + (n - 3072);
        if (n < 3648) return 2048 + (n - 3584);
        if (n < 3656) return 2112 + (n - 3648);
        if (n < 3840) return -1;
        return 3656 + (n - 3840);
    }
};
__device__ __forceinline__ void ph_weights(const Params& p, LAS unsigned char* lds) {
    unsigned char* ws = p.ws;
    const int wave = __builtin_amdgcn_readfirstlane(threadIdx.x >> 6), lane = threadIdx.x & 63;
    LAS float* scr = (LAS float*)(lds + wave * 16384);
    const int gw = blockIdx.x * NWAVES + wave, NGW = gridDim.x * NWAVES;
    constexpr int I_IN = 16 * (NPROJ / 32), I_PA = 8 * 32, I_PB = 8 * 32, I_OUT = 16 * 32, I_Q = 16 * 64;
    constexpr int NITEMS = I_IN + I_PA + I_PB + I_OUT + I_Q;
    for (int it = gw; it < NITEMS; it += NGW) {
        int r = it;
        if (r < I_IN) { transpose_item(p.w_in, INW, 1024, (bf16*)(ws + WS_WIN), scr, r, NPROJ / 32, lane, CmWin()); continue; } r -= I_IN;
        if (r < I_PA) { transpose_item(p.wpa, 1024, 512, (bf16*)(ws + WS_WPA), scr, r, 32, lane, CmIdent()); continue; } r -= I_PA;
        if (r < I_PB) { transpose_item(p.wpb, 1024, 512, (bf16*)(ws + WS_WPB), scr, r, 32, lane, CmIdent()); continue; } r -= I_PB;
        if (r < I_OUT) { transpose_item(p.wout, 1024, 1024, (bf16*)(ws + WS_WOUT), scr, r, 32, lane, CmIdent()); continue; } r -= I_OUT;
        transpose_item(p.wq, 2048, 1024, (bf16*)(ws + WS_WQ), scr, r, 64, lane, CmIdent());
    }
    for (int i = gw * 64 + lane; i < 8 * 2 * 128 * 128 / 4; i += NGW * 64) {
        const float4 v = ((const float4*)p.sk)[i]; uint2 w; w.x = pk2(v.x, v.y); w.y = pk2(v.z, v.w); ((uint2*)(ws + WS_SKB))[i] = w;
    }
}

template <bool NT> __device__ __forceinline__ void ph_norm(const float* src, const float* g, const float* mod, int shift_i, int scale_i, bf16* dst) {
    const int lane = threadIdx.x & 63, gw = blockIdx.x * NWAVES + __builtin_amdgcn_readfirstlane(threadIdx.x >> 6), ngw = gridDim.x * NWAVES;
    for (int t = gw; t < T; t += ngw) {
        const int b = t / S;
        float4 v[4]; float ss = 0.f;
#pragma unroll
        for (int i = 0; i < 4; ++i) { const f32x4_t t_ = NT ? __builtin_nontemporal_load((const f32x4_t*)(src + (size_t)t * D) + lane + 64 * i) : *((const f32x4_t*)(src + (size_t)t * D) + lane + 64 * i); v[i] = make_float4(t_.x, t_.y, t_.z, t_.w); ss += v[i].x * v[i].x + v[i].y * v[i].y + v[i].z * v[i].z + v[i].w * v[i].w; }
        ss = wave_sum(ss);
        const float r = rsqrtf(ss * (1.f / D) + EPS);
#pragma unroll
        for (int i = 0; i < 4; ++i) {
            const float4 gg = ((const float4*)g)[lane + 64 * i];
            const float4 sh = ((const float4*)(mod + b * 6144 + shift_i * D))[lane + 64 * i];
            const float4 sc = ((const float4*)(mod + b * 6144 + scale_i * D))[lane + 64 * i];
            float4 o;
            o.x = v[i].x * r * gg.x * (1.f + sc.x) + sh.x; o.y = v[i].y * r * gg.y * (1.f + sc.y) + sh.y;
            o.z = v[i].z * r * gg.z * (1.f + sc.z) + sh.z; o.w = v[i].w * r * gg.w * (1.f + sc.w) + sh.w;
            uint2 w; w.x = pk2(o.x, o.y); w.y = pk2(o.z, o.w);
            ((uint2*)(dst + (size_t)t * D))[lane + 64 * i] = w;
        }
    }
}
__device__ __forceinline__ unsigned f2ord(float f) { unsigned u = __float_as_uint(f); return (u & 0x80000000u) ? ~u : (u | 0x80000000u); }
__device__ __forceinline__ int t5_bucket(int n) {
    if (n < 16) return n;
    int large = 16 + (int)(logf((float)n * (1.f / 16.f)) / 2.0794415416798357f * 16.f);
    return large < 31 ? large : 31;
}

typedef short bf16x8_t __attribute__((ext_vector_type(8)));
template <int CTRL> __device__ __forceinline__ unsigned dppu(unsigned x) { return (unsigned)__builtin_amdgcn_mov_dpp((int)x, CTRL, 0xf, 0xf, true); }
template <int CTRL> __device__ __forceinline__ float dppf(float x) { return __builtin_bit_cast(float, __builtin_amdgcn_mov_dpp(__builtin_bit_cast(int, x), CTRL, 0xf, 0xf, true)); }
__device__ __forceinline__ unsigned row_max_u(unsigned x) { x = max(x, dppu<0xB1>(x)); x = max(x, dppu<0x4E>(x)); x = max(x, dppu<0x141>(x)); x = max(x, dppu<0x128>(x)); return x; }
__device__ __forceinline__ float row_max_f(float x) { x = fmaxf(x, dppf<0xB1>(x)); x = fmaxf(x, dppf<0x4E>(x)); x = fmaxf(x, dppf<0x141>(x)); x = fmaxf(x, dppf<0x128>(x)); return x; }
__device__ __forceinline__ float row_sum_f(float x) { x += dppf<0xB1>(x); x += dppf<0x4E>(x); x += dppf<0x141>(x); x += dppf<0x128>(x); return x; }
__device__ __forceinline__ float ord2f(unsigned k) { return __uint_as_float((k & 0x80000000u) ? (k & 0x7fffffffu) : ~k); }
__device__ __forceinline__ unsigned max3u(unsigned a, unsigned b, unsigned c) { return max(max(a, b), c); }

__device__ __forceinline__ void ph_quant(const Params& p, unsigned char* tab, float* scales) {
    const int lane = threadIdx.x & 63, gw = blockIdx.x * NWAVES + __builtin_amdgcn_readfirstlane(threadIdx.x >> 6), ngw = gridDim.x * NWAVES;
    for (int r = gw; r < 32768; r += ngw) {
        const float* src = (r < 16384) ? p.pu + (size_t)r * D : p.pv + (size_t)(r - 16384) * D;
        float4 v[4]; float am = 0.f;
#pragma unroll
        for (int i = 0; i < 4; ++i) { const f32x4_t t_ = __builtin_nontemporal_load((const f32x4_t*)src + lane + 64 * i); v[i] = make_float4(t_.x, t_.y, t_.z, t_.w);     am = fmaxf(am, fmaxf(fmaxf(fabsf(v[i].x), fabsf(v[i].y)), fmaxf(fabsf(v[i].z), fabsf(v[i].w)))); }
#pragma unroll
        for (int o = 1; o < 64; o <<= 1) am = fmaxf(am, __shfl_xor(am, o));
        const float inv = am > 0.f ? 127.f / am : 0.f;
        uint4 w; unsigned* wp = (unsigned*)&w;
#pragma unroll
        for (int i = 0; i < 4; ++i) {
            const int q0 = (int)rintf(v[i].x * inv) + 128, q1 = (int)rintf(v[i].y * inv) + 128, q2 = (int)rintf(v[i].z * inv) + 128, q3 = (int)rintf(v[i].w * inv) + 128;
            wp[i] = (unsigned)q0 | ((unsigned)q1 << 8) | ((unsigned)q2 << 16) | ((unsigned)q3 << 24);
        }
        ((uint4*)(tab + (size_t)r * 1024))[lane] = w;
        if (lane == 0) scales[r] = am * (1.f / 127.f);
    }
}

#define CE_DESC(x, y) do { const unsigned hi_ = max(x, y), lo_ = min(x, y); x = hi_; y = lo_; } while (0)
__device__ __forceinline__ int hull_ab(int c) {
    int a = 0, base = 0; bool done = false;
#pragma unroll
    for (int aa = 0; aa < 16; ++aa) { const int nb = 16 / (aa + 1); if (!done) { if (c >= base + nb) { base += nb; a = aa + 1; } else done = true; } }
    return (c < 50) ? ((a << 4) | (c - base)) : -1;
}
__device__ __forceinline__ void ph_peer_select(const bf16* qh, const bf16* skb, unsigned short* eidx, float* gate) {
    const int tid = opaque_tid();
    const int lane = tid & 63, fr = lane & 15, fq = lane >> 4;
    const int gw = blockIdx.x * NWAVES + __builtin_amdgcn_readfirstlane(tid >> 6), ngw = gridDim.x * NWAVES;
    int hab[4];
#pragma unroll
    for (int s = 0; s < 4; ++s) hab[s] = hull_ab(16 * s + fr);
    for (int unit = gw; unit < (T / 16) * 2; unit += ngw) {
        const int t0 = (unit >> 1) * 16, hh = unit & 1;
#pragma unroll 1
        for (int hi = 0; hi < 4; ++hi) {
            const int h = hh * 4 + hi;
            unsigned win[2][4];
#pragma unroll
            for (int c = 0; c < 2; ++c) {
                f32x4_t acc[8];
#pragma unroll
                for (int nt = 0; nt < 8; ++nt) acc[nt] = (f32x4_t){0.f, 0.f, 0.f, 0.f};
                const bf16* qrow = qh + (size_t)(t0 + fr) * 2048 + h * 256 + c * 128 + 8 * fq;
                bf16x8_t a[4];
#pragma unroll
                for (int ks = 0; ks < 4; ++ks) a[ks] = *(const bf16x8_t*)(qrow + 32 * ks);
                const bf16* kb = skb + ((size_t)(h * 2 + c) * 128 + fr) * 128 + 8 * fq;
#pragma unroll
                for (int nt = 0; nt < 8; ++nt)
#pragma unroll
                    for (int ks = 0; ks < 4; ++ks) { const bf16x8_t b = *(const bf16x8_t*)(kb + (size_t)nt * 16 * 128 + 32 * ks); acc[nt] = __builtin_amdgcn_mfma_f32_16x16x32_bf16(a[ks], b, acc[nt], 0, 0, 0); }
                unsigned pk[8][4];
#pragma unroll
                for (int nt = 0; nt < 8; ++nt)
#pragma unroll
                    for (int i = 0; i < 4; ++i) pk[nt][i] = (f2ord(acc[nt][i]) & ~127u) | (127u - (unsigned)(16 * nt + fr));
#pragma unroll
                for (int i = 0; i < 4; ++i) {
                    CE_DESC(pk[0][i], pk[1][i]); CE_DESC(pk[2][i], pk[3][i]); CE_DESC(pk[4][i], pk[5][i]); CE_DESC(pk[6][i], pk[7][i]);
                    CE_DESC(pk[0][i], pk[2][i]); CE_DESC(pk[1][i], pk[3][i]); CE_DESC(pk[4][i], pk[6][i]); CE_DESC(pk[5][i], pk[7][i]);
                    CE_DESC(pk[1][i], pk[2][i]); CE_DESC(pk[5][i], pk[6][i]);
                    CE_DESC(pk[0][i], pk[4][i]); CE_DESC(pk[1][i], pk[5][i]); CE_DESC(pk[2][i], pk[6][i]); CE_DESC(pk[3][i], pk[7][i]);
                    CE_DESC(pk[2][i], pk[4][i]); CE_DESC(pk[3][i], pk[5][i]);
                    CE_DESC(pk[1][i], pk[2][i]); CE_DESC(pk[3][i], pk[4][i]); CE_DESC(pk[5][i], pk[6][i]);
                }
#pragma unroll
                for (int r = 0; r < 16; ++r)
#pragma unroll
                    for (int i = 0; i < 4; ++i) {
                        const unsigned m = row_max_u(pk[0][i]);
                        if (fr == r) win[c][i] = m;
                        const bool w = pk[0][i] == m;
#pragma unroll
                        for (int nt = 0; nt < 7; ++nt) pk[nt][i] = w ? pk[nt + 1][i] : pk[nt][i];
                        pk[7][i] = w ? 0u : pk[7][i];
                    }
            }
#pragma unroll
            for (int i = 0; i < 4; ++i) {
                unsigned ck[4];
#pragma unroll
                for (int s = 0; s < 4; ++s) {
                    const int ab = hab[s] < 0 ? 0 : hab[s];
                    const unsigned wa = (unsigned)__shfl((int)win[0][i], (lane & 48) + (ab >> 4)), wb = (unsigned)__shfl((int)win[1][i], (lane & 48) + (ab & 15));
                    const float v = ord2f(wa & ~127u) + ord2f(wb & ~127u);
                    ck[s] = hab[s] < 0 ? 0u : ((f2ord(v) & ~255u) | (255u - (unsigned)ab));
                }
                unsigned mywin = 0u;
#pragma unroll
                for (int r = 0; r < 16; ++r) {
                    unsigned m = max(max(ck[0], ck[1]), max(ck[2], ck[3]));
                    m = row_max_u(m);
                    if (fr == r) mywin = m;
#pragma unroll
                    for (int s = 0; s < 4; ++s) ck[s] = (ck[s] == m) ? 0u : ck[s];
                }
                const unsigned ci = 255u - (mywin & 255u);
                const unsigned w0 = (unsigned)__shfl((int)win[0][i], (lane & 48) + (int)(ci >> 4)), w1 = (unsigned)__shfl((int)win[1][i], (lane & 48) + (int)(ci & 15u));
                const int e = (int)(127u - (w0 & 127u)) * 128 + (int)(127u - (w1 & 127u));
                const float s = ord2f(w0 & ~127u) + ord2f(w1 & ~127u);
                const float mx = row_max_f(s);
                const float ex = __expf(s - mx);
                const float sum = row_sum_f(ex);
                const int t = t0 + 4 * fq + i;
                eidx[(size_t)t * 128 + h * 16 + fr] = (unsigned short)e;
                gate[(size_t)t * 128 + h * 16 + fr] = ex / sum;
            }
        }
    }
}

__device__ __forceinline__ float wave_total_dpp(float x) {
    x = row_sum_f(x);
    return __builtin_bit_cast(float, __builtin_amdgcn_readlane(__builtin_bit_cast(int, x), 0)) + __builtin_bit_cast(float, __builtin_amdgcn_readlane(__builtin_bit_cast(int, x), 16)) +
           __builtin_bit_cast(float, __builtin_amdgcn_readlane(__builtin_bit_cast(int, x), 32)) + __builtin_bit_cast(float, __builtin_amdgcn_readlane(__builtin_bit_cast(int, x), 48));
}
__device__ __forceinline__ float gelu_erf(float x) { return 0.5f * x * (1.f + erff(x * 0.70710678118654752f)); }
__device__ __forceinline__ void ph_peer_gather(const Params& p, const bf16* hn2, const unsigned short* eidx, const float* gate, const unsigned char* tab, const float* scales, const float* mod, const float* xin, float* xout) {
    const int tid = opaque_tid();
    const int lane = tid & 63, gw = blockIdx.x * NWAVES + __builtin_amdgcn_readfirstlane(tid >> 6), ngw = gridDim.x * NWAVES;
    const unsigned char* utab = tab; const unsigned char* vtab = tab + (size_t)16384 * 1024;
    for (int t = gw; t < T; t += ngw) {
        const int b = t / S;
        float hv[16]; float hs = 0.f;
#pragma unroll
        for (int i = 0; i < 4; ++i) { const uint2 w = ((const uint2*)(hn2 + (size_t)t * D))[lane + 64 * i];
            hv[4 * i + 0] = __uint_as_float(w.x << 16); hv[4 * i + 1] = __uint_as_float(w.x & 0xffff0000u); hv[4 * i + 2] = __uint_as_float(w.y << 16); hv[4 * i + 3] = __uint_as_float(w.y & 0xffff0000u);
            hs += (hv[4 * i] + hv[4 * i + 1]) + (hv[4 * i + 2] + hv[4 * i + 3]); }
        hs = wave_total_dpp(hs);
        const int e0 = eidx[(size_t)t * 128 + lane], e1 = eidx[(size_t)t * 128 + 64 + lane];
        const float g0 = gate[(size_t)t * 128 + lane], g1 = gate[(size_t)t * 128 + 64 + lane];
        float pre0 = 0.f, pre1 = 0.f;
#pragma unroll
        for (int half = 0; half < 2; ++half) {
            const int ev = half ? e1 : e0;
            float pre = 0.f;
#pragma unroll 8
            for (int j = 0; j < 64; ++j) {
                const int e = __builtin_amdgcn_readlane(ev, j);
                const uint4 w = ((const uint4*)(utab + (size_t)e * 1024))[lane];
                const unsigned ww[4] = {w.x, w.y, w.z, w.w};
                float d = 0.f;
#pragma unroll
                for (int i = 0; i < 4; ++i) {
                    d += hv[4 * i + 0] * (float)(ww[i] & 0xffu); d += hv[4 * i + 1] * (float)((ww[i] >> 8) & 0xffu);
                    d += hv[4 * i + 2] * (float)((ww[i] >> 16) & 0xffu); d += hv[4 * i + 3] * (float)(ww[i] >> 24);
                }
                d = wave_total_dpp(d);
                pre = (lane == j) ? d : pre;
            }
            if (half) pre1 = pre; else pre0 = pre;
        }
        const float c0 = g0 * gelu_erf(scales[e0] * (pre0 - 128.f * hs)) * scales[16384 + e0];
        const float c1 = g1 * gelu_erf(scales[e1] * (pre1 - 128.f * hs)) * scales[16384 + e1];
        const float corr = 128.f * wave_total_dpp(c0 + c1);
        float acc[16];
#pragma unroll
        for (int i = 0; i < 16; ++i) acc[i] = 0.f;
#pragma unroll
        for (int half = 0; half < 2; ++half) {
            const int ev = half ? e1 : e0; const float cv = half ? c1 : c0;
#pragma unroll 8
            for (int j = 0; j < 64; ++j) {
                const int e = __builtin_amdgcn_readlane(ev, j);
                const float cf = __builtin_bit_cast(float, __builtin_amdgcn_readlane(__builtin_bit_cast(int, cv), j));
                const uint4 w = ((const uint4*)(vtab + (size_t)e * 1024))[lane];
                const unsigned ww[4] = {w.x, w.y, w.z, w.w};
#pragma unroll
                for (int i = 0; i < 4; ++i) {
                    acc[4 * i + 0] += cf * (float)(ww[i] & 0xffu); acc[4 * i + 1] += cf * (float)((ww[i] >> 8) & 0xffu);
                    acc[4 * i + 2] += cf * (float)((ww[i] >> 16) & 0xffu); acc[4 * i + 3] += cf * (float)(ww[i] >> 24);
                }
            }
        }
        float xv[16]; float ss = 0.f;
#pragma unroll
        for (int i = 0; i < 4; ++i) {
            const float4 g2 = ((const float4*)(mod + b * 6144 + 5 * D))[lane + 64 * i];
            const float4 x = ((const float4*)(xin + (size_t)t * D))[lane + 64 * i];
            xv[4 * i + 0] = x.x + g2.x * (acc[4 * i + 0] - corr); xv[4 * i + 1] = x.y + g2.y * (acc[4 * i + 1] - corr);
            xv[4 * i + 2] = x.z + g2.z * (acc[4 * i + 2] - corr); xv[4 * i + 3] = x.w + g2.w * (acc[4 * i + 3] - corr);
            ss += (xv[4 * i] * xv[4 * i] + xv[4 * i + 1] * xv[4 * i + 1]) + (xv[4 * i + 2] * xv[4 * i + 2] + xv[4 * i + 3] * xv[4 * i + 3]);
        }
        ss = wave_total_dpp(ss);
        const float r = rsqrtf(ss * (1.f / D) + EPS);
#pragma unroll
        for (int i = 0; i < 4; ++i) {
            const float4 gg = ((const float4*)p.fg)[lane + 64 * i];
            float4 o; o.x = xv[4 * i + 0] * r * gg.x; o.y = xv[4 * i + 1] * r * gg.y; o.z = xv[4 * i + 2] * r * gg.z; o.w = xv[4 * i + 3] * r * gg.w;
            ((float4*)(xout + (size_t)t * D))[lane + 64 * i] = o;
        }
    }
}

__device__ __forceinline__ void ph_vt(const bf16* proj, int voff, bf16* VT) {
    const int lane = threadIdx.x & 63, gw = blockIdx.x * NWAVES + __builtin_amdgcn_readfirstlane(threadIdx.x >> 6), ngw = gridDim.x * NWAVES;
    for (int u = gw; u < NB * 8 * (S / 64); u += ngw) {
        const int sb = u & 127, h = (u >> 7) & 7, b = u >> 10;
        const bf16* src = proj + (size_t)(b * S + sb * 64) * PW + voff + h * 64 + lane;
        bf16* dst = VT + (((size_t)(b * 8 + h) * (S / 32) + 2 * sb) * 64 + lane) * 32;
        unsigned short e[64];
#pragma unroll
        for (int j = 0; j < 64; ++j) e[j] = src[(size_t)j * PW];
#pragma unroll
        for (int blk = 0; blk < 2; ++blk)
#pragma unroll
            for (int q4 = 0; q4 < 4; ++q4) {
                const int a = 32 * blk + 4 * q4, c = a + 16;
                v4u o; o.x = e[a] | ((unsigned)e[a + 1] << 16); o.y = e[a + 2] | ((unsigned)e[a + 3] << 16); o.z = e[c] | ((unsigned)e[c + 1] << 16); o.w = e[c + 2] | ((unsigned)e[c + 3] << 16);
                *(v4u*)(dst + blk * 64 * 32 + 8 * q4) = o;
            }
    }
}
__device__ __forceinline__ void ph_stick2(const bf16* proj, const bf16* KC, const bf16* VT, bf16* yb) {
    const int tid = opaque_tid();
    const int lane = tid & 63, fr = lane & 15, fq = lane >> 4;
    const int gw = blockIdx.x * NWAVES + __builtin_amdgcn_readfirstlane(tid >> 6), ngw = gridDim.x * NWAVES;
    for (int u = gw; u < (T / 16) * 8; u += ngw) {
        const int h = (u >> 3) & 7, t0 = ((((u >> 6) << 3) | (u & 7))) * 16, b = t0 / S, tl0 = t0 % S;
        const int qpos = tl0 + fr;
        bf16x8_t bq[2];
        { const bf16* qrow = proj + (size_t)(t0 + fr) * PW + OFF_QB + 64 * h + 8 * fq; bq[0] = *(const bf16x8_t*)qrow; bq[1] = *(const bf16x8_t*)(qrow + 32); }
        f32x4_t acc[4];
#pragma unroll
        for (int dt = 0; dt < 4; ++dt) acc[dt] = (f32x4_t){0.f, 0.f, 0.f, 0.f};
        float carry = 0.f;
        const bf16* vtb = VT + ((size_t)(b * 8 + h) * (S / 32) * 64 + fr) * 32 + 8 * fq;
        const bf16* kbase = KC + ((size_t)(b * 8 + h) * S + fr) * 64 + 8 * fq;
        int kb = (tl0 + 15) >> 5;
        bf16x8_t nk[2][2]; v4u nv[4];
#pragma unroll
        for (int tile = 0; tile < 2; ++tile) { const bf16* kr = kbase + (size_t)(32 * kb + 16 * tile) * 64; nk[tile][0] = *(const bf16x8_t*)kr; nk[tile][1] = *(const bf16x8_t*)(kr + 32); }
#pragma unroll
        for (int dt = 0; dt < 4; ++dt) { const bf16* vr = vtb + (size_t)kb * 2048 + (16 * dt) * 32; nv[dt] = *(const v4u*)vr; }
        for (; kb >= 0; --kb) {
            bf16x8_t ck[2][2]; v4u cv[4];
#pragma unroll
            for (int tile = 0; tile < 2; ++tile) { ck[tile][0] = nk[tile][0]; ck[tile][1] = nk[tile][1]; }
#pragma unroll
            for (int dt = 0; dt < 4; ++dt) cv[dt] = nv[dt];
            { const int kbn = kb > 0 ? kb - 1 : 0;
#pragma unroll
              for (int tile = 0; tile < 2; ++tile) { const bf16* kr = kbase + (size_t)(32 * kbn + 16 * tile) * 64; nk[tile][0] = *(const bf16x8_t*)kr; nk[tile][1] = *(const bf16x8_t*)(kr + 32); }
#pragma unroll
              for (int dt = 0; dt < 4; ++dt) { const bf16* vr = vtb + (size_t)kbn * 2048 + (16 * dt) * 32; nv[dt] = *(const v4u*)vr; } }
            unsigned pw[4] = {0u, 0u, 0u, 0u};
#pragma unroll
            for (int tile = 1; tile >= 0; --tile) {
                const int k0 = 32 * kb + 16 * tile;
                if (k0 > tl0 + 14) continue;
                f32x4_t st = (f32x4_t){0.f, 0.f, 0.f, 0.f};
                st = __builtin_amdgcn_mfma_f32_16x16x32_bf16(ck[tile][0], bq[0], st, 0, 0, 0);
                st = __builtin_amdgcn_mfma_f32_16x16x32_bf16(ck[tile][1], bq[1], st, 0, 0, 0);
                float lb[4], l1m[4];
#pragma unroll
                for (int i = 0; i < 4; ++i) {
                    const float z = st[i] * 0.18033688011112042f;
                    const bool valid = (k0 + 4 * fq + i) < qpos;
                    const float sp = fmaxf(-z, 0.f) + __builtin_amdgcn_logf(1.f + __builtin_amdgcn_exp2f(-fabsf(z)));
                    lb[i] = valid ? -sp : -INFINITY;
                    l1m[i] = valid ? (-sp - z) : 0.f;
                }
                const float e2 = l1m[3], e1 = e2 + l1m[2], e0 = e1 + l1m[1], gsum = e0 + l1m[0];
                const float a1 = __shfl(gsum, (lane + 16) & 63), a2 = __shfl(gsum, (lane + 32) & 63), a3 = __shfl(gsum, (lane + 48) & 63);
                const float above = (fq < 3 ? a1 : 0.f) + (fq < 2 ? a2 : 0.f) + (fq < 1 ? a3 : 0.f);
                const float base = carry + above;
                const float w0 = __builtin_amdgcn_exp2f(lb[0] + base + e0), w1 = __builtin_amdgcn_exp2f(lb[1] + base + e1), w2 = __builtin_amdgcn_exp2f(lb[2] + base + e2), w3 = __builtin_amdgcn_exp2f(lb[3] + base);
                carry += (gsum + a1) + (a2 + a3);
                pw[2 * tile] = pk2(w0, w1); pw[2 * tile + 1] = pk2(w2, w3);
            }
            bf16x8_t pb;
            { v4u t; t.x = pw[0]; t.y = pw[1]; t.z = pw[2]; t.w = pw[3]; pb = __builtin_bit_cast(bf16x8_t, t); }
#pragma unroll
            for (int dt = 0; dt < 4; ++dt) {
                acc[dt] = __builtin_amdgcn_mfma_f32_16x16x32_bf16(__builtin_bit_cast(bf16x8_t, cv[dt]), pb, acc[dt], 0, 0, 0);
            }
            if (__all(carry < -173.2f)) break;
        }
#pragma unroll
        for (int dt = 0; dt < 4; ++dt) {
            uint2 o; o.x = pk2(acc[dt][0], acc[dt][1]); o.y = pk2(acc[dt][2], acc[dt][3]);
            *(uint2*)(yb + (size_t)(t0 + fr) * 512 + 64 * h + 16 * dt + 4 * fq) = o;
        }
    }
}

constexpr int IQB = 32, ICAPN = 704, ICAP = 705  , ITRIG = ICAPN - 128, ILOW = 352;
constexpr int LDS_IKEY = 0, LDS_IIDX = IQB * ICAP * 4, LDS_ICNT = ((LDS_IIDX + IQB * ICAP * 2 + 15) / 16) * 16, LDS_ITHR = LDS_ICNT + IQB * 4, LDS_IROW = LDS_ITHR + IQB * 4;
static_assert(LDS_IROW + NWAVES * 1024 <= LDS_BYTES - 16, "indexer LDS map");
__device__ __forceinline__ int wave_count(bool pred) { return __popcll(__ballot(pred)); }
__device__ __forceinline__ int index_keep(int nseen, int ntot) {
    const float f = (float)nseen / (float)ntot, a = (float)(ntot - nseen) / (float)nseen;
    const float s = 2.25f * sqrtf(a) + sqrtf(5.0625f * a + 256.f);
    return (int)ceilf(fmaxf(s * s, 272.f) * f);
}
template <int NE> __device__ __forceinline__ void index_load(LAS unsigned* keyb, LAS unsigned short* idxb, int q, int n, int lane, unsigned (&kv)[NE], unsigned (&iv)[NE]) {
#pragma unroll
    for (int j = 0; j < NE; ++j) { const int pos = lane + 64 * j; const bool in = pos < n; kv[j] = in ? keyb[q * ICAP + pos] : 0u; iv[j] = in ? (unsigned)idxb[q * ICAP + pos] : 0xFFFFu; }
}
template <int NE> __device__ __forceinline__ int index_count_ge(const unsigned (&kv)[NE], unsigned c) {
    int k = 0;
#pragma unroll
    for (int j = 0; j < NE; ++j) k += __popcll(__builtin_amdgcn_uicmp(kv[j], c, 35));
    return k;
}
template <int NE> __device__ __forceinline__ unsigned index_kth(const unsigned (&kv)[NE], int need) {
    unsigned tau = 0u;
#pragma unroll 1
    for (int bit = 31; bit >= 0; --bit) { const unsigned c = tau | (1u << bit); if (index_count_ge<NE>(kv, c) >= need) tau = c; }
    return tau;
}
template <int NE> __device__ __forceinline__ unsigned index_kth_range(const unsigned (&kv)[NE], int lo, int hi, int& cout) {
    unsigned tau = 0u;
#pragma unroll 1
    for (int bit = 31; bit >= 0; --bit) {
        const unsigned c = tau | (1u << bit); const int cc = index_count_ge<NE>(kv, c);
        if (cc >= lo) { tau = c; cout = cc; if (cc <= hi) break; }
    }
    return tau;
}
__device__ __forceinline__ void index_cut(LAS unsigned* keyb, LAS unsigned short* idxb, LAS unsigned* cnt, LAS unsigned* thr, int q, int lane, int K) {
    const int n = (int)cnt[q];
    if (n <= K) return;
    unsigned kv[11], iv[11];
    index_load<11>(keyb, idxb, q, n, lane, kv, iv);
    int c = n;
    const unsigned p = index_kth_range<11>(kv, K, K + (K >> 3), c);
    unsigned tau = p - 1u, iota = 0xFFFFu;
    if (c > 448 || p == 0u) {
        tau = index_kth<11>(kv, TOPK);
        int ngt = 0, neq = 0;
#pragma unroll
        for (int j = 0; j < 11; ++j) { ngt += __popcll(__builtin_amdgcn_uicmp(kv[j], tau, 34)); neq += __popcll(__builtin_amdgcn_uicmp(kv[j], tau, 32)); }
        const int need = TOPK - ngt;
        if (neq > need) {
            unsigned x = 0u;
#pragma unroll 1
            for (int bit = 15; bit >= 0; --bit) {
                const unsigned cc = x | (1u << bit);
                int k = 0;
#pragma unroll
                for (int j = 0; j < 11; ++j) k += wave_count(kv[j] == tau && iv[j] < cc);
                if (k < need) x = cc;
            }
            iota = x;
        }
    }
    int base = 0;
    const unsigned long long lt = (1ull << lane) - 1ull;
#pragma unroll
    for (int j = 0; j < 11; ++j) {
        const bool keep = kv[j] > tau || (kv[j] == tau && iv[j] <= iota);
        const unsigned long long m = __ballot(keep);
        const int pos = base + __popcll(m & lt);
        if (keep) { keyb[q * ICAP + pos] = kv[j]; idxb[q * ICAP + pos] = (unsigned short)iv[j]; }
        base += __popcll(m);
    }
    if (lane == 0) { cnt[q] = (unsigned)base; thr[q] = tau; }
    asm volatile("s_waitcnt lgkmcnt(0)" ::: "memory");
}
template <int NE> __device__ __forceinline__ void index_bits(LAS unsigned* keyb, LAS unsigned short* idxb, int q, int n, int lane) {
    unsigned kv[NE], iv[NE];
    index_load<NE>(keyb, idxb, q, n, lane, kv, iv);
    unsigned tau = 0u, iota = 0xFFFFu;
    if (n > TOPK) {
        int cdummy = 0; tau = index_kth_range<NE>(kv, TOPK, TOPK, cdummy);
        int ngt = 0, neq = 0;
#pragma unroll
        for (int j = 0; j < NE; ++j) { ngt += __popcll(__builtin_amdgcn_uicmp(kv[j], tau, 34)); neq += __popcll(__builtin_amdgcn_uicmp(kv[j], tau, 32)); }
        const int need = TOPK - ngt;
        if (neq > need) {
            unsigned x = 0u;
#pragma unroll 1
            for (int bit = 15; bit >= 0; --bit) {
                const unsigned c = x | (1u << bit);
                int k = 0;
#pragma unroll
                for (int j = 0; j < NE; ++j) k += wave_count(kv[j] == tau && iv[j] < c);
                if (k < need) x = c;
            }
            iota = x;
        }
    }
    LAS unsigned* rowl = keyb + q * ICAP;
    asm volatile("s_waitcnt lgkmcnt(0)" ::: "memory");
#pragma unroll
    for (int i = 0; i < 4; ++i) rowl[lane + 64 * i] = 0u;
    asm volatile("s_waitcnt lgkmcnt(0)" ::: "memory");
#pragma unroll
    for (int j = 0; j < NE; ++j) {
        const bool keep = (n > TOPK) ? (kv[j] > tau || (kv[j] == tau && iv[j] <= iota)) : (lane + 64 * j < n);
        if (keep) (void)__hip_atomic_fetch_or(rowl + (iv[j] >> 5), 1u << (iv[j] & 31u), __ATOMIC_RELAXED, __HIP_MEMORY_SCOPE_WORKGROUP);
    }
    asm volatile("s_waitcnt lgkmcnt(0)" ::: "memory");
}
__device__ __forceinline__ void index_final(LAS unsigned* keyb, LAS unsigned short* idxb, LAS unsigned* cnt, int q, int lane) {
    const int n = (int)cnt[q];
    if (n <= 384) index_bits<6>(keyb, idxb, q, n, lane); else if (n <= 448) index_bits<7>(keyb, idxb, q, n, lane); else if (n <= 576) index_bits<9>(keyb, idxb, q, n, lane); else index_bits<11>(keyb, idxb, q, n, lane);
}
template <int ABL> __device__ __forceinline__ void ph_dsa_index(const bf16* proj, const bf16* KI, const bf16* WI, unsigned* selbits, LAS unsigned char* lds) {
    LAS unsigned* keyb = (LAS unsigned*)(lds + LDS_IKEY); LAS unsigned short* idxb = (LAS unsigned short*)(lds + LDS_IIDX);
    LAS unsigned* cnt = (LAS unsigned*)(lds + LDS_ICNT); LAS unsigned* thr = (LAS unsigned*)(lds + LDS_ITHR);
    const int tid = opaque_tid(), wave = __builtin_amdgcn_readfirstlane(tid >> 6), lane = tid & 63, fr = lane & 15, fq = lane >> 4;
    LAS unsigned* rowl = (LAS unsigned*)(lds + LDS_IROW + wave * 1024);
    constexpr int NQB = S / IQB;
    for (int pr = blockIdx.x; pr < NB * NQB / 2; pr += gridDim.x) {
        const int b = pr / (NQB / 2), pp = pr % (NQB / 2);
#pragma unroll 1
        for (int ui = 0; ui < 2; ++ui) {
            const int qb = ui ? pp : (NQB - 1 - pp);
            const int q0 = qb * IQB, t0 = b * S + q0;
            bf16x8_t bqf[2][8][2]; unsigned wvp[2][4];
#pragma unroll
            for (int qg = 0; qg < 2; ++qg) {
                const bf16* qrow = proj + (size_t)(t0 + 16 * qg + fr) * PW;
#pragma unroll
                for (int h = 0; h < 8; ++h) { bqf[qg][h][0] = *(const bf16x8_t*)(qrow + OFF_QI + 64 * h + 8 * fq); bqf[qg][h][1] = *(const bf16x8_t*)(qrow + OFF_QI + 64 * h + 8 * fq + 32); }
                { const uint4 w4 = *(const uint4*)(WI + (size_t)(t0 + 16 * qg + fr) * 8); wvp[qg][0] = w4.x; wvp[qg][1] = w4.y; wvp[qg][2] = w4.z; wvp[qg][3] = w4.w; }
            }
            const int ntiles = (q0 + IQB - 1) / 128 + 1;
            const bf16* kwave = KI + (size_t)(b * S + 16 * wave + fr) * 64 + 8 * fq;
#pragma unroll 1
            for (int cons = 0; cons < 2; ++cons) {
            __syncthreads();
            if (tid < IQB) { cnt[tid] = 0u; thr[tid] = 0u; }
            bf16x8_t ak0 = *(const bf16x8_t*)kwave, ak1 = *(const bf16x8_t*)(kwave + 32);
#pragma unroll 1
            for (int kt = 0; kt < ntiles; ++kt) {
                asm volatile("s_waitcnt lgkmcnt(0)" ::: "memory"); __builtin_amdgcn_s_barrier(); asm volatile("" ::: "memory");
                if (__any((int)cnt[lane & 31] > ITRIG)) {
#pragma unroll 1
                    for (int qq = 0; qq < 4; ++qq) { const int q = 4 * wave + qq; if ((int)cnt[q] > ILOW) { if (ABL == 2) { if (lane == 0) cnt[q] = 256u; } else {
                        const int ntot = q0 + q + 1, nseen = min(128 * kt, ntot);
                        const int K = cons ? TOPK : __builtin_amdgcn_readfirstlane(max(index_keep(nseen, ntot), 32));
                        index_cut(keyb, idxb, cnt, thr, q, lane, K); } } }
                    asm volatile("s_waitcnt lgkmcnt(0)" ::: "memory"); __builtin_amdgcn_s_barrier(); asm volatile("" ::: "memory");
                }
                const unsigned th0 = thr[fr], th1 = thr[16 + fr];
                const int k0 = 128 * kt + 16 * wave;
                const bf16x8_t a0 = ak0, a1 = ak1;
                { const bf16* kn = kwave + (size_t)(128 * ((kt + 1 < ntiles) ? kt + 1 : kt)) * 64; ak0 = *(const bf16x8_t*)kn; ak1 = *(const bf16x8_t*)(kn + 32); }
#pragma unroll
                for (int qg = 0; qg < 2; ++qg) {
                    float sc[4] = {0.f, 0.f, 0.f, 0.f};
#pragma unroll
                    for (int h = 0; h < 8; ++h) {
                        f32x4_t a = (f32x4_t){0.f, 0.f, 0.f, 0.f};
                        a = __builtin_amdgcn_mfma_f32_16x16x32_bf16(a0, bqf[qg][h][0], a, 0, 0, 0);
                        a = __builtin_amdgcn_mfma_f32_16x16x32_bf16(a1, bqf[qg][h][1], a, 0, 0, 0);
                        const float wh = (h & 1) ? __uint_as_float(wvp[qg][h >> 1] & 0xffff0000u) : __uint_as_float(wvp[qg][h >> 1] << 16);
#pragma unroll
                        for (int i = 0; i < 4; ++i) { const float af_ = a[i]; sc[i] += wh * __int_as_float(max(__float_as_int(af_), 0)); asm("" : "+v"(sc[i])); }
                    }
                    const int qi = 16 * qg + fr, qpos = q0 + qi;
                    const unsigned th = qg ? th1 : th0;
                    unsigned keyv[4], slot[4]; bool prd[4];
#pragma unroll
                    for (int i = 0; i < 4; ++i) {
                        float s = sc[i]; if (s == 0.f) s = 0.f;
                        keyv[i] = f2ord(s);
                        prd[i] = (ABL != 1) && (k0 + 4 * fq + i <= qpos) && (keyv[i] > th);
                    }
#pragma unroll
                    for (int i = 0; i < 4; ++i) slot[i] = prd[i] ? __hip_atomic_fetch_add(cnt + qi, 1u, __ATOMIC_RELAXED, __HIP_MEMORY_SCOPE_WORKGROUP) : 0u;
#pragma unroll
                    for (int i = 0; i < 4; ++i) if (prd[i]) { keyb[qi * ICAP + slot[i]] = keyv[i]; idxb[qi * ICAP + slot[i]] = (unsigned short)(k0 + 4 * fq + i); }
                }
            }
            __syncthreads();
            if (!__any((int)cnt[lane & 31] < min(TOPK, q0 + (lane & 31) + 1))) break;
            }
#pragma unroll 1
            for (int qq = 0; qq < (ABL == 0 ? 4 : 0); ++qq) { const int q = 4 * wave + qq; index_final(keyb, idxb, cnt, q, lane); }
            if (ABL == 0) {
                __syncthreads();
                unsigned* dst = selbits + ((size_t)(b * (S / 32) + qb) * 128) * 64;
                for (int idx = tid; idx < 128 * 32; idx += NTHR) { const int kt = idx >> 5, qq = idx & 31;
                    uint2 w; w.x = keyb[qq * ICAP + 2 * kt]; w.y = keyb[qq * ICAP + 2 * kt + 1];
                    *(uint2*)(dst + (size_t)idx * 2) = w; }
            }
        }
    }
    __syncthreads();
}

constexpr int AQB = 256, AKT = 64, AROW = 144;
constexpr int LDS_AK = 0, LDS_AV = AKT * AROW, LDS_ABUF = 2 * AKT * AROW, LDS_ABLUT = 2 * LDS_ABUF;
__device__ __forceinline__ float max3_f(float a, float b, float c) { float r_; asm("v_max3_f32 %0, %1, %2, %3" : "=v"(r_) : "v"(a), "v"(b), "v"(c)); return r_; }
__device__ __forceinline__ float max2_f(float a, float b) { float r_; asm("v_max_f32 %0, %1, %2" : "=v"(r_) : "v"(a), "v"(b)); return r_; }
__device__ __forceinline__ float bfi_f(unsigned mask, unsigned a, unsigned b) { unsigned r_; asm("v_bfi_b32 %0, %1, %2, %3" : "=v"(r_) : "v"(mask), "v"(a), "v"(b)); return __uint_as_float(r_); }
template <bool NEAR> __device__ __forceinline__ void attn_tile(LAS unsigned char* buf, LAS float* blut, const bf16x8_t (&bq)[2][2], const uint2 cb0, const uint2 cb1, int qw, int k0, int fr, int fq,
                                                               const bf16x8_t ones, f32x4_t (&acc)[2][4], f32x4_t (&accl)[2], float (&mrun)[2]) {
    const float cfar = blut[128];
    const unsigned ninf = 0xff800000u;
    bf16x8_t kf[4][2];
#pragma unroll
    for (int tile = 0; tile < 4; ++tile)
#pragma unroll
        for (int ks = 0; ks < 2; ++ks) kf[tile][ks] = *(const LAS bf16x8_t*)(buf + LDS_AK + (16 * tile + fr) * AROW + (8 * fq + 32 * ks) * 2);
    f32x4_t sx[2][4];
#pragma unroll
    for (int qg = 0; qg < 2; ++qg)
#pragma unroll
        for (int tile = 0; tile < 4; ++tile) { sx[qg][tile] = (f32x4_t){0.f, 0.f, 0.f, 0.f};
            sx[qg][tile] = __builtin_amdgcn_mfma_f32_16x16x32_bf16(kf[tile][0], bq[qg][0], sx[qg][tile], 0, 0, 0); sx[qg][tile] = __builtin_amdgcn_mfma_f32_16x16x32_bf16(kf[tile][1], bq[qg][1], sx[qg][tile], 0, 0, 0); }
    float x[2][16]; float mt[2];
#pragma unroll
    for (int qg = 0; qg < 2; ++qg) {
        const uint2 cb = qg ? cb1 : cb0;
        const int dist0 = (qw + 16 * qg + fr) - (k0 + 4 * fq);
        const float mref = (mrun[qg] == -INFINITY) ? 0.f : mrun[qg];
        const float cfm = cfar - mref;
#pragma unroll
        for (int tile = 0; tile < 4; ++tile) {
            const int nib = (int)(((tile & 2) ? cb.y : cb.x) >> (16 * (tile & 1) + 4 * fq));
#pragma unroll
            for (int i = 0; i < 4; ++i) {
                const unsigned t = (unsigned)__builtin_amdgcn_sbfe(nib, i, 1);
                float bias = cfm;
                if (NEAR) { int n = dist0 - (16 * tile + i); n = n < 0 ? 0 : (n > 128 ? 128 : n); bias = blut[n] - mref; }
                x[qg][4 * tile + i] = __builtin_fmaf(sx[qg][tile][i], 0.18033688011112042f, bfi_f(t, __float_as_uint(bias), ninf));
                asm("" : "+v"(x[qg][4 * tile + i]));
            }
        }
        float m8 = max3_f(max3_f(max3_f(x[qg][0], x[qg][1], x[qg][2]), max3_f(x[qg][3], x[qg][4], x[qg][5]), x[qg][15]), max3_f(x[qg][6], x[qg][7], x[qg][8]), max3_f(max3_f(x[qg][9], x[qg][10], x[qg][11]), max3_f(x[qg][12], x[qg][13], x[qg][14]), -INFINITY));
        m8 = max2_f(m8, __shfl_xor(m8, 16)); mt[qg] = max2_f(m8, __shfl_xor(m8, 32));
    }
    const bool rc0 = (mt[0] > 24.f) || (mrun[0] == -INFINITY && mt[0] > -INFINITY), rc1 = (mt[1] > 24.f) || (mrun[1] == -INFINITY && mt[1] > -INFINITY);
    if (__any(rc0 || rc1)) {
#pragma unroll
        for (int qg = 0; qg < 2; ++qg) {
            const bool rc = qg ? rc1 : rc0;
            const float sh = rc ? mt[qg] : 0.f;
            const float f = (rc && mrun[qg] != -INFINITY) ? __builtin_amdgcn_exp2f(-sh) : 1.f;
            mrun[qg] = rc ? (((mrun[qg] == -INFINITY) ? 0.f : mrun[qg]) + sh) : mrun[qg];
            accl[qg] = accl[qg] * f;
#pragma unroll
            for (int dt = 0; dt < 4; ++dt) acc[qg][dt] = acc[qg][dt] * f;
#pragma unroll
            for (int e = 0; e < 16; ++e) x[qg][e] -= sh;
        }
    }
#pragma unroll
    for (int blk = 0; blk < 2; ++blk) {
        bf16x8_t vf[4];
#pragma unroll
        for (int dt = 0; dt < 4; ++dt) vf[dt] = *(const LAS bf16x8_t*)(buf + LDS_AV + (16 * dt + fr) * AROW + (32 * blk + 8 * fq) * 2);
#pragma unroll
        for (int qg = 0; qg < 2; ++qg) {
            v4u t;
            t.x = pk2(__builtin_amdgcn_exp2f(x[qg][8 * blk + 0]), __builtin_amdgcn_exp2f(x[qg][8 * blk + 1])); t.y = pk2(__builtin_amdgcn_exp2f(x[qg][8 * blk + 2]), __builtin_amdgcn_exp2f(x[qg][8 * blk + 3]));
            t.z = pk2(__builtin_amdgcn_exp2f(x[qg][8 * blk + 4]), __builtin_amdgcn_exp2f(x[qg][8 * blk + 5])); t.w = pk2(__builtin_amdgcn_exp2f(x[qg][8 * blk + 6]), __builtin_amdgcn_exp2f(x[qg][8 * blk + 7]));
            const bf16x8_t pb = __builtin_bit_cast(bf16x8_t, t);
            accl[qg] = __builtin_amdgcn_mfma_f32_16x16x32_bf16(ones, pb, accl[qg], 0, 0, 0);
#pragma unroll
            for (int dt = 0; dt < 4; ++dt) acc[qg][dt] = __builtin_amdgcn_mfma_f32_16x16x32_bf16(vf[dt], pb, acc[qg][dt], 0, 0, 0);
        }
    }
}
__device__ __forceinline__ void ph_dsa_attn2(const Params& p, const bf16* proj, const bf16* KC, const bf16* VTa, const unsigned* selbits, bf16* ya, LAS unsigned char* lds) {
    const int tid = opaque_tid(), wave = __builtin_amdgcn_readfirstlane(tid >> 6), lane = tid & 63, fr = lane & 15, fq = lane >> 4;
    LAS float* blut = (LAS float*)(lds + LDS_ABLUT);
    constexpr int NQBA = S / AQB;
    const int ldr = tid >> 3, ldc = tid & 7;
    for (int pr = blockIdx.x; pr < NB * 8 * NQBA / 2; pr += gridDim.x) {
        const int bh = pr / (NQBA / 2), pp = pr % (NQBA / 2), b = bh >> 3, h = bh & 7;
        __syncthreads();
        if (tid <= 128) blut[tid] = p.rel_bias[(tid >= 128 ? 31 : t5_bucket(tid)) * 8 + h] * 1.4426950408889634f;
        const bf16* kg = KC + ((size_t)(b * 8 + h) * S + ldr) * 64 + 8 * ldc;
        const bf16* vg = VTa + ((size_t)(b * 8 + h) * (S / 32) * 64 + (ldc >> 2) * 64 + ldr) * 32 + 8 * (ldc & 3);
#pragma unroll 1
        for (int ui = 0; ui < 2; ++ui) {
            const int qb = ui ? pp : (NQBA - 1 - pp);
            const int q0 = qb * AQB, qw = q0 + 32 * wave;
            const int ntiles = (q0 + AQB) / AKT;
            bf16x8_t bq[2][2];
#pragma unroll
            for (int qg = 0; qg < 2; ++qg) { const bf16* qrow = proj + (size_t)(b * S + qw + 16 * qg + fr) * PW + OFF_QA + 64 * h + 8 * fq; bq[qg][0] = *(const bf16x8_t*)qrow; bq[qg][1] = *(const bf16x8_t*)(qrow + 32); }
            const unsigned* brow0 = selbits + ((size_t)(b * (S / 32) + (qw >> 5)) * 128) * 64 + 2 * fr;
            const unsigned* brow1 = brow0 + 32;
            f32x4_t acc[2][4], accl[2]; float mrun[2];
            const bf16x8_t ones = __builtin_bit_cast(bf16x8_t, (v4u){0x3f803f80u, 0x3f803f80u, 0x3f803f80u, 0x3f803f80u});
#pragma unroll
            for (int qg = 0; qg < 2; ++qg) { mrun[qg] = -INFINITY; accl[qg] = (f32x4_t){0.f, 0.f, 0.f, 0.f};
#pragma unroll
                for (int dt = 0; dt < 4; ++dt) acc[qg][dt] = (f32x4_t){0.f, 0.f, 0.f, 0.f}; }
            __syncthreads();
            { const v4u kk = *(const v4u*)kg, vv = *(const v4u*)vg;
              *(LAS v4u*)(lds + LDS_AK + ldr * AROW + 16 * ldc) = kk; *(LAS v4u*)(lds + LDS_AV + ldr * AROW + 16 * ldc) = vv; }
            uint2 wb0 = *(const uint2*)brow0, wb1 = *(const uint2*)brow1;
            __syncthreads();
#pragma unroll 1
            for (int kt = 0; kt < ntiles; ++kt) {
                const int k0 = kt * AKT;
                LAS unsigned char* buf = lds + (kt & 1) * LDS_ABUF;
                const int ktn = (kt + 1 < ntiles) ? kt + 1 : kt;
                const uint2 cb0 = wb0, cb1 = wb1;
                const v4u nk = *(const v4u*)(kg + (size_t)(ktn * AKT) * 64), nvv = *(const v4u*)(vg + (size_t)(ktn * AKT / 32) * 2048);
                wb0 = *(const uint2*)(brow0 + 64 * ktn); wb1 = *(const uint2*)(brow1 + 64 * ktn);
                if (k0 <= qw + 31) {
                    if ((k0 + AKT - 1 + 128) > qw) attn_tile<true>(buf, blut, bq, cb0, cb1, qw, k0, fr, fq, ones, acc, accl, mrun);
                    else attn_tile<false>(buf, blut, bq, cb0, cb1, qw, k0, fr, fq, ones, acc, accl, mrun);
                }
                { LAS unsigned char* nb = lds + ((kt + 1) & 1) * LDS_ABUF;
                    *(LAS v4u*)(nb + LDS_AK + ldr * AROW + 16 * ldc) = nk; *(LAS v4u*)(nb + LDS_AV + ldr * AROW + 16 * ldc) = nvv; }
                asm volatile("s_waitcnt lgkmcnt(0)" ::: "memory"); __builtin_amdgcn_s_barrier(); asm volatile("" ::: "memory");
            }
#pragma unroll
            for (int qg = 0; qg < 2; ++qg) {
                const float inv = 1.f / accl[qg][0];
#pragma unroll
                for (int dt = 0; dt < 4; ++dt) { uint2 o; o.x = pk2(acc[qg][dt][0] * inv, acc[qg][dt][1] * inv); o.y = pk2(acc[qg][dt][2] * inv, acc[qg][dt][3] * inv);
                    *(uint2*)(ya + (size_t)(b * S + qw + 16 * qg + fr) * 512 + 64 * h + 16 * dt + 4 * fq) = o; }
            }
        }
    }
    __syncthreads();
}

__global__ void __launch_bounds__(NTHR, 2) mega_fwd(Params p) {
    extern __shared__ __attribute__((aligned(16))) unsigned char lds[];
    float* sm = (float*)lds;
    LAS unsigned char* ldsl = (LAS unsigned char*)lds;
    volatile LAS unsigned* bst = (volatile LAS unsigned*)(ldsl + LDS_BYTES - 16);
    if (threadIdx.x == 0) { bst[0] = 0u; bst[1] = 0u; bst[2] = 0u; bst[3] = 0u; }
    __syncthreads();
    XcdBarrier bar = xcd_barrier_post((unsigned*)(p.ws + WS_BAR), bst);
    unsigned char* ws = p.ws;
    float* mod = (float*)(ws + WS_MOD);
    bf16* proj = (bf16*)(ws + WS_PROJ);
    bf16* G = (bf16*)(ws + WS_G);
    bf16* ya = (bf16*)(ws + WS_YA); bf16* yb = (bf16*)(ws + WS_YB);
    bf16* hn2 = (bf16*)(ws + WS_HN2); bf16* qh = (bf16*)(ws + WS_QH);
    bf16* hn = (bf16*)p.out;
    const int G_ = gridDim.x, c_ = blockIdx.x;

    ph_mod(p, mod, (float*)(lds + LDS_SC_OFF));
    ph_weights(p, ldsl);
    xcd_barrier(bar);
    ph_norm<true>(p.x, p.g1, mod, 0, 1, hn);
    xcd_barrier(bar);
    {
        pg8::Gemm g{hn, (const bf16*)(ws + WS_WIN), T, NPROJ, D, D, D}; pg8::StaticOrder So; So.init(T, NPROJ, G_, c_);
        pg8::EpiX<1> E{proj, G, nullptr, nullptr, nullptr, PW, 0, (bf16*)(ws + WS_KCA), (bf16*)(ws + WS_KCB), (bf16*)(ws + WS_KI), (bf16*)(ws + WS_WI)};
        pg8::gemm_phase<pg8::EpiX<1>, pg8::StaticOrder, true, true>(ldsl, g, So, E);
    }
    xcd_barrier(bar);
    unsigned* selbits = (unsigned*)((unsigned char*)p.out + 32 * MiB); bf16* VTa = (bf16*)p.out;
    ph_vt(proj, OFF_VB, (bf16*)(ws + WS_VT));
    ph_vt(proj, OFF_VA, VTa);
    ph_dsa_index<0>(proj, (const bf16*)(ws + WS_KI), (const bf16*)(ws + WS_WI), selbits, ldsl);
    xcd_barrier(bar);
    ph_dsa_attn2(p, proj, (const bf16*)(ws + WS_KCA), VTa, selbits, ya, ldsl);
    ph_stick2(proj, (const bf16*)(ws + WS_KCB), (const bf16*)(ws + WS_VT), yb);
    xcd_barrier(bar);
    {
        pg8::Gemm g{ya, (const bf16*)(ws + WS_WPA), T, D, 512, 512, 512}; pg8::StaticOrder So; So.init(T, D, G_, c_);
        pg8::EpiX<2> E{nullptr, G, nullptr, nullptr, nullptr, 0, 0, nullptr, nullptr, nullptr, nullptr};
        pg8::gemm_phase<pg8::EpiX<2>, pg8::StaticOrder, true, true>(ldsl, g, So, E);
    }
    {
        pg8::Gemm g{yb, (const bf16*)(ws + WS_WPB), T, D, 512, 512, 512}; pg8::StaticOrder So; So.init(T, D, G_, c_);
        pg8::EpiX<3> E{nullptr, G, nullptr, nullptr, nullptr, 0, 0, nullptr, nullptr, nullptr, nullptr};
        pg8::gemm_phase<pg8::EpiX<3>, pg8::StaticOrder, true, true>(ldsl, g, So, E);
    }
    xcd_barrier(bar);
    {
        pg8::Gemm g{G, (const bf16*)(ws + WS_WOUT), T, D, D, GW, D}; pg8::StaticOrder So; So.init(T, D, G_, c_);
        pg8::EpiX<4> E{nullptr, nullptr, p.x, mod + 2 * D, p.out, 0, 0, nullptr, nullptr, nullptr, nullptr};
        pg8::gemm_phase<pg8::EpiX<4>, pg8::StaticOrder, true, true>(ldsl, g, So, E);
    }
    xcd_barrier(bar);
    ph_norm<false>(p.out, p.g2, mod, 3, 4, hn2);
    ph_quant(p, ws + WS_TAB, (float*)(ws + WS_SCALES));
    xcd_barrier(bar);
    {
        pg8::Gemm g{hn2, (const bf16*)(ws + WS_WQ), T, 2048, D, D, D}; pg8::StaticOrder So; So.init(T, 2048, G_, c_);
        pg8::EpiX<0> E{qh, nullptr, nullptr, nullptr, nullptr, 2048, 0, nullptr, nullptr, nullptr, nullptr};
        pg8::gemm_phase<pg8::EpiX<0>, pg8::StaticOrder, true, true>(ldsl, g, So, E);
    }
    xcd_barrier(bar);
    ph_peer_select(qh, (const bf16*)(ws + WS_SKB), (unsigned short*)(ws + WS_EIDX), (float*)(ws + WS_GATE));
    xcd_barrier(bar);
    ph_peer_gather(p, hn2, (const unsigned short*)(ws + WS_EIDX), (const float*)(ws + WS_GATE), ws + WS_TAB, (const float*)(ws + WS_SCALES), mod, p.out, p.out);
}

extern "C" void kernel_launch(void* const* d_in, const int* in_sizes, int n_in, void* d_out, int out_size, void* d_ws, size_t ws_size, hipStream_t stream) {
    static int grid = 0;
    if (grid == 0) {
        if (n_in != 16 || out_size != T * D || ws_size < WS_NEED) { fprintf(stderr, "kernel_launch: unexpected shapes (n_in %d out %d ws %zu)\n", n_in, out_size, ws_size); grid = -1; return; }
        int dev = 0, cus = 0, per_cu = 0;
        if (hipGetDevice(&dev) != hipSuccess || hipDeviceGetAttribute(&cus, hipDeviceAttributeMultiprocessorCount, dev) != hipSuccess) { grid = -1; return; }
        if (hipFuncSetAttribute((const void*)mega_fwd, hipFuncAttributeMaxDynamicSharedMemorySize, LDS_BYTES) != hipSuccess) { fprintf(stderr, "kernel_launch: hipFuncSetAttribute failed\n"); grid = -1; return; }
        if (hipOccupancyMaxActiveBlocksPerMultiprocessor(&per_cu, (const void*)mega_fwd, NTHR, LDS_BYTES) != hipSuccess || per_cu < 1) { fprintf(stderr, "kernel_launch: occupancy query says %d\n", per_cu); per_cu = 1; }
        (void)hipGetLastError();
        grid = cus;
    }
    if (grid < 0) return;
    (void)hipMemsetAsync((char*)d_ws + WS_BAR, 0, CTL_ZERO_BYTES, stream);
    Params p; memset(&p, 0, sizeof(p));
    p.x = (const float*)d_in[0]; p.c = (const float*)d_in[1]; p.w_ada = (const float*)d_in[2]; p.b_ada = (const float*)d_in[3];
    p.g1 = (const float*)d_in[4]; p.g2 = (const float*)d_in[5]; p.w_in = (const float*)d_in[6]; p.rel_bias = (const float*)d_in[7];
    p.wpa = (const float*)d_in[8]; p.wpb = (const float*)d_in[9]; p.wout = (const float*)d_in[10]; p.wq = (const float*)d_in[11];
    p.sk = (const float*)d_in[12]; p.pu = (const float*)d_in[13]; p.pv = (const float*)d_in[14]; p.fg = (const float*)d_in[15];
    p.out = (float*)d_out; p.ws = (unsigned char*)d_ws;
    hipLaunchKernelGGL(mega_fwd, dim3(grid), dim3(NTHR), LDS_BYTES, stream, p);
}
```

```cpp
#include <hip/hip_runtime.h>
#include <stdint.h>
#include <math.h>
#include <string.h>
#include <stdio.h>

typedef unsigned short bf16;
constexpr int D = 1024, NB = 2, S = 8192, T = NB * S;
constexpr int INW = 5704;
constexpr int OFF_QA = 0, OFF_VA = 512, OFF_QI = 1024, OFF_QB = 1536, OFF_VB = 2048;
constexpr int PW = 2560;
constexpr int NPROJ = 3840 + 2048;
constexpr int GW = 2048;
constexpr int TOPK = 256;
constexpr float EPS = 1e-6f;
constexpr size_t MiB = 1u << 20;
constexpr int NTHR = 512, NWAVES = 8;
constexpr int LDS_BYTES = 147456;

#define LAS __attribute__((address_space(3)))

__device__ __forceinline__ bf16 f2bf(float f) { unsigned u = __float_as_uint(f); return (bf16)((u + 0x7fffu + ((u >> 16) & 1u)) >> 16); }
__device__ __forceinline__ float bf2f(bf16 h) { return __uint_as_float(((unsigned)h) << 16); }
typedef __bf16 bf16x2_hw __attribute__((ext_vector_type(2)));
__device__ __forceinline__ unsigned pk2(float lo, float hi) { bf16x2_hw v; v[0] = (__bf16)lo; v[1] = (__bf16)hi; return __builtin_bit_cast(unsigned, v); }

__device__ __forceinline__ float wave_sum(float v) {
#pragma unroll
    for (int o = 1; o < 64; o <<= 1) v += __shfl_xor(v, o);
    return v;
}
__device__ __forceinline__ float block_sum(float v, float* red) {
    v = wave_sum(v);
    __syncthreads();
    if ((threadIdx.x & 63) == 0) red[threadIdx.x >> 6] = v;
    __syncthreads();
    float s = 0.f;
#pragma unroll
    for (int i = 0; i < NWAVES; ++i) s += red[i];
    return s;
}
typedef float f32x4_t __attribute__((ext_vector_type(4)));
#define XB_TMO      128
#define XB_XCNT(j)  (256  + 64 * (j))
#define XB_XSUB(j)  (1280 + 64 * (j))
#define XB_XGEN(j)  (2304 + 64 * (j))
#define XB_TOP      3328
#define XB_TOPGEN   3392
#define XCD_BAR_WORDS 3456
#define XB_SPIN_CAP (1u << 22)

__device__ __forceinline__ unsigned xb_ld(unsigned* p)              { return __hip_atomic_load(p, __ATOMIC_RELAXED, __HIP_MEMORY_SCOPE_AGENT); }
__device__ __forceinline__ unsigned xb_add(unsigned* p, unsigned v) { return __hip_atomic_fetch_add(p, v, __ATOMIC_RELAXED, __HIP_MEMORY_SCOPE_AGENT); }
__device__ __forceinline__ unsigned xb_xcc_id() { return (unsigned)__builtin_amdgcn_s_getreg((3 << 11) | 20) & 0xFu; }
#define XB_SPIN(cond, bar) do { unsigned _sp = 0; while (cond) { __builtin_amdgcn_s_sleep(1); \
    if ((++_sp & 255u) == 0u) { if (xb_ld(&(bar)[XB_TMO])) break; if (_sp > XB_SPIN_CAP) { atomicAdd(&(bar)[XB_TMO], 1u); break; } } } } while (0)

struct XcdBarrier {
    unsigned* bar; unsigned x;
    volatile LAS unsigned* st;
};

__device__ __forceinline__ XcdBarrier xcd_barrier_post(unsigned* bar, volatile LAS unsigned* st) {
    XcdBarrier b; b.bar = bar; b.x = xb_xcc_id(); b.st = st;
    if (threadIdx.x == 0) (void)xb_add(&bar[XB_XCNT(b.x)], 1u);
    return b;
}
__device__ __forceinline__ void xcd_barrier_complete(unsigned* bar, unsigned x, unsigned& nloc, unsigned& nx) {
    const unsigned G = gridDim.x * gridDim.y * gridDim.z;
    unsigned sum, cnt, mine, sp = 0u;
    for (;;) {
        sum = 0u; cnt = 0u; mine = 0u;
#pragma unroll
        for (unsigned j = 0; j < 16; ++j) { const unsigned c = xb_ld(&bar[XB_XCNT(j)]); sum += c; cnt += (c > 0u) ? 1u : 0u; mine = (j == x) ? c : mine; }
        if (sum == G) break;
        __builtin_amdgcn_s_sleep(1);
        if ((++sp & 255u) == 0u) { if (xb_ld(&bar[XB_TMO])) break; if (sp > XB_SPIN_CAP) { atomicAdd(&bar[XB_TMO], 1u); break; } }
    }
    nloc = mine > 0u ? mine : 1u; nx = cnt > 0u ? cnt : 1u;
}

__device__ __forceinline__ void xcd_barrier(const XcdBarrier& b) {
    asm volatile("s_waitcnt vmcnt(0)" ::: "memory");
    __syncthreads();
    if (threadIdx.x == 0) {
        unsigned* bar = b.bar;
        __builtin_amdgcn_s_waitcnt(0);
        unsigned nloc = b.st[0], nx = b.st[1];
        if (nloc == 0u) { xcd_barrier_complete(bar, b.x, nloc, nx); b.st[0] = nloc; b.st[1] = nx; }
        const unsigned old = xb_add(&bar[XB_XSUB(b.x)], 1u);
        const unsigned gen = old / nloc;
        if (old + 1u == (gen + 1u) * nloc) {
            __builtin_amdgcn_fence(__ATOMIC_RELEASE, "agent");
            asm volatile("s_waitcnt vmcnt(0)" ::: "memory");
            const unsigned og = xb_add(&bar[XB_TOP], 1u);
            const unsigned tg = og / nx;
            if (og + 1u == (tg + 1u) * nx) xb_add(&bar[XB_TOPGEN], 1u);
            else XB_SPIN(xb_ld(&bar[XB_TOPGEN]) == tg, bar);
            __builtin_amdgcn_fence(__ATOMIC_ACQUIRE, "agent");
            xb_add(&bar[XB_XGEN(b.x)], 1u);
            asm volatile("s_waitcnt vmcnt(0)" ::: "memory");
        } else {
            XB_SPIN(xb_ld(&bar[XB_XGEN(b.x)]) == gen, bar);
            __builtin_amdgcn_fence(__ATOMIC_ACQUIRE, "agent");
            asm volatile("s_waitcnt vmcnt(0)" ::: "memory");
        }
    }
    __syncthreads();
}


namespace pg8 {
#define PG8_LAS __attribute__((address_space(3)))
typedef unsigned short bf16_t;
typedef short bf16x8 __attribute__((ext_vector_type(8)));
typedef float f32x4 __attribute__((ext_vector_type(4)));
typedef unsigned u32x4 __attribute__((ext_vector_type(4)));
constexpr int BM = 256, BK = 64, HALF = 128, HTB = HALF * BK * 2  , STAGE_BYTES = 8 * HTB, NXCD = 8, WGM = 8;

__host__ __device__ __forceinline__ int lds_byte(int r, int c) { const int st = (r >> 4) * 2 + (c >> 5), rr = r & 15, cc = c & 31, ob = rr * 64 + cc * 2; return st * 1024 + (ob ^ (((ob >> 9) & 1) << 5)); }
__host__ __device__ __forceinline__ void stage_rc(int b, int& R, int& C) { const int st = b / 1024, sb = b % 1024, swz = sb ^ (((sb >> 9) & 1) << 5); R = (st >> 1) * 16 + swz / 64; C = (st & 1) * 32 + (swz % 64) / 2; }
__host__ __device__ __forceinline__ int perm32(int rho) { const int n = rho >> 4, i = rho & 15; return 8 * (i >> 2) + 4 * n + (i & 3); }

struct Unit { int pm, pn; };
struct Gemm { const bf16_t* A; const bf16_t* Bt; int M, N, K, lda, ldb; };

struct StaticOrder {
    int nM, nN, nwg, G, c;
    __host__ __device__ void init(int M, int N, int G_, int c_) { nM = M / BM; nN = N / BM; nwg = nM * nN; G = G_; c = c_; }
    __host__ __device__ bool next(int i, Unit& u) const {
        const long L = (long)i * G + c; if (L >= nwg) return false;
        int wgid = (int)L; { const int q = nwg / NXCD, r = nwg % NXCD, xcd = wgid % NXCD, off = wgid / NXCD; wgid = (xcd < r ? xcd * (q + 1) : r * (q + 1) + (xcd - r) * q) + off; }
        const int nig = WGM * nN, gid = wgid / nig, fm = gid * WGM, gsz = (nM - fm) < WGM ? (nM - fm) : WGM;
        u.pm = fm + ((wgid % nig) % gsz); u.pn = (wgid % nig) / gsz; return true;
    }
    __device__ __forceinline__ void a_ready(const Unit&) const {}
    __device__ __forceinline__ void done(const Unit&) const {}
};
__device__ __forceinline__ unsigned cvt_pk_bf16(float lo, float hi) { return ::pk2(lo, hi); }
template <class Epi, class Sched, bool ALIGN_EPI = false, bool SP2 = false>
__device__ __forceinline__ void gemm_phase(PG8_LAS unsigned char* lds, const Gemm g, const Sched& S, const Epi& E) {
    int tid_ = threadIdx.x; asm volatile("" : "+v"(tid_));
    const int tid = tid_, wid = __builtin_amdgcn_readfirstlane(tid >> 6), lane = tid & 63, wr = wid >> 2, wc = wid & 3, fr = lane & 15, fq = lane >> 4;
    const int K = g.K, nt = K / BK;
    unsigned voffA[2], voffB[2];
#pragma unroll
    for (int i = 0; i < 2; ++i) { int R, C; stage_rc(tid * 16 + i * 8192, R, C); const int Rb = Epi::PERM ? ((R & ~31) + perm32(R & 31)) : R;
        voffA[i] = (unsigned)(R * g.lda + C) * 2u; voffB[i] = (unsigned)(Rb * g.ldb + C) * 2u; }
    const size_t kstep = (size_t)(BK * 2);
    const size_t hstepA = (size_t)HALF * g.lda * 2, hstepB = (size_t)HALF * g.ldb * 2;
    const size_t tstepA = 2 * hstepA, tstepB = 2 * hstepB;
    const unsigned ldsw = (unsigned)wid * 1024u;
    const int aoff = lds_byte(wr * 64 + fr, fq * 8), boff = lds_byte(wc * 32 + fr, fq * 8);
#define PG8_SA(b, h) (((b) * 2 + (h)) * HTB)
#define PG8_SB(b, h) ((4 + (b) * 2 + (h)) * HTB)
#define PG8_STAGE(bufoff, gbase, voff) do { _Pragma("unroll") for (int _i = 0; _i < 2; ++_i) \
        __builtin_amdgcn_global_load_lds((const unsigned*)((const char*)(gbase) + (voff)[_i]), (PG8_LAS unsigned*)(lds + (bufoff) + ldsw + _i * 8192), 16, 0, 0); } while (0)
#define PG8_LDA(dst, b, h) do { _Pragma("unroll") for (int m = 0; m < 4; ++m) _Pragma("unroll") for (int k = 0; k < 2; ++k) dst[m][k] = *(const PG8_LAS bf16x8*)(lds + PG8_SA(b, h) + aoff + m * 2048 + k * 1024); } while (0)
#define PG8_LDB(dst, b, h) do { _Pragma("unroll") for (int n = 0; n < 2; ++n) _Pragma("unroll") for (int k = 0; k < 2; ++k) dst[n][k] = *(const PG8_LAS bf16x8*)(lds + PG8_SB(b, h) + boff + n * 2048 + k * 1024); } while (0)
#define PG8_MMA(ai, bj, At, Bt) do { __builtin_amdgcn_s_setprio(1); _Pragma("unroll") for (int m = 0; m < 4; ++m) _Pragma("unroll") for (int n = 0; n < 2; ++n) _Pragma("unroll") for (int k = 0; k < 2; ++k) \
        acc[ai][bj][m][n] = __builtin_amdgcn_mfma_f32_16x16x32_bf16(Bt[n][k], At[m][k], acc[ai][bj][m][n], 0, 0, 0); __builtin_amdgcn_s_setprio(0); } while (0)
#define PG8_WAIT_V(n) asm volatile("s_waitcnt vmcnt(" #n ")" ::: "memory")
#define PG8_WAIT_L(n) asm volatile("s_waitcnt lgkmcnt(" #n ")" ::: "memory")
#define PG8_BAR __builtin_amdgcn_s_barrier()
#define PG8_SCHED __builtin_amdgcn_sched_barrier(0)
    Unit cur, nxt; int ui = 0;
    if (!S.next(0, cur)) return;
    f32x4 acc[2][2][4][2];
#pragma unroll
    for (int a = 0; a < 2; ++a)
#pragma unroll
        for (int b = 0; b < 2; ++b)
#pragma unroll
            for (int m = 0; m < 4; ++m)
#pragma unroll
                for (int n = 0; n < 2; ++n) acc[a][b][m][n] = (f32x4){0.f, 0.f, 0.f, 0.f};
    bf16x8 At[4][2], B0[2][2], B1[2][2];
    const char* cA = (const char*)g.A + (size_t)cur.pm * tstepA; const char* cB = (const char*)g.Bt + (size_t)cur.pn * tstepB;
    S.a_ready(cur);
    if constexpr (SP2) {
        PG8_STAGE(PG8_SB(0, 0), cB, voffB); PG8_STAGE(PG8_SB(0, 1), cB + hstepB, voffB); PG8_STAGE(PG8_SA(0, 0), cA, voffA); PG8_STAGE(PG8_SA(0, 1), cA + hstepA, voffA);
        if (wr == 1) PG8_BAR;
        PG8_WAIT_V(2); PG8_BAR;
        PG8_STAGE(PG8_SB(1, 0), cB + kstep, voffB); PG8_STAGE(PG8_SA(1, 0), cA + kstep, voffA); PG8_STAGE(PG8_SB(1, 1), cB + hstepB + kstep, voffB);
        PG8_WAIT_V(6); PG8_BAR;
    } else {
        PG8_STAGE(PG8_SB(0, 0), cB, voffB); PG8_STAGE(PG8_SA(0, 0), cA, voffA); PG8_STAGE(PG8_SB(0, 1), cB + hstepB, voffB); PG8_STAGE(PG8_SA(0, 1), cA + hstepA, voffA);
        if (wr == 1) PG8_BAR;
        PG8_WAIT_V(4); PG8_BAR;
        PG8_STAGE(PG8_SB(1, 0), cB + kstep, voffB); PG8_STAGE(PG8_SA(1, 0), cA + kstep, voffA); PG8_STAGE(PG8_SB(1, 1), cB + hstepB + kstep, voffB);
        PG8_WAIT_V(6); PG8_BAR;
    }
    for (;;) {
        const bool has_next = S.next(ui + 1, nxt);
        const char* nA = has_next ? (const char*)g.A + (size_t)nxt.pm * tstepA : cA; const char* nB = has_next ? (const char*)g.Bt + (size_t)nxt.pn * tstepB : cB;
        for (int t = 0; t < nt; t += 2) {
            const bool last = (t == nt - 2);
            const char* a1 = cA + (size_t)(t + 1) * kstep;
            const char* a2 = last ? nA : cA + (size_t)(t + 2) * kstep; const char* b2 = last ? nB : cB + (size_t)(t + 2) * kstep;
            const char* a3 = a2 + kstep; const char* b3 = b2 + kstep;
            if (last && has_next) S.a_ready(nxt);
            if constexpr (SP2) {
            PG8_LDB(B0, 0, 0); PG8_LDB(B1, 0, 1); PG8_SCHED; PG8_LDA(At, 0, 0); PG8_STAGE(PG8_SA(1, 1), a1 + hstepA, voffA);
            PG8_WAIT_V(8); PG8_WAIT_L(0); PG8_BAR; PG8_MMA(0, 0, At, B0); PG8_MMA(0, 1, At, B1); PG8_BAR; PG8_SCHED;
            PG8_LDA(At, 0, 1); PG8_STAGE(PG8_SB(0, 0), b2, voffB); PG8_STAGE(PG8_SB(0, 1), b2 + hstepB, voffB); PG8_STAGE(PG8_SA(0, 0), a2, voffA);
            PG8_WAIT_V(8); PG8_WAIT_L(0); PG8_BAR; PG8_MMA(1, 0, At, B0); PG8_MMA(1, 1, At, B1); PG8_BAR; PG8_SCHED;
            PG8_LDB(B0, 1, 0); PG8_LDB(B1, 1, 1); PG8_SCHED; PG8_LDA(At, 1, 0); PG8_STAGE(PG8_SA(0, 1), a2 + hstepA, voffA);
            PG8_WAIT_V(8); PG8_WAIT_L(0); PG8_BAR; PG8_MMA(0, 0, At, B0); PG8_MMA(0, 1, At, B1); PG8_BAR; PG8_SCHED;
            PG8_LDA(At, 1, 1); PG8_STAGE(PG8_SB(1, 0), b3, voffB); PG8_STAGE(PG8_SB(1, 1), b3 + hstepB, voffB); PG8_STAGE(PG8_SA(1, 0), a3, voffA);
            PG8_WAIT_V(8); PG8_WAIT_L(0); PG8_BAR; PG8_MMA(1, 0, At, B0); PG8_MMA(1, 1, At, B1); PG8_BAR; PG8_SCHED;
            } else {
            PG8_LDB(B0, 0, 0); PG8_SCHED; PG8_LDA(At, 0, 0); PG8_STAGE(PG8_SA(1, 1), a1 + hstepA, voffA);
            PG8_WAIT_L(8); PG8_BAR; PG8_WAIT_L(0); PG8_MMA(0, 0, At, B0); PG8_BAR; PG8_SCHED;
            PG8_LDB(B1, 0, 1); PG8_STAGE(PG8_SB(0, 0), b2, voffB);
            PG8_BAR; PG8_WAIT_L(0); PG8_MMA(0, 1, At, B1); PG8_BAR;
            PG8_LDA(At, 0, 1); PG8_STAGE(PG8_SA(0, 0), a2, voffA);
            PG8_BAR; PG8_WAIT_L(0); PG8_MMA(1, 0, At, B0); PG8_BAR; PG8_SCHED;
            PG8_STAGE(PG8_SB(0, 1), b2 + hstepB, voffB);
            PG8_WAIT_V(6); PG8_BAR; PG8_MMA(1, 1, At, B1); PG8_BAR;
            PG8_LDB(B0, 1, 0); PG8_SCHED; PG8_LDA(At, 1, 0); PG8_STAGE(PG8_SA(0, 1), a2 + hstepA, voffA);
            PG8_WAIT_L(8); PG8_BAR; PG8_WAIT_L(0); PG8_MMA(0, 0, At, B0); PG8_BAR; PG8_SCHED;
            PG8_LDB(B1, 1, 1); PG8_STAGE(PG8_SB(1, 0), b3, voffB);
            PG8_BAR; PG8_WAIT_L(0); PG8_MMA(0, 1, At, B1); PG8_BAR;
            PG8_LDA(At, 1, 1); PG8_STAGE(PG8_SA(1, 0), a3, voffA);
            PG8_BAR; PG8_WAIT_L(0); PG8_MMA(1, 0, At, B0); PG8_BAR; PG8_SCHED;
            PG8_STAGE(PG8_SB(1, 1), b3 + hstepB, voffB);
            PG8_WAIT_V(6); PG8_BAR; PG8_MMA(1, 1, At, B1); PG8_BAR;
            }
        }
        if constexpr (ALIGN_EPI) { if (wr == 0) PG8_BAR; }
        if constexpr (!Epi::AFTER_DRAIN) { E(acc, cur, wr, wc, fr, fq); S.done(cur); }
        if (!has_next) break;
#pragma unroll
        for (int a = 0; a < 2; ++a)
#pragma unroll
            for (int b = 0; b < 2; ++b)
#pragma unroll
                for (int m = 0; m < 4; ++m)
#pragma unroll
                    for (int n = 0; n < 2; ++n) acc[a][b][m][n] = (f32x4){0.f, 0.f, 0.f, 0.f};
        cur = nxt; cA = nA; cB = nB; ++ui;
        if constexpr (ALIGN_EPI) { if (wr == 1) PG8_BAR; }
    }
    PG8_WAIT_V(0);
    if constexpr (!ALIGN_EPI) { if (wr == 0) PG8_BAR; }
    PG8_BAR;
    if constexpr (Epi::AFTER_DRAIN) { E.fused(acc, cur, wr, wc, fr, fq, lds, wid, lane); S.done(cur); }
#undef PG8_SA
#undef PG8_SB
#undef PG8_STAGE
#undef PG8_LDA
#undef PG8_LDB
#undef PG8_MMA
#undef PG8_WAIT_V
#undef PG8_WAIT_L
#undef PG8_BAR
#undef PG8_SCHED
}
}

namespace pg8 {
__device__ __forceinline__ float sigmoidf_(float v) { return 1.f / (1.f + __expf(-v)); }
__device__ __forceinline__ void unpack8(const u32x4 w, float (&f)[8]) {
    f[0] = __uint_as_float(w.x << 16); f[1] = __uint_as_float(w.x & 0xffff0000u); f[2] = __uint_as_float(w.y << 16); f[3] = __uint_as_float(w.y & 0xffff0000u);
    f[4] = __uint_as_float(w.z << 16); f[5] = __uint_as_float(w.z & 0xffff0000u); f[6] = __uint_as_float(w.w << 16); f[7] = __uint_as_float(w.w & 0xffff0000u);
}
template <int MODE> struct EpiX {
    static constexpr bool PERM = true, AFTER_DRAIN = false;
    bf16_t* O; bf16_t* G; const float* xres; const float* gate; float* outf; int ldc; int pad; bf16_t* KCa; bf16_t* KCb; bf16_t* KI; bf16_t* WI;
    __device__ __forceinline__ void operator()(const f32x4 (&acc)[2][2][4][2], const Unit& u, int wr, int wc, int fr, int fq) const {
        const int row0 = u.pm * BM + wr * 64 + fr;
        int colt = u.pn * BM; bf16_t* base = O; int ld = ldc; bool sig = false;
        if (MODE == 1) { if (u.pn >= 15) { colt -= 15 * BM; base = G; ld = GW; sig = true; }
            else if (u.pn >= 10) {
#pragma unroll
                for (int ai = 0; ai < 2; ++ai)
#pragma unroll
                    for (int m = 0; m < 4; ++m) {
                        const int row = row0 + ai * HALF + m * 16, bb = row / S, ss = row % S;
#pragma unroll
                        for (int bj = 0; bj < 2; ++bj) {
                            const int c = wc * 32 + 8 * fq + bj * HALF;
                            const f32x4 v0 = acc[ai][bj][m][0], v1 = acc[ai][bj][m][1];
                            u32x4 w; w.x = cvt_pk_bf16(v0[0], v0[1]); w.y = cvt_pk_bf16(v0[2], v0[3]); w.z = cvt_pk_bf16(v1[0], v1[1]); w.w = cvt_pk_bf16(v1[2], v1[3]);
                            if (u.pn < 14) { const int cc = ((u.pn - 10) & 1) * BM + c; bf16_t* kc = (u.pn < 12) ? KCa : KCb;
                                *(u32x4*)(kc + ((size_t)(bb * 8 + (cc >> 6)) * S + ss) * 64 + (cc & 63)) = w; }
                            else if (c < 64) *(u32x4*)(KI + (size_t)row * 64 + c) = w;
                            else if (c == 64) *(u32x4*)(WI + (size_t)row * 8) = w;
                        }
                    }
                return;
            } }
        if (MODE == 2 || MODE == 3) { base = G; ld = GW; }
        const int col0 = colt + wc * 32 + 8 * fq;
#pragma unroll
        for (int ai = 0; ai < 2; ++ai)
#pragma unroll
            for (int m = 0; m < 4; ++m) {
                const int row = row0 + ai * HALF + m * 16;
#pragma unroll
                for (int bj = 0; bj < 2; ++bj) {
                    const int col = col0 + bj * HALF;
                    f32x4 v0 = acc[ai][bj][m][0], v1 = acc[ai][bj][m][1];
                    if (MODE == 4) {
                        const size_t o = (size_t)row * 1024 + col;
                        const f32x4 x0 = __builtin_nontemporal_load((const f32x4*)(xres + o)), x1 = __builtin_nontemporal_load((const f32x4*)(xres + o + 4));
                        const float* gp = gate + (row / S) * 6144 + col;
                        const f32x4 g0 = *(const f32x4*)gp, g1 = *(const f32x4*)(gp + 4);
                        *(f32x4*)(outf + o) = x0 + g0 * v0; *(f32x4*)(outf + o + 4) = x1 + g1 * v1;
                    } else {
                        bf16_t* pp = base + (size_t)row * ld + col;
                        if (MODE == 1) { if (sig) {
#pragma unroll
                            for (int e = 0; e < 4; ++e) { v0[e] = sigmoidf_(v0[e]); v1[e] = sigmoidf_(v1[e]); } } }
                        if (MODE == 2) { float t[8]; unpack8(*(const u32x4*)pp, t);
#pragma unroll
                            for (int e = 0; e < 4; ++e) { v0[e] *= t[e]; v1[e] *= t[4 + e]; } }
                        if (MODE == 3) { float t[8], gg[8]; unpack8(*(const u32x4*)pp, t); unpack8(*(const u32x4*)(pp + 1024), gg);
#pragma unroll
                            for (int e = 0; e < 4; ++e) { v0[e] = t[e] + gg[e] * v0[e]; v1[e] = t[4 + e] + gg[4 + e] * v1[e]; } }
                        u32x4 w; w.x = cvt_pk_bf16(v0[0], v0[1]); w.y = cvt_pk_bf16(v0[2], v0[3]); w.z = cvt_pk_bf16(v1[0], v1[1]); w.w = cvt_pk_bf16(v1[2], v1[3]);
                        *(u32x4*)pp = w;
                    }
                }
            }
    }
};
}
struct Params {
    const float *x, *c, *w_ada, *b_ada, *g1, *g2, *w_in, *rel_bias, *wpa, *wpb, *wout, *wq, *sk, *pu, *pv, *fg;
    float* out; unsigned char* ws;
};
__device__ __forceinline__ int opaque_tid() { int t = threadIdx.x; asm volatile("" : "+v"(t)); return t; }
typedef unsigned v4u __attribute__((ext_vector_type(4)));
#define LDS_WAIT() asm volatile("s_waitcnt lgkmcnt(0)" ::: "memory")

constexpr size_t WS_BAR = 0;
constexpr size_t CTL_ZERO_BYTES = 16384;
constexpr size_t WS_MOD = 64 * 1024;
constexpr size_t WS_WIN = 1 * MiB;
constexpr size_t WS_WPA = 13 * MiB, WS_WPB = 14 * MiB;
constexpr size_t WS_WOUT = 15 * MiB;
constexpr size_t WS_WQ = 17 * MiB;
constexpr size_t WS_PROJ = 22 * MiB;
constexpr size_t WS_KCA = 102 * MiB, WS_KCB = 118 * MiB;
constexpr size_t WS_KI = 134 * MiB, WS_WI = 136 * MiB;
constexpr size_t WS_G = 142 * MiB;
constexpr size_t WS_YA = 206 * MiB, WS_YB = 222 * MiB;
constexpr size_t WS_HN2 = 22 * MiB;
constexpr size_t WS_QH = 54 * MiB;
constexpr size_t WS_SKB = 21 * MiB;
constexpr size_t WS_EIDX = 118 * MiB;
constexpr size_t WS_GATE = 122 * MiB;
constexpr size_t WS_TAB = 130 * MiB;
constexpr size_t WS_SCALES = 162 * MiB;
constexpr size_t WS_VT = 238 * MiB;
constexpr size_t WS_NEED = 254 * MiB;
constexpr int LDS_SC_OFF = 7 * 16384 + 8448;

__device__ __forceinline__ void ph_mod(const Params& p, float* mod, float* sc) {
    float* part = sc + 2048;
    const int tid = threadIdx.x, kk = tid >> 3, cc = tid & 7;
    for (int i = tid; i < 2048; i += NTHR) { float v = p.c[i]; sc[i] = v / (1.f + expf(-v)); }
    __syncthreads();
    for (int unit = blockIdx.x; unit < 6144 / 24; unit += gridDim.x) {
        const int col = unit * 24 + 3 * cc;
        float a[2][3] = {{0.f, 0.f, 0.f}, {0.f, 0.f, 0.f}};
#pragma unroll 4
        for (int k = kk; k < 1024; k += 64) {
            const float* w = p.w_ada + (size_t)k * 6144 + col;
            const float w0 = __builtin_nontemporal_load(w), w1 = __builtin_nontemporal_load(w + 1), w2 = __builtin_nontemporal_load(w + 2), s0 = sc[k], s1 = sc[1024 + k];
            a[0][0] += s0 * w0; a[0][1] += s0 * w1; a[0][2] += s0 * w2; a[1][0] += s1 * w0; a[1][1] += s1 * w1; a[1][2] += s1 * w2;
        }
#pragma unroll
        for (int b = 0; b < 2; ++b)
#pragma unroll
            for (int j = 0; j < 3; ++j) part[kk * 48 + b * 24 + 3 * cc + j] = a[b][j];
        __syncthreads();
        if (tid < 48) { float s = 0.f; for (int q = 0; q < 64; ++q) s += part[q * 48 + tid]; const int b = tid / 24, j = unit * 24 + tid % 24; mod[b * 6144 + j] = s + p.b_ada[j]; }
        __syncthreads();
    }
}

template <class CM> __device__ __forceinline__ void transpose_item(const float* W, int ldw, int K, bf16* WT, LAS float* scr, int item, int nblk, int lane, const CM& cm) {
    const int kb = item / nblk, nb = item % nblk, k0 = 64 * kb, n0 = 32 * nb;
    const int sc = cm(n0 + (lane & 31));
#pragma unroll 8
    for (int i = 0; i < 32; ++i) { const int kk = 2 * i + (lane >> 5); scr[kk * 33 + (lane & 31)] = (sc >= 0) ? __builtin_nontemporal_load(W + (size_t)(k0 + kk) * ldw + sc) : 0.f; }
    LDS_WAIT(); asm volatile("" ::: "memory");
    const int c = lane & 7;
#pragma unroll
    for (int j = 0; j < 4; ++j) { const int n = (lane >> 3) + 8 * j; const LAS float* s = scr + (8 * c) * 33 + n;
        v4u o; o.x = pk2(s[0 * 33], s[1 * 33]); o.y = pk2(s[2 * 33], s[3 * 33]); o.z = pk2(s[4 * 33], s[5 * 33]); o.w = pk2(s[6 * 33], s[7 * 33]);
        *(v4u*)(WT + (size_t)(n0 + n) * K + k0 + 8 * c) = o; }
    LDS_WAIT(); asm volatile("" ::: "memory");
}
struct CmIdent { __device__ __forceinline__ int operator()(int n) const { return n; } };
struct CmWin {
    __device__ __forceinline__ int operator()(int n) const {
        if (n < 512) return n;
        if (n < 1024) return 1024 + (n - 512);
        if (n < 1536) return 1536 + (n - 1024);
        if (n < 2048) return 2120 + (n - 1536);
        if (n < 2560) return 3144 + (n - 2048);
        if (n < 3072) return 512 + (n - 2560);
        if (n < 3584) return 2632 + (n - 3072);
        if (n < 3648) return 2048 + (n - 3584);
        if (n < 3656) return 2112 + (n - 3648);
        if (n < 3840) return -1;
        return 3656 + (n - 3840);
    }
};
__device__ __forceinline__ void ph_weights(const Params& p, LAS unsigned char* lds) {
    unsigned char* ws = p.ws;
    const int wave = __builtin_amdgcn_readfirstlane(threadIdx.x >> 6), lane = threadIdx.x & 63;
    LAS float* scr = (LAS float*)(lds + wave * 16384);
    const int gw = blockIdx.x * NWAVES + wave, NGW = gridDim.x * NWAVES;
    constexpr int I_IN = 16 * (NPROJ / 32), I_PA = 8 * 32, I_PB = 8 * 32, I_OUT = 16 * 32, I_Q = 16 * 64;
    constexpr int NITEMS = I_IN + I_PA + I_PB + I_OUT + I_Q;
    for (int it = gw; it < NITEMS; it += NGW) {
        int r = it;
        if (r < I_IN) { transpose_item(p.w_in, INW, 1024, (bf16*)(ws + WS_WIN), scr, r, NPROJ / 32, lane, CmWin()); continue; } r -= I_IN;
        if (r < I_PA) { transpose_item(p.wpa, 1024, 512, (bf16*)(ws + WS_WPA), scr, r, 32, lane, CmIdent()); continue; } r -= I_PA;
        if (r < I_PB) { transpose_item(p.wpb, 1024, 512, (bf16*)(ws + WS_WPB), scr, r, 32, lane, CmIdent()); continue; } r -= I_PB;
        if (r < I_OUT) { transpose_item(p.wout, 1024, 1024, (bf16*)(ws + WS_WOUT), scr, r, 32, lane, CmIdent()); continue; } r -= I_OUT;
        transpose_item(p.wq, 2048, 1024, (bf16*)(ws + WS_WQ), scr, r, 64, lane, CmIdent());
    }
    for (int i = gw * 64 + lane; i < 8 * 2 * 128 * 128 / 4; i += NGW * 64) {
        const float4 v = ((const float4*)p.sk)[i]; uint2 w; w.x = pk2(v.x, v.y); w.y = pk2(v.z, v.w); ((uint2*)(ws + WS_SKB))[i] = w;
    }
}

template <bool NT> __device__ __forceinline__ void ph_norm(const float* src, const float* g, const float* mod, int shift_i, int scale_i, bf16* dst) {
    const int lane = threadIdx.x & 63, gw = blockIdx.x * NWAVES + __builtin_amdgcn_readfirstlane(threadIdx.x >> 6), ngw = gridDim.x * NWAVES;
    for (int t = gw; t < T; t += ngw) {
        const int b = t / S;
        float4 v[4]; float ss = 0.f;
#pragma unroll
        for (int i = 0; i < 4; ++i) { const f32x4_t t_ = NT ? __builtin_nontemporal_load((const f32x4_t*)(src + (size_t)t * D) + lane + 64 * i) : *((const f32x4_t*)(src + (size_t)t * D) + lane + 64 * i); v[i] = make_float4(t_.x, t_.y, t_.z, t_.w); ss += v[i].x * v[i].x + v[i].y * v[i].y + v[i].z * v[i].z + v[i].w * v[i].w; }
        ss = wave_sum(ss);
        const float r = rsqrtf(ss * (1.f / D) + EPS);
#pragma unroll
        for (int i = 0; i < 4; ++i) {
            const float4 gg = ((const float4*)g)[lane + 64 * i];
            const float4 sh = ((const float4*)(mod + b * 6144 + shift_i * D))[lane + 64 * i];
            const float4 sc = ((const float4*)(mod + b * 6144 + scale_i * D))[lane + 64 * i];
            float4 o;
            o.x = v[i].x * r * gg.x * (1.f + sc.x) + sh.x; o.y = v[i].y * r * gg.y * (1.f + sc.y) + sh.y;
            o.z = v[i].z * r * gg.z * (1.f + sc.z) + sh.z; o.w = v[i].w * r * gg.w * (1.f + sc.w) + sh.w;
            uint2 w; w.x = pk2(o.x, o.y); w.y = pk2(o.z, o.w);
            ((uint2*)(dst + (size_t)t * D))[lane + 64 * i] = w;
        }
    }
}
__device__ __forceinline__ unsigned f2ord(float f) { unsigned u = __float_as_uint(f); return (u & 0x80000000u) ? ~u : (u | 0x80000000u); }
__device__ __forceinline__ int t5_bucket(int n) {
    if (n < 16) return n;
    int large = 16 + (int)(logf((float)n * (1.f / 16.f)) / 2.0794415416798357f * 16.f);
    return large < 31 ? large : 31;
}

typedef short bf16x8_t __attribute__((ext_vector_type(8)));
template <int CTRL> __device__ __forceinline__ unsigned dppu(unsigned x) { return (unsigned)__builtin_amdgcn_mov_dpp((int)x, CTRL, 0xf, 0xf, true); }
template <int CTRL> __device__ __forceinline__ float dppf(float x) { return __builtin_bit_cast(float, __builtin_amdgcn_mov_dpp(__builtin_bit_cast(int, x), CTRL, 0xf, 0xf, true)); }
__device__ __forceinline__ unsigned row_max_u(unsigned x) { x = max(x, dppu<0xB1>(x)); x = max(x, dppu<0x4E>(x)); x = max(x, dppu<0x141>(x)); x = max(x, dppu<0x128>(x)); return x; }
__device__ __forceinline__ float row_max_f(float x) { x = fmaxf(x, dppf<0xB1>(x)); x = fmaxf(x, dppf<0x4E>(x)); x = fmaxf(x, dppf<0x141>(x)); x = fmaxf(x, dppf<0x128>(x)); return x; }
__device__ __forceinline__ float row_sum_f(float x) { x += dppf<0xB1>(x); x += dppf<0x4E>(x); x += dppf<0x141>(x); x += dppf<0x128>(x); return x; }
__device__ __forceinline__ float ord2f(unsigned k) { return __uint_as_float((k & 0x80000000u) ? (k & 0x7fffffffu) : ~k); }
__device__ __forceinline__ unsigned max3u(unsigned a, unsigned b, unsigned c) { return max(max(a, b), c); }

__device__ __forceinline__ void ph_quant(const Params& p, unsigned char* tab, float* scales) {
    const int lane = threadIdx.x & 63, gw = blockIdx.x * NWAVES + __builtin_amdgcn_readfirstlane(threadIdx.x >> 6), ngw = gridDim.x * NWAVES;
    for (int r = gw; r < 32768; r += ngw) {
        const float* src = (r < 16384) ? p.pu + (size_t)r * D : p.pv + (size_t)(r - 16384) * D;
        float4 v[4]; float am = 0.f;
#pragma unroll
        for (int i = 0; i < 4; ++i) { const f32x4_t t_ = __builtin_nontemporal_load((const f32x4_t*)src + lane + 64 * i); v[i] = make_float4(t_.x, t_.y, t_.z, t_.w);     am = fmaxf(am, fmaxf(fmaxf(fabsf(v[i].x), fabsf(v[i].y)), fmaxf(fabsf(v[i].z), fabsf(v[i].w)))); }
#pragma unroll
        for (int o = 1; o < 64; o <<= 1) am = fmaxf(am, __shfl_xor(am, o));
        const float inv = am > 0.f ? 127.f / am : 0.f;
        uint4 w; unsigned* wp = (unsigned*)&w;
#pragma unroll
        for (int i = 0; i < 4; ++i) {
            const int q0 = (int)rintf(v[i].x * inv) + 128, q1 = (int)rintf(v[i].y * inv) + 128, q2 = (int)rintf(v[i].z * inv) + 128, q3 = (int)rintf(v[i].w * inv) + 128;
            wp[i] = (unsigned)q0 | ((unsigned)q1 << 8) | ((unsigned)q2 << 16) | ((unsigned)q3 << 24);
        }
        ((uint4*)(tab + (size_t)r * 1024))[lane] = w;
        if (lane == 0) scales[r] = am * (1.f / 127.f);
    }
}

#define CE_DESC(x, y) do { const unsigned hi_ = max(x, y), lo_ = min(x, y); x = hi_; y = lo_; } while (0)
__device__ __forceinline__ int hull_ab(int c) {
    int a = 0, base = 0; bool done = false;
#pragma unroll
    for (int aa = 0; aa < 16; ++aa) { const int nb = 16 / (aa + 1); if (!done) { if (c >= base + nb) { base += nb; a = aa + 1; } else done = true; } }
    return (c < 50) ? ((a << 4) | (c - base)) : -1;
}
__device__ __forceinline__ void ph_peer_select(const bf16* qh, const bf16* skb, unsigned short* eidx, float* gate) {
    const int tid = opaque_tid();
    const int lane = tid & 63, fr = lane & 15, fq = lane >> 4;
    const int gw = blockIdx.x * NWAVES + __builtin_amdgcn_readfirstlane(tid >> 6), ngw = gridDim.x * NWAVES;
    int hab[4];
#pragma unroll
    for (int s = 0; s < 4; ++s) hab[s] = hull_ab(16 * s + fr);
    for (int unit = gw; unit < (T / 16) * 2; unit += ngw) {
        const int t0 = (unit >> 1) * 16, hh = unit & 1;
#pragma unroll 1
        for (int hi = 0; hi < 4; ++hi) {
            const int h = hh * 4 + hi;
            unsigned win[2][4];
#pragma unroll
            for (int c = 0; c < 2; ++c) {
                f32x4_t acc[8];
#pragma unroll
                for (int nt = 0; nt < 8; ++nt) acc[nt] = (f32x4_t){0.f, 0.f, 0.f, 0.f};
                const bf16* qrow = qh + (size_t)(t0 + fr) * 2048 + h * 256 + c * 128 + 8 * fq;
                bf16x8_t a[4];
#pragma unroll
                for (int ks = 0; ks < 4; ++ks) a[ks] = *(const bf16x8_t*)(qrow + 32 * ks);
                const bf16* kb = skb + ((size_t)(h * 2 + c) * 128 + fr) * 128 + 8 * fq;
#pragma unroll
                for (int nt = 0; nt < 8; ++nt)
#pragma unroll
                    for (int ks = 0; ks < 4; ++ks) { const bf16x8_t b = *(const bf16x8_t*)(kb + (size_t)nt * 16 * 128 + 32 * ks); acc[nt] = __builtin_amdgcn_mfma_f32_16x16x32_bf16(a[ks], b, acc[nt], 0, 0, 0); }
                unsigned pk[8][4];
#pragma unroll
                for (int nt = 0; nt < 8; ++nt)
#pragma unroll
                    for (int i = 0; i < 4; ++i) pk[nt][i] = (f2ord(acc[nt][i]) & ~127u) | (127u - (unsigned)(16 * nt + fr));
#pragma unroll
                for (int i = 0; i < 4; ++i) {
                    CE_DESC(pk[0][i], pk[1][i]); CE_DESC(pk[2][i], pk[3][i]); CE_DESC(pk[4][i], pk[5][i]); CE_DESC(pk[6][i], pk[7][i]);
                    CE_DESC(pk[0][i], pk[2][i]); CE_DESC(pk[1][i], pk[3][i]); CE_DESC(pk[4][i], pk[6][i]); CE_DESC(pk[5][i], pk[7][i]);
                    CE_DESC(pk[1][i], pk[2][i]); CE_DESC(pk[5][i], pk[6][i]);
                    CE_DESC(pk[0][i], pk[4][i]); CE_DESC(pk[1][i], pk[5][i]); CE_DESC(pk[2][i], pk[6][i]); CE_DESC(pk[3][i], pk[7][i]);
                    CE_DESC(pk[2][i], pk[4][i]); CE_DESC(pk[3][i], pk[5][i]);
                    CE_DESC(pk[1][i], pk[2][i]); CE_DESC(pk[3][i], pk[4][i]); CE_DESC(pk[5][i], pk[6][i]);
                }
#pragma unroll
                for (int r = 0; r < 16; ++r)
#pragma unroll
                    for (int i = 0; i < 4; ++i) {
                        const unsigned m = row_max_u(pk[0][i]);
                        if (fr == r) win[c][i] = m;
                        const bool w = pk[0][i] == m;
#pragma unroll
                        for (int nt = 0; nt < 7; ++nt) pk[nt][i] = w ? pk[nt + 1][i] : pk[nt][i];
                        pk[7][i] = w ? 0u : pk[7][i];
                    }
            }
#pragma unroll
            for (int i = 0; i < 4; ++i) {
                unsigned ck[4];
#pragma unroll
                for (int s = 0; s < 4; ++s) {
                    const int ab = hab[s] < 0 ? 0 : hab[s];
                    const unsigned wa = (unsigned)__shfl((int)win[0][i], (lane & 48) + (ab >> 4)), wb = (unsigned)__shfl((int)win[1][i], (lane & 48) + (ab & 15));
                    const float v = ord2f(wa & ~127u) + ord2f(wb & ~127u);
                    ck[s] = hab[s] < 0 ? 0u : ((f2ord(v) & ~255u) | (255u - (unsigned)ab));
                }
                unsigned mywin = 0u;
#pragma unroll
                for (int r = 0; r < 16; ++r) {
                    unsigned m = max(max(ck[0], ck[1]), max(ck[2], ck[3]));
                    m = row_max_u(m);
                    if (fr == r) mywin = m;
#pragma unroll
                    for (int s = 0; s < 4; ++s) ck[s] = (ck[s] == m) ? 0u : ck[s];
                }
                const unsigned ci = 255u - (mywin & 255u);
                const unsigned w0 = (unsigned)__shfl((int)win[0][i], (lane & 48) + (int)(ci >> 4)), w1 = (unsigned)__shfl((int)win[1][i], (lane & 48) + (int)(ci & 15u));
                const int e = (int)(127u - (w0 & 127u)) * 128 + (int)(127u - (w1 & 127u));
                const float s = ord2f(w0 & ~127u) + ord2f(w1 & ~127u);
                const float mx = row_max_f(s);
                const float ex = __expf(s - mx);
                const float sum = row_sum_f(ex);
                const int t = t0 + 4 * fq + i;
                eidx[(size_t)t * 128 + h * 16 + fr] = (unsigned short)e;
                gate[(size_t)t * 128 + h * 16 + fr] = ex / sum;
            }
        }
    }
}

__device__ __forceinline__ float wave_total_dpp(float x) {
    x = row_sum_f(x);
    return __builtin_bit_cast(float, __builtin_amdgcn_readlane(__builtin_bit_cast(int, x), 0)) + __builtin_bit_cast(float, __builtin_amdgcn_readlane(__builtin_bit_cast(int, x), 16)) +
           __builtin_bit_cast(float, __builtin_amdgcn_readlane(__builtin_bit_cast(int, x), 32)) + __builtin_bit_cast(float, __builtin_amdgcn_readlane(__builtin_bit_cast(int, x), 48));
}
__device__ __forceinline__ float gelu_erf(float x) { return 0.5f * x * (1.f + erff(x * 0.70710678118654752f)); }
__device__ __forceinline__ void ph_peer_gather(const Params& p, const bf16* hn2, const unsigned short* eidx, const float* gate, const unsigned char* tab, const float* scales, const float* mod, const float* xin, float* xout) {
    const int tid = opaque_tid();
    const int lane = tid & 63, gw = blockIdx.x * NWAVES + __builtin_amdgcn_readfirstlane(tid >> 6), ngw = gridDim.x * NWAVES;
    const unsigned char* utab = tab; const unsigned char* vtab = tab + (size_t)16384 * 1024;
    for (int t = gw; t < T; t += ngw) {
        const int b = t / S;
        float hv[16]; float hs = 0.f;
#pragma unroll
        for (int i = 0; i < 4; ++i) { const uint2 w = ((const uint2*)(hn2 + (size_t)t * D))[lane + 64 * i];
            hv[4 * i + 0] = __uint_as_float(w.x << 16); hv[4 * i + 1] = __uint_as_float(w.x & 0xffff0000u); hv[4 * i + 2] = __uint_as_float(w.y << 16); hv[4 * i + 3] = __uint_as_float(w.y & 0xffff0000u);
            hs += (hv[4 * i] + hv[4 * i + 1]) + (hv[4 * i + 2] + hv[4 * i + 3]); }
        hs = wave_total_dpp(hs);
        const int e0 = eidx[(size_t)t * 128 + lane], e1 = eidx[(size_t)t * 128 + 64 + lane];
        const float g0 = gate[(size_t)t * 128 + lane], g1 = gate[(size_t)t * 128 + 64 + lane];
        float pre0 = 0.f, pre1 = 0.f;
#pragma unroll
        for (int half = 0; half < 2; ++half) {
            const int ev = half ? e1 : e0;
            float pre = 0.f;
#pragma unroll 8
            for (int j = 0; j < 64; ++j) {
                const int e = __builtin_amdgcn_readlane(ev, j);
                const uint4 w = ((const uint4*)(utab + (size_t)e * 1024))[lane];
                const unsigned ww[4] = {w.x, w.y, w.z, w.w};
                float d = 0.f;
#pragma unroll
                for (int i = 0; i < 4; ++i) {
                    d += hv[4 * i + 0] * (float)(ww[i] & 0xffu); d += hv[4 * i + 1] * (float)((ww[i] >> 8) & 0xffu);
                    d += hv[4 * i + 2] * (float)((ww[i] >> 16) & 0xffu); d += hv[4 * i + 3] * (float)(ww[i] >> 24);
                }
                d = wave_total_dpp(d);
                pre = (lane == j) ? d : pre;
            }
            if (half) pre1 = pre; else pre0 = pre;
        }
        const float c0 = g0 * gelu_erf(scales[e0] * (pre0 - 128.f * hs)) * scales[16384 + e0];
        const float c1 = g1 * gelu_erf(scales[e1] * (pre1 - 128.f * hs)) * scales[16384 + e1];
        const float corr = 128.f * wave_total_dpp(c0 + c1);
        float acc[16];
#pragma unroll
        for (int i = 0; i < 16; ++i) acc[i] = 0.f;
#pragma unroll
        for (int half = 0; half < 2; ++half) {
            const int ev = half ? e1 : e0; const float cv = half ? c1 : c0;
#pragma unroll 8
            for (int j = 0; j < 64; ++j) {
                const int e = __builtin_amdgcn_readlane(ev, j);
                const float cf = __builtin_bit_cast(float, __builtin_amdgcn_readlane(__builtin_bit_cast(int, cv), j));
                const uint4 w = ((const uint4*)(vtab + (size_t)e * 1024))[lane];
                const unsigned ww[4] = {w.x, w.y, w.z, w.w};
#pragma unroll
                for (int i = 0; i < 4; ++i) {
                    acc[4 * i + 0] += cf * (float)(ww[i] & 0xffu); acc[4 * i + 1] += cf * (float)((ww[i] >> 8) & 0xffu);
                    acc[4 * i + 2] += cf * (float)((ww[i] >> 16) & 0xffu); acc[4 * i + 3] += cf * (float)(ww[i] >> 24);
                }
            }
        }
        float xv[16]; float ss = 0.f;
#pragma unroll
        for (int i = 0; i < 4; ++i) {
            const float4 g2 = ((const float4*)(mod + b * 6144 + 5 * D))[lane + 64 * i];
            const float4 x = ((const float4*)(xin + (size_t)t * D))[lane + 64 * i];
            xv[4 * i + 0] = x.x + g2.x * (acc[4 * i + 0] - corr); xv[4 * i + 1] = x.y + g2.y * (acc[4 * i + 1] - corr);
            xv[4 * i + 2] = x.z + g2.z * (acc[4 * i + 2] - corr); xv[4 * i + 3] = x.w + g2.w * (acc[4 * i + 3] - corr);
            ss += (xv[4 * i] * xv[4 * i] + xv[4 * i + 1] * xv[4 * i + 1]) + (xv[4 * i + 2] * xv[4 * i + 2] + xv[4 * i + 3] * xv[4 * i + 3]);
        }
        ss = wave_total_dpp(ss);
        const float r = rsqrtf(ss * (1.f / D) + EPS);
#pragma unroll
        for (int i = 0; i < 4; ++i) {
            const float4 gg = ((const float4*)p.fg)[lane + 64 * i];
            float4 o; o.x = xv[4 * i + 0] * r * gg.x; o.y = xv[4 * i + 1] * r * gg.y; o.z = xv[4 * i + 2] * r * gg.z; o.w = xv[4 * i + 3] * r * gg.w;
            ((float4*)(xout + (size_t)t * D))[lane + 64 * i] = o;
        }
    }
}

__device__ __forceinline__ void ph_vt(const bf16* proj, int voff, bf16* VT) {
    const int lane = threadIdx.x & 63, gw = blockIdx.x * NWAVES + __builtin_amdgcn_readfirstlane(threadIdx.x >> 6), ngw = gridDim.x * NWAVES;
    for (int u = gw; u < NB * 8 * (S / 64); u += ngw) {
        const int sb = u & 127, h = (u >> 7) & 7, b = u >> 10;
        const bf16* src = proj + (size_t)(b * S + sb * 64) * PW + voff + h * 64 + lane;
        bf16* dst = VT + (((size_t)(b * 8 + h) * (S / 32) + 2 * sb) * 64 + lane) * 32;
        unsigned short e[64];
#pragma unroll
        for (int j = 0; j < 64; ++j) e[j] = src[(size_t)j * PW];
#pragma unroll
        for (int blk = 0; blk < 2; ++blk)
#pragma unroll
            for (int q4 = 0; q4 < 4; ++q4) {
                const int a = 32 * blk + 4 * q4, c = a + 16;
                v4u o; o.x = e[a] | ((unsigned)e[a + 1] << 16); o.y = e[a + 2] | ((unsigned)e[a + 3] << 16); o.z = e[c] | ((unsigned)e[c + 1] << 16); o.w = e[c + 2] | ((unsigned)e[c + 3] << 16);
                *(v4u*)(dst + blk * 64 * 32 + 8 * q4) = o;
            }
    }
}
__device__ __forceinline__ void ph_stick2(const bf16* proj, const bf16* KC, const bf16* VT, bf16* yb) {
    const int tid = opaque_tid();
    const int lane = tid & 63, fr = lane & 15, fq = lane >> 4;
    const int gw = blockIdx.x * NWAVES + __builtin_amdgcn_readfirstlane(tid >> 6), ngw = gridDim.x * NWAVES;
    for (int u = gw; u < (T / 16) * 8; u += ngw) {
        const int h = (u >> 3) & 7, t0 = ((((u >> 6) << 3) | (u & 7))) * 16, b = t0 / S, tl0 = t0 % S;
        const int qpos = tl0 + fr;
        bf16x8_t bq[2];
        { const bf16* qrow = proj + (size_t)(t0 + fr) * PW + OFF_QB + 64 * h + 8 * fq; bq[0] = *(const bf16x8_t*)qrow; bq[1] = *(const bf16x8_t*)(qrow + 32); }
        f32x4_t acc[4];
#pragma unroll
        for (int dt = 0; dt < 4; ++dt) acc[dt] = (f32x4_t){0.f, 0.f, 0.f, 0.f};
        float carry = 0.f;
        const bf16* vtb = VT + ((size_t)(b * 8 + h) * (S / 32) * 64 + fr) * 32 + 8 * fq;
        const bf16* kbase = KC + ((size_t)(b * 8 + h) * S + fr) * 64 + 8 * fq;
        int kb = (tl0 + 15) >> 5;
        bf16x8_t nk[2][2]; v4u nv[4];
#pragma unroll
        for (int tile = 0; tile < 2; ++tile) { const bf16* kr = kbase + (size_t)(32 * kb + 16 * tile) * 64; nk[tile][0] = *(const bf16x8_t*)kr; nk[tile][1] = *(const bf16x8_t*)(kr + 32); }
#pragma unroll
        for (int dt = 0; dt < 4; ++dt) { const bf16* vr = vtb + (size_t)kb * 2048 + (16 * dt) * 32; nv[dt] = *(const v4u*)vr; }
        for (; kb >= 0; --kb) {
            bf16x8_t ck[2][2]; v4u cv[4];
#pragma unroll
            for (int tile = 0; tile < 2; ++tile) { ck[tile][0] = nk[tile][0]; ck[tile][1] = nk[tile][1]; }
#pragma unroll
            for (int dt = 0; dt < 4; ++dt) cv[dt] = nv[dt];
            { const int kbn = kb > 0 ? kb - 1 : 0;
#pragma unroll
              for (int tile = 0; tile < 2; ++tile) { const bf16* kr = kbase + (size_t)(32 * kbn + 16 * tile) * 64; nk[tile][0] = *(const bf16x8_t*)kr; nk[tile][1] = *(const bf16x8_t*)(kr + 32); }
#pragma unroll
              for (int dt = 0; dt < 4; ++dt) { const bf16* vr = vtb + (size_t)kbn * 2048 + (16 * dt) * 32; nv[dt] = *(const v4u*)vr; } }
            unsigned pw[4] = {0u, 0u, 0u, 0u};
#pragma unroll
            for (int tile = 1; tile >= 0; --tile) {
                const int k0 = 32 * kb + 16 * tile;
                if (k0 > tl0 + 14) continue;
                f32x4_t st = (f32x4_t){0.f, 0.f, 0.f, 0.f};
                st = __builtin_amdgcn_mfma_f32_16x16x32_bf16(ck[tile][0], bq[0], st, 0, 0, 0);
                st = __builtin_amdgcn_mfma_f32_16x16x32_bf16(ck[tile][1], bq[1], st, 0, 0, 0);
                float lb[4], l1m[4];
#pragma unroll
                for (int i = 0; i < 4; ++i) {
                    const float z = st[i] * 0.18033688011112042f;
                    const bool valid = (k0 + 4 * fq + i) < qpos;
                    const float sp = fmaxf(-z, 0.f) + __builtin_amdgcn_logf(1.f + __builtin_amdgcn_exp2f(-fabsf(z)));
                    lb[i] = valid ? -sp : -INFINITY;
                    l1m[i] = valid ? (-sp - z) : 0.f;
                }
                const float e2 = l1m[3], e1 = e2 + l1m[2], e0 = e1 + l1m[1], gsum = e0 + l1m[0];
                const float a1 = __shfl(gsum, (lane + 16) & 63), a2 = __shfl(gsum, (lane + 32) & 63), a3 = __shfl(gsum, (lane + 48) & 63);
                const float above = (fq < 3 ? a1 : 0.f) + (fq < 2 ? a2 : 0.f) + (fq < 1 ? a3 : 0.f);
                const float base = carry + above;
                const float w0 = __builtin_amdgcn_exp2f(lb[0] + base + e0), w1 = __builtin_amdgcn_exp2f(lb[1] + base + e1), w2 = __builtin_amdgcn_exp2f(lb[2] + base + e2), w3 = __builtin_amdgcn_exp2f(lb[3] + base);
                carry += (gsum + a1) + (a2 + a3);
                pw[2 * tile] = pk2(w0, w1); pw[2 * tile + 1] = pk2(w2, w3);
            }
            bf16x8_t pb;
            { v4u t; t.x = pw[0]; t.y = pw[1]; t.z = pw[2]; t.w = pw[3]; pb = __builtin_bit_cast(bf16x8_t, t); }
#pragma unroll
            for (int dt = 0; dt < 4; ++dt) {
                acc[dt] = __builtin_amdgcn_mfma_f32_16x16x32_bf16(__builtin_bit_cast(bf16x8_t, cv[dt]), pb, acc[dt], 0, 0, 0);
            }
            if (__all(carry < -173.2f)) break;
        }
#pragma unroll
        for (int dt = 0; dt < 4; ++dt) {
            uint2 o; o.x = pk2(acc[dt][0], acc[dt][1]); o.y = pk2(acc[dt][2], acc[dt][3]);
            *(uint2*)(yb + (size_t)(t0 + fr) * 512 + 64 * h + 16 * dt + 4 * fq) = o;
        }
    }
}

constexpr int IQB = 32, ICAPN = 704, ICAP = 705  , ITRIG = ICAPN - 128, ILOW = 352;
constexpr int LDS_IKEY = 0, LDS_IIDX = IQB * ICAP * 4, LDS_ICNT = ((LDS_IIDX + IQB * ICAP * 2 + 15) / 16) * 16, LDS_ITHR = LDS_ICNT + IQB * 4, LDS_IROW = LDS_ITHR + IQB * 4;
static_assert(LDS_IROW + NWAVES * 1024 <= LDS_BYTES - 16, "indexer LDS map");
__device__ __forceinline__ int wave_count(bool pred) { return __popcll(__ballot(pred)); }
__device__ __forceinline__ int index_keep(int nseen, int ntot) {
    const float f = (float)nseen / (float)ntot, a = (float)(ntot - nseen) / (float)nseen;
    const float s = 2.25f * sqrtf(a) + sqrtf(5.0625f * a + 256.f);
    return (int)ceilf(fmaxf(s * s, 272.f) * f);
}
template <int NE> __device__ __forceinline__ void index_load(LAS unsigned* keyb, LAS unsigned short* idxb, int q, int n, int lane, unsigned (&kv)[NE], unsigned (&iv)[NE]) {
#pragma unroll
    for (int j = 0; j < NE; ++j) { const int pos = lane + 64 * j; const bool in = pos < n; kv[j] = in ? keyb[q * ICAP + pos] : 0u; iv[j] = in ? (unsigned)idxb[q * ICAP + pos] : 0xFFFFu; }
}
template <int NE> __device__ __forceinline__ int index_count_ge(const unsigned (&kv)[NE], unsigned c) {
    int k = 0;
#pragma unroll
    for (int j = 0; j < NE; ++j) k += __popcll(__builtin_amdgcn_uicmp(kv[j], c, 35));
    return k;
}
template <int NE> __device__ __forceinline__ unsigned index_kth(const unsigned (&kv)[NE], int need) {
    unsigned tau = 0u;
#pragma unroll 1
    for (int bit = 31; bit >= 0; --bit) { const unsigned c = tau | (1u << bit); if (index_count_ge<NE>(kv, c) >= need) tau = c; }
    return tau;
}
template <int NE> __device__ __forceinline__ unsigned index_kth_range(const unsigned (&kv)[NE], int lo, int hi, int& cout) {
    unsigned tau = 0u;
#pragma unroll 1
    for (int bit = 31; bit >= 0; --bit) {
        const unsigned c = tau | (1u << bit); const int cc = index_count_ge<NE>(kv, c);
        if (cc >= lo) { tau = c; cout = cc; if (cc <= hi) break; }
    }
    return tau;
}
__device__ __forceinline__ void index_cut(LAS unsigned* keyb, LAS unsigned short* idxb, LAS unsigned* cnt, LAS unsigned* thr, int q, int lane, int K) {
    const int n = (int)cnt[q];
    if (n <= K) return;
    unsigned kv[11], iv[11];
    index_load<11>(keyb, idxb, q, n, lane, kv, iv);
    int c = n;
    const unsigned p = index_kth_range<11>(kv, K, K + (K >> 3), c);
    unsigned tau = p - 1u, iota = 0xFFFFu;
    if (c > 448 || p == 0u) {
        tau = index_kth<11>(kv, TOPK);
        int ngt = 0, neq = 0;
#pragma unroll
        for (int j = 0; j < 11; ++j) { ngt += __popcll(__builtin_amdgcn_uicmp(kv[j], tau, 34)); neq += __popcll(__builtin_amdgcn_uicmp(kv[j], tau, 32)); }
        const int need = TOPK - ngt;
        if (neq > need) {
            unsigned x = 0u;
#pragma unroll 1
            for (int bit = 15; bit >= 0; --bit) {
                const unsigned cc = x | (1u << bit);
                int k = 0;
#pragma unroll
                for (int j = 0; j < 11; ++j) k += wave_count(kv[j] == tau && iv[j] < cc);
                if (k < need) x = cc;
            }
            iota = x;
        }
    }
    int base = 0;
    const unsigned long long lt = (1ull << lane) - 1ull;
#pragma unroll
    for (int j = 0; j < 11; ++j) {
        const bool keep = kv[j] > tau || (kv[j] == tau && iv[j] <= iota);
        const unsigned long long m = __ballot(keep);
        const int pos = base + __popcll(m & lt);
        if (keep) { keyb[q * ICAP + pos] = kv[j]; idxb[q * ICAP + pos] = (unsigned short)iv[j]; }
        base += __popcll(m);
    }
    if (lane == 0) { cnt[q] = (unsigned)base; thr[q] = tau; }
    asm volatile("s_waitcnt lgkmcnt(0)" ::: "memory");
}
template <int NE> __device__ __forceinline__ void index_bits(LAS unsigned* keyb, LAS unsigned short* idxb, int q, int n, int lane) {
    unsigned kv[NE], iv[NE];
    index_load<NE>(keyb, idxb, q, n, lane, kv, iv);
    unsigned tau = 0u, iota = 0xFFFFu;
    if (n > TOPK) {
        int cdummy = 0; tau = index_kth_range<NE>(kv, TOPK, TOPK, cdummy);
        int ngt = 0, neq = 0;
#pragma unroll
        for (int j = 0; j < NE; ++j) { ngt += __popcll(__builtin_amdgcn_uicmp(kv[j], tau, 34)); neq += __popcll(__builtin_amdgcn_uicmp(kv[j], tau, 32)); }
        const int need = TOPK - ngt;
        if (neq > need) {
            unsigned x = 0u;
#pragma unroll 1
            for (int bit = 15; bit >= 0; --bit) {
                const unsigned c = x | (1u << bit);
                int k = 0;
#pragma unroll
                for (int j = 0; j < NE; ++j) k += wave_count(kv[j] == tau && iv[j] < c);
                if (k < need) x = c;
            }
            iota = x;
        }
    }
    LAS unsigned* rowl = keyb + q * ICAP;
    asm volatile("s_waitcnt lgkmcnt(0)" ::: "memory");
#pragma unroll
    for (int i = 0; i < 4; ++i) rowl[lane + 64 * i] = 0u;
    asm volatile("s_waitcnt lgkmcnt(0)" ::: "memory");
#pragma unroll
    for (int j = 0; j < NE; ++j) {
        const bool keep = (n > TOPK) ? (kv[j] > tau || (kv[j] == tau && iv[j] <= iota)) : (lane + 64 * j < n);
        if (keep) (void)__hip_atomic_fetch_or(rowl + (iv[j] >> 5), 1u << (iv[j] & 31u), __ATOMIC_RELAXED, __HIP_MEMORY_SCOPE_WORKGROUP);
    }
    asm volatile("s_waitcnt lgkmcnt(0)" ::: "memory");
}
__device__ __forceinline__ void index_final(LAS unsigned* keyb, LAS unsigned short* idxb, LAS unsigned* cnt, int q, int lane) {
    const int n = (int)cnt[q];
    if (n <= 384) index_bits<6>(keyb, idxb, q, n, lane); else if (n <= 448) index_bits<7>(keyb, idxb, q, n, lane); else if (n <= 576) index_bits<9>(keyb, idxb, q, n, lane); else index_bits<11>(keyb, idxb, q, n, lane);
}
template <int ABL> __device__ __forceinline__ void ph_dsa_index(const bf16* proj, const bf16* KI, const bf16* WI, unsigned* selbits, LAS unsigned char* lds) {
    LAS unsigned* keyb = (LAS unsigned*)(lds + LDS_IKEY); LAS unsigned short* idxb = (LAS unsigned short*)(lds + LDS_IIDX);
    LAS unsigned* cnt = (LAS unsigned*)(lds + LDS_ICNT); LAS unsigned* thr = (LAS unsigned*)(lds + LDS_ITHR);
    const int tid = opaque_tid(), wave = __builtin_amdgcn_readfirstlane(tid >> 6), lane = tid & 63, fr = lane & 15, fq = lane >> 4;
    LAS unsigned* rowl = (LAS unsigned*)(lds + LDS_IROW + wave * 1024);
    constexpr int NQB = S / IQB;
    for (int pr = blockIdx.x; pr < NB * NQB / 2; pr += gridDim.x) {
        const int b = pr / (NQB / 2), pp = pr % (NQB / 2);
#pragma unroll 1
        for (int ui = 0; ui < 2; ++ui) {
            const int qb = ui ? pp : (NQB - 1 - pp);
            const int q0 = qb * IQB, t0 = b * S + q0;
            bf16x8_t bqf[2][8][2]; unsigned wvp[2][4];
#pragma unroll
            for (int qg = 0; qg < 2; ++qg) {
                const bf16* qrow = proj + (size_t)(t0 + 16 * qg + fr) * PW;
#pragma unroll
                for (int h = 0; h < 8; ++h) { bqf[qg][h][0] = *(const bf16x8_t*)(qrow + OFF_QI + 64 * h + 8 * fq); bqf[qg][h][1] = *(const bf16x8_t*)(qrow + OFF_QI + 64 * h + 8 * fq + 32); }
                { const uint4 w4 = *(const uint4*)(WI + (size_t)(t0 + 16 * qg + fr) * 8); wvp[qg][0] = w4.x; wvp[qg][1] = w4.y; wvp[qg][2] = w4.z; wvp[qg][3] = w4.w; }
            }
            const int ntiles = (q0 + IQB - 1) / 128 + 1;
            const bf16* kwave = KI + (size_t)(b * S + 16 * wave + fr) * 64 + 8 * fq;
#pragma unroll 1
            for (int cons = 0; cons < 2; ++cons) {
            __syncthreads();
            if (tid < IQB) { cnt[tid] = 0u; thr[tid] = 0u; }
            bf16x8_t ak0 = *(const bf16x8_t*)kwave, ak1 = *(const bf16x8_t*)(kwave + 32);
#pragma unroll 1
            for (int kt = 0; kt < ntiles; ++kt) {
                asm volatile("s_waitcnt lgkmcnt(0)" ::: "memory"); __builtin_amdgcn_s_barrier(); asm volatile("" ::: "memory");
                if (__any((int)cnt[lane & 31] > ITRIG)) {
#pragma unroll 1
                    for (int qq = 0; qq < 4; ++qq) { const int q = 4 * wave + qq; if ((int)cnt[q] > ILOW) { if (ABL == 2) { if (lane == 0) cnt[q] = 256u; } else {
                        const int ntot = q0 + q + 1, nseen = min(128 * kt, ntot);
                        const int K = cons ? TOPK : __builtin_amdgcn_readfirstlane(max(index_keep(nseen, ntot), 32));
                        index_cut(keyb, idxb, cnt, thr, q, lane, K); } } }
                    asm volatile("s_waitcnt lgkmcnt(0)" ::: "memory"); __builtin_amdgcn_s_barrier(); asm volatile("" ::: "memory");
                }
                const unsigned th0 = thr[fr], th1 = thr[16 + fr];
                const int k0 = 128 * kt + 16 * wave;
                const bf16x8_t a0 = ak0, a1 = ak1;
                { const bf16* kn = kwave + (size_t)(128 * ((kt + 1 < ntiles) ? kt + 1 : kt)) * 64; ak0 = *(const bf16x8_t*)kn; ak1 = *(const bf16x8_t*)(kn + 32); }
#pragma unroll
                for (int qg = 0; qg < 2; ++qg) {
                    float sc[4] = {0.f, 0.f, 0.f, 0.f};
#pragma unroll
                    for (int h = 0; h < 8; ++h) {
                        f32x4_t a = (f32x4_t){0.f, 0.f, 0.f, 0.f};
                        a = __builtin_amdgcn_mfma_f32_16x16x32_bf16(a0, bqf[qg][h][0], a, 0, 0, 0);
                        a = __builtin_amdgcn_mfma_f32_16x16x32_bf16(a1, bqf[qg][h][1], a, 0, 0, 0);
                        const float wh = (h & 1) ? __uint_as_float(wvp[qg][h >> 1] & 0xffff0000u) : __uint_as_float(wvp[qg][h >> 1] << 16);
#pragma unroll
                        for (int i = 0; i < 4; ++i) { const float af_ = a[i]; sc[i] += wh * __int_as_float(max(__float_as_int(af_), 0)); asm("" : "+v"(sc[i])); }
                    }
                    const int qi = 16 * qg + fr, qpos = q0 + qi;
                    const unsigned th = qg ? th1 : th0;
                    unsigned keyv[4], slot[4]; bool prd[4];
#pragma unroll
                    for (int i = 0; i < 4; ++i) {
                        float s = sc[i]; if (s == 0.f) s = 0.f;
                        keyv[i] = f2ord(s);
                        prd[i] = (ABL != 1) && (k0 + 4 * fq + i <= qpos) && (keyv[i] > th);
                    }
#pragma unroll
                    for (int i = 0; i < 4; ++i) slot[i] = prd[i] ? __hip_atomic_fetch_add(cnt + qi, 1u, __ATOMIC_RELAXED, __HIP_MEMORY_SCOPE_WORKGROUP) : 0u;
#pragma unroll
                    for (int i = 0; i < 4; ++i) if (prd[i]) { keyb[qi * ICAP + slot[i]] = keyv[i]; idxb[qi * ICAP + slot[i]] = (unsigned short)(k0 + 4 * fq + i); }
                }
            }
            __syncthreads();
            if (!__any((int)cnt[lane & 31] < min(TOPK, q0 + (lane & 31) + 1))) break;
            }
#pragma unroll 1
            for (int qq = 0; qq < (ABL == 0 ? 4 : 0); ++qq) { const int q = 4 * wave + qq; index_final(keyb, idxb, cnt, q, lane); }
            if (ABL == 0) {
                __syncthreads();
                unsigned* dst = selbits + ((size_t)(b * (S / 32) + qb) * 128) * 64;
                for (int idx = tid; idx < 128 * 32; idx += NTHR) { const int kt = idx >> 5, qq = idx & 31;
                    uint2 w; w.x = keyb[qq * ICAP + 2 * kt]; w.y = keyb[qq * ICAP + 2 * kt + 1];
                    *(uint2*)(dst + (size_t)idx * 2) = w; }
            }
        }
    }
    __syncthreads();
}

constexpr int AQB = 256, AKT = 64, AROW = 144;
constexpr int LDS_AK = 0, LDS_AV = AKT * AROW, LDS_ABUF = 2 * AKT * AROW, LDS_ABLUT = 2 * LDS_ABUF;
__device__ __forceinline__ float max3_f(float a, float b, float c) { float r_; asm("v_max3_f32 %0, %1, %2, %3" : "=v"(r_) : "v"(a), "v"(b), "v"(c)); return r_; }
__device__ __forceinline__ float max2_f(float a, float b) { float r_; asm("v_max_f32 %0, %1, %2" : "=v"(r_) : "v"(a), "v"(b)); return r_; }
__device__ __forceinline__ float bfi_f(unsigned mask, unsigned a, unsigned b) { unsigned r_; asm("v_bfi_b32 %0, %1, %2, %3" : "=v"(r_) : "v"(mask), "v"(a), "v"(b)); return __uint_as_float(r_); }
template <bool NEAR> __device__ __forceinline__ void attn_tile(LAS unsigned char* buf, LAS float* blut, const bf16x8_t (&bq)[2][2], const uint2 cb0, const uint2 cb1, int qw, int k0, int fr, int fq,
                                                               const bf16x8_t ones, f32x4_t (&acc)[2][4], f32x4_t (&accl)[2], const float (&mref_)[2], float (&mlane)[2]) {
    const float cfar = blut[128];
    const unsigned ninf = 0xff800000u;
    bf16x8_t kf[4][2];
#pragma unroll
    for (int tile = 0; tile < 4; ++tile)
#pragma unroll
        for (int ks = 0; ks < 2; ++ks) kf[tile][ks] = *(const LAS bf16x8_t*)(buf + LDS_AK + (16 * tile + fr) * AROW + (8 * fq + 32 * ks) * 2);
    f32x4_t sx[2][4];
#pragma unroll
    for (int qg = 0; qg < 2; ++qg)
#pragma unroll
        for (int tile = 0; tile < 4; ++tile) { sx[qg][tile] = (f32x4_t){0.f, 0.f, 0.f, 0.f};
            sx[qg][tile] = __builtin_amdgcn_mfma_f32_16x16x32_bf16(kf[tile][0], bq[qg][0], sx[qg][tile], 0, 0, 0); sx[qg][tile] = __builtin_amdgcn_mfma_f32_16x16x32_bf16(kf[tile][1], bq[qg][1], sx[qg][tile], 0, 0, 0); }
    float x[2][16];
#pragma unroll
    for (int qg = 0; qg < 2; ++qg) {
        const uint2 cb = qg ? cb1 : cb0;
        const int dist0 = (qw + 16 * qg + fr) - (k0 + 4 * fq);
        const float mref = mref_[qg];
        const float cfm = cfar - mref;
#pragma unroll
        for (int tile = 0; tile < 4; ++tile) {
            const int nib = (int)(((tile & 2) ? cb.y : cb.x) >> (16 * (tile & 1) + 4 * fq));
#pragma unroll
            for (int i = 0; i < 4; ++i) {
                const unsigned t = (unsigned)__builtin_amdgcn_sbfe(nib, i, 1);
                float bias = cfm;
                if (NEAR) { int n = dist0 - (16 * tile + i); n = n < 0 ? 0 : (n > 128 ? 128 : n); bias = blut[n] - mref; }
                x[qg][4 * tile + i] = __builtin_fmaf(sx[qg][tile][i], 0.18033688011112042f, bfi_f(t, __float_as_uint(bias), ninf));
                asm("" : "+v"(x[qg][4 * tile + i]));
            }
        }
        mlane[qg] = max3_f(max3_f(max3_f(x[qg][0], x[qg][1], x[qg][2]), max3_f(x[qg][3], x[qg][4], x[qg][5]), x[qg][15]), max3_f(x[qg][6], x[qg][7], x[qg][8]), max3_f(max3_f(x[qg][9], x[qg][10], x[qg][11]), max3_f(x[qg][12], x[qg][13], x[qg][14]), mlane[qg]));
    }
#pragma unroll
    for (int blk = 0; blk < 2; ++blk) {
        bf16x8_t vf[4];
#pragma unroll
        for (int dt = 0; dt < 4; ++dt) vf[dt] = *(const LAS bf16x8_t*)(buf + LDS_AV + (16 * dt + fr) * AROW + (32 * blk + 8 * fq) * 2);
#pragma unroll
        for (int qg = 0; qg < 2; ++qg) {
            v4u t;
            t.x = pk2(__builtin_amdgcn_exp2f(x[qg][8 * blk + 0]), __builtin_amdgcn_exp2f(x[qg][8 * blk + 1])); t.y = pk2(__builtin_amdgcn_exp2f(x[qg][8 * blk + 2]), __builtin_amdgcn_exp2f(x[qg][8 * blk + 3]));
            t.z = pk2(__builtin_amdgcn_exp2f(x[qg][8 * blk + 4]), __builtin_amdgcn_exp2f(x[qg][8 * blk + 5])); t.w = pk2(__builtin_amdgcn_exp2f(x[qg][8 * blk + 6]), __builtin_amdgcn_exp2f(x[qg][8 * blk + 7]));
            const bf16x8_t pb = __builtin_bit_cast(bf16x8_t, t);
            accl[qg] = __builtin_amdgcn_mfma_f32_16x16x32_bf16(ones, pb, accl[qg], 0, 0, 0);
#pragma unroll
            for (int dt = 0; dt < 4; ++dt) acc[qg][dt] = __builtin_amdgcn_mfma_f32_16x16x32_bf16(vf[dt], pb, acc[qg][dt], 0, 0, 0);
        }
    }
}
__device__ __forceinline__ void ph_dsa_attn2(const Params& p, const bf16* proj, const bf16* KC, const bf16* VTa, const unsigned* selbits, bf16* ya, LAS unsigned char* lds) {
    const int tid = opaque_tid(), wave = __builtin_amdgcn_readfirstlane(tid >> 6), lane = tid & 63, fr = lane & 15, fq = lane >> 4;
    LAS float* blut = (LAS float*)(lds + LDS_ABLUT);
    LAS unsigned* aflag = (LAS unsigned*)(lds + LDS_ABLUT + 1024);
    constexpr int NQBA = S / AQB;
    const int ldr = tid >> 3, ldc = tid & 7;
    for (int pr = blockIdx.x; pr < NB * 8 * NQBA / 2; pr += gridDim.x) {
        const int bh = pr / (NQBA / 2), pp = pr % (NQBA / 2), b = bh >> 3, h = bh & 7;
        __syncthreads();
        if (tid <= 128) blut[tid] = p.rel_bias[(tid >= 128 ? 31 : t5_bucket(tid)) * 8 + h] * 1.4426950408889634f;
        const bf16* kg = KC + ((size_t)(b * 8 + h) * S + ldr) * 64 + 8 * ldc;
        const bf16* vg = VTa + ((size_t)(b * 8 + h) * (S / 32) * 64 + (ldc >> 2) * 64 + ldr) * 32 + 8 * (ldc & 3);
#pragma unroll 1
        for (int ui = 0; ui < 2; ++ui) {
            const int qb = ui ? pp : (NQBA - 1 - pp);
            const int q0 = qb * AQB, qw = q0 + 32 * wave;
            const int ntiles = (q0 + AQB) / AKT;
            bf16x8_t bq[2][2];
#pragma unroll
            for (int qg = 0; qg < 2; ++qg) { const bf16* qrow = proj + (size_t)(b * S + qw + 16 * qg + fr) * PW + OFF_QA + 64 * h + 8 * fq; bq[qg][0] = *(const bf16x8_t*)qrow; bq[qg][1] = *(const bf16x8_t*)(qrow + 32); }
            const unsigned* brow0 = selbits + ((size_t)(b * (S / 32) + (qw >> 5)) * 128) * 64 + 2 * fr;
            const unsigned* brow1 = brow0 + 32;
            f32x4_t acc[2][4], accl[2]; float mref[2] = {0.f, 0.f}, mlane[2];
            const bf16x8_t ones = __builtin_bit_cast(bf16x8_t, (v4u){0x3f803f80u, 0x3f803f80u, 0x3f803f80u, 0x3f803f80u});
#pragma unroll 1
            for (int pass = 0; pass < 2; ++pass) {
#pragma unroll
            for (int qg = 0; qg < 2; ++qg) { mlane[qg] = -INFINITY; accl[qg] = (f32x4_t){0.f, 0.f, 0.f, 0.f};
#pragma unroll
                for (int dt = 0; dt < 4; ++dt) acc[qg][dt] = (f32x4_t){0.f, 0.f, 0.f, 0.f}; }
            __syncthreads();
            if (tid == 0) aflag[0] = 0u;
            { const v4u kk = *(const v4u*)kg, vv = *(const v4u*)vg;
              *(LAS v4u*)(lds + LDS_AK + ldr * AROW + 16 * ldc) = kk; *(LAS v4u*)(lds + LDS_AV + ldr * AROW + 16 * ldc) = vv; }
            uint2 wb0 = *(const uint2*)brow0, wb1 = *(const uint2*)brow1;
            __syncthreads();
            const int nfar = min(ntiles, max(0, (qw - 191 + 64) >> 6));
            const int nact = min(ntiles, (qw + 31) / AKT + 1);
#define ATTN_TILE_LOOP(KT_BEGIN, KT_END, BODY) \
            _Pragma("unroll 1") for (int kt = (KT_BEGIN); kt < (KT_END); ++kt) { \
                const int k0 = kt * AKT; \
                LAS unsigned char* buf = lds + (kt & 1) * LDS_ABUF; \
                const int ktn = (kt + 1 < ntiles) ? kt + 1 : kt;             \
                const uint2 cb0 = wb0, cb1 = wb1; \
                const v4u nk = *(const v4u*)(kg + (size_t)(ktn * AKT) * 64), nvv = *(const v4u*)(vg + (size_t)(ktn * AKT / 32) * 2048); \
                wb0 = *(const uint2*)(brow0 + 64 * ktn); wb1 = *(const uint2*)(brow1 + 64 * ktn); \
                BODY \
                { LAS unsigned char* nb = lds + ((kt + 1) & 1) * LDS_ABUF; \
                    *(LAS v4u*)(nb + LDS_AK + ldr * AROW + 16 * ldc) = nk; *(LAS v4u*)(nb + LDS_AV + ldr * AROW + 16 * ldc) = nvv; } \
                asm volatile("s_waitcnt lgkmcnt(0)" ::: "memory"); __builtin_amdgcn_s_barrier(); asm volatile("" ::: "memory");     \
            }
            ATTN_TILE_LOOP(0, nfar, attn_tile<false>(buf, blut, bq, cb0, cb1, qw, k0, fr, fq, ones, acc, accl, mref, mlane);)
            ATTN_TILE_LOOP(nfar, nact, attn_tile<true>(buf, blut, bq, cb0, cb1, qw, k0, fr, fq, ones, acc, accl, mref, mlane);)
            ATTN_TILE_LOOP(nact, ntiles, (void)buf; (void)k0; (void)cb0; (void)cb1;)
#undef ATTN_TILE_LOOP
            if (pass == 1) break;
            float mq[2];
#pragma unroll
            for (int qg = 0; qg < 2; ++qg) { float m_ = mlane[qg]; m_ = fmaxf(m_, __shfl_xor(m_, 16)); mq[qg] = fmaxf(m_, __shfl_xor(m_, 32)); }
            const bool bad = (mq[0] > 60.f) || (mq[0] < -60.f && mq[0] > -INFINITY) || (mq[1] > 60.f) || (mq[1] < -60.f && mq[1] > -INFINITY);
            if (__any(bad) && lane == 0) aflag[0] = 1u;
            __syncthreads();
            if (aflag[0] == 0u) break;
            mref[0] = (mq[0] > -INFINITY) ? mq[0] : 0.f; mref[1] = (mq[1] > -INFINITY) ? mq[1] : 0.f;
            }
#pragma unroll
            for (int qg = 0; qg < 2; ++qg) {
                const float inv = 1.f / accl[qg][0];
#pragma unroll
                for (int dt = 0; dt < 4; ++dt) { uint2 o; o.x = pk2(acc[qg][dt][0] * inv, acc[qg][dt][1] * inv); o.y = pk2(acc[qg][dt][2] * inv, acc[qg][dt][3] * inv);
                    *(uint2*)(ya + (size_t)(b * S + qw + 16 * qg + fr) * 512 + 64 * h + 16 * dt + 4 * fq) = o; }
            }
        }
    }
    __syncthreads();
}

__global__ void __launch_bounds__(NTHR, 2) mega_fwd(Params p) {
    extern __shared__ __attribute__((aligned(16))) unsigned char lds[];
    float* sm = (float*)lds;
    LAS unsigned char* ldsl = (LAS unsigned char*)lds;
    volatile LAS unsigned* bst = (volatile LAS unsigned*)(ldsl + LDS_BYTES - 16);
    if (threadIdx.x == 0) { bst[0] = 0u; bst[1] = 0u; bst[2] = 0u; bst[3] = 0u; }
    __syncthreads();
    XcdBarrier bar = xcd_barrier_post((unsigned*)(p.ws + WS_BAR), bst);
    unsigned char* ws = p.ws;
    float* mod = (float*)(ws + WS_MOD);
    bf16* proj = (bf16*)(ws + WS_PROJ);
    bf16* G = (bf16*)(ws + WS_G);
    bf16* ya = (bf16*)(ws + WS_YA); bf16* yb = (bf16*)(ws + WS_YB);
    bf16* hn2 = (bf16*)(ws + WS_HN2); bf16* qh = (bf16*)(ws + WS_QH);
    bf16* hn = (bf16*)p.out;
    const int G_ = gridDim.x, c_ = blockIdx.x;

    ph_mod(p, mod, (float*)(lds + LDS_SC_OFF));
    ph_weights(p, ldsl);
    xcd_barrier(bar);
    ph_norm<true>(p.x, p.g1, mod, 0, 1, hn);
    xcd_barrier(bar);
    {
        pg8::Gemm g{hn, (const bf16*)(ws + WS_WIN), T, NPROJ, D, D, D}; pg8::StaticOrder So; So.init(T, NPROJ, G_, c_);
        pg8::EpiX<1> E{proj, G, nullptr, nullptr, nullptr, PW, 0, (bf16*)(ws + WS_KCA), (bf16*)(ws + WS_KCB), (bf16*)(ws + WS_KI), (bf16*)(ws + WS_WI)};
        pg8::gemm_phase<pg8::EpiX<1>, pg8::StaticOrder, true, true>(ldsl, g, So, E);
    }
    xcd_barrier(bar);
    unsigned* selbits = (unsigned*)((unsigned char*)p.out + 32 * MiB); bf16* VTa = (bf16*)p.out;
    ph_vt(proj, OFF_VB, (bf16*)(ws + WS_VT));
    ph_vt(proj, OFF_VA, VTa);
    ph_dsa_index<0>(proj, (const bf16*)(ws + WS_KI), (const bf16*)(ws + WS_WI), selbits, ldsl);
    xcd_barrier(bar);
    ph_dsa_attn2(p, proj, (const bf16*)(ws + WS_KCA), VTa, selbits, ya, ldsl);
    ph_stick2(proj, (const bf16*)(ws + WS_KCB), (const bf16*)(ws + WS_VT), yb);
    xcd_barrier(bar);
    {
        pg8::Gemm g{ya, (const bf16*)(ws + WS_WPA), T, D, 512, 512, 512}; pg8::StaticOrder So; So.init(T, D, G_, c_);
        pg8::EpiX<2> E{nullptr, G, nullptr, nullptr, nullptr, 0, 0, nullptr, nullptr, nullptr, nullptr};
        pg8::gemm_phase<pg8::EpiX<2>, pg8::StaticOrder, true, true>(ldsl, g, So, E);
    }
    {
        pg8::Gemm g{yb, (const bf16*)(ws + WS_WPB), T, D, 512, 512, 512}; pg8::StaticOrder So; So.init(T, D, G_, c_);
        pg8::EpiX<3> E{nullptr, G, nullptr, nullptr, nullptr, 0, 0, nullptr, nullptr, nullptr, nullptr};
        pg8::gemm_phase<pg8::EpiX<3>, pg8::StaticOrder, true, true>(ldsl, g, So, E);
    }
    xcd_barrier(bar);
    {
        pg8::Gemm g{G, (const bf16*)(ws + WS_WOUT), T, D, D, GW, D}; pg8::StaticOrder So; So.init(T, D, G_, c_);
        pg8::EpiX<4> E{nullptr, nullptr, p.x, mod + 2 * D, p.out, 0, 0, nullptr, nullptr, nullptr, nullptr};
        pg8::gemm_phase<pg8::EpiX<4>, pg8::StaticOrder, true, true>(ldsl, g, So, E);
    }
    xcd_barrier(bar);
    ph_norm<false>(p.out, p.g2, mod, 3, 4, hn2);
    ph_quant(p, ws + WS_TAB, (float*)(ws + WS_SCALES));
    xcd_barrier(bar);
    {
        pg8::Gemm g{hn2, (const bf16*)(ws + WS_WQ), T, 2048, D, D, D}; pg8::StaticOrder So; So.init(T, 2048, G_, c_);
        pg8::EpiX<0> E{qh, nullptr, nullptr, nullptr, nullptr, 2048, 0, nullptr, nullptr, nullptr, nullptr};
        pg8::gemm_phase<pg8::EpiX<0>, pg8::StaticOrder, true, true>(ldsl, g, So, E);
    }
    xcd_barrier(bar);
    ph_peer_select(qh, (const bf16*)(ws + WS_SKB), (unsigned short*)(ws + WS_EIDX), (float*)(ws + WS_GATE));
    xcd_barrier(bar);
    ph_peer_gather(p, hn2, (const unsigned short*)(ws + WS_EIDX), (const float*)(ws + WS_GATE), ws + WS_TAB, (const float*)(ws + WS_SCALES), mod, p.out, p.out);
}

extern "C" void kernel_launch(void* const* d_in, const int* in_sizes, int n_in, void* d_out, int out_size, void* d_ws, size_t ws_size, hipStream_t stream) {
    static int grid = 0;
    if (grid == 0) {
        if (n_in != 16 || out_size != T * D || ws_size < WS_NEED) { fprintf(stderr, "kernel_launch: unexpected shapes (n_in %d out %d ws %zu)\n", n_in, out_size, ws_size); grid = -1; return; }
        int dev = 0, cus = 0, per_cu = 0;
        if (hipGetDevice(&dev) != hipSuccess || hipDeviceGetAttribute(&cus, hipDeviceAttributeMultiprocessorCount, dev) != hipSuccess) { grid = -1; return; }
        if (hipFuncSetAttribute((const void*)mega_fwd, hipFuncAttributeMaxDynamicSharedMemorySize, LDS_BYTES) != hipSuccess) { fprintf(stderr, "kernel_launch: hipFuncSetAttribute failed\n"); grid = -1; return; }
        if (hipOccupancyMaxActiveBlocksPerMultiprocessor(&per_cu, (const void*)mega_fwd, NTHR, LDS_BYTES) != hipSuccess || per_cu < 1) { fprintf(stderr, "kernel_launch: occupancy query says %d\n", per_cu); per_cu = 1; }
        (void)hipGetLastError();
        grid = cus;
    }
    if (grid < 0) return;
    (void)hipMemsetAsync((char*)d_ws + WS_BAR, 0, CTL_ZERO_BYTES, stream);
    Params p; memset(&p, 0, sizeof(p));
    p.x = (const float*)d_in[0]; p.c = (const float*)d_in[1]; p.w_ada = (const float*)d_in[2]; p.b_ada = (const float*)d_in[3];
    p.g1 = (const float*)d_in[4]; p.g2 = (const float*)d_in[5]; p.w_in = (const float*)d_in[6]; p.rel_bias = (const float*)d_in[7];
    p.wpa = (const float*)d_in[8]; p.wpb = (const float*)d_in[9]; p.wout = (const float*)d_in[10]; p.wq = (const float*)d_in[11];
    p.sk = (const float*)d_in[12]; p.pu = (const float*)d_in[13]; p.pv = (const float*)d_in[14]; p.fg = (const float*)d_in[15];
    p.out = (float*)d_out; p.ws = (unsigned char*)d_ws;
    hipLaunchKernelGGL(mega_fwd, dim3(grid), dim3(NTHR), LDS_BYTES, stream, p);
}
```

```cpp
#include <hip/hip_runtime.h>
#include <stdint.h>
#include <math.h>
#include <string.h>
#include <stdio.h>

typedef unsigned short bf16;
constexpr int D = 1024, NB = 2, S = 8192, T = NB * S;
constexpr int INW = 5704;
constexpr int OFF_QA = 0, OFF_VA = 512, OFF_QI = 1024, OFF_QB = 1536, OFF_VB = 2048;
constexpr int PW = 2560;
constexpr int NPROJ = 3840 + 2048;
constexpr int GW = 2048;
constexpr int TOPK = 256;
constexpr float EPS = 1e-6f;
constexpr size_t MiB = 1u << 20;
constexpr int NTHR = 512, NWAVES = 8;
constexpr int LDS_BYTES = 147456;

#define LAS __attribute__((address_space(3)))

__device__ __forceinline__ bf16 f2bf(float f) { unsigned u = __float_as_uint(f); return (bf16)((u + 0x7fffu + ((u >> 16) & 1u)) >> 16); }
__device__ __forceinline__ float bf2f(bf16 h) { return __uint_as_float(((unsigned)h) << 16); }
typedef __bf16 bf16x2_hw __attribute__((ext_vector_type(2)));
__device__ __forceinline__ unsigned pk2(float lo, float hi) { bf16x2_hw v; v[0] = (__bf16)lo; v[1] = (__bf16)hi; return __builtin_bit_cast(unsigned, v); }

__device__ __forceinline__ float wave_sum(float v) {
#pragma unroll
    for (int o = 1; o < 64; o <<= 1) v += __shfl_xor(v, o);
    return v;
}
__device__ __forceinline__ float block_sum(float v, float* red) {
    v = wave_sum(v);
    __syncthreads();
    if ((threadIdx.x & 63) == 0) red[threadIdx.x >> 6] = v;
    __syncthreads();
    float s = 0.f;
#pragma unroll
    for (int i = 0; i < NWAVES; ++i) s += red[i];
    return s;
}
typedef float f32x4_t __attribute__((ext_vector_type(4)));
#define XB_TMO      128
#define XB_XCNT(j)  (256  + 64 * (j))
#define XB_XSUB(j)  (1280 + 64 * (j))
#define XB_XGEN(j)  (2304 + 64 * (j))
#define XB_TOP      3328
#define XB_TOPGEN   3392
#define XCD_BAR_WORDS 3456
#define XB_SPIN_CAP (1u << 22)

__device__ __forceinline__ unsigned xb_ld(unsigned* p)              { return __hip_atomic_load(p, __ATOMIC_RELAXED, __HIP_MEMORY_SCOPE_AGENT); }
__device__ __forceinline__ unsigned xb_add(unsigned* p, unsigned v) { return __hip_atomic_fetch_add(p, v, __ATOMIC_RELAXED, __HIP_MEMORY_SCOPE_AGENT); }
__device__ __forceinline__ unsigned xb_xcc_id() { return (unsigned)__builtin_amdgcn_s_getreg((3 << 11) | 20) & 0xFu; }
#define XB_SPIN(cond, bar) do { unsigned _sp = 0; while (cond) { __builtin_amdgcn_s_sleep(1); \
    if ((++_sp & 255u) == 0u) { if (xb_ld(&(bar)[XB_TMO])) break; if (_sp > XB_SPIN_CAP) { atomicAdd(&(bar)[XB_TMO], 1u); break; } } } } while (0)

struct XcdBarrier {
    unsigned* bar; unsigned x;
    volatile LAS unsigned* st;
};

__device__ __forceinline__ XcdBarrier xcd_barrier_post(unsigned* bar, volatile LAS unsigned* st) {
    XcdBarrier b; b.bar = bar; b.x = xb_xcc_id(); b.st = st;
    if (threadIdx.x == 0) (void)xb_add(&bar[XB_XCNT(b.x)], 1u);
    return b;
}
__device__ __forceinline__ void xcd_barrier_complete(unsigned* bar, unsigned x, unsigned& nloc, unsigned& nx) {
    const unsigned G = gridDim.x * gridDim.y * gridDim.z;
    unsigned sum, cnt, mine, sp = 0u;
    for (;;) {
        sum = 0u; cnt = 0u; mine = 0u;
#pragma unroll
        for (unsigned j = 0; j < 16; ++j) { const unsigned c = xb_ld(&bar[XB_XCNT(j)]); sum += c; cnt += (c > 0u) ? 1u : 0u; mine = (j == x) ? c : mine; }
        if (sum == G) break;
        __builtin_amdgcn_s_sleep(1);
        if ((++sp & 255u) == 0u) { if (xb_ld(&bar[XB_TMO])) break; if (sp > XB_SPIN_CAP) { atomicAdd(&bar[XB_TMO], 1u); break; } }
    }
    nloc = mine > 0u ? mine : 1u; nx = cnt > 0u ? cnt : 1u;
}

__device__ __forceinline__ void xcd_barrier(const XcdBarrier& b) {
    asm volatile("s_waitcnt vmcnt(0)" ::: "memory");
    __syncthreads();
    if (threadIdx.x == 0) {
        unsigned* bar = b.bar;
        __builtin_amdgcn_s_waitcnt(0);
        unsigned nloc = b.st[0], nx = b.st[1];
        if (nloc == 0u) { xcd_barrier_complete(bar, b.x, nloc, nx); b.st[0] = nloc; b.st[1] = nx; }
        const unsigned old = xb_add(&bar[XB_XSUB(b.x)], 1u);
        const unsigned gen = old / nloc;
        if (old + 1u == (gen + 1u) * nloc) {
            __builtin_amdgcn_fence(__ATOMIC_RELEASE, "agent");
            asm volatile("s_waitcnt vmcnt(0)" ::: "memory");
            const unsigned og = xb_add(&bar[XB_TOP], 1u);
            const unsigned tg = og / nx;
            if (og + 1u == (tg + 1u) * nx) xb_add(&bar[XB_TOPGEN], 1u);
            else XB_SPIN(xb_ld(&bar[XB_TOPGEN]) == tg, bar);
            __builtin_amdgcn_fence(__ATOMIC_ACQUIRE, "agent");
            xb_add(&bar[XB_XGEN(b.x)], 1u);
            asm volatile("s_waitcnt vmcnt(0)" ::: "memory");
        } else {
            XB_SPIN(xb_ld(&bar[XB_XGEN(b.x)]) == gen, bar);
            __builtin_amdgcn_fence(__ATOMIC_ACQUIRE, "agent");
            asm volatile("s_waitcnt vmcnt(0)" ::: "memory");
        }
    }
    __syncthreads();
}


namespace pg8 {
#define PG8_LAS __attribute__((address_space(3)))
typedef unsigned short bf16_t;
typedef short bf16x8 __attribute__((ext_vector_type(8)));
typedef float f32x4 __attribute__((ext_vector_type(4)));
typedef unsigned u32x4 __attribute__((ext_vector_type(4)));
constexpr int BM = 256, BK = 64, HALF = 128, HTB = HALF * BK * 2  , STAGE_BYTES = 8 * HTB, NXCD = 8, WGM = 8;

__host__ __device__ __forceinline__ int lds_byte(int r, int c) { const int st = (r >> 4) * 2 + (c >> 5), rr = r & 15, cc = c & 31, ob = rr * 64 + cc * 2; return st * 1024 + (ob ^ (((ob >> 9) & 1) << 5)); }
__host__ __device__ __forceinline__ void stage_rc(int b, int& R, int& C) { const int st = b / 1024, sb = b % 1024, swz = sb ^ (((sb >> 9) & 1) << 5); R = (st >> 1) * 16 + swz / 64; C = (st & 1) * 32 + (swz % 64) / 2; }
__host__ __device__ __forceinline__ int perm32(int rho) { const int n = rho >> 4, i = rho & 15; return 8 * (i >> 2) + 4 * n + (i & 3); }

struct Unit { int pm, pn; };
struct Gemm { const bf16_t* A; const bf16_t* Bt; int M, N, K, lda, ldb; };

struct StaticOrder {
    int nM, nN, nwg, G, c;
    __host__ __device__ void init(int M, int N, int G_, int c_) { nM = M / BM; nN = N / BM; nwg = nM * nN; G = G_; c = c_; }
    __host__ __device__ bool next(int i, Unit& u) const {
        const long L = (long)i * G + c; if (L >= nwg) return false;
        int wgid = (int)L; { const int q = nwg / NXCD, r = nwg % NXCD, xcd = wgid % NXCD, off = wgid / NXCD; wgid = (xcd < r ? xcd * (q + 1) : r * (q + 1) + (xcd - r) * q) + off; }
        const int nig = WGM * nN, gid = wgid / nig, fm = gid * WGM, gsz = (nM - fm) < WGM ? (nM - fm) : WGM;
        u.pm = fm + ((wgid % nig) % gsz); u.pn = (wgid % nig) / gsz; return true;
    }
    __device__ __forceinline__ void a_ready(const Unit&) const {}
    __device__ __forceinline__ void done(const Unit&) const {}
};
__device__ __forceinline__ unsigned cvt_pk_bf16(float lo, float hi) { return ::pk2(lo, hi); }
template <class Epi, class Sched, bool ALIGN_EPI = false, bool SP2 = false>
__device__ __forceinline__ void gemm_phase(PG8_LAS unsigned char* lds, const Gemm g, const Sched& S, const Epi& E) {
    int tid_ = threadIdx.x; asm volatile("" : "+v"(tid_));
    const int tid = tid_, wid = __builtin_amdgcn_readfirstlane(tid >> 6), lane = tid & 63, wr = wid >> 2, wc = wid & 3, fr = lane & 15, fq = lane >> 4;
    const int K = g.K, nt = K / BK;
    unsigned voffA[2], voffB[2];
#pragma unroll
    for (int i = 0; i < 2; ++i) { int R, C; stage_rc(tid * 16 + i * 8192, R, C); const int Rb = Epi::PERM ? ((R & ~31) + perm32(R & 31)) : R;
        voffA[i] = (unsigned)(R * g.lda + C) * 2u; voffB[i] = (unsigned)(Rb * g.ldb + C) * 2u; }
    const size_t kstep = (size_t)(BK * 2);
    const size_t hstepA = (size_t)HALF * g.lda * 2, hstepB = (size_t)HALF * g.ldb * 2;
    const size_t tstepA = 2 * hstepA, tstepB = 2 * hstepB;
    const unsigned ldsw = (unsigned)wid * 1024u;
    const int aoff = lds_byte(wr * 64 + fr, fq * 8), boff = lds_byte(wc * 32 + fr, fq * 8);
#define PG8_SA(b, h) (((b) * 2 + (h)) * HTB)
#define PG8_SB(b, h) ((4 + (b) * 2 + (h)) * HTB)
#define PG8_STAGE(bufoff, gbase, voff) do { _Pragma("unroll") for (int _i = 0; _i < 2; ++_i) \
        __builtin_amdgcn_global_load_lds((const unsigned*)((const char*)(gbase) + (voff)[_i]), (PG8_LAS unsigned*)(lds + (bufoff) + ldsw + _i * 8192), 16, 0, 0); } while (0)
#define PG8_LDA(dst, b, h) do { _Pragma("unroll") for (int m = 0; m < 4; ++m) _Pragma("unroll") for (int k = 0; k < 2; ++k) dst[m][k] = *(const PG8_LAS bf16x8*)(lds + PG8_SA(b, h) + aoff + m * 2048 + k * 1024); } while (0)
#define PG8_LDB(dst, b, h) do { _Pragma("unroll") for (int n = 0; n < 2; ++n) _Pragma("unroll") for (int k = 0; k < 2; ++k) dst[n][k] = *(const PG8_LAS bf16x8*)(lds + PG8_SB(b, h) + boff + n * 2048 + k * 1024); } while (0)
#define PG8_MMA(ai, bj, At, Bt) do { __builtin_amdgcn_s_setprio(1); _Pragma("unroll") for (int m = 0; m < 4; ++m) _Pragma("unroll") for (int n = 0; n < 2; ++n) _Pragma("unroll") for (int k = 0; k < 2; ++k) \
        acc[ai][bj][m][n] = __builtin_amdgcn_mfma_f32_16x16x32_bf16(Bt[n][k], At[m][k], acc[ai][bj][m][n], 0, 0, 0); __builtin_amdgcn_s_setprio(0); } while (0)
#define PG8_WAIT_V(n) asm volatile("s_waitcnt vmcnt(" #n ")" ::: "memory")
#define PG8_WAIT_L(n) asm volatile("s_waitcnt lgkmcnt(" #n ")" ::: "memory")
#define PG8_BAR __builtin_amdgcn_s_barrier()
#define PG8_SCHED __builtin_amdgcn_sched_barrier(0)
    Unit cur, nxt; int ui = 0;
    if (!S.next(0, cur)) return;
    f32x4 acc[2][2][4][2];
#pragma unroll
    for (int a = 0; a < 2; ++a)
#pragma unroll
        for (int b = 0; b < 2; ++b)
#pragma unroll
            for (int m = 0; m < 4; ++m)
#pragma unroll
                for (int n = 0; n < 2; ++n) acc[a][b][m][n] = (f32x4){0.f, 0.f, 0.f, 0.f};
    bf16x8 At[4][2], B0[2][2], B1[2][2];
    const char* cA = (const char*)g.A + (size_t)cur.pm * tstepA; const char* cB = (const char*)g.Bt + (size_t)cur.pn * tstepB;
    S.a_ready(cur);
    if constexpr (SP2) {
        PG8_STAGE(PG8_SB(0, 0), cB, voffB); PG8_STAGE(PG8_SB(0, 1), cB + hstepB, voffB); PG8_STAGE(PG8_SA(0, 0), cA, voffA); PG8_STAGE(PG8_SA(0, 1), cA + hstepA, voffA);
        if (wr == 1) PG8_BAR;
        PG8_WAIT_V(2); PG8_BAR;
        PG8_STAGE(PG8_SB(1, 0), cB + kstep, voffB); PG8_STAGE(PG8_SA(1, 0), cA + kstep, voffA); PG8_STAGE(PG8_SB(1, 1), cB + hstepB + kstep, voffB);
        PG8_WAIT_V(6); PG8_BAR;
    } else {
        PG8_STAGE(PG8_SB(0, 0), cB, voffB); PG8_STAGE(PG8_SA(0, 0), cA, voffA); PG8_STAGE(PG8_SB(0, 1), cB + hstepB, voffB); PG8_STAGE(PG8_SA(0, 1), cA + hstepA, voffA);
        if (wr == 1) PG8_BAR;
        PG8_WAIT_V(4); PG8_BAR;
        PG8_STAGE(PG8_SB(1, 0), cB + kstep, voffB); PG8_STAGE(PG8_SA(1, 0), cA + kstep, voffA); PG8_STAGE(PG8_SB(1, 1), cB + hstepB + kstep, voffB);
        PG8_WAIT_V(6); PG8_BAR;
    }
    for (;;) {
        const bool has_next = S.next(ui + 1, nxt);
        const char* nA = has_next ? (const char*)g.A + (size_t)nxt.pm * tstepA : cA; const char* nB = has_next ? (const char*)g.Bt + (size_t)nxt.pn * tstepB : cB;
        for (int t = 0; t < nt; t += 2) {
            const bool last = (t == nt - 2);
            const char* a1 = cA + (size_t)(t + 1) * kstep;
            const char* a2 = last ? nA : cA + (size_t)(t + 2) * kstep; const char* b2 = last ? nB : cB + (size_t)(t + 2) * kstep;
            const char* a3 = a2 + kstep; const char* b3 = b2 + kstep;
            if (last && has_next) S.a_ready(nxt);
            if constexpr (SP2) {
            PG8_LDB(B0, 0, 0); PG8_LDB(B1, 0, 1); PG8_SCHED; PG8_LDA(At, 0, 0); PG8_STAGE(PG8_SA(1, 1), a1 + hstepA, voffA);
            PG8_WAIT_V(8); PG8_WAIT_L(0); PG8_BAR; PG8_MMA(0, 0, At, B0); PG8_MMA(0, 1, At, B1); PG8_BAR; PG8_SCHED;
            PG8_LDA(At, 0, 1); PG8_STAGE(PG8_SB(0, 0), b2, voffB); PG8_STAGE(PG8_SB(0, 1), b2 + hstepB, voffB); PG8_STAGE(PG8_SA(0, 0), a2, voffA);
            PG8_WAIT_V(8); PG8_WAIT_L(0); PG8_BAR; PG8_MMA(1, 0, At, B0); PG8_MMA(1, 1, At, B1); PG8_BAR; PG8_SCHED;
            PG8_LDB(B0, 1, 0); PG8_LDB(B1, 1, 1); PG8_SCHED; PG8_LDA(At, 1, 0); PG8_STAGE(PG8_SA(0, 1), a2 + hstepA, voffA);
            PG8_WAIT_V(8); PG8_WAIT_L(0); PG8_BAR; PG8_MMA(0, 0, At, B0); PG8_MMA(0, 1, At, B1); PG8_BAR; PG8_SCHED;
            PG8_LDA(At, 1, 1); PG8_STAGE(PG8_SB(1, 0), b3, voffB); PG8_STAGE(PG8_SB(1, 1), b3 + hstepB, voffB); PG8_STAGE(PG8_SA(1, 0), a3, voffA);
            PG8_WAIT_V(8); PG8_WAIT_L(0); PG8_BAR; PG8_MMA(1, 0, At, B0); PG8_MMA(1, 1, At, B1); PG8_BAR; PG8_SCHED;
            } else {
            PG8_LDB(B0, 0, 0); PG8_SCHED; PG8_LDA(At, 0, 0); PG8_STAGE(PG8_SA(1, 1), a1 + hstepA, voffA);
            PG8_WAIT_L(8); PG8_BAR; PG8_WAIT_L(0); PG8_MMA(0, 0, At, B0); PG8_BAR; PG8_SCHED;
            PG8_LDB(B1, 0, 1); PG8_STAGE(PG8_SB(0, 0), b2, voffB);
            PG8_BAR; PG8_WAIT_L(0); PG8_MMA(0, 1, At, B1); PG8_BAR;
            PG8_LDA(At, 0, 1); PG8_STAGE(PG8_SA(0, 0), a2, voffA);
            PG8_BAR; PG8_WAIT_L(0); PG8_MMA(1, 0, At, B0); PG8_BAR; PG8_SCHED;
            PG8_STAGE(PG8_SB(0, 1), b2 + hstepB, voffB);
            PG8_WAIT_V(6); PG8_BAR; PG8_MMA(1, 1, At, B1); PG8_BAR;
            PG8_LDB(B0, 1, 0); PG8_SCHED; PG8_LDA(At, 1, 0); PG8_STAGE(PG8_SA(0, 1), a2 + hstepA, voffA);
            PG8_WAIT_L(8); PG8_BAR; PG8_WAIT_L(0); PG8_MMA(0, 0, At, B0); PG8_BAR; PG8_SCHED;
            PG8_LDB(B1, 1, 1); PG8_STAGE(PG8_SB(1, 0), b3, voffB);
            PG8_BAR; PG8_WAIT_L(0); PG8_MMA(0, 1, At, B1); PG8_BAR;
            PG8_LDA(At, 1, 1); PG8_STAGE(PG8_SA(1, 0), a3, voffA);
            PG8_BAR; PG8_WAIT_L(0); PG8_MMA(1, 0, At, B0); PG8_BAR; PG8_SCHED;
            PG8_STAGE(PG8_SB(1, 1), b3 + hstepB, voffB);
            PG8_WAIT_V(6); PG8_BAR; PG8_MMA(1, 1, At, B1); PG8_BAR;
            }
        }
        if constexpr (ALIGN_EPI) { if (wr == 0) PG8_BAR; }
        if constexpr (!Epi::AFTER_DRAIN) { E(acc, cur, wr, wc, fr, fq); S.done(cur); }
        if (!has_next) break;
#pragma unroll
        for (int a = 0; a < 2; ++a)
#pragma unroll
            for (int b = 0; b < 2; ++b)
#pragma unroll
                for (int m = 0; m < 4; ++m)
#pragma unroll
                    for (int n = 0; n < 2; ++n) acc[a][b][m][n] = (f32x4){0.f, 0.f, 0.f, 0.f};
        cur = nxt; cA = nA; cB = nB; ++ui;
        if constexpr (ALIGN_EPI) { if (wr == 1) PG8_BAR; }
    }
    PG8_WAIT_V(0);
    if constexpr (!ALIGN_EPI) { if (wr == 0) PG8_BAR; }
    PG8_BAR;
    if constexpr (Epi::AFTER_DRAIN) { E.fused(acc, cur, wr, wc, fr, fq, lds, wid, lane); S.done(cur); }
#undef PG8_SA
#undef PG8_SB
#undef PG8_STAGE
#undef PG8_LDA
#undef PG8_LDB
#undef PG8_MMA
#undef PG8_WAIT_V
#undef PG8_WAIT_L
#undef PG8_BAR
#undef PG8_SCHED
}
}

namespace pg8 {
__device__ __forceinline__ float sigmoidf_(float v) { return 1.f / (1.f + __expf(-v)); }
__device__ __forceinline__ void unpack8(const u32x4 w, float (&f)[8]) {
    f[0] = __uint_as_float(w.x << 16); f[1] = __uint_as_float(w.x & 0xffff0000u); f[2] = __uint_as_float(w.y << 16); f[3] = __uint_as_float(w.y & 0xffff0000u);
    f[4] = __uint_as_float(w.z << 16); f[5] = __uint_as_float(w.z & 0xffff0000u); f[6] = __uint_as_float(w.w << 16); f[7] = __uint_as_float(w.w & 0xffff0000u);
}
template <int MODE> struct EpiX {
    static constexpr bool PERM = true, AFTER_DRAIN = false;
    bf16_t* O; bf16_t* G; const float* xres; const float* gate; float* outf; int ldc; int pad; bf16_t* KCa; bf16_t* KCb; bf16_t* KI; bf16_t* WI;
    __device__ __forceinline__ void operator()(const f32x4 (&acc)[2][2][4][2], const Unit& u, int wr, int wc, int fr, int fq) const {
        const int row0 = u.pm * BM + wr * 64 + fr;
        int colt = u.pn * BM; bf16_t* base = O; int ld = ldc; bool sig = false;
        if (MODE == 1) { if (u.pn >= 15) { colt -= 15 * BM; base = G; ld = GW; sig = true; }
            else if (u.pn >= 10) {
#pragma unroll
                for (int ai = 0; ai < 2; ++ai)
#pragma unroll
                    for (int m = 0; m < 4; ++m) {
                        const int row = row0 + ai * HALF + m * 16, bb = row / S, ss = row % S;
#pragma unroll
                        for (int bj = 0; bj < 2; ++bj) {
                            const int c = wc * 32 + 8 * fq + bj * HALF;
                            const f32x4 v0 = acc[ai][bj][m][0], v1 = acc[ai][bj][m][1];
                            u32x4 w; w.x = cvt_pk_bf16(v0[0], v0[1]); w.y = cvt_pk_bf16(v0[2], v0[3]); w.z = cvt_pk_bf16(v1[0], v1[1]); w.w = cvt_pk_bf16(v1[2], v1[3]);
                            if (u.pn < 14) { const int cc = ((u.pn - 10) & 1) * BM + c; bf16_t* kc = (u.pn < 12) ? KCa : KCb;
                                *(u32x4*)(kc + ((size_t)(bb * 8 + (cc >> 6)) * S + ss) * 64 + (cc & 63)) = w; }
                            else if (c < 64) *(u32x4*)(KI + (size_t)row * 64 + c) = w;
                            else if (c == 64) *(u32x4*)(WI + (size_t)row * 8) = w;
                        }
                    }
                return;
            } }
        if (MODE == 2 || MODE == 3) { base = G; ld = GW; }
        const int col0 = colt + wc * 32 + 8 * fq;
#pragma unroll
        for (int ai = 0; ai < 2; ++ai)
#pragma unroll
            for (int m = 0; m < 4; ++m) {
                const int row = row0 + ai * HALF + m * 16;
#pragma unroll
                for (int bj = 0; bj < 2; ++bj) {
                    const int col = col0 + bj * HALF;
                    f32x4 v0 = acc[ai][bj][m][0], v1 = acc[ai][bj][m][1];
                    if (MODE == 4) {
                        const size_t o = (size_t)row * 1024 + col;
                        const f32x4 x0 = __builtin_nontemporal_load((const f32x4*)(xres + o)), x1 = __builtin_nontemporal_load((const f32x4*)(xres + o + 4));
                        const float* gp = gate + (row / S) * 6144 + col;
                        const f32x4 g0 = *(const f32x4*)gp, g1 = *(const f32x4*)(gp + 4);
                        *(f32x4*)(outf + o) = x0 + g0 * v0; *(f32x4*)(outf + o + 4) = x1 + g1 * v1;
                    } else {
                        bf16_t* pp = base + (size_t)row * ld + col;
                        if (MODE == 1) { if (sig) {
#pragma unroll
                            for (int e = 0; e < 4; ++e) { v0[e] = sigmoidf_(v0[e]); v1[e] = sigmoidf_(v1[e]); } } }
                        if (MODE == 2) { float t[8]; unpack8(*(const u32x4*)pp, t);
#pragma unroll
                            for (int e = 0; e < 4; ++e) { v0[e] *= t[e]; v1[e] *= t[4 + e]; } }
                        if (MODE == 3) { float t[8], gg[8]; unpack8(*(const u32x4*)pp, t); unpack8(*(const u32x4*)(pp + 1024), gg);
#pragma unroll
                            for (int e = 0; e < 4; ++e) { v0[e] = t[e] + gg[e] * v0[e]; v1[e] = t[4 + e] + gg[4 + e] * v1[e]; } }
                        u32x4 w; w.x = cvt_pk_bf16(v0[0], v0[1]); w.y = cvt_pk_bf16(v0[2], v0[3]); w.z = cvt_pk_bf16(v1[0], v1[1]); w.w = cvt_pk_bf16(v1[2], v1[3]);
                        *(u32x4*)pp = w;
                    }
                }
            }
    }
};
}
struct Params {
    const float *x, *c, *w_ada, *b_ada, *g1, *g2, *w_in, *rel_bias, *wpa, *wpb, *wout, *wq, *sk, *pu, *pv, *fg;
    float* out; unsigned char* ws;
};
__device__ __forceinline__ int opaque_tid() { int t = threadIdx.x; asm volatile("" : "+v"(t)); return t; }
typedef unsigned v4u __attribute__((ext_vector_type(4)));
#define LDS_WAIT() asm volatile("s_waitcnt lgkmcnt(0)" ::: "memory")

constexpr size_t WS_BAR = 0;
constexpr size_t CTL_ZERO_BYTES = 16384;
constexpr size_t WS_MOD = 64 * 1024;
constexpr size_t WS_WIN = 1 * MiB;
constexpr size_t WS_WPA = 13 * MiB, WS_WPB = 14 * MiB;
constexpr size_t WS_WOUT = 15 * MiB;
constexpr size_t WS_WQ = 17 * MiB;
constexpr size_t WS_PROJ = 22 * MiB;
constexpr size_t WS_KCA = 102 * MiB, WS_KCB = 118 * MiB;
constexpr size_t WS_KI = 134 * MiB, WS_WI = 136 * MiB;
constexpr size_t WS_G = 142 * MiB;
constexpr size_t WS_YA = 206 * MiB, WS_YB = 222 * MiB;
constexpr size_t WS_HN2 = 22 * MiB;
constexpr size_t WS_QH = 54 * MiB;
constexpr size_t WS_SKB = 21 * MiB;
constexpr size_t WS_EIDX = 118 * MiB;
constexpr size_t WS_GATE = 122 * MiB;
constexpr size_t WS_TAB = 130 * MiB;
constexpr size_t WS_SCALES = 162 * MiB;
constexpr size_t WS_VT = 238 * MiB;
constexpr size_t WS_NEED = 254 * MiB;
constexpr int LDS_SC_OFF = 7 * 16384 + 8448;

__device__ __forceinline__ void ph_mod(const Params& p, float* mod, float* sc) {
    float* part = sc + 2048;
    const int tid = threadIdx.x, kk = tid >> 3, cc = tid & 7;
    for (int i = tid; i < 2048; i += NTHR) { float v = p.c[i]; sc[i] = v / (1.f + expf(-v)); }
    __syncthreads();
    for (int unit = blockIdx.x; unit < 6144 / 24; unit += gridDim.x) {
        const int col = unit * 24 + 3 * cc;
        float a[2][3] = {{0.f, 0.f, 0.f}, {0.f, 0.f, 0.f}};
#pragma unroll 4
        for (int k = kk; k < 1024; k += 64) {
            const float* w = p.w_ada + (size_t)k * 6144 + col;
            const float w0 = __builtin_nontemporal_load(w), w1 = __builtin_nontemporal_load(w + 1), w2 = __builtin_nontemporal_load(w + 2), s0 = sc[k], s1 = sc[1024 + k];
            a[0][0] += s0 * w0; a[0][1] += s0 * w1; a[0][2] += s0 * w2; a[1][0] += s1 * w0; a[1][1] += s1 * w1; a[1][2] += s1 * w2;
        }
#pragma unroll
        for (int b = 0; b < 2; ++b)
#pragma unroll
            for (int j = 0; j < 3; ++j) part[kk * 48 + b * 24 + 3 * cc + j] = a[b][j];
        __syncthreads();
        if (tid < 48) { float s = 0.f; for (int q = 0; q < 64; ++q) s += part[q * 48 + tid]; const int b = tid / 24, j = unit * 24 + tid % 24; mod[b * 6144 + j] = s + p.b_ada[j]; }
        __syncthreads();
    }
}

template <class CM> __device__ __forceinline__ void transpose_item(const float* W, int ldw, int K, bf16* WT, LAS float* scr, int item, int nblk, int lane, const CM& cm) {
    const int kb = item / nblk, nb = item % nblk, k0 = 64 * kb, n0 = 32 * nb;
    const int sc = cm(n0 + (lane & 31));
#pragma unroll 8
    for (int i = 0; i < 32; ++i) { const int kk = 2 * i + (lane >> 5); scr[kk * 33 + (lane & 31)] = (sc >= 0) ? __builtin_nontemporal_load(W + (size_t)(k0 + kk) * ldw + sc) : 0.f; }
    LDS_WAIT(); asm volatile("" ::: "memory");
    const int c = lane & 7;
#pragma unroll
    for (int j = 0; j < 4; ++j) { const int n = (lane >> 3) + 8 * j; const LAS float* s = scr + (8 * c) * 33 + n;
        v4u o; o.x = pk2(s[0 * 33], s[1 * 33]); o.y = pk2(s[2 * 33], s[3 * 33]); o.z = pk2(s[4 * 33], s[5 * 33]); o.w = pk2(s[6 * 33], s[7 * 33]);
        *(v4u*)(WT + (size_t)(n0 + n) * K + k0 + 8 * c) = o; }
    LDS_WAIT(); asm volatile("" ::: "memory");
}
struct CmIdent { __device__ __forceinline__ int operator()(int n) const { return n; } };
struct CmWin {
    __device__ __forceinline__ int operator()(int n) const {
        if (n < 512) return n;
        if (n < 1024) return 1024 + (n - 512);
        if (n < 1536) return 1536 + (n - 1024);
        if (n < 2048) return 2120 + (n - 1536);
        if (n < 2560) return 3144 + (n - 2048);
        if (n < 3072) return 512 + (n - 2560);
        if (n < 3584) return 2632 + (n - 3072);
        if (n < 3648) return 2048 + (n - 3584);
        if (n < 3656) return 2112 + (n - 3648);
        if (n < 3840) return -1;
        return 3656 + (n - 3840);
    }
};
__device__ __forceinline__ void ph_weights(const Params& p, LAS unsigned char* lds) {
    unsigned char* ws = p.ws;
    const int wave = __builtin_amdgcn_readfirstlane(threadIdx.x >> 6), lane = threadIdx.x & 63;
    LAS float* scr = (LAS float*)(lds + wave * 16384);
    const int gw = blockIdx.x * NWAVES + wave, NGW = gridDim.x * NWAVES;
    constexpr int I_IN = 16 * (NPROJ / 32), I_PA = 8 * 32, I_PB = 8 * 32, I_OUT = 16 * 32, I_Q = 16 * 64;
    constexpr int NITEMS = I_IN + I_PA + I_PB + I_OUT + I_Q;
    for (int it = gw; it < NITEMS; it += NGW) {
        int r = it;
        if (r < I_IN) { transpose_item(p.w_in, INW, 1024, (bf16*)(ws + WS_WIN), scr, r, NPROJ / 32, lane, CmWin()); continue; } r -= I_IN;
        if (r < I_PA) { transpose_item(p.wpa, 1024, 512, (bf16*)(ws + WS_WPA), scr, r, 32, lane, CmIdent()); continue; } r -= I_PA;
        if (r < I_PB) { transpose_item(p.wpb, 1024, 512, (bf16*)(ws + WS_WPB), scr, r, 32, lane, CmIdent()); continue; } r -= I_PB;
        if (r < I_OUT) { transpose_item(p.wout, 1024, 1024, (bf16*)(ws + WS_WOUT), scr, r, 32, lane, CmIdent()); continue; } r -= I_OUT;
        transpose_item(p.wq, 2048, 1024, (bf16*)(ws + WS_WQ), scr, r, 64, lane, CmIdent());
    }
    for (int i = gw * 64 + lane; i < 8 * 2 * 128 * 128 / 4; i += NGW * 64) {
        const float4 v = ((const float4*)p.sk)[i]; uint2 w; w.x = pk2(v.x, v.y); w.y = pk2(v.z, v.w); ((uint2*)(ws + WS_SKB))[i] = w;
    }
}

template <bool NT> __device__ __forceinline__ void ph_norm(const float* src, const float* g, const float* mod, int shift_i, int scale_i, bf16* dst) {
    const int lane = threadIdx.x & 63, gw = blockIdx.x * NWAVES + __builtin_amdgcn_readfirstlane(threadIdx.x >> 6), ngw = gridDim.x * NWAVES;
    for (int t = gw; t < T; t += ngw) {
        const int b = t / S;
        float4 v[4]; float ss = 0.f;
#pragma unroll
        for (int i = 0; i < 4; ++i) { const f32x4_t t_ = NT ? __builtin_nontemporal_load((const f32x4_t*)(src + (size_t)t * D) + lane + 64 * i) : *((const f32x4_t*)(src + (size_t)t * D) + lane + 64 * i); v[i] = make_float4(t_.x, t_.y, t_.z, t_.w); ss += v[i].x * v[i].x + v[i].y * v[i].y + v[i].z * v[i].z + v[i].w * v[i].w; }
        ss = wave_sum(ss);
        const float r = rsqrtf(ss * (1.f / D) + EPS);
#pragma unroll
        for (int i = 0; i < 4; ++i) {
            const float4 gg = ((const float4*)g)[lane + 64 * i];
            const float4 sh = ((const float4*)(mod + b * 6144 + shift_i * D))[lane + 64 * i];
            const float4 sc = ((const float4*)(mod + b * 6144 + scale_i * D))[lane + 64 * i];
            float4 o;
            o.x = v[i].x * r * gg.x * (1.f + sc.x) + sh.x; o.y = v[i].y * r * gg.y * (1.f + sc.y) + sh.y;
            o.z = v[i].z * r * gg.z * (1.f + sc.z) + sh.z; o.w = v[i].w * r * gg.w * (1.f + sc.w) + sh.w;
            uint2 w; w.x = pk2(o.x, o.y); w.y = pk2(o.z, o.w);
            ((uint2*)(dst + (size_t)t * D))[lane + 64 * i] = w;
        }
    }
}
__device__ __forceinline__ unsigned f2ord(float f) { unsigned u = __float_as_uint(f); return (u & 0x80000000u) ? ~u : (u | 0x80000000u); }
__device__ __forceinline__ int t5_bucket(int n) {
    if (n < 16) return n;
    int large = 16 + (int)(logf((float)n * (1.f / 16.f)) / 2.0794415416798357f * 16.f);
    return large < 31 ? large : 31;
}

typedef short bf16x8_t __attribute__((ext_vector_type(8)));
template <int CTRL> __device__ __forceinline__ unsigned dppu(unsigned x) { return (unsigned)__builtin_amdgcn_mov_dpp((int)x, CTRL, 0xf, 0xf, true); }
template <int CTRL> __device__ __forceinline__ float dppf(float x) { return __builtin_bit_cast(float, __builtin_amdgcn_mov_dpp(__builtin_bit_cast(int, x), CTRL, 0xf, 0xf, true)); }
__device__ __forceinline__ unsigned row_max_u(unsigned x) { x = max(x, dppu<0xB1>(x)); x = max(x, dppu<0x4E>(x)); x = max(x, dppu<0x141>(x)); x = max(x, dppu<0x128>(x)); return x; }
__device__ __forceinline__ float row_max_f(float x) { x = fmaxf(x, dppf<0xB1>(x)); x = fmaxf(x, dppf<0x4E>(x)); x = fmaxf(x, dppf<0x141>(x)); x = fmaxf(x, dppf<0x128>(x)); return x; }
__device__ __forceinline__ float row_sum_f(float x) { x += dppf<0xB1>(x); x += dppf<0x4E>(x); x += dppf<0x141>(x); x += dppf<0x128>(x); return x; }
__device__ __forceinline__ float ord2f(unsigned k) { return __uint_as_float((k & 0x80000000u) ? (k & 0x7fffffffu) : ~k); }
__device__ __forceinline__ unsigned max3u(unsigned a, unsigned b, unsigned c) { return max(max(a, b), c); }

__device__ __forceinline__ void ph_quant(const Params& p, unsigned char* tab, float* scales) {
    const int lane = threadIdx.x & 63, gw = blockIdx.x * NWAVES + __builtin_amdgcn_readfirstlane(threadIdx.x >> 6), ngw = gridDim.x * NWAVES;
    for (int r = gw; r < 32768; r += ngw) {
        const float* src = (r < 16384) ? p.pu + (size_t)r * D : p.pv + (size_t)(r - 16384) * D;
        float4 v[4]; float am = 0.f;
#pragma unroll
        for (int i = 0; i < 4; ++i) { const f32x4_t t_ = __builtin_nontemporal_load((const f32x4_t*)src + lane + 64 * i); v[i] = make_float4(t_.x, t_.y, t_.z, t_.w);     am = fmaxf(am, fmaxf(fmaxf(fabsf(v[i].x), fabsf(v[i].y)), fmaxf(fabsf(v[i].z), fabsf(v[i].w)))); }
#pragma unroll
        for (int o = 1; o < 64; o <<= 1) am = fmaxf(am, __shfl_xor(am, o));
        const float inv = am > 0.f ? 127.f / am : 0.f;
        uint4 w; unsigned* wp = (unsigned*)&w;
#pragma unroll
        for (int i = 0; i < 4; ++i) {
            const int q0 = (int)rintf(v[i].x * inv) + 128, q1 = (int)rintf(v[i].y * inv) + 128, q2 = (int)rintf(v[i].z * inv) + 128, q3 = (int)rintf(v[i].w * inv) + 128;
            wp[i] = (unsigned)q0 | ((unsigned)q1 << 8) | ((unsigned)q2 << 16) | ((unsigned)q3 << 24);
        }
        ((uint4*)(tab + (size_t)r * 1024))[lane] = w;
        if (lane == 0) scales[r] = am * (1.f / 127.f);
    }
}

#define CE_DESC(x, y) do { const unsigned hi_ = max(x, y), lo_ = min(x, y); x = hi_; y = lo_; } while (0)
__device__ __forceinline__ int hull_ab(int c) {
    int a = 0, base = 0; bool done = false;
#pragma unroll
    for (int aa = 0; aa < 16; ++aa) { const int nb = 16 / (aa + 1); if (!done) { if (c >= base + nb) { base += nb; a = aa + 1; } else done = true; } }
    return (c < 50) ? ((a << 4) | (c - base)) : -1;
}
__device__ __forceinline__ void ph_peer_select(const bf16* qh, const bf16* skb, unsigned short* eidx, float* gate) {
    const int tid = opaque_tid();
    const int lane = tid & 63, fr = lane & 15, fq = lane >> 4;
    const int gw = blockIdx.x * NWAVES + __builtin_amdgcn_readfirstlane(tid >> 6), ngw = gridDim.x * NWAVES;
    int hab[4];
#pragma unroll
    for (int s = 0; s < 4; ++s) hab[s] = hull_ab(16 * s + fr);
    for (int unit = gw; unit < (T / 16) * 2; unit += ngw) {
        const int t0 = (unit >> 1) * 16, hh = unit & 1;
#pragma unroll 1
        for (int hi = 0; hi < 4; ++hi) {
            const int h = hh * 4 + hi;
            unsigned win[2][4];
#pragma unroll
            for (int c = 0; c < 2; ++c) {
                f32x4_t acc[8];
#pragma unroll
                for (int nt = 0; nt < 8; ++nt) acc[nt] = (f32x4_t){0.f, 0.f, 0.f, 0.f};
                const bf16* qrow = qh + (size_t)(t0 + fr) * 2048 + h * 256 + c * 128 + 8 * fq;
                bf16x8_t a[4];
#pragma unroll
                for (int ks = 0; ks < 4; ++ks) a[ks] = *(const bf16x8_t*)(qrow + 32 * ks);
                const bf16* kb = skb + ((size_t)(h * 2 + c) * 128 + fr) * 128 + 8 * fq;
#pragma unroll
                for (int nt = 0; nt < 8; ++nt)
#pragma unroll
                    for (int ks = 0; ks < 4; ++ks) { const bf16x8_t b = *(const bf16x8_t*)(kb + (size_t)nt * 16 * 128 + 32 * ks); acc[nt] = __builtin_amdgcn_mfma_f32_16x16x32_bf16(a[ks], b, acc[nt], 0, 0, 0); }
                unsigned pk[8][4];
#pragma unroll
                for (int nt = 0; nt < 8; ++nt)
#pragma unroll
                    for (int i = 0; i < 4; ++i) pk[nt][i] = (f2ord(acc[nt][i]) & ~127u) | (127u - (unsigned)(16 * nt + fr));
#pragma unroll
                for (int i = 0; i < 4; ++i) {
                    CE_DESC(pk[0][i], pk[1][i]); CE_DESC(pk[2][i], pk[3][i]); CE_DESC(pk[4][i], pk[5][i]); CE_DESC(pk[6][i], pk[7][i]);
                    CE_DESC(pk[0][i], pk[2][i]); CE_DESC(pk[1][i], pk[3][i]); CE_DESC(pk[4][i], pk[6][i]); CE_DESC(pk[5][i], pk[7][i]);
                    CE_DESC(pk[1][i], pk[2][i]); CE_DESC(pk[5][i], pk[6][i]);
                    CE_DESC(pk[0][i], pk[4][i]); CE_DESC(pk[1][i], pk[5][i]); CE_DESC(pk[2][i], pk[6][i]); CE_DESC(pk[3][i], pk[7][i]);
                    CE_DESC(pk[2][i], pk[4][i]); CE_DESC(pk[3][i], pk[5][i]);
                    CE_DESC(pk[1][i], pk[2][i]); CE_DESC(pk[3][i], pk[4][i]); CE_DESC(pk[5][i], pk[6][i]);
                }
#pragma unroll
                for (int r = 0; r < 16; ++r)
#pragma unroll
                    for (int i = 0; i < 4; ++i) {
                        const unsigned m = row_max_u(pk[0][i]);
                        if (fr == r) win[c][i] = m;
                        const bool w = pk[0][i] == m;
#pragma unroll
                        for (int nt = 0; nt < 7; ++nt) pk[nt][i] = w ? pk[nt + 1][i] : pk[nt][i];
                        pk[7][i] = w ? 0u : pk[7][i];
                    }
            }
#pragma unroll
            for (int i = 0; i < 4; ++i) {
                unsigned ck[4];
#pragma unroll
                for (int s = 0; s < 4; ++s) {
                    const int ab = hab[s] < 0 ? 0 : hab[s];
                    const unsigned wa = (unsigned)__shfl((int)win[0][i], (lane & 48) + (ab >> 4)), wb = (unsigned)__shfl((int)win[1][i], (lane & 48) + (ab & 15));
                    const float v = ord2f(wa & ~127u) + ord2f(wb & ~127u);
                    ck[s] = hab[s] < 0 ? 0u : ((f2ord(v) & ~255u) | (255u - (unsigned)ab));
                }
                unsigned mywin = 0u;
#pragma unroll
                for (int r = 0; r < 16; ++r) {
                    unsigned m = max(max(ck[0], ck[1]), max(ck[2], ck[3]));
                    m = row_max_u(m);
                    if (fr == r) mywin = m;
#pragma unroll
                    for (int s = 0; s < 4; ++s) ck[s] = (ck[s] == m) ? 0u : ck[s];
                }
                const unsigned ci = 255u - (mywin & 255u);
                const unsigned w0 = (unsigned)__shfl((int)win[0][i], (lane & 48) + (int)(ci >> 4)), w1 = (unsigned)__shfl((int)win[1][i], (lane & 48) + (int)(ci & 15u));
                const int e = (int)(127u - (w0 & 127u)) * 128 + (int)(127u - (w1 & 127u));
                const float s = ord2f(w0 & ~127u) + ord2f(w1 & ~127u);
                const float mx = row_max_f(s);
                const float ex = __expf(s - mx);
                const float sum = row_sum_f(ex);
                const int t = t0 + 4 * fq + i;
                eidx[(size_t)t * 128 + h * 16 + fr] = (unsigned short)e;
                gate[(size_t)t * 128 + h * 16 + fr] = ex / sum;
            }
        }
    }
}

__device__ __forceinline__ float wave_total_dpp(float x) {
    x = row_sum_f(x);
    return __builtin_bit_cast(float, __builtin_amdgcn_readlane(__builtin_bit_cast(int, x), 0)) + __builtin_bit_cast(float, __builtin_amdgcn_readlane(__builtin_bit_cast(int, x), 16)) +
           __builtin_bit_cast(float, __builtin_amdgcn_readlane(__builtin_bit_cast(int, x), 32)) + __builtin_bit_cast(float, __builtin_amdgcn_readlane(__builtin_bit_cast(int, x), 48));
}
__device__ __forceinline__ float gelu_erf(float x) { return 0.5f * x * (1.f + erff(x * 0.70710678118654752f)); }
__device__ __forceinline__ void ph_peer_gather(const Params& p, const bf16* hn2, const unsigned short* eidx, const float* gate, const unsigned char* tab, const float* scales, const float* mod, const float* xin, float* xout) {
    const int tid = opaque_tid();
    const int lane = tid & 63, gw = blockIdx.x * NWAVES + __builtin_amdgcn_readfirstlane(tid >> 6), ngw = gridDim.x * NWAVES;
    const unsigned char* utab = tab; const unsigned char* vtab = tab + (size_t)16384 * 1024;
    for (int t = gw; t < T; t += ngw) {
        const int b = t / S;
        float hv[16]; float hs = 0.f;
#pragma unroll
        for (int i = 0; i < 4; ++i) { const uint2 w = ((const uint2*)(hn2 + (size_t)t * D))[lane + 64 * i];
            hv[4 * i + 0] = __uint_as_float(w.x << 16); hv[4 * i + 1] = __uint_as_float(w.x & 0xffff0000u); hv[4 * i + 2] = __uint_as_float(w.y << 16); hv[4 * i + 3] = __uint_as_float(w.y & 0xffff0000u);
            hs += (hv[4 * i] + hv[4 * i + 1]) + (hv[4 * i + 2] + hv[4 * i + 3]); }
        hs = wave_total_dpp(hs);
        const int e0 = eidx[(size_t)t * 128 + lane], e1 = eidx[(size_t)t * 128 + 64 + lane];
        const float g0 = gate[(size_t)t * 128 + lane], g1 = gate[(size_t)t * 128 + 64 + lane];
        float pre0 = 0.f, pre1 = 0.f;
#pragma unroll
        for (int half = 0; half < 2; ++half) {
            const int ev = half ? e1 : e0;
            float pre = 0.f;
#pragma unroll 8
            for (int j = 0; j < 64; ++j) {
                const int e = __builtin_amdgcn_readlane(ev, j);
                const uint4 w = ((const uint4*)(utab + (size_t)e * 1024))[lane];
                const unsigned ww[4] = {w.x, w.y, w.z, w.w};
                float d = 0.f;
#pragma unroll
                for (int i = 0; i < 4; ++i) {
                    d += hv[4 * i + 0] * (float)(ww[i] & 0xffu); d += hv[4 * i + 1] * (float)((ww[i] >> 8) & 0xffu);
                    d += hv[4 * i + 2] * (float)((ww[i] >> 16) & 0xffu); d += hv[4 * i + 3] * (float)(ww[i] >> 24);
                }
                d = wave_total_dpp(d);
                pre = (lane == j) ? d : pre;
            }
            if (half) pre1 = pre; else pre0 = pre;
        }
        const float c0 = g0 * gelu_erf(scales[e0] * (pre0 - 128.f * hs)) * scales[16384 + e0];
        const float c1 = g1 * gelu_erf(scales[e1] * (pre1 - 128.f * hs)) * scales[16384 + e1];
        const float corr = 128.f * wave_total_dpp(c0 + c1);
        float acc[16];
#pragma unroll
        for (int i = 0; i < 16; ++i) acc[i] = 0.f;
#pragma unroll
        for (int half = 0; half < 2; ++half) {
            const int ev = half ? e1 : e0; const float cv = half ? c1 : c0;
#pragma unroll 8
            for (int j = 0; j < 64; ++j) {
                const int e = __builtin_amdgcn_readlane(ev, j);
                const float cf = __builtin_bit_cast(float, __builtin_amdgcn_readlane(__builtin_bit_cast(int, cv), j));
                const uint4 w = ((const uint4*)(vtab + (size_t)e * 1024))[lane];
                const unsigned ww[4] = {w.x, w.y, w.z, w.w};
#pragma unroll
                for (int i = 0; i < 4; ++i) {
                    acc[4 * i + 0] += cf * (float)(ww[i] & 0xffu); acc[4 * i + 1] += cf * (float)((ww[i] >> 8) & 0xffu);
                    acc[4 * i + 2] += cf * (float)((ww[i] >> 16) & 0xffu); acc[4 * i + 3] += cf * (float)(ww[i] >> 24);
                }
            }
        }
        float xv[16]; float ss = 0.f;
#pragma unroll
        for (int i = 0; i < 4; ++i) {
            const float4 g2 = ((const float4*)(mod + b * 6144 + 5 * D))[lane + 64 * i];
            const float4 x = ((const float4*)(xin + (size_t)t * D))[lane + 64 * i];
            xv[4 * i + 0] = x.x + g2.x * (acc[4 * i + 0] - corr); xv[4 * i + 1] = x.y + g2.y * (acc[4 * i + 1] - corr);
            xv[4 * i + 2] = x.z + g2.z * (acc[4 * i + 2] - corr); xv[4 * i + 3] = x.w + g2.w * (acc[4 * i + 3] - corr);
            ss += (xv[4 * i] * xv[4 * i] + xv[4 * i + 1] * xv[4 * i + 1]) + (xv[4 * i + 2] * xv[4 * i + 2] + xv[4 * i + 3] * xv[4 * i + 3]);
        }
        ss = wave_total_dpp(ss);
        const float r = rsqrtf(ss * (1.f / D) + EPS);
#pragma unroll
        for (int i = 0; i < 4; ++i) {
            const float4 gg = ((const float4*)p.fg)[lane + 64 * i];
            float4 o; o.x = xv[4 * i + 0] * r * gg.x; o.y = xv[4 * i + 1] * r * gg.y; o.z = xv[4 * i + 2] * r * gg.z; o.w = xv[4 * i + 3] * r * gg.w;
            ((float4*)(xout + (size_t)t * D))[lane + 64 * i] = o;
        }
    }
}

__device__ __forceinline__ void ph_vt(const bf16* proj, int voff, bf16* VT) {
    const int lane = threadIdx.x & 63, gw = blockIdx.x * NWAVES + __builtin_amdgcn_readfirstlane(threadIdx.x >> 6), ngw = gridDim.x * NWAVES;
    for (int u = gw; u < NB * 8 * (S / 64); u += ngw) {
        const int sb = u & 127, h = (u >> 7) & 7, b = u >> 10;
        const bf16* src = proj + (size_t)(b * S + sb * 64) * PW + voff + h * 64 + lane;
        bf16* dst = VT + (((size_t)(b * 8 + h) * (S / 32) + 2 * sb) * 64 + lane) * 32;
        unsigned short e[64];
#pragma unroll
        for (int j = 0; j < 64; ++j) e[j] = src[(size_t)j * PW];
#pragma unroll
        for (int blk = 0; blk < 2; ++blk)
#pragma unroll
            for (int q4 = 0; q4 < 4; ++q4) {
                const int a = 32 * blk + 4 * q4, c = a + 16;
                v4u o; o.x = e[a] | ((unsigned)e[a + 1] << 16); o.y = e[a + 2] | ((unsigned)e[a + 3] << 16); o.z = e[c] | ((unsigned)e[c + 1] << 16); o.w = e[c + 2] | ((unsigned)e[c + 3] << 16);
                *(v4u*)(dst + blk * 64 * 32 + 8 * q4) = o;
            }
    }
}
__device__ __forceinline__ void ph_stick2(const bf16* proj, const bf16* KC, const bf16* VT, bf16* yb) {
    const int tid = opaque_tid();
    const int lane = tid & 63, fr = lane & 15, fq = lane >> 4;
    const int gw = blockIdx.x * NWAVES + __builtin_amdgcn_readfirstlane(tid >> 6), ngw = gridDim.x * NWAVES;
    for (int u = gw; u < (T / 16) * 8; u += ngw) {
        const int h = (u >> 3) & 7, t0 = ((((u >> 6) << 3) | (u & 7))) * 16, b = t0 / S, tl0 = t0 % S;
        const int qpos = tl0 + fr;
        bf16x8_t bq[2];
        { const bf16* qrow = proj + (size_t)(t0 + fr) * PW + OFF_QB + 64 * h + 8 * fq; bq[0] = *(const bf16x8_t*)qrow; bq[1] = *(const bf16x8_t*)(qrow + 32); }
        f32x4_t acc[4];
#pragma unroll
        for (int dt = 0; dt < 4; ++dt) acc[dt] = (f32x4_t){0.f, 0.f, 0.f, 0.f};
        float carry = 0.f;
        const bf16* vtb = VT + ((size_t)(b * 8 + h) * (S / 32) * 64 + fr) * 32 + 8 * fq;
        const bf16* kbase = KC + ((size_t)(b * 8 + h) * S + fr) * 64 + 8 * fq;
        int kb = (tl0 + 15) >> 5;
        bf16x8_t nk[2][2]; v4u nv[4];
#pragma unroll
        for (int tile = 0; tile < 2; ++tile) { const bf16* kr = kbase + (size_t)(32 * kb + 16 * tile) * 64; nk[tile][0] = *(const bf16x8_t*)kr; nk[tile][1] = *(const bf16x8_t*)(kr + 32); }
#pragma unroll
        for (int dt = 0; dt < 4; ++dt) { const bf16* vr = vtb + (size_t)kb * 2048 + (16 * dt) * 32; nv[dt] = *(const v4u*)vr; }
        for (; kb >= 0; --kb) {
            bf16x8_t ck[2][2]; v4u cv[4];
#pragma unroll
            for (int tile = 0; tile < 2; ++tile) { ck[tile][0] = nk[tile][0]; ck[tile][1] = nk[tile][1]; }
#pragma unroll
            for (int dt = 0; dt < 4; ++dt) cv[dt] = nv[dt];
            { const int kbn = kb > 0 ? kb - 1 : 0;
#pragma unroll
              for (int tile = 0; tile < 2; ++tile) { const bf16* kr = kbase + (size_t)(32 * kbn + 16 * tile) * 64; nk[tile][0] = *(const bf16x8_t*)kr; nk[tile][1] = *(const bf16x8_t*)(kr + 32); }
#pragma unroll
              for (int dt = 0; dt < 4; ++dt) { const bf16* vr = vtb + (size_t)kbn * 2048 + (16 * dt) * 32; nv[dt] = *(const v4u*)vr; } }
            unsigned pw[4] = {0u, 0u, 0u, 0u};
#pragma unroll
            for (int tile = 1; tile >= 0; --tile) {
                const int k0 = 32 * kb + 16 * tile;
                if (k0 > tl0 + 14) continue;
                f32x4_t st = (f32x4_t){0.f, 0.f, 0.f, 0.f};
                st = __builtin_amdgcn_mfma_f32_16x16x32_bf16(ck[tile][0], bq[0], st, 0, 0, 0);
                st = __builtin_amdgcn_mfma_f32_16x16x32_bf16(ck[tile][1], bq[1], st, 0, 0, 0);
                float lb[4], l1m[4];
#pragma unroll
                for (int i = 0; i < 4; ++i) {
                    const float z = st[i] * 0.18033688011112042f;
                    const bool valid = (k0 + 4 * fq + i) < qpos;
                    const float sp = fmaxf(-z, 0.f) + __builtin_amdgcn_logf(1.f + __builtin_amdgcn_exp2f(-fabsf(z)));
                    lb[i] = valid ? -sp : -INFINITY;
                    l1m[i] = valid ? (-sp - z) : 0.f;
                }
                const float e2 = l1m[3], e1 = e2 + l1m[2], e0 = e1 + l1m[1], gsum = e0 + l1m[0];
                const float a1 = __shfl(gsum, (lane + 16) & 63), a2 = __shfl(gsum, (lane + 32) & 63), a3 = __shfl(gsum, (lane + 48) & 63);
                const float above = (fq < 3 ? a1 : 0.f) + (fq < 2 ? a2 : 0.f) + (fq < 1 ? a3 : 0.f);
                const float base = carry + above;
                const float w0 = __builtin_amdgcn_exp2f(lb[0] + base + e0), w1 = __builtin_amdgcn_exp2f(lb[1] + base + e1), w2 = __builtin_amdgcn_exp2f(lb[2] + base + e2), w3 = __builtin_amdgcn_exp2f(lb[3] + base);
                carry += (gsum + a1) + (a2 + a3);
                pw[2 * tile] = pk2(w0, w1); pw[2 * tile + 1] = pk2(w2, w3);
            }
            bf16x8_t pb;
            { v4u t; t.x = pw[0]; t.y = pw[1]; t.z = pw[2]; t.w = pw[3]; pb = __builtin_bit_cast(bf16x8_t, t); }
#pragma unroll
            for (int dt = 0; dt < 4; ++dt) {
                acc[dt] = __builtin_amdgcn_mfma_f32_16x16x32_bf16(__builtin_bit_cast(bf16x8_t, cv[dt]), pb, acc[dt], 0, 0, 0);
            }
            if (__all(carry < -173.2f)) break;
        }
#pragma unroll
        for (int dt = 0; dt < 4; ++dt) {
            uint2 o; o.x = pk2(acc[dt][0], acc[dt][1]); o.y = pk2(acc[dt][2], acc[dt][3]);
            *(uint2*)(yb + (size_t)(t0 + fr) * 512 + 64 * h + 16 * dt + 4 * fq) = o;
        }
    }
}

constexpr int IQB = 32, ICAPN = 704, ICAP = 705  , ITRIG = ICAPN - 128, ILOW = 352;
constexpr int LDS_IKEY = 0, LDS_IIDX = IQB * ICAP * 4, LDS_ICNT = ((LDS_IIDX + IQB * ICAP * 2 + 15) / 16) * 16, LDS_ITHR = LDS_ICNT + IQB * 4, LDS_IROW = LDS_ITHR + IQB * 4;
static_assert(LDS_IROW + NWAVES * 1024 <= LDS_BYTES - 16, "indexer LDS map");
__device__ __forceinline__ int wave_count(bool pred) { return __popcll(__ballot(pred)); }
__device__ __forceinline__ int index_keep(int nseen, int ntot) {
    const float f = (float)nseen / (float)ntot, a = (float)(ntot - nseen) / (float)nseen;
    const float s = 2.25f * sqrtf(a) + sqrtf(5.0625f * a + 256.f);
    return (int)ceilf(fmaxf(s * s, 272.f) * f);
}
template <int NE> __device__ __forceinline__ void index_load(LAS unsigned* keyb, LAS unsigned short* idxb, int q, int n, int lane, unsigned (&kv)[NE], unsigned (&iv)[NE]) {
#pragma unroll
    for (int j = 0; j < NE; ++j) { const int pos = lane + 64 * j; const bool in = pos < n; kv[j] = in ? keyb[q * ICAP + pos] : 0u; iv[j] = in ? (unsigned)idxb[q * ICAP + pos] : 0xFFFFu; }
}
template <int NE> __device__ __forceinline__ int index_count_ge(const unsigned (&kv)[NE], unsigned c) {
    int k = 0;
#pragma unroll
    for (int j = 0; j < NE; ++j) k += __popcll(__builtin_amdgcn_uicmp(kv[j], c, 35));
    return k;
}
template <int NE> __device__ __forceinline__ unsigned index_kth(const unsigned (&kv)[NE], int need) {
    unsigned tau = 0u;
#pragma unroll 1
    for (int bit = 31; bit >= 0; --bit) { const unsigned c = tau | (1u << bit); if (index_count_ge<NE>(kv, c) >= need) tau = c; }
    return tau;
}
template <int NE> __device__ __forceinline__ unsigned index_kth_range(const unsigned (&kv)[NE], int lo, int hi, int& cout) {
    unsigned tau = 0u;
#pragma unroll 1
    for (int bit = 31; bit >= 0; --bit) {
        const unsigned c = tau | (1u << bit); const int cc = index_count_ge<NE>(kv, c);
        if (cc >= lo) { tau = c; cout = cc; if (cc <= hi) break; }
    }
    return tau;
}
__device__ __forceinline__ void index_cut(LAS unsigned* keyb, LAS unsigned short* idxb, LAS unsigned* cnt, LAS unsigned* thr, int q, int lane, int K) {
    const int n = (int)cnt[q];
    if (n <= K) return;
    unsigned kv[11], iv[11];
    index_load<11>(keyb, idxb, q, n, lane, kv, iv);
    int c = n;
    const unsigned p = index_kth_range<11>(kv, K, K + (K >> 3), c);
    unsigned tau = p - 1u, iota = 0xFFFFu;
    if (c > 448 || p == 0u) {
        tau = index_kth<11>(kv, TOPK);
        int ngt = 0, neq = 0;
#pragma unroll
        for (int j = 0; j < 11; ++j) { ngt += __popcll(__builtin_amdgcn_uicmp(kv[j], tau, 34)); neq += __popcll(__builtin_amdgcn_uicmp(kv[j], tau, 32)); }
        const int need = TOPK - ngt;
        if (neq > need) {
            unsigned x = 0u;
#pragma unroll 1
            for (int bit = 15; bit >= 0; --bit) {
                const unsigned cc = x | (1u << bit);
                int k = 0;
#pragma unroll
                for (int j = 0; j < 11; ++j) k += wave_count(kv[j] == tau && iv[j] < cc);
                if (k < need) x = cc;
            }
            iota = x;
        }
    }
    int base = 0;
    const unsigned long long lt = (1ull << lane) - 1ull;
#pragma unroll
    for (int j = 0; j < 11; ++j) {
        const bool keep = kv[j] > tau || (kv[j] == tau && iv[j] <= iota);
        const unsigned long long m = __ballot(keep);
        const int pos = base + __popcll(m & lt);
        if (keep) { keyb[q * ICAP + pos] = kv[j]; idxb[q * ICAP + pos] = (unsigned short)iv[j]; }
        base += __popcll(m);
    }
    if (lane == 0) { cnt[q] = (unsigned)base; thr[q] = tau; }
    asm volatile("s_waitcnt lgkmcnt(0)" ::: "memory");
}
template <int NE> __device__ __forceinline__ void index_bits(LAS unsigned* keyb, LAS unsigned short* idxb, int q, int n, int lane) {
    unsigned kv[NE], iv[NE];
    index_load<NE>(keyb, idxb, q, n, lane, kv, iv);
    unsigned tau = 0u, iota = 0xFFFFu;
    if (n > TOPK) {
        int cdummy = 0; tau = index_kth_range<NE>(kv, TOPK, TOPK, cdummy);
        int ngt = 0, neq = 0;
#pragma unroll
        for (int j = 0; j < NE; ++j) { ngt += __popcll(__builtin_amdgcn_uicmp(kv[j], tau, 34)); neq += __popcll(__builtin_amdgcn_uicmp(kv[j], tau, 32)); }
        const int need = TOPK - ngt;
        if (neq > need) {
            unsigned x = 0u;
#pragma unroll 1
            for (int bit = 15; bit >= 0; --bit) {
                const unsigned c = x | (1u << bit);
                int k = 0;
#pragma unroll
                for (int j = 0; j < NE; ++j) k += wave_count(kv[j] == tau && iv[j] < c);
                if (k < need) x = c;
            }
            iota = x;
        }
    }
    LAS unsigned* rowl = keyb + q * ICAP;
    asm volatile("s_waitcnt lgkmcnt(0)" ::: "memory");
#pragma unroll
    for (int i = 0; i < 4; ++i) rowl[lane + 64 * i] = 0u;
    asm volatile("s_waitcnt lgkmcnt(0)" ::: "memory");
#pragma unroll
    for (int j = 0; j < NE; ++j) {
        const bool keep = (n > TOPK) ? (kv[j] > tau || (kv[j] == tau && iv[j] <= iota)) : (lane + 64 * j < n);
        if (keep) (void)__hip_atomic_fetch_or(rowl + (iv[j] >> 5), 1u << (iv[j] & 31u), __ATOMIC_RELAXED, __HIP_MEMORY_SCOPE_WORKGROUP);
    }
    asm volatile("s_waitcnt lgkmcnt(0)" ::: "memory");
}
__device__ __forceinline__ void index_final(LAS unsigned* keyb, LAS unsigned short* idxb, LAS unsigned* cnt, int q, int lane) {
    const int n = (int)cnt[q];
    if (n <= 384) index_bits<6>(keyb, idxb, q, n, lane); else if (n <= 448) index_bits<7>(keyb, idxb, q, n, lane); else if (n <= 576) index_bits<9>(keyb, idxb, q, n, lane); else index_bits<11>(keyb, idxb, q, n, lane);
}
template <int ABL> __device__ __forceinline__ void ph_dsa_index(const bf16* proj, const bf16* KI, const bf16* WI, unsigned* selbits, LAS unsigned char* lds) {
    LAS unsigned* keyb = (LAS unsigned*)(lds + LDS_IKEY); LAS unsigned short* idxb = (LAS unsigned short*)(lds + LDS_IIDX);
    LAS unsigned* cnt = (LAS unsigned*)(lds + LDS_ICNT); LAS unsigned* thr = (LAS unsigned*)(lds + LDS_ITHR);
    const int tid = opaque_tid(), wave = __builtin_amdgcn_readfirstlane(tid >> 6), lane = tid & 63, fr = lane & 15, fq = lane >> 4;
    LAS unsigned* rowl = (LAS unsigned*)(lds + LDS_IROW + wave * 1024);
    constexpr int NQB = S / IQB;
    for (int pr = blockIdx.x; pr < NB * NQB / 2; pr += gridDim.x) {
        const int b = pr / (NQB / 2), pp = pr % (NQB / 2);
#pragma unroll 1
        for (int ui = 0; ui < 2; ++ui) {
            const int qb = ui ? pp : (NQB - 1 - pp);
            const int q0 = qb * IQB, t0 = b * S + q0;
            bf16x8_t bqf[2][8][2]; unsigned wvp[2][4];
#pragma unroll
            for (int qg = 0; qg < 2; ++qg) {
                const bf16* qrow = proj + (size_t)(t0 + 16 * qg + fr) * PW;
#pragma unroll
                for (int h = 0; h < 8; ++h) { bqf[qg][h][0] = *(const bf16x8_t*)(qrow + OFF_QI + 64 * h + 8 * fq); bqf[qg][h][1] = *(const bf16x8_t*)(qrow + OFF_QI + 64 * h + 8 * fq + 32); }
                { const uint4 w4 = *(const uint4*)(WI + (size_t)(t0 + 16 * qg + fr) * 8); wvp[qg][0] = w4.x; wvp[qg][1] = w4.y; wvp[qg][2] = w4.z; wvp[qg][3] = w4.w; }
            }
            bf16x8_t bql[2][1][2];
#pragma unroll
            for (int qg = 0; qg < 2; ++qg) {
#pragma unroll
                for (int ks = 0; ks < 2; ++ks) {
                    float ql[8] = {0.f, 0.f, 0.f, 0.f, 0.f, 0.f, 0.f, 0.f};
#pragma unroll
                    for (int h = 0; h < 8; ++h) {
                        const float wh = (h & 1) ? __uint_as_float(wvp[qg][h >> 1] & 0xffff0000u) : __uint_as_float(wvp[qg][h >> 1] << 16);
#pragma unroll
                        for (int j = 0; j < 8; ++j) ql[j] = __builtin_fmaf(wh, __uint_as_float((unsigned)(unsigned short)bqf[qg][h][ks][j] << 16), ql[j]);
                    }
                    v4u hi, lo; unsigned hw[4], lw[4];
#pragma unroll
                    for (int j = 0; j < 4; ++j) {
                        hw[j] = pk2(ql[2 * j], ql[2 * j + 1]);
                        lw[j] = pk2(ql[2 * j] - __uint_as_float(hw[j] << 16), ql[2 * j + 1] - __uint_as_float(hw[j] & 0xffff0000u));
                    }
                    hi.x = hw[0]; hi.y = hw[1]; hi.z = hw[2]; hi.w = hw[3]; (void)lw; (void)lo;
                    bql[qg][0][ks] = __builtin_bit_cast(bf16x8_t, hi);
                }
            }
            const int ntiles = (q0 + IQB - 1) / 128 + 1;
            const bf16* kwave = KI + (size_t)(b * S + 16 * wave + fr) * 64 + 8 * fq;
#pragma unroll 1
            for (int cons = 0; cons < 2; ++cons) {
            __syncthreads();
            if (tid < IQB) { cnt[tid] = 0u; thr[tid] = 0u; }
            bf16x8_t ak0 = *(const bf16x8_t*)kwave, ak1 = *(const bf16x8_t*)(kwave + 32);
#pragma unroll 1
            for (int kt = 0; kt < ntiles; ++kt) {
                asm volatile("s_waitcnt lgkmcnt(0)" ::: "memory"); __builtin_amdgcn_s_barrier(); asm volatile("" ::: "memory");
                if (__any((int)cnt[lane & 31] > ITRIG)) {
#pragma unroll 1
                    for (int qq = 0; qq < 4; ++qq) { const int q = 4 * wave + qq; if ((int)cnt[q] > ILOW) { if (ABL == 2) { if (lane == 0) cnt[q] = 256u; } else {
                        const int ntot = q0 + q + 1, nseen = min(128 * kt, ntot);
                        const int K = cons ? TOPK : __builtin_amdgcn_readfirstlane(max(index_keep(nseen, ntot), 32));
                        index_cut(keyb, idxb, cnt, thr, q, lane, K); } } }
                    asm volatile("s_waitcnt lgkmcnt(0)" ::: "memory"); __builtin_amdgcn_s_barrier(); asm volatile("" ::: "memory");
                }
                const unsigned th0 = thr[fr], th1 = thr[16 + fr];
                const int k0 = 128 * kt + 16 * wave;
                const bf16x8_t a0 = ak0, a1 = ak1;
                { const bf16* kn = kwave + (size_t)(128 * ((kt + 1 < ntiles) ? kt + 1 : kt)) * 64; ak0 = *(const bf16x8_t*)kn; ak1 = *(const bf16x8_t*)(kn + 32); }
#pragma unroll
                for (int qg = 0; qg < 2; ++qg) {
                    float sc[4]; f32x4_t pa[3];
#define IDX_STAGE(SLOT, B0, B1) { pa[SLOT] = (f32x4_t){0.f, 0.f, 0.f, 0.f}; pa[SLOT] = __builtin_amdgcn_mfma_f32_16x16x32_bf16(a0, B0, pa[SLOT], 0, 0, 0); pa[SLOT] = __builtin_amdgcn_mfma_f32_16x16x32_bf16(a1, B1, pa[SLOT], 0, 0, 0); }
                    IDX_STAGE(0, bql[qg][0][0], bql[qg][0][1])
                    IDX_STAGE(1, bqf[qg][0][0], bqf[qg][0][1])
                    IDX_STAGE(2, bqf[qg][1][0], bqf[qg][1][1])
                    __builtin_amdgcn_sched_barrier(0);
#pragma unroll
                    for (int i = 0; i < 4; ++i) sc[i] = pa[0][i];
#pragma unroll
                    for (int h = 0; h < 8; ++h) {
                        if (h + 2 < 8) IDX_STAGE(h % 3, bqf[qg][h + 2][0], bqf[qg][h + 2][1])
                        const float wh = (h & 1) ? __uint_as_float(wvp[qg][h >> 1] & 0xffff0000u) : __uint_as_float(wvp[qg][h >> 1] << 16);
#pragma unroll
                        for (int i = 0; i < 4; ++i) { sc[i] = __builtin_fmaf(__builtin_fabsf(pa[(h + 1) % 3][i]), wh, sc[i]); asm("" : "+v"(sc[i])); }
                        __builtin_amdgcn_sched_barrier(0);
                    }
#undef IDX_STAGE
                    const int qi = 16 * qg + fr, qpos = q0 + qi;
                    const unsigned th = qg ? th1 : th0;
                    unsigned keyv[4], slot[4]; bool prd[4];
#pragma unroll
                    for (int i = 0; i < 4; ++i) {
                        float s = sc[i]; if (s == 0.f) s = 0.f;
                        keyv[i] = f2ord(s);
                        prd[i] = (ABL != 1) && (k0 + 4 * fq + i <= qpos) && (keyv[i] > th);
                    }
#pragma unroll
                    for (int i = 0; i < 4; ++i) slot[i] = prd[i] ? __hip_atomic_fetch_add(cnt + qi, 1u, __ATOMIC_RELAXED, __HIP_MEMORY_SCOPE_WORKGROUP) : 0u;
#pragma unroll
                    for (int i = 0; i < 4; ++i) if (prd[i]) { keyb[qi * ICAP + slot[i]] = keyv[i]; idxb[qi * ICAP + slot[i]] = (unsigned short)(k0 + 4 * fq + i); }
                }
            }
            __syncthreads();
            if (!__any((int)cnt[lane & 31] < min(TOPK, q0 + (lane & 31) + 1))) break;
            }
#pragma unroll 1
            for (int qq = 0; qq < (ABL == 0 ? 4 : 0); ++qq) { const int q = 4 * wave + qq; index_final(keyb, idxb, cnt, q, lane); }
            if (ABL == 0) {
                __syncthreads();
                unsigned* dst = selbits + ((size_t)(b * (S / 32) + qb) * 128) * 64;
                for (int idx = tid; idx < 128 * 32; idx += NTHR) { const int kt = idx >> 5, qq = idx & 31;
                    uint2 w; w.x = keyb[qq * ICAP + 2 * kt]; w.y = keyb[qq * ICAP + 2 * kt + 1];
                    *(uint2*)(dst + (size_t)idx * 2) = w; }
            }
        }
    }
    __syncthreads();
}

constexpr int AQB = 256, AKT = 64, AROW = 144;
constexpr int LDS_AK = 0, LDS_AV = AKT * AROW, LDS_ABUF = 2 * AKT * AROW, LDS_ABLUT = 2 * LDS_ABUF;
__device__ __forceinline__ float max3_f(float a, float b, float c) { float r_; asm("v_max3_f32 %0, %1, %2, %3" : "=v"(r_) : "v"(a), "v"(b), "v"(c)); return r_; }
__device__ __forceinline__ float max2_f(float a, float b) { float r_; asm("v_max_f32 %0, %1, %2" : "=v"(r_) : "v"(a), "v"(b)); return r_; }
__device__ __forceinline__ float bfi_f(unsigned mask, unsigned a, unsigned b) { unsigned r_; asm("v_bfi_b32 %0, %1, %2, %3" : "=v"(r_) : "v"(mask), "v"(a), "v"(b)); return __uint_as_float(r_); }
template <bool NEAR> __device__ __forceinline__ void attn_tile(LAS unsigned char* buf, LAS float* blut, const bf16x8_t (&bq)[2][2], const uint2 cb0, const uint2 cb1, int qw, int k0, int fr, int fq,
                                                               const bf16x8_t ones, f32x4_t (&acc)[2][4], f32x4_t (&accl)[2], const float (&mref_)[2], float (&mlane)[2]) {
    const float cfar = blut[128];
    const unsigned ninf = 0xff800000u;
    bf16x8_t kf[4][2];
#pragma unroll
    for (int tile = 0; tile < 4; ++tile)
#pragma unroll
        for (int ks = 0; ks < 2; ++ks) kf[tile][ks] = *(const LAS bf16x8_t*)(buf + LDS_AK + (16 * tile + fr) * AROW + (8 * fq + 32 * ks) * 2);
    f32x4_t sx[2][4];
#pragma unroll
    for (int qg = 0; qg < 2; ++qg)
#pragma unroll
        for (int tile = 0; tile < 4; ++tile) { sx[qg][tile] = (f32x4_t){0.f, 0.f, 0.f, 0.f};
            sx[qg][tile] = __builtin_amdgcn_mfma_f32_16x16x32_bf16(kf[tile][0], bq[qg][0], sx[qg][tile], 0, 0, 0); sx[qg][tile] = __builtin_amdgcn_mfma_f32_16x16x32_bf16(kf[tile][1], bq[qg][1], sx[qg][tile], 0, 0, 0); }
    float x[2][16];
#pragma unroll
    for (int qg = 0; qg < 2; ++qg) {
        const uint2 cb = qg ? cb1 : cb0;
        const int dist0 = (qw + 16 * qg + fr) - (k0 + 4 * fq);
        const float mref = mref_[qg];
        const float cfm = cfar - mref;
#pragma unroll
        for (int tile = 0; tile < 4; ++tile) {
            const int nib = (int)(((tile & 2) ? cb.y : cb.x) >> (16 * (tile & 1) + 4 * fq));
#pragma unroll
            for (int i = 0; i < 4; ++i) {
                const unsigned t = (unsigned)__builtin_amdgcn_sbfe(nib, i, 1);
                float bias = cfm;
                if (NEAR) { int n = dist0 - (16 * tile + i); n = n < 0 ? 0 : (n > 128 ? 128 : n); bias = blut[n] - mref; }
                x[qg][4 * tile + i] = __builtin_fmaf(sx[qg][tile][i], 0.18033688011112042f, bfi_f(t, __float_as_uint(bias), ninf));
                asm("" : "+v"(x[qg][4 * tile + i]));
            }
        }
        mlane[qg] = max3_f(max3_f(max3_f(x[qg][0], x[qg][1], x[qg][2]), max3_f(x[qg][3], x[qg][4], x[qg][5]), x[qg][15]), max3_f(x[qg][6], x[qg][7], x[qg][8]), max3_f(max3_f(x[qg][9], x[qg][10], x[qg][11]), max3_f(x[qg][12], x[qg][13], x[qg][14]), mlane[qg]));
    }
#pragma unroll
    for (int blk = 0; blk < 2; ++blk) {
        bf16x8_t vf[4];
#pragma unroll
        for (int dt = 0; dt < 4; ++dt) vf[dt] = *(const LAS bf16x8_t*)(buf + LDS_AV + (16 * dt + fr) * AROW + (32 * blk + 8 * fq) * 2);
#pragma unroll
        for (int qg = 0; qg < 2; ++qg) {
            v4u t;
            t.x = pk2(__builtin_amdgcn_exp2f(x[qg][8 * blk + 0]), __builtin_amdgcn_exp2f(x[qg][8 * blk + 1])); t.y = pk2(__builtin_amdgcn_exp2f(x[qg][8 * blk + 2]), __builtin_amdgcn_exp2f(x[qg][8 * blk + 3]));
            t.z = pk2(__builtin_amdgcn_exp2f(x[qg][8 * blk + 4]), __builtin_amdgcn_exp2f(x[qg][8 * blk + 5])); t.w = pk2(__builtin_amdgcn_exp2f(x[qg][8 * blk + 6]), __builtin_amdgcn_exp2f(x[qg][8 * blk + 7]));
            const bf16x8_t pb = __builtin_bit_cast(bf16x8_t, t);
            accl[qg] = __builtin_amdgcn_mfma_f32_16x16x32_bf16(ones, pb, accl[qg], 0, 0, 0);
#pragma unroll
            for (int dt = 0; dt < 4; ++dt) acc[qg][dt] = __builtin_amdgcn_mfma_f32_16x16x32_bf16(vf[dt], pb, acc[qg][dt], 0, 0, 0);
        }
    }
}
__device__ __forceinline__ void ph_dsa_attn2(const Params& p, const bf16* proj, const bf16* KC, const bf16* VTa, const unsigned* selbits, bf16* ya, LAS unsigned char* lds) {
    const int tid = opaque_tid(), wave = __builtin_amdgcn_readfirstlane(tid >> 6), lane = tid & 63, fr = lane & 15, fq = lane >> 4;
    LAS float* blut = (LAS float*)(lds + LDS_ABLUT);
    LAS unsigned* aflag = (LAS unsigned*)(lds + LDS_ABLUT + 1024);
    constexpr int NQBA = S / AQB;
    const int ldr = tid >> 3, ldc = tid & 7;
    for (int pr = blockIdx.x; pr < NB * 8 * NQBA / 2; pr += gridDim.x) {
        const int bh = pr / (NQBA / 2), pp = pr % (NQBA / 2), b = bh >> 3, h = bh & 7;
        __syncthreads();
        if (tid <= 128) blut[tid] = p.rel_bias[(tid >= 128 ? 31 : t5_bucket(tid)) * 8 + h] * 1.4426950408889634f;
        const bf16* kg = KC + ((size_t)(b * 8 + h) * S + ldr) * 64 + 8 * ldc;
        const bf16* vg = VTa + ((size_t)(b * 8 + h) * (S / 32) * 64 + (ldc >> 2) * 64 + ldr) * 32 + 8 * (ldc & 3);
#pragma unroll 1
        for (int ui = 0; ui < 2; ++ui) {
            const int qb = ui ? pp : (NQBA - 1 - pp);
            const int q0 = qb * AQB, qw = q0 + 32 * wave;
            const int ntiles = (q0 + AQB) / AKT;
            bf16x8_t bq[2][2];
#pragma unroll
            for (int qg = 0; qg < 2; ++qg) { const bf16* qrow = proj + (size_t)(b * S + qw + 16 * qg + fr) * PW + OFF_QA + 64 * h + 8 * fq; bq[qg][0] = *(const bf16x8_t*)qrow; bq[qg][1] = *(const bf16x8_t*)(qrow + 32); }
            const unsigned* brow0 = selbits + ((size_t)(b * (S / 32) + (qw >> 5)) * 128) * 64 + 2 * fr;
            const unsigned* brow1 = brow0 + 32;
            f32x4_t acc[2][4], accl[2]; float mref[2] = {0.f, 0.f}, mlane[2];
            const bf16x8_t ones = __builtin_bit_cast(bf16x8_t, (v4u){0x3f803f80u, 0x3f803f80u, 0x3f803f80u, 0x3f803f80u});
#pragma unroll 1
            for (int pass = 0; pass < 2; ++pass) {
#pragma unroll
            for (int qg = 0; qg < 2; ++qg) { mlane[qg] = -INFINITY; accl[qg] = (f32x4_t){0.f, 0.f, 0.f, 0.f};
#pragma unroll
                for (int dt = 0; dt < 4; ++dt) acc[qg][dt] = (f32x4_t){0.f, 0.f, 0.f, 0.f}; }
            __syncthreads();
            if (tid == 0) aflag[0] = 0u;
            { const v4u kk = *(const v4u*)kg, vv = *(const v4u*)vg;
              *(LAS v4u*)(lds + LDS_AK + ldr * AROW + 16 * ldc) = kk; *(LAS v4u*)(lds + LDS_AV + ldr * AROW + 16 * ldc) = vv; }
            uint2 wb0 = *(const uint2*)brow0, wb1 = *(const uint2*)brow1;
            __syncthreads();
            const int nfar = min(ntiles, max(0, (qw - 191 + 64) >> 6));
            const int nact = min(ntiles, (qw + 31) / AKT + 1);
#define ATTN_TILE_LOOP(KT_BEGIN, KT_END, BODY) \
            _Pragma("unroll 1") for (int kt = (KT_BEGIN); kt < (KT_END); ++kt) { \
                const int k0 = kt * AKT; \
                LAS unsigned char* buf = lds + (kt & 1) * LDS_ABUF; \
                const int ktn = (kt + 1 < ntiles) ? kt + 1 : kt;             \
                const uint2 cb0 = wb0, cb1 = wb1; \
                const v4u nk = *(const v4u*)(kg + (size_t)(ktn * AKT) * 64), nvv = *(const v4u*)(vg + (size_t)(ktn * AKT / 32) * 2048); \
                wb0 = *(const uint2*)(brow0 + 64 * ktn); wb1 = *(const uint2*)(brow1 + 64 * ktn); \
                BODY \
                { LAS unsigned char* nb = lds + ((kt + 1) & 1) * LDS_ABUF; \
                    *(LAS v4u*)(nb + LDS_AK + ldr * AROW + 16 * ldc) = nk; *(LAS v4u*)(nb + LDS_AV + ldr * AROW + 16 * ldc) = nvv; } \
                asm volatile("s_waitcnt lgkmcnt(0)" ::: "memory"); __builtin_amdgcn_s_barrier(); asm volatile("" ::: "memory");     \
            }
            ATTN_TILE_LOOP(0, nfar, attn_tile<false>(buf, blut, bq, cb0, cb1, qw, k0, fr, fq, ones, acc, accl, mref, mlane);)
            ATTN_TILE_LOOP(nfar, nact, attn_tile<true>(buf, blut, bq, cb0, cb1, qw, k0, fr, fq, ones, acc, accl, mref, mlane);)
            ATTN_TILE_LOOP(nact, ntiles, (void)buf; (void)k0; (void)cb0; (void)cb1;)
#undef ATTN_TILE_LOOP
            if (pass == 1) break;
            float mq[2];
#pragma unroll
            for (int qg = 0; qg < 2; ++qg) { float m_ = mlane[qg]; m_ = fmaxf(m_, __shfl_xor(m_, 16)); mq[qg] = fmaxf(m_, __shfl_xor(m_, 32)); }
            const bool bad = (mq[0] > 60.f) || (mq[0] < -60.f && mq[0] > -INFINITY) || (mq[1] > 60.f) || (mq[1] < -60.f && mq[1] > -INFINITY);
            if (__any(bad) && lane == 0) aflag[0] = 1u;
            __syncthreads();
            if (aflag[0] == 0u) break;
            mref[0] = (mq[0] > -INFINITY) ? mq[0] : 0.f; mref[1] = (mq[1] > -INFINITY) ? mq[1] : 0.f;
            }
#pragma unroll
            for (int qg = 0; qg < 2; ++qg) {
                const float inv = 1.f / accl[qg][0];
#pragma unroll
                for (int dt = 0; dt < 4; ++dt) { uint2 o; o.x = pk2(acc[qg][dt][0] * inv, acc[qg][dt][1] * inv); o.y = pk2(acc[qg][dt][2] * inv, acc[qg][dt][3] * inv);
                    *(uint2*)(ya + (size_t)(b * S + qw + 16 * qg + fr) * 512 + 64 * h + 16 * dt + 4 * fq) = o; }
            }
        }
    }
    __syncthreads();
}

__global__ void __launch_bounds__(NTHR, 2) mega_fwd(Params p) {
    extern __shared__ __attribute__((aligned(16))) unsigned char lds[];
    float* sm = (float*)lds;
    LAS unsigned char* ldsl = (LAS unsigned char*)lds;
    volatile LAS unsigned* bst = (volatile LAS unsigned*)(ldsl + LDS_BYTES - 16);
    if (threadIdx.x == 0) { bst[0] = 0u; bst[1] = 0u; bst[2] = 0u; bst[3] = 0u; }
    __syncthreads();
    XcdBarrier bar = xcd_barrier_post((unsigned*)(p.ws + WS_BAR), bst);
    unsigned char* ws = p.ws;
    float* mod = (float*)(ws + WS_MOD);
    bf16* proj = (bf16*)(ws + WS_PROJ);
    bf16* G = (bf16*)(ws + WS_G);
    bf16* ya = (bf16*)(ws + WS_YA); bf16* yb = (bf16*)(ws + WS_YB);
    bf16* hn2 = (bf16*)(ws + WS_HN2); bf16* qh = (bf16*)(ws + WS_QH);
    bf16* hn = (bf16*)p.out;
    const int G_ = gridDim.x, c_ = blockIdx.x;

    ph_mod(p, mod, (float*)(lds + LDS_SC_OFF));
    ph_weights(p, ldsl);
    xcd_barrier(bar);
    ph_norm<true>(p.x, p.g1, mod, 0, 1, hn);
    xcd_barrier(bar);
    {
        pg8::Gemm g{hn, (const bf16*)(ws + WS_WIN), T, NPROJ, D, D, D}; pg8::StaticOrder So; So.init(T, NPROJ, G_, c_);
        pg8::EpiX<1> E{proj, G, nullptr, nullptr, nullptr, PW, 0, (bf16*)(ws + WS_KCA), (bf16*)(ws + WS_KCB), (bf16*)(ws + WS_KI), (bf16*)(ws + WS_WI)};
        pg8::gemm_phase<pg8::EpiX<1>, pg8::StaticOrder, true, true>(ldsl, g, So, E);
    }
    xcd_barrier(bar);
    unsigned* selbits = (unsigned*)((unsigned char*)p.out + 32 * MiB); bf16* VTa = (bf16*)p.out;
    ph_vt(proj, OFF_VB, (bf16*)(ws + WS_VT));
    ph_vt(proj, OFF_VA, VTa);
    ph_dsa_index<0>(proj, (const bf16*)(ws + WS_KI), (const bf16*)(ws + WS_WI), selbits, ldsl);
    xcd_barrier(bar);
    ph_dsa_attn2(p, proj, (const bf16*)(ws + WS_KCA), VTa, selbits, ya, ldsl);
    ph_stick2(proj, (const bf16*)(ws + WS_KCB), (const bf16*)(ws + WS_VT), yb);
    xcd_barrier(bar);
    {
        pg8::Gemm g{ya, (const bf16*)(ws + WS_WPA), T, D, 512, 512, 512}; pg8::StaticOrder So; So.init(T, D, G_, c_);
        pg8::EpiX<2> E{nullptr, G, nullptr, nullptr, nullptr, 0, 0, nullptr, nullptr, nullptr, nullptr};
        pg8::gemm_phase<pg8::EpiX<2>, pg8::StaticOrder, true, true>(ldsl, g, So, E);
    }
    {
        pg8::Gemm g{yb, (const bf16*)(ws + WS_WPB), T, D, 512, 512, 512}; pg8::StaticOrder So; So.init(T, D, G_, c_);
        pg8::EpiX<3> E{nullptr, G, nullptr, nullptr, nullptr, 0, 0, nullptr, nullptr, nullptr, nullptr};
        pg8::gemm_phase<pg8::EpiX<3>, pg8::StaticOrder, true, true>(ldsl, g, So, E);
    }
    xcd_barrier(bar);
    {
        pg8::Gemm g{G, (const bf16*)(ws + WS_WOUT), T, D, D, GW, D}; pg8::StaticOrder So; So.init(T, D, G_, c_);
        pg8::EpiX<4> E{nullptr, nullptr, p.x, mod + 2 * D, p.out, 0, 0, nullptr, nullptr, nullptr, nullptr};
        pg8::gemm_phase<pg8::EpiX<4>, pg8::StaticOrder, true, true>(ldsl, g, So, E);
    }
    xcd_barrier(bar);
    ph_norm<false>(p.out, p.g2, mod, 3, 4, hn2);
    ph_quant(p, ws + WS_TAB, (float*)(ws + WS_SCALES));
    xcd_barrier(bar);
    {
        pg8::Gemm g{hn2, (const bf16*)(ws + WS_WQ), T, 2048, D, D, D}; pg8::StaticOrder So; So.init(T, 2048, G_, c_);
        pg8::EpiX<0> E{qh, nullptr, nullptr, nullptr, nullptr, 2048, 0, nullptr, nullptr, nullptr, nullptr};
        pg8::gemm_phase<pg8::EpiX<0>, pg8::StaticOrder, true, true>(ldsl, g, So, E);
    }
    xcd_barrier(bar);
    ph_peer_select(qh, (const bf16*)(ws + WS_SKB), (unsigned short*)(ws + WS_EIDX), (float*)(ws + WS_GATE));
    xcd_barrier(bar);
    ph_peer_gather(p, hn2, (const unsigned short*)(ws + WS_EIDX), (const float*)(ws + WS_GATE), ws + WS_TAB, (const float*)(ws + WS_SCALES), mod, p.out, p.out);
}

extern "C" void kernel_launch(void* const* d_in, const int* in_sizes, int n_in, void* d_out, int out_size, void* d_ws, size_t ws_size, hipStream_t stream) {
    static int grid = 0;
    if (grid == 0) {
        if (n_in != 16 || out_size != T * D || ws_size < WS_NEED) { fprintf(stderr, "kernel_launch: unexpected shapes (n_in %d out %d ws %zu)\n", n_in, out_size, ws_size); grid = -1; return; }
        int dev = 0, cus = 0, per_cu = 0;
        if (hipGetDevice(&dev) != hipSuccess || hipDeviceGetAttribute(&cus, hipDeviceAttributeMultiprocessorCount, dev) != hipSuccess) { grid = -1; return; }
        if (hipFuncSetAttribute((const void*)mega_fwd, hipFuncAttributeMaxDynamicSharedMemorySize, LDS_BYTES) != hipSuccess) { fprintf(stderr, "kernel_launch: hipFuncSetAttribute failed\n"); grid = -1; return; }
        if (hipOccupancyMaxActiveBlocksPerMultiprocessor(&per_cu, (const void*)mega_fwd, NTHR, LDS_BYTES) != hipSuccess || per_cu < 1) { fprintf(stderr, "kernel_launch: occupancy query says %d\n", per_cu); per_cu = 1; }
        (void)hipGetLastError();
        grid = cus;
    }
    if (grid < 0) return;
    (void)hipMemsetAsync((char*)d_ws + WS_BAR, 0, CTL_ZERO_BYTES, stream);
    Params p; memset(&p, 0, sizeof(p));
    p.x = (const float*)d_in[0]; p.c = (const float*)d_in[1]; p.w_ada = (const float*)d_in[2]; p.b_ada = (const float*)d_in[3];
    p.g1 = (const float*)d_in[4]; p.g2 = (const float*)d_in[5]; p.w_in = (const float*)d_in[6]; p.rel_bias = (const float*)d_in[7];
    p.wpa = (const float*)d_in[8]; p.wpb = (const float*)d_in[9]; p.wout = (const float*)d_in[10]; p.wq = (const float*)d_in[11];
    p.sk = (const float*)d_in[12]; p.pu = (const float*)d_in[13]; p.pv = (const float*)d_in[14]; p.fg = (const float*)d_in[15];
    p.out = (float*)d_out; p.ws = (unsigned char*)d_ws;
    hipLaunchKernelGGL(mega_fwd, dim3(grid), dim3(NTHR), LDS_BYTES, stream, p);
}
```

```cpp
#include <hip/hip_runtime.h>
#include <stdint.h>
#include <math.h>
#include <string.h>
#include <stdio.h>

typedef unsigned short bf16;
constexpr int D = 1024, NB = 2, S = 8192, T = NB * S;
constexpr int INW = 5704;
constexpr int OFF_QA = 0, OFF_VA = 512, OFF_QI = 1024, OFF_QB = 1536, OFF_VB = 2048;
constexpr int PW = 2560;
constexpr int NPROJ = 3840 + 2048;
constexpr int GW = 2048;
constexpr int TOPK = 256;
constexpr float EPS = 1e-6f;
constexpr size_t MiB = 1u << 20;
constexpr int NTHR = 512, NWAVES = 8;
constexpr int LDS_BYTES = 147456;

#define LAS __attribute__((address_space(3)))

__device__ __forceinline__ bf16 f2bf(float f) { unsigned u = __float_as_uint(f); return (bf16)((u + 0x7fffu + ((u >> 16) & 1u)) >> 16); }
__device__ __forceinline__ float bf2f(bf16 h) { return __uint_as_float(((unsigned)h) << 16); }
typedef __bf16 bf16x2_hw __attribute__((ext_vector_type(2)));
__device__ __forceinline__ unsigned pk2(float lo, float hi) { bf16x2_hw v; v[0] = (__bf16)lo; v[1] = (__bf16)hi; return __builtin_bit_cast(unsigned, v); }

__device__ __forceinline__ float wave_sum(float v) {
#pragma unroll
    for (int o = 1; o < 64; o <<= 1) v += __shfl_xor(v, o);
    return v;
}
__device__ __forceinline__ float block_sum(float v, float* red) {
    v = wave_sum(v);
    __syncthreads();
    if ((threadIdx.x & 63) == 0) red[threadIdx.x >> 6] = v;
    __syncthreads();
    float s = 0.f;
#pragma unroll
    for (int i = 0; i < NWAVES; ++i) s += red[i];
    return s;
}
typedef float f32x4_t __attribute__((ext_vector_type(4)));
#define XB_TMO      128
#define XB_XCNT(j)  (256  + 64 * (j))
#define XB_XSUB(j)  (1280 + 64 * (j))
#define XB_XGEN(j)  (2304 + 64 * (j))
#define XB_TOP      3328
#define XB_TOPGEN   3392
#define XCD_BAR_WORDS 3456
#define XB_SPIN_CAP (1u << 22)

__device__ __forceinline__ unsigned xb_ld(unsigned* p)              { return __hip_atomic_load(p, __ATOMIC_RELAXED, __HIP_MEMORY_SCOPE_AGENT); }
__device__ __forceinline__ unsigned xb_add(unsigned* p, unsigned v) { return __hip_atomic_fetch_add(p, v, __ATOMIC_RELAXED, __HIP_MEMORY_SCOPE_AGENT); }
__device__ __forceinline__ unsigned xb_xcc_id() { return (unsigned)__builtin_amdgcn_s_getreg((3 << 11) | 20) & 0xFu; }
#define XB_SPIN(cond, bar) do { unsigned _sp = 0; while (cond) { __builtin_amdgcn_s_sleep(1); \
    if ((++_sp & 255u) == 0u) { if (xb_ld(&(bar)[XB_TMO])) break; if (_sp > XB_SPIN_CAP) { atomicAdd(&(bar)[XB_TMO], 1u); break; } } } } while (0)

struct XcdBarrier {
    unsigned* bar; unsigned x;
    volatile LAS unsigned* st;
};

__device__ __forceinline__ XcdBarrier xcd_barrier_post(unsigned* bar, volatile LAS unsigned* st) {
    XcdBarrier b; b.bar = bar; b.x = xb_xcc_id(); b.st = st;
    if (threadIdx.x == 0) (void)xb_add(&bar[XB_XCNT(b.x)], 1u);
    return b;
}
__device__ __forceinline__ void xcd_barrier_complete(unsigned* bar, unsigned x, unsigned& nloc, unsigned& nx) {
    const unsigned G = gridDim.x * gridDim.y * gridDim.z;
    unsigned sum, cnt, mine, sp = 0u;
    for (;;) {
        sum = 0u; cnt = 0u; mine = 0u;
#pragma unroll
        for (unsigned j = 0; j < 16; ++j) { const unsigned c = xb_ld(&bar[XB_XCNT(j)]); sum += c; cnt += (c > 0u) ? 1u : 0u; mine = (j == x) ? c : mine; }
        if (sum == G) break;
        __builtin_amdgcn_s_sleep(1);
        if ((++sp & 255u) == 0u) { if (xb_ld(&bar[XB_TMO])) break; if (sp > XB_SPIN_CAP) { atomicAdd(&bar[XB_TMO], 1u); break; } }
    }
    nloc = mine > 0u ? mine : 1u; nx = cnt > 0u ? cnt : 1u;
}

__device__ __forceinline__ void xcd_barrier(const XcdBarrier& b) {
    asm volatile("s_waitcnt vmcnt(0)" ::: "memory");
    __syncthreads();
    if (threadIdx.x == 0) {
        unsigned* bar = b.bar;
        __builtin_amdgcn_s_waitcnt(0);
        unsigned nloc = b.st[0], nx = b.st[1];
        if (nloc == 0u) { xcd_barrier_complete(bar, b.x, nloc, nx); b.st[0] = nloc; b.st[1] = nx; }
        const unsigned old = xb_add(&bar[XB_XSUB(b.x)], 1u);
        const unsigned gen = old / nloc;
        if (old + 1u == (gen + 1u) * nloc) {
            __builtin_amdgcn_fence(__ATOMIC_RELEASE, "agent");
            asm volatile("s_waitcnt vmcnt(0)" ::: "memory");
            const unsigned og = xb_add(&bar[XB_TOP], 1u);
            const unsigned tg = og / nx;
            if (og + 1u == (tg + 1u) * nx) xb_add(&bar[XB_TOPGEN], 1u);
            else XB_SPIN(xb_ld(&bar[XB_TOPGEN]) == tg, bar);
            __builtin_amdgcn_fence(__ATOMIC_ACQUIRE, "agent");
            xb_add(&bar[XB_XGEN(b.x)], 1u);
            asm volatile("s_waitcnt vmcnt(0)" ::: "memory");
        } else {
            XB_SPIN(xb_ld(&bar[XB_XGEN(b.x)]) == gen, bar);
            __builtin_amdgcn_fence(__ATOMIC_ACQUIRE, "agent");
            asm volatile("s_waitcnt vmcnt(0)" ::: "memory");
        }
    }
    __syncthreads();
}


namespace pg8 {
#define PG8_LAS __attribute__((address_space(3)))
typedef unsigned short bf16_t;
typedef short bf16x8 __attribute__((ext_vector_type(8)));
typedef float f32x4 __attribute__((ext_vector_type(4)));
typedef unsigned u32x4 __attribute__((ext_vector_type(4)));
constexpr int BM = 256, BK = 64, HALF = 128, HTB = HALF * BK * 2  , STAGE_BYTES = 8 * HTB, NXCD = 8, WGM = 8;

__host__ __device__ __forceinline__ int lds_byte(int r, int c) { const int st = (r >> 4) * 2 + (c >> 5), rr = r & 15, cc = c & 31, ob = rr * 64 + cc * 2; return st * 1024 + (ob ^ (((ob >> 9) & 1) << 5)); }
__host__ __device__ __forceinline__ void stage_rc(int b, int& R, int& C) { const int st = b / 1024, sb = b % 1024, swz = sb ^ (((sb >> 9) & 1) << 5); R = (st >> 1) * 16 + swz / 64; C = (st & 1) * 32 + (swz % 64) / 2; }
__host__ __device__ __forceinline__ int perm32(int rho) { const int n = rho >> 4, i = rho & 15; return 8 * (i >> 2) + 4 * n + (i & 3); }

struct Unit { int pm, pn; };
struct Gemm { const bf16_t* A; const bf16_t* Bt; int M, N, K, lda, ldb; };

struct StaticOrder {
    int nM, nN, nwg, G, c;
    __host__ __device__ void init(int M, int N, int G_, int c_) { nM = M / BM; nN = N / BM; nwg = nM * nN; G = G_; c = c_; }
    __host__ __device__ bool next(int i, Unit& u) const {
        const long L = (long)i * G + c; if (L >= nwg) return false;
        int wgid = (int)L; { const int q = nwg / NXCD, r = nwg % NXCD, xcd = wgid % NXCD, off = wgid / NXCD; wgid = (xcd < r ? xcd * (q + 1) : r * (q + 1) + (xcd - r) * q) + off; }
        const int nig = WGM * nN, gid = wgid / nig, fm = gid * WGM, gsz = (nM - fm) < WGM ? (nM - fm) : WGM;
        u.pm = fm + ((wgid % nig) % gsz); u.pn = (wgid % nig) / gsz; return true;
    }
    __device__ __forceinline__ void a_ready(const Unit&) const {}
    __device__ __forceinline__ void done(const Unit&) const {}
};
__device__ __forceinline__ unsigned cvt_pk_bf16(float lo, float hi) { return ::pk2(lo, hi); }
template <class Epi, class Sched, bool ALIGN_EPI = false, bool SP2 = false>
__device__ __forceinline__ void gemm_phase(PG8_LAS unsigned char* lds, const Gemm g, const Sched& S, const Epi& E) {
    int tid_ = threadIdx.x; asm volatile("" : "+v"(tid_));
    const int tid = tid_, wid = __builtin_amdgcn_readfirstlane(tid >> 6), lane = tid & 63, wr = wid >> 2, wc = wid & 3, fr = lane & 15, fq = lane >> 4;
    const int K = g.K, nt = K / BK;
    unsigned voffA[2], voffB[2];
#pragma unroll
    for (int i = 0; i < 2; ++i) { int R, C; stage_rc(tid * 16 + i * 8192, R, C); const int Rb = Epi::PERM ? ((R & ~31) + perm32(R & 31)) : R;
        voffA[i] = (unsigned)(R * g.lda + C) * 2u; voffB[i] = (unsigned)(Rb * g.ldb + C) * 2u; }
    const size_t kstep = (size_t)(BK * 2);
    const size_t hstepA = (size_t)HALF * g.lda * 2, hstepB = (size_t)HALF * g.ldb * 2;
    const size_t tstepA = 2 * hstepA, tstepB = 2 * hstepB;
    const unsigned ldsw = (unsigned)wid * 1024u;
    const int aoff = lds_byte(wr * 64 + fr, fq * 8), boff = lds_byte(wc * 32 + fr, fq * 8);
#define PG8_SA(b, h) (((b) * 2 + (h)) * HTB)
#define PG8_SB(b, h) ((4 + (b) * 2 + (h)) * HTB)
#define PG8_STAGE(bufoff, gbase, voff) do { _Pragma("unroll") for (int _i = 0; _i < 2; ++_i) \
        __builtin_amdgcn_global_load_lds((const unsigned*)((const char*)(gbase) + (voff)[_i]), (PG8_LAS unsigned*)(lds + (bufoff) + ldsw + _i * 8192), 16, 0, 0); } while (0)
#define PG8_LDA(dst, b, h) do { _Pragma("unroll") for (int m = 0; m < 4; ++m) _Pragma("unroll") for (int k = 0; k < 2; ++k) dst[m][k] = *(const PG8_LAS bf16x8*)(lds + PG8_SA(b, h) + aoff + m * 2048 + k * 1024); } while (0)
#define PG8_LDB(dst, b, h) do { _Pragma("unroll") for (int n = 0; n < 2; ++n) _Pragma("unroll") for (int k = 0; k < 2; ++k) dst[n][k] = *(const PG8_LAS bf16x8*)(lds + PG8_SB(b, h) + boff + n * 2048 + k * 1024); } while (0)
#define PG8_MMA(ai, bj, At, Bt) do { __builtin_amdgcn_s_setprio(1); _Pragma("unroll") for (int m = 0; m < 4; ++m) _Pragma("unroll") for (int n = 0; n < 2; ++n) _Pragma("unroll") for (int k = 0; k < 2; ++k) \
        acc[ai][bj][m][n] = __builtin_amdgcn_mfma_f32_16x16x32_bf16(Bt[n][k], At[m][k], acc[ai][bj][m][n], 0, 0, 0); __builtin_amdgcn_s_setprio(0); } while (0)
#define PG8_WAIT_V(n) asm volatile("s_waitcnt vmcnt(" #n ")" ::: "memory")
#define PG8_WAIT_L(n) asm volatile("s_waitcnt lgkmcnt(" #n ")" ::: "memory")
#define PG8_BAR __builtin_amdgcn_s_barrier()
#define PG8_SCHED __builtin_amdgcn_sched_barrier(0)
    Unit cur, nxt; int ui = 0;
    if (!S.next(0, cur)) return;
    f32x4 acc[2][2][4][2];
#pragma unroll
    for (int a = 0; a < 2; ++a)
#pragma unroll
        for (int b = 0; b < 2; ++b)
#pragma unroll
            for (int m = 0; m < 4; ++m)
#pragma unroll
                for (int n = 0; n < 2; ++n) acc[a][b][m][n] = (f32x4){0.f, 0.f, 0.f, 0.f};
    bf16x8 At[4][2], B0[2][2], B1[2][2];
    const char* cA = (const char*)g.A + (size_t)cur.pm * tstepA; const char* cB = (const char*)g.Bt + (size_t)cur.pn * tstepB;
    S.a_ready(cur);
    if constexpr (SP2) {
        PG8_STAGE(PG8_SB(0, 0), cB, voffB); PG8_STAGE(PG8_SB(0, 1), cB + hstepB, voffB); PG8_STAGE(PG8_SA(0, 0), cA, voffA); PG8_STAGE(PG8_SA(0, 1), cA + hstepA, voffA);
        if (wr == 1) PG8_BAR;
        PG8_WAIT_V(2); PG8_BAR;
        PG8_STAGE(PG8_SB(1, 0), cB + kstep, voffB); PG8_STAGE(PG8_SA(1, 0), cA + kstep, voffA); PG8_STAGE(PG8_SB(1, 1), cB + hstepB + kstep, voffB);
        PG8_WAIT_V(6); PG8_BAR;
    } else {
        PG8_STAGE(PG8_SB(0, 0), cB, voffB); PG8_STAGE(PG8_SA(0, 0), cA, voffA); PG8_STAGE(PG8_SB(0, 1), cB + hstepB, voffB); PG8_STAGE(PG8_SA(0, 1), cA + hstepA, voffA);
        if (wr == 1) PG8_BAR;
        PG8_WAIT_V(4); PG8_BAR;
        PG8_STAGE(PG8_SB(1, 0), cB + kstep, voffB); PG8_STAGE(PG8_SA(1, 0), cA + kstep, voffA); PG8_STAGE(PG8_SB(1, 1), cB + hstepB + kstep, voffB);
        PG8_WAIT_V(6); PG8_BAR;
    }
    for (;;) {
        const bool has_next = S.next(ui + 1, nxt);
        const char* nA = has_next ? (const char*)g.A + (size_t)nxt.pm * tstepA : cA; const char* nB = has_next ? (const char*)g.Bt + (size_t)nxt.pn * tstepB : cB;
        for (int t = 0; t < nt; t += 2) {
            const bool last = (t == nt - 2);
            const char* a1 = cA + (size_t)(t + 1) * kstep;
            const char* a2 = last ? nA : cA + (size_t)(t + 2) * kstep; const char* b2 = last ? nB : cB + (size_t)(t + 2) * kstep;
            const char* a3 = a2 + kstep; const char* b3 = b2 + kstep;
            if (last && has_next) S.a_ready(nxt);
            if constexpr (SP2) {
            PG8_LDB(B0, 0, 0); PG8_LDB(B1, 0, 1); PG8_SCHED; PG8_LDA(At, 0, 0); PG8_STAGE(PG8_SA(1, 1), a1 + hstepA, voffA);
            PG8_WAIT_V(8); PG8_WAIT_L(0); PG8_BAR; PG8_MMA(0, 0, At, B0); PG8_MMA(0, 1, At, B1); PG8_BAR; PG8_SCHED;
            PG8_LDA(At, 0, 1); PG8_STAGE(PG8_SB(0, 0), b2, voffB); PG8_STAGE(PG8_SB(0, 1), b2 + hstepB, voffB); PG8_STAGE(PG8_SA(0, 0), a2, voffA);
            PG8_WAIT_V(8); PG8_WAIT_L(0); PG8_BAR; PG8_MMA(1, 0, At, B0); PG8_MMA(1, 1, At, B1); PG8_BAR; PG8_SCHED;
            PG8_LDB(B0, 1, 0); PG8_LDB(B1, 1, 1); PG8_SCHED; PG8_LDA(At, 1, 0); PG8_STAGE(PG8_SA(0, 1), a2 + hstepA, voffA);
            PG8_WAIT_V(8); PG8_WAIT_L(0); PG8_BAR; PG8_MMA(0, 0, At, B0); PG8_MMA(0, 1, At, B1); PG8_BAR; PG8_SCHED;
            PG8_LDA(At, 1, 1); PG8_STAGE(PG8_SB(1, 0), b3, voffB); PG8_STAGE(PG8_SB(1, 1), b3 + hstepB, voffB); PG8_STAGE(PG8_SA(1, 0), a3, voffA);
            PG8_WAIT_V(8); PG8_WAIT_L(0); PG8_BAR; PG8_MMA(1, 0, At, B0); PG8_MMA(1, 1, At, B1); PG8_BAR; PG8_SCHED;
            } else {
            PG8_LDB(B0, 0, 0); PG8_SCHED; PG8_LDA(At, 0, 0); PG8_STAGE(PG8_SA(1, 1), a1 + hstepA, voffA);
            PG8_WAIT_L(8); PG8_BAR; PG8_WAIT_L(0); PG8_MMA(0, 0, At, B0); PG8_BAR; PG8_SCHED;
            PG8_LDB(B1, 0, 1); PG8_STAGE(PG8_SB(0, 0), b2, voffB);
            PG8_BAR; PG8_WAIT_L(0); PG8_MMA(0, 1, At, B1); PG8_BAR;
            PG8_LDA(At, 0, 1); PG8_STAGE(PG8_SA(0, 0), a2, voffA);
            PG8_BAR; PG8_WAIT_L(0); PG8_MMA(1, 0, At, B0); PG8_BAR; PG8_SCHED;
            PG8_STAGE(PG8_SB(0, 1), b2 + hstepB, voffB);
            PG8_WAIT_V(6); PG8_BAR; PG8_MMA(1, 1, At, B1); PG8_BAR;
            PG8_LDB(B0, 1, 0); PG8_SCHED; PG8_LDA(At, 1, 0); PG8_STAGE(PG8_SA(0, 1), a2 + hstepA, voffA);
            PG8_WAIT_L(8); PG8_BAR; PG8_WAIT_L(0); PG8_MMA(0, 0, At, B0); PG8_BAR; PG8_SCHED;
            PG8_LDB(B1, 1, 1); PG8_STAGE(PG8_SB(1, 0), b3, voffB);
            PG8_BAR; PG8_WAIT_L(0); PG8_MMA(0, 1, At, B1); PG8_BAR;
            PG8_LDA(At, 1, 1); PG8_STAGE(PG8_SA(1, 0), a3, voffA);
            PG8_BAR; PG8_WAIT_L(0); PG8_MMA(1, 0, At, B0); PG8_BAR; PG8_SCHED;
            PG8_STAGE(PG8_SB(1, 1), b3 + hstepB, voffB);
            PG8_WAIT_V(6); PG8_BAR; PG8_MMA(1, 1, At, B1); PG8_BAR;
            }
        }
        if constexpr (ALIGN_EPI) { if (wr == 0) PG8_BAR; }
        if constexpr (!Epi::AFTER_DRAIN) { E(acc, cur, wr, wc, fr, fq); S.done(cur); }
        if (!has_next) break;
#pragma unroll
        for (int a = 0; a < 2; ++a)
#pragma unroll
            for (int b = 0; b < 2; ++b)
#pragma unroll
                for (int m = 0; m < 4; ++m)
#pragma unroll
                    for (int n = 0; n < 2; ++n) acc[a][b][m][n] = (f32x4){0.f, 0.f, 0.f, 0.f};
        cur = nxt; cA = nA; cB = nB; ++ui;
        if constexpr (ALIGN_EPI) { if (wr == 1) PG8_BAR; }
    }
    PG8_WAIT_V(0);
    if constexpr (!ALIGN_EPI) { if (wr == 0) PG8_BAR; }
    PG8_BAR;
    if constexpr (Epi::AFTER_DRAIN) { E.fused(acc, cur, wr, wc, fr, fq, lds, wid, lane); S.done(cur); }
#undef PG8_SA
#undef PG8_SB
#undef PG8_STAGE
#undef PG8_LDA
#undef PG8_LDB
#undef PG8_MMA
#undef PG8_WAIT_V
#undef PG8_WAIT_L
#undef PG8_BAR
#undef PG8_SCHED
}
}

namespace pg8 {
__device__ __forceinline__ float sigmoidf_(float v) { return 1.f / (1.f + __expf(-v)); }
__device__ __forceinline__ void unpack8(const u32x4 w, float (&f)[8]) {
    f[0] = __uint_as_float(w.x << 16); f[1] = __uint_as_float(w.x & 0xffff0000u); f[2] = __uint_as_float(w.y << 16); f[3] = __uint_as_float(w.y & 0xffff0000u);
    f[4] = __uint_as_float(w.z << 16); f[5] = __uint_as_float(w.z & 0xffff0000u); f[6] = __uint_as_float(w.w << 16); f[7] = __uint_as_float(w.w & 0xffff0000u);
}
template <int MODE> struct EpiX {
    static constexpr bool PERM = true, AFTER_DRAIN = false;
    bf16_t* O; bf16_t* G; const float* xres; const float* gate; float* outf; int ldc; int pad; bf16_t* KCa; bf16_t* KCb; bf16_t* KI; bf16_t* WI;
    __device__ __forceinline__ void operator()(const f32x4 (&acc)[2][2][4][2], const Unit& u, int wr, int wc, int fr, int fq) const {
        const int row0 = u.pm * BM + wr * 64 + fr;
        int colt = u.pn * BM; bf16_t* base = O; int ld = ldc; bool sig = false;
        if (MODE == 1) { if (u.pn >= 15) { colt -= 15 * BM; base = G; ld = GW; sig = true; }
            else if (u.pn >= 10) {
#pragma unroll
                for (int ai = 0; ai < 2; ++ai)
#pragma unroll
                    for (int m = 0; m < 4; ++m) {
                        const int row = row0 + ai * HALF + m * 16, bb = row / S, ss = row % S;
#pragma unroll
                        for (int bj = 0; bj < 2; ++bj) {
                            const int c = wc * 32 + 8 * fq + bj * HALF;
                            const f32x4 v0 = acc[ai][bj][m][0], v1 = acc[ai][bj][m][1];
                            u32x4 w; w.x = cvt_pk_bf16(v0[0], v0[1]); w.y = cvt_pk_bf16(v0[2], v0[3]); w.z = cvt_pk_bf16(v1[0], v1[1]); w.w = cvt_pk_bf16(v1[2], v1[3]);
                            if (u.pn < 14) { const int cc = ((u.pn - 10) & 1) * BM + c; bf16_t* kc = (u.pn < 12) ? KCa : KCb;
                                *(u32x4*)(kc + ((size_t)(bb * 8 + (cc >> 6)) * S + ss) * 64 + (cc & 63)) = w; }
                            else if (c < 64) *(u32x4*)(KI + (size_t)row * 64 + c) = w;
                            else if (c == 64) *(u32x4*)(WI + (size_t)row * 8) = w;
                        }
                    }
                return;
            } }
        if (MODE == 2 || MODE == 3) { base = G; ld = GW; }
        const int col0 = colt + wc * 32 + 8 * fq;
#pragma unroll
        for (int ai = 0; ai < 2; ++ai)
#pragma unroll
            for (int m = 0; m < 4; ++m) {
                const int row = row0 + ai * HALF + m * 16;
#pragma unroll
                for (int bj = 0; bj < 2; ++bj) {
                    const int col = col0 + bj * HALF;
                    f32x4 v0 = acc[ai][bj][m][0], v1 = acc[ai][bj][m][1];
                    if (MODE == 4) {
                        const size_t o = (size_t)row * 1024 + col;
                        const f32x4 x0 = __builtin_nontemporal_load((const f32x4*)(xres + o)), x1 = __builtin_nontemporal_load((const f32x4*)(xres + o + 4));
                        const float* gp = gate + (row / S) * 6144 + col;
                        const f32x4 g0 = *(const f32x4*)gp, g1 = *(const f32x4*)(gp + 4);
                        *(f32x4*)(outf + o) = x0 + g0 * v0; *(f32x4*)(outf + o + 4) = x1 + g1 * v1;
                    } else {
                        bf16_t* pp = base + (size_t)row * ld + col;
                        if (MODE == 1) { if (sig) {
#pragma unroll
                            for (int e = 0; e < 4; ++e) { v0[e] = sigmoidf_(v0[e]); v1[e] = sigmoidf_(v1[e]); } } }
                        if (MODE == 2) { float t[8]; unpack8(*(const u32x4*)pp, t);
#pragma unroll
                            for (int e = 0; e < 4; ++e) { v0[e] *= t[e]; v1[e] *= t[4 + e]; } }
                        if (MODE == 3) { float t[8], gg[8]; unpack8(*(const u32x4*)pp, t); unpack8(*(const u32x4*)(pp + 1024), gg);
#pragma unroll
                            for (int e = 0; e < 4; ++e) { v0[e] = t[e] + gg[e] * v0[e]; v1[e] = t[4 + e] + gg[4 + e] * v1[e]; } }
                        u32x4 w; w.x = cvt_pk_bf16(v0[0], v0[1]); w.y = cvt_pk_bf16(v0[2], v0[3]); w.z = cvt_pk_bf16(v1[0], v1[1]); w.w = cvt_pk_bf16(v1[2], v1[3]);
                        *(u32x4*)pp = w;
                    }
                }
            }
    }
};
}
struct Params {
    const float *x, *c, *w_ada, *b_ada, *g1, *g2, *w_in, *rel_bias, *wpa, *wpb, *wout, *wq, *sk, *pu, *pv, *fg;
    float* out; unsigned char* ws;
};
__device__ __forceinline__ int opaque_tid() { int t = threadIdx.x; asm volatile("" : "+v"(t)); return t; }
typedef unsigned v4u __attribute__((ext_vector_type(4)));
#define LDS_WAIT() asm volatile("s_waitcnt lgkmcnt(0)" ::: "memory")

constexpr size_t WS_BAR = 0;
constexpr size_t CTL_ZERO_BYTES = 16384;
constexpr size_t WS_MOD = 64 * 1024;
constexpr size_t WS_WIN = 1 * MiB;
constexpr size_t WS_WPA = 13 * MiB, WS_WPB = 14 * MiB;
constexpr size_t WS_WOUT = 15 * MiB;
constexpr size_t WS_WQ = 17 * MiB;
constexpr size_t WS_PROJ = 22 * MiB;
constexpr size_t WS_KCA = 102 * MiB, WS_KCB = 118 * MiB;
constexpr size_t WS_KI = 134 * MiB, WS_WI = 136 * MiB;
constexpr size_t WS_G = 142 * MiB;
constexpr size_t WS_YA = 206 * MiB, WS_YB = 222 * MiB;
constexpr size_t WS_HN2 = 22 * MiB;
constexpr size_t WS_QH = 54 * MiB;
constexpr size_t WS_SKB = 21 * MiB;
constexpr size_t WS_EIDX = 118 * MiB;
constexpr size_t WS_GATE = 122 * MiB;
constexpr size_t WS_TAB = 130 * MiB;
constexpr size_t WS_SCALES = 162 * MiB;
constexpr size_t WS_VT = 238 * MiB;
constexpr size_t WS_NEED = 254 * MiB;
constexpr int LDS_SC_OFF = 7 * 16384 + 8448;

__device__ __forceinline__ void ph_mod(const Params& p, float* mod, float* sc) {
    float* part = sc + 2048;
    const int tid = threadIdx.x, kk = tid >> 3, cc = tid & 7;
    for (int i = tid; i < 2048; i += NTHR) { float v = p.c[i]; sc[i] = v / (1.f + expf(-v)); }
    __syncthreads();
    for (int unit = blockIdx.x; unit < 6144 / 24; unit += gridDim.x) {
        const int col = unit * 24 + 3 * cc;
        float a[2][3] = {{0.f, 0.f, 0.f}, {0.f, 0.f, 0.f}};
#pragma unroll 4
        for (int k = kk; k < 1024; k += 64) {
            const float* w = p.w_ada + (size_t)k * 6144 + col;
            const float w0 = __builtin_nontemporal_load(w), w1 = __builtin_nontemporal_load(w + 1), w2 = __builtin_nontemporal_load(w + 2), s0 = sc[k], s1 = sc[1024 + k];
            a[0][0] += s0 * w0; a[0][1] += s0 * w1; a[0][2] += s0 * w2; a[1][0] += s1 * w0; a[1][1] += s1 * w1; a[1][2] += s1 * w2;
        }
#pragma unroll
        for (int b = 0; b < 2; ++b)
#pragma unroll
            for (int j = 0; j < 3; ++j) part[kk * 48 + b * 24 + 3 * cc + j] = a[b][j];
        __syncthreads();
        if (tid < 48) { float s = 0.f; for (int q = 0; q < 64; ++q) s += part[q * 48 + tid]; const int b = tid / 24, j = unit * 24 + tid % 24; mod[b * 6144 + j] = s + p.b_ada[j]; }
        __syncthreads();
    }
}

template <class CM> __device__ __forceinline__ void transpose_item(const float* W, int ldw, int K, bf16* WT, LAS float* scr, int item, int nblk, int lane, const CM& cm) {
    const int kb = item / nblk, nb = item % nblk, k0 = 64 * kb, n0 = 32 * nb;
    const int sc = cm(n0 + (lane & 31));
#pragma unroll 8
    for (int i = 0; i < 32; ++i) { const int kk = 2 * i + (lane >> 5); scr[kk * 33 + (lane & 31)] = (sc >= 0) ? __builtin_nontemporal_load(W + (size_t)(k0 + kk) * ldw + sc) : 0.f; }
    LDS_WAIT(); asm volatile("" ::: "memory");
    const int c = lane & 7;
#pragma unroll
    for (int j = 0; j < 4; ++j) { const int n = (lane >> 3) + 8 * j; const LAS float* s = scr + (8 * c) * 33 + n;
        v4u o; o.x = pk2(s[0 * 33], s[1 * 33]); o.y = pk2(s[2 * 33], s[3 * 33]); o.z = pk2(s[4 * 33], s[5 * 33]); o.w = pk2(s[6 * 33], s[7 * 33]);
        *(v4u*)(WT + (size_t)(n0 + n) * K + k0 + 8 * c) = o; }
    LDS_WAIT(); asm volatile("" ::: "memory");
}
struct CmIdent { __device__ __forceinline__ int operator()(int n) const { return n; } };
struct CmWin {
    __device__ __forceinline__ int operator()(int n) const {
        if (n < 512) return n;
        if (n < 1024) return 1024 + (n - 512);
        if (n < 1536) return 1536 + (n - 1024);
        if (n < 2048) return 2120 + (n - 1536);
        if (n < 2560) return 3144 + (n - 2048);
        if (n < 3072) return 512 + (n - 2560);
        if (n < 3584) return 2632 + (n - 3072);
        if (n < 3648) return 2048 + (n - 3584);
        if (n < 3656) return 2112 + (n - 3648);
        if (n < 3840) return -1;
        return 3656 + (n - 3840);
    }
};
__device__ __forceinline__ void ph_weights(const Params& p, LAS unsigned char* lds) {
    unsigned char* ws = p.ws;
    const int wave = __builtin_amdgcn_readfirstlane(threadIdx.x >> 6), lane = threadIdx.x & 63;
    LAS float* scr = (LAS float*)(lds + wave * 16384);
    const int gw = blockIdx.x * NWAVES + wave, NGW = gridDim.x * NWAVES;
    constexpr int I_IN = 16 * (NPROJ / 32), I_PA = 8 * 32, I_PB = 8 * 32, I_OUT = 16 * 32, I_Q = 16 * 64;
    constexpr int NITEMS = I_IN + I_PA + I_PB + I_OUT + I_Q;
    for (int it = gw; it < NITEMS; it += NGW) {
        int r = it;
        if (r < I_IN) { transpose_item(p.w_in, INW, 1024, (bf16*)(ws + WS_WIN), scr, r, NPROJ / 32, lane, CmWin()); continue; } r -= I_IN;
        if (r < I_PA) { transpose_item(p.wpa, 1024, 512, (bf16*)(ws + WS_WPA), scr, r, 32, lane, CmIdent()); continue; } r -= I_PA;
        if (r < I_PB) { transpose_item(p.wpb, 1024, 512, (bf16*)(ws + WS_WPB), scr, r, 32, lane, CmIdent()); continue; } r -= I_PB;
        if (r < I_OUT) { transpose_item(p.wout, 1024, 1024, (bf16*)(ws + WS_WOUT), scr, r, 32, lane, CmIdent()); continue; } r -= I_OUT;
        transpose_item(p.wq, 2048, 1024, (bf16*)(ws + WS_WQ), scr, r, 64, lane, CmIdent());
    }
    for (int i = gw * 64 + lane; i < 8 * 2 * 128 * 128 / 4; i += NGW * 64) {
        const float4 v = ((const float4*)p.sk)[i]; uint2 w; w.x = pk2(v.x, v.y); w.y = pk2(v.z, v.w); ((uint2*)(ws + WS_SKB))[i] = w;
    }
}

template <bool NT> __device__ __forceinline__ void ph_norm(const float* src, const float* g, const float* mod, int shift_i, int scale_i, bf16* dst) {
    const int lane = threadIdx.x & 63, gw = blockIdx.x * NWAVES + __builtin_amdgcn_readfirstlane(threadIdx.x >> 6), ngw = gridDim.x * NWAVES;
    for (int t = gw; t < T; t += ngw) {
        const int b = t / S;
        float4 v[4]; float ss = 0.f;
#pragma unroll
        for (int i = 0; i < 4; ++i) { const f32x4_t t_ = NT ? __builtin_nontemporal_load((const f32x4_t*)(src + (size_t)t * D) + lane + 64 * i) : *((const f32x4_t*)(src + (size_t)t * D) + lane + 64 * i); v[i] = make_float4(t_.x, t_.y, t_.z, t_.w); ss += v[i].x * v[i].x + v[i].y * v[i].y + v[i].z * v[i].z + v[i].w * v[i].w; }
        ss = wave_sum(ss);
        const float r = rsqrtf(ss * (1.f / D) + EPS);
#pragma unroll
        for (int i = 0; i < 4; ++i) {
            const float4 gg = ((const float4*)g)[lane + 64 * i];
            const float4 sh = ((const float4*)(mod + b * 6144 + shift_i * D))[lane + 64 * i];
            const float4 sc = ((const float4*)(mod + b * 6144 + scale_i * D))[lane + 64 * i];
            float4 o;
            o.x = v[i].x * r * gg.x * (1.f + sc.x) + sh.x; o.y = v[i].y * r * gg.y * (1.f + sc.y) + sh.y;
            o.z = v[i].z * r * gg.z * (1.f + sc.z) + sh.z; o.w = v[i].w * r * gg.w * (1.f + sc.w) + sh.w;
            uint2 w; w.x = pk2(o.x, o.y); w.y = pk2(o.z, o.w);
            ((uint2*)(dst + (size_t)t * D))[lane + 64 * i] = w;
        }
    }
}
__device__ __forceinline__ unsigned f2ord(float f) { unsigned u = __float_as_uint(f); return (u & 0x80000000u) ? ~u : (u | 0x80000000u); }
__device__ __forceinline__ int t5_bucket(int n) {
    if (n < 16) return n;
    int large = 16 + (int)(logf((float)n * (1.f / 16.f)) / 2.0794415416798357f * 16.f);
    return large < 31 ? large : 31;
}

typedef short bf16x8_t __attribute__((ext_vector_type(8)));
template <int CTRL> __device__ __forceinline__ unsigned dppu(unsigned x) { return (unsigned)__builtin_amdgcn_mov_dpp((int)x, CTRL, 0xf, 0xf, true); }
template <int CTRL> __device__ __forceinline__ float dppf(float x) { return __builtin_bit_cast(float, __builtin_amdgcn_mov_dpp(__builtin_bit_cast(int, x), CTRL, 0xf, 0xf, true)); }
__device__ __forceinline__ unsigned row_max_u(unsigned x) { x = max(x, dppu<0xB1>(x)); x = max(x, dppu<0x4E>(x)); x = max(x, dppu<0x141>(x)); x = max(x, dppu<0x128>(x)); return x; }
__device__ __forceinline__ float row_max_f(float x) { x = fmaxf(x, dppf<0xB1>(x)); x = fmaxf(x, dppf<0x4E>(x)); x = fmaxf(x, dppf<0x141>(x)); x = fmaxf(x, dppf<0x128>(x)); return x; }
__device__ __forceinline__ float row_sum_f(float x) { x += dppf<0xB1>(x); x += dppf<0x4E>(x); x += dppf<0x141>(x); x += dppf<0x128>(x); return x; }
__device__ __forceinline__ float ord2f(unsigned k) { return __uint_as_float((k & 0x80000000u) ? (k & 0x7fffffffu) : ~k); }
__device__ __forceinline__ unsigned max3u(unsigned a, unsigned b, unsigned c) { return max(max(a, b), c); }

__device__ __forceinline__ void ph_quant(const Params& p, unsigned char* tab, float* scales) {
    const int lane = threadIdx.x & 63, gw = blockIdx.x * NWAVES + __builtin_amdgcn_readfirstlane(threadIdx.x >> 6), ngw = gridDim.x * NWAVES;
    for (int r = gw; r < 32768; r += ngw) {
        const float* src = (r < 16384) ? p.pu + (size_t)r * D : p.pv + (size_t)(r - 16384) * D;
        float4 v[4]; float am = 0.f;
#pragma unroll
        for (int i = 0; i < 4; ++i) { const f32x4_t t_ = __builtin_nontemporal_load((const f32x4_t*)src + lane + 64 * i); v[i] = make_float4(t_.x, t_.y, t_.z, t_.w);     am = fmaxf(am, fmaxf(fmaxf(fabsf(v[i].x), fabsf(v[i].y)), fmaxf(fabsf(v[i].z), fabsf(v[i].w)))); }
#pragma unroll
        for (int o = 1; o < 64; o <<= 1) am = fmaxf(am, __shfl_xor(am, o));
        const float inv = am > 0.f ? 127.f / am : 0.f;
        uint4 w; unsigned* wp = (unsigned*)&w;
#pragma unroll
        for (int i = 0; i < 4; ++i) {
            const int q0 = (int)rintf(v[i].x * inv) + 128, q1 = (int)rintf(v[i].y * inv) + 128, q2 = (int)rintf(v[i].z * inv) + 128, q3 = (int)rintf(v[i].w * inv) + 128;
            wp[i] = (unsigned)q0 | ((unsigned)q1 << 8) | ((unsigned)q2 << 16) | ((unsigned)q3 << 24);
        }
        ((uint4*)(tab + (size_t)r * 1024))[lane] = w;
        if (lane == 0) scales[r] = am * (1.f / 127.f);
    }
}

#define CE_DESC(x, y) do { const unsigned hi_ = max(x, y), lo_ = min(x, y); x = hi_; y = lo_; } while (0)
__device__ __forceinline__ int hull_ab(int c) {
    int a = 0, base = 0; bool done = false;
#pragma unroll
    for (int aa = 0; aa < 16; ++aa) { const int nb = 16 / (aa + 1); if (!done) { if (c >= base + nb) { base += nb; a = aa + 1; } else done = true; } }
    return (c < 50) ? ((a << 4) | (c - base)) : -1;
}
__device__ __forceinline__ void ph_peer_select(const bf16* qh, const bf16* skb, unsigned short* eidx, float* gate) {
    const int tid = opaque_tid();
    const int lane = tid & 63, fr = lane & 15, fq = lane >> 4;
    const int gw = blockIdx.x * NWAVES + __builtin_amdgcn_readfirstlane(tid >> 6), ngw = gridDim.x * NWAVES;
    int hab[4];
#pragma unroll
    for (int s = 0; s < 4; ++s) hab[s] = hull_ab(16 * s + fr);
    for (int unit = gw; unit < (T / 16) * 2; unit += ngw) {
        const int t0 = (unit >> 1) * 16, hh = unit & 1;
#pragma unroll 1
        for (int hi = 0; hi < 4; ++hi) {
            const int h = hh * 4 + hi;
            unsigned win[2][4];
#pragma unroll
            for (int c = 0; c < 2; ++c) {
                f32x4_t acc[8];
#pragma unroll
                for (int nt = 0; nt < 8; ++nt) acc[nt] = (f32x4_t){0.f, 0.f, 0.f, 0.f};
                const bf16* qrow = qh + (size_t)(t0 + fr) * 2048 + h * 256 + c * 128 + 8 * fq;
                bf16x8_t a[4];
#pragma unroll
                for (int ks = 0; ks < 4; ++ks) a[ks] = *(const bf16x8_t*)(qrow + 32 * ks);
                const bf16* kb = skb + ((size_t)(h * 2 + c) * 128 + fr) * 128 + 8 * fq;
#pragma unroll
                for (int nt = 0; nt < 8; ++nt)
#pragma unroll
                    for (int ks = 0; ks < 4; ++ks) { const bf16x8_t b = *(const bf16x8_t*)(kb + (size_t)nt * 16 * 128 + 32 * ks); acc[nt] = __builtin_amdgcn_mfma_f32_16x16x32_bf16(a[ks], b, acc[nt], 0, 0, 0); }
                unsigned pk[8][4];
#pragma unroll
                for (int nt = 0; nt < 8; ++nt)
#pragma unroll
                    for (int i = 0; i < 4; ++i) pk[nt][i] = (f2ord(acc[nt][i]) & ~127u) | (127u - (unsigned)(16 * nt + fr));
#pragma unroll
                for (int i = 0; i < 4; ++i) {
                    CE_DESC(pk[0][i], pk[1][i]); CE_DESC(pk[2][i], pk[3][i]); CE_DESC(pk[4][i], pk[5][i]); CE_DESC(pk[6][i], pk[7][i]);
                    CE_DESC(pk[0][i], pk[2][i]); CE_DESC(pk[1][i], pk[3][i]); CE_DESC(pk[4][i], pk[6][i]); CE_DESC(pk[5][i], pk[7][i]);
                    CE_DESC(pk[1][i], pk[2][i]); CE_DESC(pk[5][i], pk[6][i]);
                    CE_DESC(pk[0][i], pk[4][i]); CE_DESC(pk[1][i], pk[5][i]); CE_DESC(pk[2][i], pk[6][i]); CE_DESC(pk[3][i], pk[7][i]);
                    CE_DESC(pk[2][i], pk[4][i]); CE_DESC(pk[3][i], pk[5][i]);
                    CE_DESC(pk[1][i], pk[2][i]); CE_DESC(pk[3][i], pk[4][i]); CE_DESC(pk[5][i], pk[6][i]);
                }
#pragma unroll
                for (int r = 0; r < 16; ++r)
#pragma unroll
                    for (int i = 0; i < 4; ++i) {
                        const unsigned m = row_max_u(pk[0][i]);
                        if (fr == r) win[c][i] = m;
                        const bool w = pk[0][i] == m;
#pragma unroll
                        for (int nt = 0; nt < 7; ++nt) if (nt <= 14 - r) pk[nt][i] = w ? pk[nt + 1][i] : pk[nt][i];
                        if (7 <= 14 - r) pk[7][i] = w ? 0u : pk[7][i];
                    }
            }
#pragma unroll
            for (int i = 0; i < 4; ++i) {
                unsigned ck[4];
#pragma unroll
                for (int s = 0; s < 4; ++s) {
                    const int ab = hab[s] < 0 ? 0 : hab[s];
                    const unsigned wa = (unsigned)__shfl((int)win[0][i], (lane & 48) + (ab >> 4)), wb = (unsigned)__shfl((int)win[1][i], (lane & 48) + (ab & 15));
                    const float v = ord2f(wa & ~127u) + ord2f(wb & ~127u);
                    ck[s] = hab[s] < 0 ? 0u : ((f2ord(v) & ~255u) | (255u - (unsigned)ab));
                }
                CE_DESC(ck[0], ck[1]); CE_DESC(ck[2], ck[3]); CE_DESC(ck[0], ck[2]); CE_DESC(ck[1], ck[3]); CE_DESC(ck[1], ck[2]);
                unsigned mywin = 0u;
#pragma unroll
                for (int r = 0; r < 16; ++r) {
                    const unsigned m = row_max_u(ck[0]);
                    if (fr == r) mywin = m;
                    const bool w = ck[0] == m;
                    if (r < 15) { ck[0] = w ? ck[1] : ck[0]; ck[1] = w ? ck[2] : ck[1]; ck[2] = w ? ck[3] : ck[2]; ck[3] = w ? 0u : ck[3]; }
                }
                const unsigned ci = 255u - (mywin & 255u);
                const unsigned w0 = (unsigned)__shfl((int)win[0][i], (lane & 48) + (int)(ci >> 4)), w1 = (unsigned)__shfl((int)win[1][i], (lane & 48) + (int)(ci & 15u));
                const int e = (int)(127u - (w0 & 127u)) * 128 + (int)(127u - (w1 & 127u));
                const float s = ord2f(w0 & ~127u) + ord2f(w1 & ~127u);
                const float mx = row_max_f(s);
                const float ex = __expf(s - mx);
                const float sum = row_sum_f(ex);
                const int t = t0 + 4 * fq + i;
                eidx[(size_t)t * 128 + h * 16 + fr] = (unsigned short)e;
                gate[(size_t)t * 128 + h * 16 + fr] = ex / sum;
            }
        }
    }
}

__device__ __forceinline__ float wave_total_dpp(float x) {
    x = row_sum_f(x);
    return __builtin_bit_cast(float, __builtin_amdgcn_readlane(__builtin_bit_cast(int, x), 0)) + __builtin_bit_cast(float, __builtin_amdgcn_readlane(__builtin_bit_cast(int, x), 16)) +
           __builtin_bit_cast(float, __builtin_amdgcn_readlane(__builtin_bit_cast(int, x), 32)) + __builtin_bit_cast(float, __builtin_amdgcn_readlane(__builtin_bit_cast(int, x), 48));
}
__device__ __forceinline__ float gelu_erf(float x) { return 0.5f * x * (1.f + erff(x * 0.70710678118654752f)); }
__device__ __forceinline__ void ph_peer_gather(const Params& p, const bf16* hn2, const unsigned short* eidx, const float* gate, const unsigned char* tab, const float* scales, const float* mod, const float* xin, float* xout) {
    const int tid = opaque_tid();
    const int lane = tid & 63, gw = blockIdx.x * NWAVES + __builtin_amdgcn_readfirstlane(tid >> 6), ngw = gridDim.x * NWAVES;
    const unsigned char* utab = tab; const unsigned char* vtab = tab + (size_t)16384 * 1024;
    for (int t = gw; t < T; t += ngw) {
        const int b = t / S;
        float hv[16]; float hs = 0.f;
#pragma unroll
        for (int i = 0; i < 4; ++i) { const uint2 w = ((const uint2*)(hn2 + (size_t)t * D))[lane + 64 * i];
            hv[4 * i + 0] = __uint_as_float(w.x << 16); hv[4 * i + 1] = __uint_as_float(w.x & 0xffff0000u); hv[4 * i + 2] = __uint_as_float(w.y << 16); hv[4 * i + 3] = __uint_as_float(w.y & 0xffff0000u);
            hs += (hv[4 * i] + hv[4 * i + 1]) + (hv[4 * i + 2] + hv[4 * i + 3]); }
        hs = wave_total_dpp(hs);
        const int e0 = eidx[(size_t)t * 128 + lane], e1 = eidx[(size_t)t * 128 + 64 + lane];
        const float g0 = gate[(size_t)t * 128 + lane], g1 = gate[(size_t)t * 128 + 64 + lane];
        float pre0 = 0.f, pre1 = 0.f;
#pragma unroll
        for (int half = 0; half < 2; ++half) {
            const int ev = half ? e1 : e0;
            float pre = 0.f;
#pragma unroll 8
            for (int j = 0; j < 64; ++j) {
                const int e = __builtin_amdgcn_readlane(ev, j);
                const uint4 w = ((const uint4*)(utab + (size_t)e * 1024))[lane];
                const unsigned ww[4] = {w.x, w.y, w.z, w.w};
                float d = 0.f;
#pragma unroll
                for (int i = 0; i < 4; ++i) {
                    d += hv[4 * i + 0] * (float)(ww[i] & 0xffu); d += hv[4 * i + 1] * (float)((ww[i] >> 8) & 0xffu);
                    d += hv[4 * i + 2] * (float)((ww[i] >> 16) & 0xffu); d += hv[4 * i + 3] * (float)(ww[i] >> 24);
                }
                d = wave_total_dpp(d);
                pre = (lane == j) ? d : pre;
            }
            if (half) pre1 = pre; else pre0 = pre;
        }
        const float c0 = g0 * gelu_erf(scales[e0] * (pre0 - 128.f * hs)) * scales[16384 + e0];
        const float c1 = g1 * gelu_erf(scales[e1] * (pre1 - 128.f * hs)) * scales[16384 + e1];
        const float corr = 128.f * wave_total_dpp(c0 + c1);
        float acc[16];
#pragma unroll
        for (int i = 0; i < 16; ++i) acc[i] = 0.f;
#pragma unroll
        for (int half = 0; half < 2; ++half) {
            const int ev = half ? e1 : e0; const float cv = half ? c1 : c0;
#pragma unroll 8
            for (int j = 0; j < 64; ++j) {
                const int e = __builtin_amdgcn_readlane(ev, j);
                const float cf = __builtin_bit_cast(float, __builtin_amdgcn_readlane(__builtin_bit_cast(int, cv), j));
                const uint4 w = ((const uint4*)(vtab + (size_t)e * 1024))[lane];
                const unsigned ww[4] = {w.x, w.y, w.z, w.w};
#pragma unroll
                for (int i = 0; i < 4; ++i) {
                    acc[4 * i + 0] += cf * (float)(ww[i] & 0xffu); acc[4 * i + 1] += cf * (float)((ww[i] >> 8) & 0xffu);
                    acc[4 * i + 2] += cf * (float)((ww[i] >> 16) & 0xffu); acc[4 * i + 3] += cf * (float)(ww[i] >> 24);
                }
            }
        }
        float xv[16]; float ss = 0.f;
#pragma unroll
        for (int i = 0; i < 4; ++i) {
            const float4 g2 = ((const float4*)(mod + b * 6144 + 5 * D))[lane + 64 * i];
            const float4 x = ((const float4*)(xin + (size_t)t * D))[lane + 64 * i];
            xv[4 * i + 0] = x.x + g2.x * (acc[4 * i + 0] - corr); xv[4 * i + 1] = x.y + g2.y * (acc[4 * i + 1] - corr);
            xv[4 * i + 2] = x.z + g2.z * (acc[4 * i + 2] - corr); xv[4 * i + 3] = x.w + g2.w * (acc[4 * i + 3] - corr);
            ss += (xv[4 * i] * xv[4 * i] + xv[4 * i + 1] * xv[4 * i + 1]) + (xv[4 * i + 2] * xv[4 * i + 2] + xv[4 * i + 3] * xv[4 * i + 3]);
        }
        ss = wave_total_dpp(ss);
        const float r = rsqrtf(ss * (1.f / D) + EPS);
#pragma unroll
        for (int i = 0; i < 4; ++i) {
            const float4 gg = ((const float4*)p.fg)[lane + 64 * i];
            float4 o; o.x = xv[4 * i + 0] * r * gg.x; o.y = xv[4 * i + 1] * r * gg.y; o.z = xv[4 * i + 2] * r * gg.z; o.w = xv[4 * i + 3] * r * gg.w;
            ((float4*)(xout + (size_t)t * D))[lane + 64 * i] = o;
        }
    }
}

__device__ __forceinline__ void ph_vt(const bf16* proj, int voff, bf16* VT) {
    const int lane = threadIdx.x & 63, gw = blockIdx.x * NWAVES + __builtin_amdgcn_readfirstlane(threadIdx.x >> 6), ngw = gridDim.x * NWAVES;
    for (int u = gw; u < NB * 8 * (S / 64); u += ngw) {
        const int sb = u & 127, h = (u >> 7) & 7, b = u >> 10;
        const bf16* src = proj + (size_t)(b * S + sb * 64) * PW + voff + h * 64 + lane;
        bf16* dst = VT + (((size_t)(b * 8 + h) * (S / 32) + 2 * sb) * 64 + lane) * 32;
        unsigned short e[64];
#pragma unroll
        for (int j = 0; j < 64; ++j) e[j] = src[(size_t)j * PW];
#pragma unroll
        for (int blk = 0; blk < 2; ++blk)
#pragma unroll
            for (int q4 = 0; q4 < 4; ++q4) {
                const int a = 32 * blk + 4 * q4, c = a + 16;
                v4u o; o.x = e[a] | ((unsigned)e[a + 1] << 16); o.y = e[a + 2] | ((unsigned)e[a + 3] << 16); o.z = e[c] | ((unsigned)e[c + 1] << 16); o.w = e[c + 2] | ((unsigned)e[c + 3] << 16);
                *(v4u*)(dst + blk * 64 * 32 + 8 * q4) = o;
            }
    }
}
__device__ __forceinline__ void ph_stick2(const bf16* proj, const bf16* KC, const bf16* VT, bf16* yb) {
    const int tid = opaque_tid();
    const int lane = tid & 63, fr = lane & 15, fq = lane >> 4;
    const int gw = blockIdx.x * NWAVES + __builtin_amdgcn_readfirstlane(tid >> 6), ngw = gridDim.x * NWAVES;
    for (int u = gw; u < (T / 16) * 8; u += ngw) {
        const int h = (u >> 3) & 7, t0 = ((((u >> 6) << 3) | (u & 7))) * 16, b = t0 / S, tl0 = t0 % S;
        const int qpos = tl0 + fr;
        bf16x8_t bq[2];
        { const bf16* qrow = proj + (size_t)(t0 + fr) * PW + OFF_QB + 64 * h + 8 * fq; bq[0] = *(const bf16x8_t*)qrow; bq[1] = *(const bf16x8_t*)(qrow + 32); }
        f32x4_t acc[4];
#pragma unroll
        for (int dt = 0; dt < 4; ++dt) acc[dt] = (f32x4_t){0.f, 0.f, 0.f, 0.f};
        float carry = 0.f;
        const bf16* vtb = VT + ((size_t)(b * 8 + h) * (S / 32) * 64 + fr) * 32 + 8 * fq;
        const bf16* kbase = KC + ((size_t)(b * 8 + h) * S + fr) * 64 + 8 * fq;
        int kb = (tl0 + 15) >> 5;
        bf16x8_t nk[2][2]; v4u nv[4];
#pragma unroll
        for (int tile = 0; tile < 2; ++tile) { const bf16* kr = kbase + (size_t)(32 * kb + 16 * tile) * 64; nk[tile][0] = *(const bf16x8_t*)kr; nk[tile][1] = *(const bf16x8_t*)(kr + 32); }
#pragma unroll
        for (int dt = 0; dt < 4; ++dt) { const bf16* vr = vtb + (size_t)kb * 2048 + (16 * dt) * 32; nv[dt] = *(const v4u*)vr; }
        for (; kb >= 0; --kb) {
            bf16x8_t ck[2][2]; v4u cv[4];
#pragma unroll
            for (int tile = 0; tile < 2; ++tile) { ck[tile][0] = nk[tile][0]; ck[tile][1] = nk[tile][1]; }
#pragma unroll
            for (int dt = 0; dt < 4; ++dt) cv[dt] = nv[dt];
            { const int kbn = kb > 0 ? kb - 1 : 0;
#pragma unroll
              for (int tile = 0; tile < 2; ++tile) { const bf16* kr = kbase + (size_t)(32 * kbn + 16 * tile) * 64; nk[tile][0] = *(const bf16x8_t*)kr; nk[tile][1] = *(const bf16x8_t*)(kr + 32); }
#pragma unroll
              for (int dt = 0; dt < 4; ++dt) { const bf16* vr = vtb + (size_t)kbn * 2048 + (16 * dt) * 32; nv[dt] = *(const v4u*)vr; } }
            unsigned pw[4] = {0u, 0u, 0u, 0u};
#pragma unroll
            for (int tile = 1; tile >= 0; --tile) {
                const int k0 = 32 * kb + 16 * tile;
                if (k0 > tl0 + 14) continue;
                f32x4_t st = (f32x4_t){0.f, 0.f, 0.f, 0.f};
                st = __builtin_amdgcn_mfma_f32_16x16x32_bf16(ck[tile][0], bq[0], st, 0, 0, 0);
                st = __builtin_amdgcn_mfma_f32_16x16x32_bf16(ck[tile][1], bq[1], st, 0, 0, 0);
                float lb[4], l1m[4];
#pragma unroll
                for (int i = 0; i < 4; ++i) {
                    const float z = st[i] * 0.18033688011112042f;
                    const bool valid = (k0 + 4 * fq + i) < qpos;
                    const float sp = fmaxf(-z, 0.f) + __builtin_amdgcn_logf(1.f + __builtin_amdgcn_exp2f(-fabsf(z)));
                    lb[i] = valid ? -sp : -INFINITY;
                    l1m[i] = valid ? (-sp - z) : 0.f;
                }
                const float e2 = l1m[3], e1 = e2 + l1m[2], e0 = e1 + l1m[1], gsum = e0 + l1m[0];
                const float a1 = __shfl(gsum, (lane + 16) & 63), a2 = __shfl(gsum, (lane + 32) & 63), a3 = __shfl(gsum, (lane + 48) & 63);
                const float above = (fq < 3 ? a1 : 0.f) + (fq < 2 ? a2 : 0.f) + (fq < 1 ? a3 : 0.f);
                const float base = carry + above;
                const float w0 = __builtin_amdgcn_exp2f(lb[0] + base + e0), w1 = __builtin_amdgcn_exp2f(lb[1] + base + e1), w2 = __builtin_amdgcn_exp2f(lb[2] + base + e2), w3 = __builtin_amdgcn_exp2f(lb[3] + base);
                carry += (gsum + a1) + (a2 + a3);
                pw[2 * tile] = pk2(w0, w1); pw[2 * tile + 1] = pk2(w2, w3);
            }
            bf16x8_t pb;
            { v4u t; t.x = pw[0]; t.y = pw[1]; t.z = pw[2]; t.w = pw[3]; pb = __builtin_bit_cast(bf16x8_t, t); }
#pragma unroll
            for (int dt = 0; dt < 4; ++dt) {
                acc[dt] = __builtin_amdgcn_mfma_f32_16x16x32_bf16(__builtin_bit_cast(bf16x8_t, cv[dt]), pb, acc[dt], 0, 0, 0);
            }
            if (__all(carry < -173.2f)) break;
        }
#pragma unroll
        for (int dt = 0; dt < 4; ++dt) {
            uint2 o; o.x = pk2(acc[dt][0], acc[dt][1]); o.y = pk2(acc[dt][2], acc[dt][3]);
            *(uint2*)(yb + (size_t)(t0 + fr) * 512 + 64 * h + 16 * dt + 4 * fq) = o;
        }
    }
}

constexpr int IQB = 32, ICAPN = 704, ICAP = 705  , ITRIG = ICAPN - 128, ILOW = 352;
constexpr int LDS_IKEY = 0, LDS_IIDX = IQB * ICAP * 4, LDS_ICNT = ((LDS_IIDX + IQB * ICAP * 2 + 15) / 16) * 16, LDS_ITHR = LDS_ICNT + IQB * 4, LDS_IROW = LDS_ITHR + IQB * 4;
static_assert(LDS_IROW + NWAVES * 1024 <= LDS_BYTES - 16, "indexer LDS map");
__device__ __forceinline__ int wave_count(bool pred) { return __popcll(__ballot(pred)); }
__device__ __forceinline__ int index_keep(int nseen, int ntot) {
    const float f = (float)nseen / (float)ntot, a = (float)(ntot - nseen) / (float)nseen;
    const float s = 2.25f * sqrtf(a) + sqrtf(5.0625f * a + 256.f);
    return (int)ceilf(fmaxf(s * s, 272.f) * f);
}
template <int NE> __device__ __forceinline__ void index_load(LAS unsigned* keyb, LAS unsigned short* idxb, int q, int n, int lane, unsigned (&kv)[NE], unsigned (&iv)[NE]) {
#pragma unroll
    for (int j = 0; j < NE; ++j) { const int pos = lane + 64 * j; const bool in = pos < n; kv[j] = in ? keyb[q * ICAP + pos] : 0u; iv[j] = in ? (unsigned)idxb[q * ICAP + pos] : 0xFFFFu; }
}
template <int NE> __device__ __forceinline__ int index_count_ge(const unsigned (&kv)[NE], unsigned c) {
    int k = 0;
#pragma unroll
    for (int j = 0; j < NE; ++j) k += __popcll(__builtin_amdgcn_uicmp(kv[j], c, 35));
    return k;
}
template <int NE> __device__ __forceinline__ unsigned index_kth(const unsigned (&kv)[NE], int need) {
    unsigned tau = 0u;
#pragma unroll 1
    for (int bit = 31; bit >= 0; --bit) { const unsigned c = tau | (1u << bit); if (index_count_ge<NE>(kv, c) >= need) tau = c; }
    return tau;
}
template <int NE> __device__ __forceinline__ unsigned index_kth_range(const unsigned (&kv)[NE], int lo, int hi, int& cout) {
    unsigned tau = 0u;
#pragma unroll 1
    for (int bit = 31; bit >= 0; --bit) {
        const unsigned c = tau | (1u << bit); const int cc = index_count_ge<NE>(kv, c);
        if (cc >= lo) { tau = c; cout = cc; if (cc <= hi) break; }
    }
    return tau;
}
template <int NE> __device__ __forceinline__ unsigned index_bisect(const unsigned (&kv)[NE], unsigned lo, int K, int Khi, int& cout) {
    unsigned m = kv[0];
#pragma unroll
    for (int j = 1; j < NE; ++j) m = max(m, kv[j]);
    m = row_max_u(m);
    unsigned hi = max(max((unsigned)__builtin_amdgcn_readlane((int)m, 0), (unsigned)__builtin_amdgcn_readlane((int)m, 16)), max((unsigned)__builtin_amdgcn_readlane((int)m, 32), (unsigned)__builtin_amdgcn_readlane((int)m, 48)));
    if (hi > lo && hi - lo > (4u << 23)) {
        const unsigned g = hi - (3u << 23); const int cc = index_count_ge<NE>(kv, g);
        if (cc >= K) { lo = g; cout = cc; if (cc <= Khi) return lo; } else hi = g - 1u;
    }
#pragma unroll 1
    while (lo < hi) {
        const unsigned mid = lo + ((hi - lo + 1u) >> 1); const int cc = index_count_ge<NE>(kv, mid);
        if (cc >= K) { lo = mid; cout = cc; if (cc <= Khi) break; } else hi = mid - 1u;
    }
    return lo;
}
__device__ __forceinline__ void index_cut(LAS unsigned* keyb, LAS unsigned short* idxb, LAS unsigned* cnt, LAS unsigned* thr, int q, int lane, int K) {
    const int n = (int)cnt[q];
    if (n <= K) return;
    unsigned kv[11], iv[11];
    index_load<11>(keyb, idxb, q, n, lane, kv, iv);
    int c = n;
    const unsigned p = index_bisect<11>(kv, thr[q], K, K + (K >> 3), c);
    unsigned tau = p - 1u, iota = 0xFFFFu;
    if (c > 448 || p == 0u) {
        tau = index_kth<11>(kv, TOPK);
        int ngt = 0, neq = 0;
#pragma unroll
        for (int j = 0; j < 11; ++j) { ngt += __popcll(__builtin_amdgcn_uicmp(kv[j], tau, 34)); neq += __popcll(__builtin_amdgcn_uicmp(kv[j], tau, 32)); }
        const int need = TOPK - ngt;
        if (neq > need) {
            unsigned x = 0u;
#pragma unroll 1
            for (int bit = 15; bit >= 0; --bit) {
                const unsigned cc = x | (1u << bit);
                int k = 0;
#pragma unroll
                for (int j = 0; j < 11; ++j) k += wave_count(kv[j] == tau && iv[j] < cc);
                if (k < need) x = cc;
            }
            iota = x;
        }
    }
    int base = 0;
    const unsigned long long lt = (1ull << lane) - 1ull;
#pragma unroll
    for (int j = 0; j < 11; ++j) {
        const bool keep = kv[j] > tau || (kv[j] == tau && iv[j] <= iota);
        const unsigned long long m = __ballot(keep);
        const int pos = base + __popcll(m & lt);
        if (keep) { keyb[q * ICAP + pos] = kv[j]; idxb[q * ICAP + pos] = (unsigned short)iv[j]; }
        base += __popcll(m);
    }
    if (lane == 0) { cnt[q] = (unsigned)base; thr[q] = tau; }
    asm volatile("s_waitcnt lgkmcnt(0)" ::: "memory");
}
template <int NE> __device__ __forceinline__ void index_bits(LAS unsigned* keyb, LAS unsigned short* idxb, int q, int n, int lane, unsigned lo0) {
    unsigned kv[NE], iv[NE];
    index_load<NE>(keyb, idxb, q, n, lane, kv, iv);
    unsigned tau = 0u, iota = 0xFFFFu;
    if (n > TOPK) {
        int cdummy = n; tau = index_bisect<NE>(kv, lo0, TOPK, TOPK, cdummy);
        int ngt = 0, neq = 0;
#pragma unroll
        for (int j = 0; j < NE; ++j) { ngt += __popcll(__builtin_amdgcn_uicmp(kv[j], tau, 34)); neq += __popcll(__builtin_amdgcn_uicmp(kv[j], tau, 32)); }
        const int need = TOPK - ngt;
        if (neq > need) {
            unsigned x = 0u;
#pragma unroll 1
            for (int bit = 15; bit >= 0; --bit) {
                const unsigned c = x | (1u << bit);
                int k = 0;
#pragma unroll
                for (int j = 0; j < NE; ++j) k += wave_count(kv[j] == tau && iv[j] < c);
                if (k < need) x = c;
            }
            iota = x;
        }
    }
    LAS unsigned* rowl = keyb + q * ICAP;
    asm volatile("s_waitcnt lgkmcnt(0)" ::: "memory");
#pragma unroll
    for (int i = 0; i < 4; ++i) rowl[lane + 64 * i] = 0u;
    asm volatile("s_waitcnt lgkmcnt(0)" ::: "memory");
#pragma unroll
    for (int j = 0; j < NE; ++j) {
        const bool keep = (n > TOPK) ? (kv[j] > tau || (kv[j] == tau && iv[j] <= iota)) : (lane + 64 * j < n);
        if (keep) (void)__hip_atomic_fetch_or(rowl + (iv[j] >> 5), 1u << (iv[j] & 31u), __ATOMIC_RELAXED, __HIP_MEMORY_SCOPE_WORKGROUP);
    }
    asm volatile("s_waitcnt lgkmcnt(0)" ::: "memory");
}
__device__ __forceinline__ void index_final(LAS unsigned* keyb, LAS unsigned short* idxb, LAS unsigned* cnt, LAS unsigned* thr, int q, int lane) {
    const int n = (int)cnt[q]; const unsigned lo0 = thr[q];
    if (n <= 384) index_bits<6>(keyb, idxb, q, n, lane, lo0); else if (n <= 448) index_bits<7>(keyb, idxb, q, n, lane, lo0); else if (n <= 576) index_bits<9>(keyb, idxb, q, n, lane, lo0); else index_bits<11>(keyb, idxb, q, n, lane, lo0);
}
template <int ABL> __device__ __forceinline__ void ph_dsa_index(const bf16* proj, const bf16* KI, const bf16* WI, unsigned* selbits, LAS unsigned char* lds) {
    LAS unsigned* keyb = (LAS unsigned*)(lds + LDS_IKEY); LAS unsigned short* idxb = (LAS unsigned short*)(lds + LDS_IIDX);
    LAS unsigned* cnt = (LAS unsigned*)(lds + LDS_ICNT); LAS unsigned* thr = (LAS unsigned*)(lds + LDS_ITHR);
    const int tid = opaque_tid(), wave = __builtin_amdgcn_readfirstlane(tid >> 6), lane = tid & 63, fr = lane & 15, fq = lane >> 4;
    LAS unsigned* rowl = (LAS unsigned*)(lds + LDS_IROW + wave * 1024);
    constexpr int NQB = S / IQB;
    for (int pr = blockIdx.x; pr < NB * NQB / 2; pr += gridDim.x) {
        const int b = pr / (NQB / 2), pp = pr % (NQB / 2);
#pragma unroll 1
        for (int ui = 0; ui < 2; ++ui) {
            const int qb = ui ? pp : (NQB - 1 - pp);
            const int q0 = qb * IQB, t0 = b * S + q0;
            bf16x8_t bqf[2][8][2]; unsigned wvp[2][4];
#pragma unroll
            for (int qg = 0; qg < 2; ++qg) {
                const bf16* qrow = proj + (size_t)(t0 + 16 * qg + fr) * PW;
#pragma unroll
                for (int h = 0; h < 8; ++h) { bqf[qg][h][0] = *(const bf16x8_t*)(qrow + OFF_QI + 64 * h + 8 * fq); bqf[qg][h][1] = *(const bf16x8_t*)(qrow + OFF_QI + 64 * h + 8 * fq + 32); }
                { const uint4 w4 = *(const uint4*)(WI + (size_t)(t0 + 16 * qg + fr) * 8); wvp[qg][0] = w4.x; wvp[qg][1] = w4.y; wvp[qg][2] = w4.z; wvp[qg][3] = w4.w; }
            }
            bf16x8_t bql[2][1][2];
#pragma unroll
            for (int qg = 0; qg < 2; ++qg) {
#pragma unroll
                for (int ks = 0; ks < 2; ++ks) {
                    float ql[8] = {0.f, 0.f, 0.f, 0.f, 0.f, 0.f, 0.f, 0.f};
#pragma unroll
                    for (int h = 0; h < 8; ++h) {
                        const float wh = (h & 1) ? __uint_as_float(wvp[qg][h >> 1] & 0xffff0000u) : __uint_as_float(wvp[qg][h >> 1] << 16);
#pragma unroll
                        for (int j = 0; j < 8; ++j) ql[j] = __builtin_fmaf(wh, __uint_as_float((unsigned)(unsigned short)bqf[qg][h][ks][j] << 16), ql[j]);
                    }
                    v4u hi, lo; unsigned hw[4], lw[4];
#pragma unroll
                    for (int j = 0; j < 4; ++j) {
                        hw[j] = pk2(ql[2 * j], ql[2 * j + 1]);
                        lw[j] = pk2(ql[2 * j] - __uint_as_float(hw[j] << 16), ql[2 * j + 1] - __uint_as_float(hw[j] & 0xffff0000u));
                    }
                    hi.x = hw[0]; hi.y = hw[1]; hi.z = hw[2]; hi.w = hw[3]; (void)lw; (void)lo;
                    bql[qg][0][ks] = __builtin_bit_cast(bf16x8_t, hi);
                }
            }
            const int ntiles = (q0 + IQB - 1) / 128 + 1;
            const bf16* kwave = KI + (size_t)(b * S + 16 * wave + fr) * 64 + 8 * fq;
#pragma unroll 1
            for (int cons = 0; cons < 2; ++cons) {
            __syncthreads();
            if (tid < IQB) { cnt[tid] = 0u; thr[tid] = 0u; }
            bf16x8_t ak0 = *(const bf16x8_t*)kwave, ak1 = *(const bf16x8_t*)(kwave + 32);
#pragma unroll 1
            for (int kt = 0; kt < ntiles; ++kt) {
                asm volatile("s_waitcnt lgkmcnt(0)" ::: "memory"); __builtin_amdgcn_s_barrier(); asm volatile("" ::: "memory");
                if (__any((int)cnt[lane & 31] > ITRIG)) {
#pragma unroll 1
                    for (int qq = 0; qq < 4; ++qq) { const int q = 4 * wave + qq; if ((int)cnt[q] > ILOW) { if (ABL == 2) { if (lane == 0) cnt[q] = 256u; } else {
                        const int ntot = q0 + q + 1, nseen = min(128 * kt, ntot);
                        const int K = cons ? TOPK : __builtin_amdgcn_readfirstlane(max(index_keep(nseen, ntot), 32));
                        index_cut(keyb, idxb, cnt, thr, q, lane, K); } } }
                    asm volatile("s_waitcnt lgkmcnt(0)" ::: "memory"); __builtin_amdgcn_s_barrier(); asm volatile("" ::: "memory");
                }
                const unsigned th0 = thr[fr], th1 = thr[16 + fr];
                const int k0 = 128 * kt + 16 * wave;
                const bf16x8_t a0 = ak0, a1 = ak1;
                { const bf16* kn = kwave + (size_t)(128 * ((kt + 1 < ntiles) ? kt + 1 : kt)) * 64; ak0 = *(const bf16x8_t*)kn; ak1 = *(const bf16x8_t*)(kn + 32); }
#pragma unroll
                for (int qg = 0; qg < 2; ++qg) {
                    float sc[4]; f32x4_t pa[3];
#define IDX_STAGE(SLOT, B0, B1) { pa[SLOT] = (f32x4_t){0.f, 0.f, 0.f, 0.f}; pa[SLOT] = __builtin_amdgcn_mfma_f32_16x16x32_bf16(a0, B0, pa[SLOT], 0, 0, 0); pa[SLOT] = __builtin_amdgcn_mfma_f32_16x16x32_bf16(a1, B1, pa[SLOT], 0, 0, 0); }
                    IDX_STAGE(0, bql[qg][0][0], bql[qg][0][1])
                    IDX_STAGE(1, bqf[qg][0][0], bqf[qg][0][1])
                    IDX_STAGE(2, bqf[qg][1][0], bqf[qg][1][1])
                    __builtin_amdgcn_sched_barrier(0);
#pragma unroll
                    for (int i = 0; i < 4; ++i) sc[i] = pa[0][i];
#pragma unroll
                    for (int h = 0; h < 8; ++h) {
                        if (h + 2 < 8) IDX_STAGE(h % 3, bqf[qg][h + 2][0], bqf[qg][h + 2][1])
                        const float wh = (h & 1) ? __uint_as_float(wvp[qg][h >> 1] & 0xffff0000u) : __uint_as_float(wvp[qg][h >> 1] << 16);
#pragma unroll
                        for (int i = 0; i < 4; ++i) { sc[i] = __builtin_fmaf(__builtin_fabsf(pa[(h + 1) % 3][i]), wh, sc[i]); asm("" : "+v"(sc[i])); }
                        __builtin_amdgcn_sched_barrier(0);
                    }
#undef IDX_STAGE
                    const int qi = 16 * qg + fr, qpos = q0 + qi;
                    const unsigned th = qg ? th1 : th0;
                    unsigned keyv[4], slot[4]; bool prd[4];
#pragma unroll
                    for (int i = 0; i < 4; ++i) {
                        float s = sc[i]; if (s == 0.f) s = 0.f;
                        keyv[i] = f2ord(s);
                        prd[i] = (ABL != 1) && (k0 + 4 * fq + i <= qpos) && (keyv[i] > th);
                    }
#pragma unroll
                    for (int i = 0; i < 4; ++i) slot[i] = prd[i] ? __hip_atomic_fetch_add(cnt + qi, 1u, __ATOMIC_RELAXED, __HIP_MEMORY_SCOPE_WORKGROUP) : 0u;
#pragma unroll
                    for (int i = 0; i < 4; ++i) if (prd[i]) { keyb[qi * ICAP + slot[i]] = keyv[i]; idxb[qi * ICAP + slot[i]] = (unsigned short)(k0 + 4 * fq + i); }
                }
            }
            __syncthreads();
            if (!__any((int)cnt[lane & 31] < min(TOPK, q0 + (lane & 31) + 1))) break;
            }
#pragma unroll 1
            for (int qq = 0; qq < (ABL == 0 ? 4 : 0); ++qq) { const int q = 4 * wave + qq; index_final(keyb, idxb, cnt, thr, q, lane); }
            if (ABL == 0) {
                __syncthreads();
                unsigned* dst = selbits + ((size_t)(b * (S / 32) + qb) * 128) * 64;
                for (int idx = tid; idx < 128 * 32; idx += NTHR) { const int kt = idx >> 5, qq = idx & 31;
                    uint2 w; w.x = keyb[qq * ICAP + 2 * kt]; w.y = keyb[qq * ICAP + 2 * kt + 1];
                    *(uint2*)(dst + (size_t)idx * 2) = w; }
            }
        }
    }
    __syncthreads();
}

constexpr int AQB = 256, AKT = 64, AROW = 144;
constexpr int LDS_AK = 0, LDS_AV = AKT * AROW, LDS_ABUF = 2 * AKT * AROW, LDS_ABLUT = 2 * LDS_ABUF;
__device__ __forceinline__ float max3_f(float a, float b, float c) { float r_; asm("v_max3_f32 %0, %1, %2, %3" : "=v"(r_) : "v"(a), "v"(b), "v"(c)); return r_; }
__device__ __forceinline__ float max2_f(float a, float b) { float r_; asm("v_max_f32 %0, %1, %2" : "=v"(r_) : "v"(a), "v"(b)); return r_; }
__device__ __forceinline__ float bfi_f(unsigned mask, unsigned a, unsigned b) { unsigned r_; asm("v_bfi_b32 %0, %1, %2, %3" : "=v"(r_) : "v"(mask), "v"(a), "v"(b)); return __uint_as_float(r_); }
template <bool NEAR> __device__ __forceinline__ void attn_tile(LAS unsigned char* buf, LAS float* blut, const bf16x8_t (&bq)[2][2], const uint2 cb0, const uint2 cb1, int qw, int k0, int fr, int fq,
                                                               const bf16x8_t ones, f32x4_t (&acc)[2][4], f32x4_t (&accl)[2], const float (&mref_)[2], float (&mlane)[2]) {
    const float cfar = blut[128];
    const unsigned ninf = 0xff800000u;
    bf16x8_t kf[4][2];
#pragma unroll
    for (int tile = 0; tile < 4; ++tile)
#pragma unroll
        for (int ks = 0; ks < 2; ++ks) kf[tile][ks] = *(const LAS bf16x8_t*)(buf + LDS_AK + (16 * tile + fr) * AROW + (8 * fq + 32 * ks) * 2);
    f32x4_t sx[2][4];
#pragma unroll
    for (int qg = 0; qg < 2; ++qg)
#pragma unroll
        for (int tile = 0; tile < 4; ++tile) { sx[qg][tile] = (f32x4_t){0.f, 0.f, 0.f, 0.f};
            sx[qg][tile] = __builtin_amdgcn_mfma_f32_16x16x32_bf16(kf[tile][0], bq[qg][0], sx[qg][tile], 0, 0, 0); sx[qg][tile] = __builtin_amdgcn_mfma_f32_16x16x32_bf16(kf[tile][1], bq[qg][1], sx[qg][tile], 0, 0, 0); }
    float x[2][16];
#pragma unroll
    for (int qg = 0; qg < 2; ++qg) {
        const uint2 cb = qg ? cb1 : cb0;
        const int dist0 = (qw + 16 * qg + fr) - (k0 + 4 * fq);
        const float mref = mref_[qg];
        const float cfm = cfar - mref;
#pragma unroll
        for (int tile = 0; tile < 4; ++tile) {
            const int nib = (int)(((tile & 2) ? cb.y : cb.x) >> (16 * (tile & 1) + 4 * fq));
#pragma unroll
            for (int i = 0; i < 4; ++i) {
                const unsigned t = (unsigned)__builtin_amdgcn_sbfe(nib, i, 1);
                float bias = cfm;
                if (NEAR) { int n = dist0 - (16 * tile + i); n = n < 0 ? 0 : (n > 128 ? 128 : n); bias = blut[n] - mref; }
                x[qg][4 * tile + i] = __builtin_fmaf(sx[qg][tile][i], 0.18033688011112042f, bfi_f(t, __float_as_uint(bias), ninf));
                asm("" : "+v"(x[qg][4 * tile + i]));
            }
        }
        mlane[qg] = max3_f(max3_f(max3_f(x[qg][0], x[qg][1], x[qg][2]), max3_f(x[qg][3], x[qg][4], x[qg][5]), x[qg][15]), max3_f(x[qg][6], x[qg][7], x[qg][8]), max3_f(max3_f(x[qg][9], x[qg][10], x[qg][11]), max3_f(x[qg][12], x[qg][13], x[qg][14]), mlane[qg]));
    }
#pragma unroll
    for (int blk = 0; blk < 2; ++blk) {
        bf16x8_t vf[4];
#pragma unroll
        for (int dt = 0; dt < 4; ++dt) vf[dt] = *(const LAS bf16x8_t*)(buf + LDS_AV + (16 * dt + fr) * AROW + (32 * blk + 8 * fq) * 2);
#pragma unroll
        for (int qg = 0; qg < 2; ++qg) {
            v4u t;
            t.x = pk2(__builtin_amdgcn_exp2f(x[qg][8 * blk + 0]), __builtin_amdgcn_exp2f(x[qg][8 * blk + 1])); t.y = pk2(__builtin_amdgcn_exp2f(x[qg][8 * blk + 2]), __builtin_amdgcn_exp2f(x[qg][8 * blk + 3]));
            t.z = pk2(__builtin_amdgcn_exp2f(x[qg][8 * blk + 4]), __builtin_amdgcn_exp2f(x[qg][8 * blk + 5])); t.w = pk2(__builtin_amdgcn_exp2f(x[qg][8 * blk + 6]), __builtin_amdgcn_exp2f(x[qg][8 * blk + 7]));
            const bf16x8_t pb = __builtin_bit_cast(bf16x8_t, t);
            accl[qg] = __builtin_amdgcn_mfma_f32_16x16x32_bf16(ones, pb, accl[qg], 0, 0, 0);
#pragma unroll
            for (int dt = 0; dt < 4; ++dt) acc[qg][dt] = __builtin_amdgcn_mfma_f32_16x16x32_bf16(vf[dt], pb, acc[qg][dt], 0, 0, 0);
        }
    }
}
__device__ __forceinline__ void ph_dsa_attn2(const Params& p, const bf16* proj, const bf16* KC, const bf16* VTa, const unsigned* selbits, bf16* ya, LAS unsigned char* lds) {
    const int tid = opaque_tid(), wave = __builtin_amdgcn_readfirstlane(tid >> 6), lane = tid & 63, fr = lane & 15, fq = lane >> 4;
    LAS float* blut = (LAS float*)(lds + LDS_ABLUT);
    LAS unsigned* aflag = (LAS unsigned*)(lds + LDS_ABLUT + 1024);
    constexpr int NQBA = S / AQB;
    const int ldr = tid >> 3, ldc = tid & 7;
    for (int pr = blockIdx.x; pr < NB * 8 * NQBA / 2; pr += gridDim.x) {
        const int bh = pr / (NQBA / 2), pp = pr % (NQBA / 2), b = bh >> 3, h = bh & 7;
        __syncthreads();
        if (tid <= 128) blut[tid] = p.rel_bias[(tid >= 128 ? 31 : t5_bucket(tid)) * 8 + h] * 1.4426950408889634f;
        const bf16* kg = KC + ((size_t)(b * 8 + h) * S + ldr) * 64 + 8 * ldc;
        const bf16* vg = VTa + ((size_t)(b * 8 + h) * (S / 32) * 64 + (ldc >> 2) * 64 + ldr) * 32 + 8 * (ldc & 3);
#pragma unroll 1
        for (int ui = 0; ui < 2; ++ui) {
            const int qb = ui ? pp : (NQBA - 1 - pp);
            const int q0 = qb * AQB, qw = q0 + 32 * wave;
            const int ntiles = (q0 + AQB) / AKT;
            bf16x8_t bq[2][2];
#pragma unroll
            for (int qg = 0; qg < 2; ++qg) { const bf16* qrow = proj + (size_t)(b * S + qw + 16 * qg + fr) * PW + OFF_QA + 64 * h + 8 * fq; bq[qg][0] = *(const bf16x8_t*)qrow; bq[qg][1] = *(const bf16x8_t*)(qrow + 32); }
            const unsigned* brow0 = selbits + ((size_t)(b * (S / 32) + (qw >> 5)) * 128) * 64 + 2 * fr;
            const unsigned* brow1 = brow0 + 32;
            f32x4_t acc[2][4], accl[2]; float mref[2] = {0.f, 0.f}, mlane[2];
            const bf16x8_t ones = __builtin_bit_cast(bf16x8_t, (v4u){0x3f803f80u, 0x3f803f80u, 0x3f803f80u, 0x3f803f80u});
#pragma unroll 1
            for (int pass = 0; pass < 2; ++pass) {
#pragma unroll
            for (int qg = 0; qg < 2; ++qg) { mlane[qg] = -INFINITY; accl[qg] = (f32x4_t){0.f, 0.f, 0.f, 0.f};
#pragma unroll
                for (int dt = 0; dt < 4; ++dt) acc[qg][dt] = (f32x4_t){0.f, 0.f, 0.f, 0.f}; }
            __syncthreads();
            if (tid == 0) aflag[0] = 0u;
            { const v4u kk = *(const v4u*)kg, vv = *(const v4u*)vg;
              *(LAS v4u*)(lds + LDS_AK + ldr * AROW + 16 * ldc) = kk; *(LAS v4u*)(lds + LDS_AV + ldr * AROW + 16 * ldc) = vv; }
            uint2 wb0 = *(const uint2*)brow0, wb1 = *(const uint2*)brow1;
            __syncthreads();
            const int nfar = min(ntiles, max(0, (qw - 191 + 64) >> 6));
            const int nact = min(ntiles, (qw + 31) / AKT + 1);
#define ATTN_TILE_LOOP(KT_BEGIN, KT_END, BODY) \
            _Pragma("unroll 1") for (int kt = (KT_BEGIN); kt < (KT_END); ++kt) { \
                const int k0 = kt * AKT; \
                LAS unsigned char* buf = lds + (kt & 1) * LDS_ABUF; \
                const int ktn = (kt + 1 < ntiles) ? kt + 1 : kt;             \
                const uint2 cb0 = wb0, cb1 = wb1; \
                const v4u nk = *(const v4u*)(kg + (size_t)(ktn * AKT) * 64), nvv = *(const v4u*)(vg + (size_t)(ktn * AKT / 32) * 2048); \
                wb0 = *(const uint2*)(brow0 + 64 * ktn); wb1 = *(const uint2*)(brow1 + 64 * ktn); \
                BODY \
                { LAS unsigned char* nb = lds + ((kt + 1) & 1) * LDS_ABUF; \
                    *(LAS v4u*)(nb + LDS_AK + ldr * AROW + 16 * ldc) = nk; *(LAS v4u*)(nb + LDS_AV + ldr * AROW + 16 * ldc) = nvv; } \
                asm volatile("s_waitcnt lgkmcnt(0)" ::: "memory"); __builtin_amdgcn_s_barrier(); asm volatile("" ::: "memory");     \
            }
            ATTN_TILE_LOOP(0, nfar, attn_tile<false>(buf, blut, bq, cb0, cb1, qw, k0, fr, fq, ones, acc, accl, mref, mlane);)
            ATTN_TILE_LOOP(nfar, nact, attn_tile<true>(buf, blut, bq, cb0, cb1, qw, k0, fr, fq, ones, acc, accl, mref, mlane);)
            ATTN_TILE_LOOP(nact, ntiles, (void)buf; (void)k0; (void)cb0; (void)cb1;)
#undef ATTN_TILE_LOOP
            if (pass == 1) break;
            float mq[2];
#pragma unroll
            for (int qg = 0; qg < 2; ++qg) { float m_ = mlane[qg]; m_ = fmaxf(m_, __shfl_xor(m_, 16)); mq[qg] = fmaxf(m_, __shfl_xor(m_, 32)); }
            const bool bad = (mq[0] > 60.f) || (mq[0] < -60.f && mq[0] > -INFINITY) || (mq[1] > 60.f) || (mq[1] < -60.f && mq[1] > -INFINITY);
            if (__any(bad) && lane == 0) aflag[0] = 1u;
            __syncthreads();
            if (aflag[0] == 0u) break;
            mref[0] = (mq[0] > -INFINITY) ? mq[0] : 0.f; mref[1] = (mq[1] > -INFINITY) ? mq[1] : 0.f;
            }
#pragma unroll
            for (int qg = 0; qg < 2; ++qg) {
                const float inv = 1.f / accl[qg][0];
#pragma unroll
                for (int dt = 0; dt < 4; ++dt) { uint2 o; o.x = pk2(acc[qg][dt][0] * inv, acc[qg][dt][1] * inv); o.y = pk2(acc[qg][dt][2] * inv, acc[qg][dt][3] * inv);
                    *(uint2*)(ya + (size_t)(b * S + qw + 16 * qg + fr) * 512 + 64 * h + 16 * dt + 4 * fq) = o; }
            }
        }
    }
    __syncthreads();
}

__global__ void __launch_bounds__(NTHR, 2) mega_fwd(Params p) {
    extern __shared__ __attribute__((aligned(16))) unsigned char lds[];
    float* sm = (float*)lds;
    LAS unsigned char* ldsl = (LAS unsigned char*)lds;
    volatile LAS unsigned* bst = (volatile LAS unsigned*)(ldsl + LDS_BYTES - 16);
    if (threadIdx.x == 0) { bst[0] = 0u; bst[1] = 0u; bst[2] = 0u; bst[3] = 0u; }
    __syncthreads();
    XcdBarrier bar = xcd_barrier_post((unsigned*)(p.ws + WS_BAR), bst);
    unsigned char* ws = p.ws;
    float* mod = (float*)(ws + WS_MOD);
    bf16* proj = (bf16*)(ws + WS_PROJ);
    bf16* G = (bf16*)(ws + WS_G);
    bf16* ya = (bf16*)(ws + WS_YA); bf16* yb = (bf16*)(ws + WS_YB);
    bf16* hn2 = (bf16*)(ws + WS_HN2); bf16* qh = (bf16*)(ws + WS_QH);
    bf16* hn = (bf16*)p.out;
    const int G_ = gridDim.x, c_ = blockIdx.x;

    ph_mod(p, mod, (float*)(lds + LDS_SC_OFF));
    ph_weights(p, ldsl);
    xcd_barrier(bar);
    ph_norm<true>(p.x, p.g1, mod, 0, 1, hn);
    xcd_barrier(bar);
    {
        pg8::Gemm g{hn, (const bf16*)(ws + WS_WIN), T, NPROJ, D, D, D}; pg8::StaticOrder So; So.init(T, NPROJ, G_, c_);
        pg8::EpiX<1> E{proj, G, nullptr, nullptr, nullptr, PW, 0, (bf16*)(ws + WS_KCA), (bf16*)(ws + WS_KCB), (bf16*)(ws + WS_KI), (bf16*)(ws + WS_WI)};
        pg8::gemm_phase<pg8::EpiX<1>, pg8::StaticOrder, true, true>(ldsl, g, So, E);
    }
    xcd_barrier(bar);
    unsigned* selbits = (unsigned*)((unsigned char*)p.out + 32 * MiB); bf16* VTa = (bf16*)p.out;
    ph_vt(proj, OFF_VB, (bf16*)(ws + WS_VT));
    ph_vt(proj, OFF_VA, VTa);
    ph_dsa_index<0>(proj, (const bf16*)(ws + WS_KI), (const bf16*)(ws + WS_WI), selbits, ldsl);
    xcd_barrier(bar);
    ph_dsa_attn2(p, proj, (const bf16*)(ws + WS_KCA), VTa, selbits, ya, ldsl);
    ph_stick2(proj, (const bf16*)(ws + WS_KCB), (const bf16*)(ws + WS_VT), yb);
    xcd_barrier(bar);
    {
        pg8::Gemm g{ya, (const bf16*)(ws + WS_WPA), T, D, 512, 512, 512}; pg8::StaticOrder So; So.init(T, D, G_, c_);
        pg8::EpiX<2> E{nullptr, G, nullptr, nullptr, nullptr, 0, 0, nullptr, nullptr, nullptr, nullptr};
        pg8::gemm_phase<pg8::EpiX<2>, pg8::StaticOrder, true, true>(ldsl, g, So, E);
    }
    {
        pg8::Gemm g{yb, (const bf16*)(ws + WS_WPB), T, D, 512, 512, 512}; pg8::StaticOrder So; So.init(T, D, G_, c_);
        pg8::EpiX<3> E{nullptr, G, nullptr, nullptr, nullptr, 0, 0, nullptr, nullptr, nullptr, nullptr};
        pg8::gemm_phase<pg8::EpiX<3>, pg8::StaticOrder, true, true>(ldsl, g, So, E);
    }
    xcd_barrier(bar);
    {
        pg8::Gemm g{G, (const bf16*)(ws + WS_WOUT), T, D, D, GW, D}; pg8::StaticOrder So; So.init(T, D, G_, c_);
        pg8::EpiX<4> E{nullptr, nullptr, p.x, mod + 2 * D, p.out, 0, 0, nullptr, nullptr, nullptr, nullptr};
        pg8::gemm_phase<pg8::EpiX<4>, pg8::StaticOrder, true, true>(ldsl, g, So, E);
    }
    xcd_barrier(bar);
    ph_norm<false>(p.out, p.g2, mod, 3, 4, hn2);
    ph_quant(p, ws + WS_TAB, (float*)(ws + WS_SCALES));
    xcd_barrier(bar);
    {
        pg8::Gemm g{hn2, (const bf16*)(ws + WS_WQ), T, 2048, D, D, D}; pg8::StaticOrder So; So.init(T, 2048, G_, c_);
        pg8::EpiX<0> E{qh, nullptr, nullptr, nullptr, nullptr, 2048, 0, nullptr, nullptr, nullptr, nullptr};
        pg8::gemm_phase<pg8::EpiX<0>, pg8::StaticOrder, true, true>(ldsl, g, So, E);
    }
    xcd_barrier(bar);
    ph_peer_select(qh, (const bf16*)(ws + WS_SKB), (unsigned short*)(ws + WS_EIDX), (float*)(ws + WS_GATE));
    xcd_barrier(bar);
    ph_peer_gather(p, hn2, (const unsigned short*)(ws + WS_EIDX), (const float*)(ws + WS_GATE), ws + WS_TAB, (const float*)(ws + WS_SCALES), mod, p.out, p.out);
}

extern "C" void kernel_launch(void* const* d_in, const int* in_sizes, int n_in, void* d_out, int out_size, void* d_ws, size_t ws_size, hipStream_t stream) {
    static int grid = 0;
    if (grid == 0) {
        if (n_in != 16 || out_size != T * D || ws_size < WS_NEED) { fprintf(stderr, "kernel_launch: unexpected shapes (n_in %d out %d ws %zu)\n", n_in, out_size, ws_size); grid = -1; return; }
        int dev = 0, cus = 0, per_cu = 0;
        if (hipGetDevice(&dev) != hipSuccess || hipDeviceGetAttribute(&cus, hipDeviceAttributeMultiprocessorCount, dev) != hipSuccess) { grid = -1; return; }
        if (hipFuncSetAttribute((const void*)mega_fwd, hipFuncAttributeMaxDynamicSharedMemorySize, LDS_BYTES) != hipSuccess) { fprintf(stderr, "kernel_launch: hipFuncSetAttribute failed\n"); grid = -1; return; }
        if (hipOccupancyMaxActiveBlocksPerMultiprocessor(&per_cu, (const void*)mega_fwd, NTHR, LDS_BYTES) != hipSuccess || per_cu < 1) { fprintf(stderr, "kernel_launch: occupancy query says %d\n", per_cu); per_cu = 1; }
        (void)hipGetLastError();
        grid = cus;
    }
    if (grid < 0) return;
    (void)hipMemsetAsync((char*)d_ws + WS_BAR, 0, CTL_ZERO_BYTES, stream);
    Params p; memset(&p, 0, sizeof(p));
    p.x = (const float*)d_in[0]; p.c = (const float*)d_in[1]; p.w_ada = (const float*)d_in[2]; p.b_ada = (const float*)d_in[3];
    p.g1 = (const float*)d_in[4]; p.g2 = (const float*)d_in[5]; p.w_in = (const float*)d_in[6]; p.rel_bias = (const float*)d_in[7];
    p.wpa = (const float*)d_in[8]; p.wpb = (const float*)d_in[9]; p.wout = (const float*)d_in[10]; p.wq = (const float*)d_in[11];
    p.sk = (const float*)d_in[12]; p.pu = (const float*)d_in[13]; p.pv = (const float*)d_in[14]; p.fg = (const float*)d_in[15];
    p.out = (float*)d_out; p.ws = (unsigned char*)d_ws;
    hipLaunchKernelGGL(mega_fwd, dim3(grid), dim3(NTHR), LDS_BYTES, stream, p);
}
```

```cpp
#include <hip/hip_runtime.h>
#include <stdint.h>
#include <math.h>
#include <string.h>
#include <stdio.h>

typedef unsigned short bf16;
constexpr int D = 1024, NB = 2, S = 8192, T = NB * S;
constexpr int INW = 5704;
constexpr int OFF_QA = 0, OFF_VA = 512, OFF_QI = 1024, OFF_QB = 1536, OFF_VB = 2048;
constexpr int PW = 2560;
constexpr int NPROJ = 3840 + 2048;
constexpr int GW = 2048;
constexpr int TOPK = 256;
constexpr float EPS = 1e-6f;
constexpr size_t MiB = 1u << 20;
constexpr int NTHR = 512, NWAVES = 8;
constexpr int LDS_BYTES = 147456;

#define LAS __attribute__((address_space(3)))

__device__ __forceinline__ bf16 f2bf(float f) { unsigned u = __float_as_uint(f); return (bf16)((u + 0x7fffu + ((u >> 16) & 1u)) >> 16); }
__device__ __forceinline__ float bf2f(bf16 h) { return __uint_as_float(((unsigned)h) << 16); }
typedef __bf16 bf16x2_hw __attribute__((ext_vector_type(2)));
__device__ __forceinline__ unsigned pk2(float lo, float hi) { bf16x2_hw v; v[0] = (__bf16)lo; v[1] = (__bf16)hi; return __builtin_bit_cast(unsigned, v); }

__device__ __forceinline__ float wave_sum(float v) {
#pragma unroll
    for (int o = 1; o < 64; o <<= 1) v += __shfl_xor(v, o);
    return v;
}
__device__ __forceinline__ float block_sum(float v, float* red) {
    v = wave_sum(v);
    __syncthreads();
    if ((threadIdx.x & 63) == 0) red[threadIdx.x >> 6] = v;
    __syncthreads();
    float s = 0.f;
#pragma unroll
    for (int i = 0; i < NWAVES; ++i) s += red[i];
    return s;
}
typedef float f32x4_t __attribute__((ext_vector_type(4)));
#define XB_TMO      128
#define XB_XCNT(j)  (256  + 64 * (j))
#define XB_XSUB(j)  (1280 + 64 * (j))
#define XB_XGEN(j)  (2304 + 64 * (j))
#define XB_TOP      3328
#define XB_TOPGEN   3392
#define XCD_BAR_WORDS 3456
#define XB_SPIN_CAP (1u << 22)

__device__ __forceinline__ unsigned xb_ld(unsigned* p)              { return __hip_atomic_load(p, __ATOMIC_RELAXED, __HIP_MEMORY_SCOPE_AGENT); }
__device__ __forceinline__ unsigned xb_add(unsigned* p, unsigned v) { return __hip_atomic_fetch_add(p, v, __ATOMIC_RELAXED, __HIP_MEMORY_SCOPE_AGENT); }
__device__ __forceinline__ unsigned xb_xcc_id() { return (unsigned)__builtin_amdgcn_s_getreg((3 << 11) | 20) & 0xFu; }
#define XB_SPIN(cond, bar) do { unsigned _sp = 0; while (cond) { __builtin_amdgcn_s_sleep(1); \
    if ((++_sp & 255u) == 0u) { if (xb_ld(&(bar)[XB_TMO])) break; if (_sp > XB_SPIN_CAP) { atomicAdd(&(bar)[XB_TMO], 1u); break; } } } } while (0)

struct XcdBarrier {
    unsigned* bar; unsigned x;
    volatile LAS unsigned* st;
};

__device__ __forceinline__ XcdBarrier xcd_barrier_post(unsigned* bar, volatile LAS unsigned* st) {
    XcdBarrier b; b.bar = bar; b.x = xb_xcc_id(); b.st = st;
    if (threadIdx.x == 0) (void)xb_add(&bar[XB_XCNT(b.x)], 1u);
    return b;
}
__device__ __forceinline__ void xcd_barrier_complete(unsigned* bar, unsigned x, unsigned& nloc, unsigned& nx) {
    const unsigned G = gridDim.x * gridDim.y * gridDim.z;
    unsigned sum, cnt, mine, sp = 0u;
    for (;;) {
        sum = 0u; cnt = 0u; mine = 0u;
#pragma unroll
        for (unsigned j = 0; j < 16; ++j) { const unsigned c = xb_ld(&bar[XB_XCNT(j)]); sum += c; cnt += (c > 0u) ? 1u : 0u; mine = (j == x) ? c : mine; }
        if (sum == G) break;
        __builtin_amdgcn_s_sleep(1);
        if ((++sp & 255u) == 0u) { if (xb_ld(&bar[XB_TMO])) break; if (sp > XB_SPIN_CAP) { atomicAdd(&bar[XB_TMO], 1u); break; } }
    }
    nloc = mine > 0u ? mine : 1u; nx = cnt > 0u ? cnt : 1u;
}

__device__ __forceinline__ void xcd_barrier(const XcdBarrier& b) {
    asm volatile("s_waitcnt vmcnt(0)" ::: "memory");
    __syncthreads();
    if (threadIdx.x == 0) {
        unsigned* bar = b.bar;
        __builtin_amdgcn_s_waitcnt(0);
        unsigned nloc = b.st[0], nx = b.st[1];
        if (nloc == 0u) { xcd_barrier_complete(bar, b.x, nloc, nx); b.st[0] = nloc; b.st[1] = nx; }
        const unsigned old = xb_add(&bar[XB_XSUB(b.x)], 1u);
        const unsigned gen = old / nloc;
        if (old + 1u == (gen + 1u) * nloc) {
            __builtin_amdgcn_fence(__ATOMIC_RELEASE, "agent");
            asm volatile("s_waitcnt vmcnt(0)" ::: "memory");
            const unsigned og = xb_add(&bar[XB_TOP], 1u);
            const unsigned tg = og / nx;
            if (og + 1u == (tg + 1u) * nx) xb_add(&bar[XB_TOPGEN], 1u);
            else XB_SPIN(xb_ld(&bar[XB_TOPGEN]) == tg, bar);
            __builtin_amdgcn_fence(__ATOMIC_ACQUIRE, "agent");
            xb_add(&bar[XB_XGEN(b.x)], 1u);
            asm volatile("s_waitcnt vmcnt(0)" ::: "memory");
        } else {
            XB_SPIN(xb_ld(&bar[XB_XGEN(b.x)]) == gen, bar);
            __builtin_amdgcn_fence(__ATOMIC_ACQUIRE, "agent");
            asm volatile("s_waitcnt vmcnt(0)" ::: "memory");
        }
    }
    __syncthreads();
}


namespace pg8 {
#define PG8_LAS __attribute__((address_space(3)))
typedef unsigned short bf16_t;
typedef short bf16x8 __attribute__((ext_vector_type(8)));
typedef float f32x4 __attribute__((ext_vector_type(4)));
typedef unsigned u32x4 __attribute__((ext_vector_type(4)));
constexpr int BM = 256, BK = 64, HALF = 128, HTB = HALF * BK * 2  , STAGE_BYTES = 8 * HTB, NXCD = 8, WGM = 8;

__host__ __device__ __forceinline__ int lds_byte(int r, int c) { const int st = (r >> 4) * 2 + (c >> 5), rr = r & 15, cc = c & 31, ob = rr * 64 + cc * 2; return st * 1024 + (ob ^ (((ob >> 9) & 1) << 5)); }
__host__ __device__ __forceinline__ void stage_rc(int b, int& R, int& C) { const int st = b / 1024, sb = b % 1024, swz = sb ^ (((sb >> 9) & 1) << 5); R = (st >> 1) * 16 + swz / 64; C = (st & 1) * 32 + (swz % 64) / 2; }
__host__ __device__ __forceinline__ int perm32(int rho) { const int n = rho >> 4, i = rho & 15; return 8 * (i >> 2) + 4 * n + (i & 3); }

struct Unit { int pm, pn; };
struct Gemm { const bf16_t* A; const bf16_t* Bt; int M, N, K, lda, ldb; };

struct StaticOrder {
    int nM, nN, nwg, G, c;
    __host__ __device__ void init(int M, int N, int G_, int c_) { nM = M / BM; nN = N / BM; nwg = nM * nN; G = G_; c = c_; }
    __host__ __device__ bool next(int i, Unit& u) const {
        const long L = (long)i * G + c; if (L >= nwg) return false;
        int wgid = (int)L; { const int q = nwg / NXCD, r = nwg % NXCD, xcd = wgid % NXCD, off = wgid / NXCD; wgid = (xcd < r ? xcd * (q + 1) : r * (q + 1) + (xcd - r) * q) + off; }
        const int nig = WGM * nN, gid = wgid / nig, fm = gid * WGM, gsz = (nM - fm) < WGM ? (nM - fm) : WGM;
        u.pm = fm + ((wgid % nig) % gsz); u.pn = (wgid % nig) / gsz; return true;
    }
    __device__ __forceinline__ void a_ready(const Unit&) const {}
    __device__ __forceinline__ void done(const Unit&) const {}
};
__device__ __forceinline__ unsigned cvt_pk_bf16(float lo, float hi) { return ::pk2(lo, hi); }
template <class Epi, class Sched, bool ALIGN_EPI = false, bool SP2 = false>
__device__ __forceinline__ void gemm_phase(PG8_LAS unsigned char* lds, const Gemm g, const Sched& S, const Epi& E) {
    int tid_ = threadIdx.x; asm volatile("" : "+v"(tid_));
    const int tid = tid_, wid = __builtin_amdgcn_readfirstlane(tid >> 6), lane = tid & 63, wr = wid >> 2, wc = wid & 3, fr = lane & 15, fq = lane >> 4;
    const int K = g.K, nt = K / BK;
    unsigned voffA[2], voffB[2];
#pragma unroll
    for (int i = 0; i < 2; ++i) { int R, C; stage_rc(tid * 16 + i * 8192, R, C); const int Rb = Epi::PERM ? ((R & ~31) + perm32(R & 31)) : R;
        voffA[i] = (unsigned)(R * g.lda + C) * 2u; voffB[i] = (unsigned)(Rb * g.ldb + C) * 2u; }
    const size_t kstep = (size_t)(BK * 2);
    const size_t hstepA = (size_t)HALF * g.lda * 2, hstepB = (size_t)HALF * g.ldb * 2;
    const size_t tstepA = 2 * hstepA, tstepB = 2 * hstepB;
    const unsigned ldsw = (unsigned)wid * 1024u;
    const int aoff = lds_byte(wr * 64 + fr, fq * 8), boff = lds_byte(wc * 32 + fr, fq * 8);
#define PG8_SA(b, h) (((b) * 2 + (h)) * HTB)
#define PG8_SB(b, h) ((4 + (b) * 2 + (h)) * HTB)
#define PG8_STAGE(bufoff, gbase, voff) do { _Pragma("unroll") for (int _i = 0; _i < 2; ++_i) \
        __builtin_amdgcn_global_load_lds((const unsigned*)((const char*)(gbase) + (voff)[_i]), (PG8_LAS unsigned*)(lds + (bufoff) + ldsw + _i * 8192), 16, 0, 0); } while (0)
#define PG8_LDA(dst, b, h) do { _Pragma("unroll") for (int m = 0; m < 4; ++m) _Pragma("unroll") for (int k = 0; k < 2; ++k) dst[m][k] = *(const PG8_LAS bf16x8*)(lds + PG8_SA(b, h) + aoff + m * 2048 + k * 1024); } while (0)
#define PG8_LDB(dst, b, h) do { _Pragma("unroll") for (int n = 0; n < 2; ++n) _Pragma("unroll") for (int k = 0; k < 2; ++k) dst[n][k] = *(const PG8_LAS bf16x8*)(lds + PG8_SB(b, h) + boff + n * 2048 + k * 1024); } while (0)
#define PG8_MMA(ai, bj, At, Bt) do { __builtin_amdgcn_s_setprio(1); _Pragma("unroll") for (int m = 0; m < 4; ++m) _Pragma("unroll") for (int n = 0; n < 2; ++n) _Pragma("unroll") for (int k = 0; k < 2; ++k) \
        acc[ai][bj][m][n] = __builtin_amdgcn_mfma_f32_16x16x32_bf16(Bt[n][k], At[m][k], acc[ai][bj][m][n], 0, 0, 0); __builtin_amdgcn_s_setprio(0); } while (0)
#define PG8_WAIT_V(n) asm volatile("s_waitcnt vmcnt(" #n ")" ::: "memory")
#define PG8_WAIT_L(n) asm volatile("s_waitcnt lgkmcnt(" #n ")" ::: "memory")
#define PG8_BAR __builtin_amdgcn_s_barrier()
#define PG8_SCHED __builtin_amdgcn_sched_barrier(0)
    Unit cur, nxt; int ui = 0;
    if (!S.next(0, cur)) return;
    f32x4 acc[2][2][4][2];
#pragma unroll
    for (int a = 0; a < 2; ++a)
#pragma unroll
        for (int b = 0; b < 2; ++b)
#pragma unroll
            for (int m = 0; m < 4; ++m)
#pragma unroll
                for (int n = 0; n < 2; ++n) acc[a][b][m][n] = (f32x4){0.f, 0.f, 0.f, 0.f};
    bf16x8 At[4][2], B0[2][2], B1[2][2];
    const char* cA = (const char*)g.A + (size_t)cur.pm * tstepA; const char* cB = (const char*)g.Bt + (size_t)cur.pn * tstepB;
    S.a_ready(cur);
    if constexpr (SP2) {
        PG8_STAGE(PG8_SB(0, 0), cB, voffB); PG8_STAGE(PG8_SB(0, 1), cB + hstepB, voffB); PG8_STAGE(PG8_SA(0, 0), cA, voffA); PG8_STAGE(PG8_SA(0, 1), cA + hstepA, voffA);
        if (wr == 1) PG8_BAR;
        PG8_WAIT_V(2); PG8_BAR;
        PG8_STAGE(PG8_SB(1, 0), cB + kstep, voffB); PG8_STAGE(PG8_SA(1, 0), cA + kstep, voffA); PG8_STAGE(PG8_SB(1, 1), cB + hstepB + kstep, voffB);
        PG8_WAIT_V(6); PG8_BAR;
    } else {
        PG8_STAGE(PG8_SB(0, 0), cB, voffB); PG8_STAGE(PG8_SA(0, 0), cA, voffA); PG8_STAGE(PG8_SB(0, 1), cB + hstepB, voffB); PG8_STAGE(PG8_SA(0, 1), cA + hstepA, voffA);
        if (wr == 1) PG8_BAR;
        PG8_WAIT_V(4); PG8_BAR;
        PG8_STAGE(PG8_SB(1, 0), cB + kstep, voffB); PG8_STAGE(PG8_SA(1, 0), cA + kstep, voffA); PG8_STAGE(PG8_SB(1, 1), cB + hstepB + kstep, voffB);
        PG8_WAIT_V(6); PG8_BAR;
    }
    for (;;) {
        const bool has_next = S.next(ui + 1, nxt);
        const char* nA = has_next ? (const char*)g.A + (size_t)nxt.pm * tstepA : cA; const char* nB = has_next ? (const char*)g.Bt + (size_t)nxt.pn * tstepB : cB;
        for (int t = 0; t < nt; t += 2) {
            const bool last = (t == nt - 2);
            const char* a1 = cA + (size_t)(t + 1) * kstep;
            const char* a2 = last ? nA : cA + (size_t)(t + 2) * kstep; const char* b2 = last ? nB : cB + (size_t)(t + 2) * kstep;
            const char* a3 = a2 + kstep; const char* b3 = b2 + kstep;
            if (last && has_next) S.a_ready(nxt);
            if constexpr (SP2) {
            PG8_LDB(B0, 0, 0); PG8_LDB(B1, 0, 1); PG8_SCHED; PG8_LDA(At, 0, 0); PG8_STAGE(PG8_SA(1, 1), a1 + hstepA, voffA);
            PG8_WAIT_V(8); PG8_WAIT_L(0); PG8_BAR; PG8_MMA(0, 0, At, B0); PG8_MMA(0, 1, At, B1); PG8_BAR; PG8_SCHED;
            PG8_LDA(At, 0, 1); PG8_STAGE(PG8_SB(0, 0), b2, voffB); PG8_STAGE(PG8_SB(0, 1), b2 + hstepB, voffB); PG8_STAGE(PG8_SA(0, 0), a2, voffA);
            PG8_WAIT_V(8); PG8_WAIT_L(0); PG8_BAR; PG8_MMA(1, 0, At, B0); PG8_MMA(1, 1, At, B1); PG8_BAR; PG8_SCHED;
            PG8_LDB(B0, 1, 0); PG8_LDB(B1, 1, 1); PG8_SCHED; PG8_LDA(At, 1, 0); PG8_STAGE(PG8_SA(0, 1), a2 + hstepA, voffA);
            PG8_WAIT_V(8); PG8_WAIT_L(0); PG8_BAR; PG8_MMA(0, 0, At, B0); PG8_MMA(0, 1, At, B1); PG8_BAR; PG8_SCHED;
            PG8_LDA(At, 1, 1); PG8_STAGE(PG8_SB(1, 0), b3, voffB); PG8_STAGE(PG8_SB(1, 1), b3 + hstepB, voffB); PG8_STAGE(PG8_SA(1, 0), a3, voffA);
            PG8_WAIT_V(8); PG8_WAIT_L(0); PG8_BAR; PG8_MMA(1, 0, At, B0); PG8_MMA(1, 1, At, B1); PG8_BAR; PG8_SCHED;
            } else {
            PG8_LDB(B0, 0, 0); PG8_SCHED; PG8_LDA(At, 0, 0); PG8_STAGE(PG8_SA(1, 1), a1 + hstepA, voffA);
            PG8_WAIT_L(8); PG8_BAR; PG8_WAIT_L(0); PG8_MMA(0, 0, At, B0); PG8_BAR; PG8_SCHED;
            PG8_LDB(B1, 0, 1); PG8_STAGE(PG8_SB(0, 0), b2, voffB);
            PG8_BAR; PG8_WAIT_L(0); PG8_MMA(0, 1, At, B1); PG8_BAR;
            PG8_LDA(At, 0, 1); PG8_STAGE(PG8_SA(0, 0), a2, voffA);
            PG8_BAR; PG8_WAIT_L(0); PG8_MMA(1, 0, At, B0); PG8_BAR; PG8_SCHED;
            PG8_STAGE(PG8_SB(0, 1), b2 + hstepB, voffB);
            PG8_WAIT_V(6); PG8_BAR; PG8_MMA(1, 1, At, B1); PG8_BAR;
            PG8_LDB(B0, 1, 0); PG8_SCHED; PG8_LDA(At, 1, 0); PG8_STAGE(PG8_SA(0, 1), a2 + hstepA, voffA);
            PG8_WAIT_L(8); PG8_BAR; PG8_WAIT_L(0); PG8_MMA(0, 0, At, B0); PG8_BAR; PG8_SCHED;
            PG8_LDB(B1, 1, 1); PG8_STAGE(PG8_SB(1, 0), b3, voffB);
            PG8_BAR; PG8_WAIT_L(0); PG8_MMA(0, 1, At, B1); PG8_BAR;
            PG8_LDA(At, 1, 1); PG8_STAGE(PG8_SA(1, 0), a3, voffA);
            PG8_BAR; PG8_WAIT_L(0); PG8_MMA(1, 0, At, B0); PG8_BAR; PG8_SCHED;
            PG8_STAGE(PG8_SB(1, 1), b3 + hstepB, voffB);
            PG8_WAIT_V(6); PG8_BAR; PG8_MMA(1, 1, At, B1); PG8_BAR;
            }
        }
        if constexpr (ALIGN_EPI) { if (wr == 0) PG8_BAR; }
        if constexpr (!Epi::AFTER_DRAIN) { E(acc, cur, wr, wc, fr, fq); S.done(cur); }
        if (!has_next) break;
#pragma unroll
        for (int a = 0; a < 2; ++a)
#pragma unroll
            for (int b = 0; b < 2; ++b)
#pragma unroll
                for (int m = 0; m < 4; ++m)
#pragma unroll
                    for (int n = 0; n < 2; ++n) acc[a][b][m][n] = (f32x4){0.f, 0.f, 0.f, 0.f};
        cur = nxt; cA = nA; cB = nB; ++ui;
        if constexpr (ALIGN_EPI) { if (wr == 1) PG8_BAR; }
    }
    PG8_WAIT_V(0);
    if constexpr (!ALIGN_EPI) { if (wr == 0) PG8_BAR; }
    PG8_BAR;
    if constexpr (Epi::AFTER_DRAIN) { E.fused(acc, cur, wr, wc, fr, fq, lds, wid, lane); S.done(cur); }
#undef PG8_SA
#undef PG8_SB
#undef PG8_STAGE
#undef PG8_LDA
#undef PG8_LDB
#undef PG8_MMA
#undef PG8_WAIT_V
#undef PG8_WAIT_L
#undef PG8_BAR
#undef PG8_SCHED
}
}

namespace pg8 {
__device__ __forceinline__ float sigmoidf_(float v) { return 1.f / (1.f + __expf(-v)); }
__device__ __forceinline__ void unpack8(const u32x4 w, float (&f)[8]) {
    f[0] = __uint_as_float(w.x << 16); f[1] = __uint_as_float(w.x & 0xffff0000u); f[2] = __uint_as_float(w.y << 16); f[3] = __uint_as_float(w.y & 0xffff0000u);
    f[4] = __uint_as_float(w.z << 16); f[5] = __uint_as_float(w.z & 0xffff0000u); f[6] = __uint_as_float(w.w << 16); f[7] = __uint_as_float(w.w & 0xffff0000u);
}
template <int MODE> struct EpiX {
    static constexpr bool PERM = true, AFTER_DRAIN = false;
    bf16_t* O; bf16_t* G; const float* xres; const float* gate; float* outf; int ldc; int pad; bf16_t* KCa; bf16_t* KCb; bf16_t* KI; bf16_t* WI;
    __device__ __forceinline__ void operator()(const f32x4 (&acc)[2][2][4][2], const Unit& u, int wr, int wc, int fr, int fq) const {
        const int row0 = u.pm * BM + wr * 64 + fr;
        int colt = u.pn * BM; bf16_t* base = O; int ld = ldc; bool sig = false;
        if (MODE == 1) { if (u.pn >= 15) { colt -= 15 * BM; base = G; ld = GW; sig = true; }
            else if (u.pn >= 10) {
#pragma unroll
                for (int ai = 0; ai < 2; ++ai)
#pragma unroll
                    for (int m = 0; m < 4; ++m) {
                        const int row = row0 + ai * HALF + m * 16, bb = row / S, ss = row % S;
#pragma unroll
                        for (int bj = 0; bj < 2; ++bj) {
                            const int c = wc * 32 + 8 * fq + bj * HALF;
                            const f32x4 v0 = acc[ai][bj][m][0], v1 = acc[ai][bj][m][1];
                            u32x4 w; w.x = cvt_pk_bf16(v0[0], v0[1]); w.y = cvt_pk_bf16(v0[2], v0[3]); w.z = cvt_pk_bf16(v1[0], v1[1]); w.w = cvt_pk_bf16(v1[2], v1[3]);
                            if (u.pn < 14) { const int cc = ((u.pn - 10) & 1) * BM + c; bf16_t* kc = (u.pn < 12) ? KCa : KCb;
                                *(u32x4*)(kc + ((size_t)(bb * 8 + (cc >> 6)) * S + ss) * 64 + (cc & 63)) = w; }
                            else if (c < 64) *(u32x4*)(KI + (size_t)row * 64 + c) = w;
                            else if (c == 64) *(u32x4*)(WI + (size_t)row * 8) = w;
                        }
                    }
                return;
            } }
        if (MODE == 2 || MODE == 3) { base = G; ld = GW; }
        const int col0 = colt + wc * 32 + 8 * fq;
#pragma unroll
        for (int ai = 0; ai < 2; ++ai)
#pragma unroll
            for (int m = 0; m < 4; ++m) {
                const int row = row0 + ai * HALF + m * 16;
#pragma unroll
                for (int bj = 0; bj < 2; ++bj) {
                    const int col = col0 + bj * HALF;
                    f32x4 v0 = acc[ai][bj][m][0], v1 = acc[ai][bj][m][1];
                    if (MODE == 4) {
                        const size_t o = (size_t)row * 1024 + col;
                        const f32x4 x0 = __builtin_nontemporal_load((const f32x4*)(xres + o)), x1 = __builtin_nontemporal_load((const f32x4*)(xres + o + 4));
                        const float* gp = gate + (row / S) * 6144 + col;
                        const f32x4 g0 = *(const f32x4*)gp, g1 = *(const f32x4*)(gp + 4);
                        *(f32x4*)(outf + o) = x0 + g0 * v0; *(f32x4*)(outf + o + 4) = x1 + g1 * v1;
                    } else {
                        bf16_t* pp = base + (size_t)row * ld + col;
                        if (MODE == 1) { if (sig) {
#pragma unroll
                            for (int e = 0; e < 4; ++e) { v0[e] = sigmoidf_(v0[e]); v1[e] = sigmoidf_(v1[e]); } } }
                        if (MODE == 2) { float t[8]; unpack8(*(const u32x4*)pp, t);
#pragma unroll
                            for (int e = 0; e < 4; ++e) { v0[e] *= t[e]; v1[e] *= t[4 + e]; } }
                        if (MODE == 3) { float t[8], gg[8]; unpack8(*(const u32x4*)pp, t); unpack8(*(const u32x4*)(pp + 1024), gg);
#pragma unroll
                            for (int e = 0; e < 4; ++e) { v0[e] = t[e] + gg[e] * v0[e]; v1[e] = t[4 + e] + gg[4 + e] * v1[e]; } }
                        u32x4 w; w.x = cvt_pk_bf16(v0[0], v0[1]); w.y = cvt_pk_bf16(v0[2], v0[3]); w.z = cvt_pk_bf16(v1[0], v1[1]); w.w = cvt_pk_bf16(v1[2], v1[3]);
                        *(u32x4*)pp = w;
                    }
                }
            }
    }
};
}
struct Params {
    const float *x, *c, *w_ada, *b_ada, *g1, *g2, *w_in, *rel_bias, *wpa, *wpb, *wout, *wq, *sk, *pu, *pv, *fg;
    float* out; unsigned char* ws;
};
__device__ __forceinline__ int opaque_tid() { int t = threadIdx.x; asm volatile("" : "+v"(t)); return t; }
typedef unsigned v4u __attribute__((ext_vector_type(4)));
#define LDS_WAIT() asm volatile("s_waitcnt lgkmcnt(0)" ::: "memory")

constexpr size_t WS_BAR = 0;
constexpr size_t CTL_ZERO_BYTES = 16384;
constexpr size_t WS_MOD = 64 * 1024;
constexpr size_t WS_WIN = 1 * MiB;
constexpr size_t WS_WPA = 13 * MiB, WS_WPB = 14 * MiB;
constexpr size_t WS_WOUT = 15 * MiB;
constexpr size_t WS_WQ = 17 * MiB;
constexpr size_t WS_PROJ = 22 * MiB;
constexpr size_t WS_KCA = 102 * MiB, WS_KCB = 118 * MiB;
constexpr size_t WS_KI = 134 * MiB, WS_WI = 136 * MiB;
constexpr size_t WS_G = 142 * MiB;
constexpr size_t WS_YA = 206 * MiB, WS_YB = 222 * MiB;
constexpr size_t WS_HN2 = 22 * MiB;
constexpr size_t WS_QH = 54 * MiB;
constexpr size_t WS_SKB = 21 * MiB;
constexpr size_t WS_EIDX = 118 * MiB;
constexpr size_t WS_GATE = 122 * MiB;
constexpr size_t WS_TAB = 130 * MiB;
constexpr size_t WS_SCALES = 162 * MiB;
constexpr size_t WS_VT = 238 * MiB;
constexpr size_t WS_NEED = 254 * MiB;
constexpr int LDS_SC_OFF = 7 * 16384 + 8448;

__device__ __forceinline__ void ph_mod(const Params& p, float* mod, float* sc) {
    float* part = sc + 2048;
    const int tid = threadIdx.x, kk = tid >> 3, cc = tid & 7;
    for (int i = tid; i < 2048; i += NTHR) { float v = p.c[i]; sc[i] = v / (1.f + expf(-v)); }
    __syncthreads();
    for (int unit = blockIdx.x; unit < 6144 / 24; unit += gridDim.x) {
        const int col = unit * 24 + 3 * cc;
        float a[2][3] = {{0.f, 0.f, 0.f}, {0.f, 0.f, 0.f}};
#pragma unroll 4
        for (int k = kk; k < 1024; k += 64) {
            const float* w = p.w_ada + (size_t)k * 6144 + col;
            const float w0 = __builtin_nontemporal_load(w), w1 = __builtin_nontemporal_load(w + 1), w2 = __builtin_nontemporal_load(w + 2), s0 = sc[k], s1 = sc[1024 + k];
            a[0][0] += s0 * w0; a[0][1] += s0 * w1; a[0][2] += s0 * w2; a[1][0] += s1 * w0; a[1][1] += s1 * w1; a[1][2] += s1 * w2;
        }
#pragma unroll
        for (int b = 0; b < 2; ++b)
#pragma unroll
            for (int j = 0; j < 3; ++j) part[kk * 48 + b * 24 + 3 * cc + j] = a[b][j];
        __syncthreads();
        if (tid < 48) { float s = 0.f; for (int q = 0; q < 64; ++q) s += part[q * 48 + tid]; const int b = tid / 24, j = unit * 24 + tid % 24; mod[b * 6144 + j] = s + p.b_ada[j]; }
        __syncthreads();
    }
}

template <class CM> __device__ __forceinline__ void transpose_item(const float* W, int ldw, int K, bf16* WT, LAS float* scr, int item, int nblk, int lane, const CM& cm) {
    const int kb = item / nblk, nb = item % nblk, k0 = 64 * kb, n0 = 32 * nb;
    const int sc = cm(n0 + (lane & 31));
#pragma unroll 8
    for (int i = 0; i < 32; ++i) { const int kk = 2 * i + (lane >> 5); scr[kk * 33 + (lane & 31)] = (sc >= 0) ? __builtin_nontemporal_load(W + (size_t)(k0 + kk) * ldw + sc) : 0.f; }
    LDS_WAIT(); asm volatile("" ::: "memory");
    const int c = lane & 7;
#pragma unroll
    for (int j = 0; j < 4; ++j) { const int n = (lane >> 3) + 8 * j; const LAS float* s = scr + (8 * c) * 33 + n;
        v4u o; o.x = pk2(s[0 * 33], s[1 * 33]); o.y = pk2(s[2 * 33], s[3 * 33]); o.z = pk2(s[4 * 33], s[5 * 33]); o.w = pk2(s[6 * 33], s[7 * 33]);
        *(v4u*)(WT + (size_t)(n0 + n) * K + k0 + 8 * c) = o; }
    LDS_WAIT(); asm volatile("" ::: "memory");
}
struct CmIdent { __device__ __forceinline__ int operator()(int n) const { return n; } };
struct CmWin {
    __device__ __forceinline__ int operator()(int n) const {
        if (n < 512) return n;
        if (n < 1024) return 1024 + (n - 512);
        if (n < 1536) return 1536 + (n - 1024);
        if (n < 2048) return 2120 + (n - 1536);
        if (n < 2560) return 3144 + (n - 2048);
        if (n < 3072) return 512 + (n - 2560);
        if (n < 3584) return 2632 + (n - 3072);
        if (n < 3648) return 2048 + (n - 3584);
        if (n < 3656) return 2112 + (n - 3648);
        if (n < 3840) return -1;
        return 3656 + (n - 3840);
    }
};
__device__ __forceinline__ void ph_weights(const Params& p, LAS unsigned char* lds) {
    unsigned char* ws = p.ws;
    const int wave = __builtin_amdgcn_readfirstlane(threadIdx.x >> 6), lane = threadIdx.x & 63;
    LAS float* scr = (LAS float*)(lds + wave * 16384);
    const int gw = blockIdx.x * NWAVES + wave, NGW = gridDim.x * NWAVES;
    constexpr int I_IN = 16 * (NPROJ / 32), I_PA = 8 * 32, I_PB = 8 * 32, I_OUT = 16 * 32, I_Q = 16 * 64;
    constexpr int NITEMS = I_IN + I_PA + I_PB + I_OUT + I_Q;
    for (int it = gw; it < NITEMS; it += NGW) {
        int r = it;
        if (r < I_IN) { transpose_item(p.w_in, INW, 1024, (bf16*)(ws + WS_WIN), scr, r, NPROJ / 32, lane, CmWin()); continue; } r -= I_IN;
        if (r < I_PA) { transpose_item(p.wpa, 1024, 512, (bf16*)(ws + WS_WPA), scr, r, 32, lane, CmIdent()); continue; } r -= I_PA;
        if (r < I_PB) { transpose_item(p.wpb, 1024, 512, (bf16*)(ws + WS_WPB), scr, r, 32, lane, CmIdent()); continue; } r -= I_PB;
        if (r < I_OUT) { transpose_item(p.wout, 1024, 1024, (bf16*)(ws + WS_WOUT), scr, r, 32, lane, CmIdent()); continue; } r -= I_OUT;
        transpose_item(p.wq, 2048, 1024, (bf16*)(ws + WS_WQ), scr, r, 64, lane, CmIdent());
    }
    for (int i = gw * 64 + lane; i < 8 * 2 * 128 * 128 / 4; i += NGW * 64) {
        const float4 v = ((const float4*)p.sk)[i]; uint2 w; w.x = pk2(v.x, v.y); w.y = pk2(v.z, v.w); ((uint2*)(ws + WS_SKB))[i] = w;
    }
}

template <bool NT> __device__ __forceinline__ void ph_norm(const float* src, const float* g, const float* mod, int shift_i, int scale_i, bf16* dst) {
    const int lane = threadIdx.x & 63, gw = blockIdx.x * NWAVES + __builtin_amdgcn_readfirstlane(threadIdx.x >> 6), ngw = gridDim.x * NWAVES;
    for (int t = gw; t < T; t += ngw) {
        const int b = t / S;
        float4 v[4]; float ss = 0.f;
#pragma unroll
        for (int i = 0; i < 4; ++i) { const f32x4_t t_ = NT ? __builtin_nontemporal_load((const f32x4_t*)(src + (size_t)t * D) + lane + 64 * i) : *((const f32x4_t*)(src + (size_t)t * D) + lane + 64 * i); v[i] = make_float4(t_.x, t_.y, t_.z, t_.w); ss += v[i].x * v[i].x + v[i].y * v[i].y + v[i].z * v[i].z + v[i].w * v[i].w; }
        ss = wave_sum(ss);
        const float r = rsqrtf(ss * (1.f / D) + EPS);
#pragma unroll
        for (int i = 0; i < 4; ++i) {
            const float4 gg = ((const float4*)g)[lane + 64 * i];
            const float4 sh = ((const float4*)(mod + b * 6144 + shift_i * D))[lane + 64 * i];
            const float4 sc = ((const float4*)(mod + b * 6144 + scale_i * D))[lane + 64 * i];
            float4 o;
            o.x = v[i].x * r * gg.x * (1.f + sc.x) + sh.x; o.y = v[i].y * r * gg.y * (1.f + sc.y) + sh.y;
            o.z = v[i].z * r * gg.z * (1.f + sc.z) + sh.z; o.w = v[i].w * r * gg.w * (1.f + sc.w) + sh.w;
            uint2 w; w.x = pk2(o.x, o.y); w.y = pk2(o.z, o.w);
            ((uint2*)(dst + (size_t)t * D))[lane + 64 * i] = w;
        }
    }
}
__device__ __forceinline__ unsigned f2ord(float f) { unsigned u = __float_as_uint(f); return (u & 0x80000000u) ? ~u : (u | 0x80000000u); }
__device__ __forceinline__ int t5_bucket(int n) {
    if (n < 16) return n;
    int large = 16 + (int)(logf((float)n * (1.f / 16.f)) / 2.0794415416798357f * 16.f);
    return large < 31 ? large : 31;
}

typedef short bf16x8_t __attribute__((ext_vector_type(8)));
template <int CTRL> __device__ __forceinline__ unsigned dppu(unsigned x) { return (unsigned)__builtin_amdgcn_mov_dpp((int)x, CTRL, 0xf, 0xf, true); }
template <int CTRL> __device__ __forceinline__ float dppf(float x) { return __builtin_bit_cast(float, __builtin_amdgcn_mov_dpp(__builtin_bit_cast(int, x), CTRL, 0xf, 0xf, true)); }
__device__ __forceinline__ unsigned row_max_u(unsigned x) { x = max(x, dppu<0xB1>(x)); x = max(x, dppu<0x4E>(x)); x = max(x, dppu<0x141>(x)); x = max(x, dppu<0x128>(x)); return x; }
__device__ __forceinline__ float row_max_f(float x) { x = fmaxf(x, dppf<0xB1>(x)); x = fmaxf(x, dppf<0x4E>(x)); x = fmaxf(x, dppf<0x141>(x)); x = fmaxf(x, dppf<0x128>(x)); return x; }
__device__ __forceinline__ float row_sum_f(float x) { x += dppf<0xB1>(x); x += dppf<0x4E>(x); x += dppf<0x141>(x); x += dppf<0x128>(x); return x; }
__device__ __forceinline__ float ord2f(unsigned k) { return __uint_as_float((k & 0x80000000u) ? (k & 0x7fffffffu) : ~k); }
__device__ __forceinline__ unsigned max3u(unsigned a, unsigned b, unsigned c) { return max(max(a, b), c); }

__device__ __forceinline__ void ph_quant(const Params& p, unsigned char* tab, float* scales) {
    const int lane = threadIdx.x & 63, gw = blockIdx.x * NWAVES + __builtin_amdgcn_readfirstlane(threadIdx.x >> 6), ngw = gridDim.x * NWAVES;
    for (int r = gw; r < 32768; r += ngw) {
        const float* src = (r < 16384) ? p.pu + (size_t)r * D : p.pv + (size_t)(r - 16384) * D;
        float4 v[4]; float am = 0.f;
#pragma unroll
        for (int i = 0; i < 4; ++i) { const f32x4_t t_ = __builtin_nontemporal_load((const f32x4_t*)src + lane + 64 * i); v[i] = make_float4(t_.x, t_.y, t_.z, t_.w);     am = fmaxf(am, fmaxf(fmaxf(fabsf(v[i].x), fabsf(v[i].y)), fmaxf(fabsf(v[i].z), fabsf(v[i].w)))); }
#pragma unroll
        for (int o = 1; o < 64; o <<= 1) am = fmaxf(am, __shfl_xor(am, o));
        const float inv = am > 0.f ? 127.f / am : 0.f;
        uint4 w; unsigned* wp = (unsigned*)&w;
#pragma unroll
        for (int i = 0; i < 4; ++i) {
            const int q0 = (int)rintf(v[i].x * inv) + 128, q1 = (int)rintf(v[i].y * inv) + 128, q2 = (int)rintf(v[i].z * inv) + 128, q3 = (int)rintf(v[i].w * inv) + 128;
            wp[i] = (unsigned)q0 | ((unsigned)q1 << 8) | ((unsigned)q2 << 16) | ((unsigned)q3 << 24);
        }
        ((uint4*)(tab + (size_t)r * 1024))[lane] = w;
        if (lane == 0) scales[r] = am * (1.f / 127.f);
    }
}

#define CE_DESC(x, y) do { const unsigned hi_ = max(x, y), lo_ = min(x, y); x = hi_; y = lo_; } while (0)
__device__ __forceinline__ int hull_ab(int c) {
    int a = 0, base = 0; bool done = false;
#pragma unroll
    for (int aa = 0; aa < 16; ++aa) { const int nb = 16 / (aa + 1); if (!done) { if (c >= base + nb) { base += nb; a = aa + 1; } else done = true; } }
    return (c < 50) ? ((a << 4) | (c - base)) : -1;
}
__device__ __forceinline__ void ph_peer_select(const bf16* qh, const bf16* skb, unsigned short* eidx, float* gate) {
    const int tid = opaque_tid();
    const int lane = tid & 63, fr = lane & 15, fq = lane >> 4;
    const int gw = blockIdx.x * NWAVES + __builtin_amdgcn_readfirstlane(tid >> 6), ngw = gridDim.x * NWAVES;
    int hab[4];
#pragma unroll
    for (int s = 0; s < 4; ++s) hab[s] = hull_ab(16 * s + fr);
    for (int unit = gw; unit < (T / 16) * 2; unit += ngw) {
        const int t0 = (unit >> 1) * 16, hh = unit & 1;
#pragma unroll 1
        for (int hi = 0; hi < 4; ++hi) {
            const int h = hh * 4 + hi;
            unsigned win[2][4];
#pragma unroll
            for (int c = 0; c < 2; ++c) {
                f32x4_t acc[8];
#pragma unroll
                for (int nt = 0; nt < 8; ++nt) acc[nt] = (f32x4_t){0.f, 0.f, 0.f, 0.f};
                const bf16* qrow = qh + (size_t)(t0 + fr) * 2048 + h * 256 + c * 128 + 8 * fq;
                bf16x8_t a[4];
#pragma unroll
                for (int ks = 0; ks < 4; ++ks) a[ks] = *(const bf16x8_t*)(qrow + 32 * ks);
                const bf16* kb = skb + ((size_t)(h * 2 + c) * 128 + fr) * 128 + 8 * fq;
#pragma unroll
                for (int nt = 0; nt < 8; ++nt)
#pragma unroll
                    for (int ks = 0; ks < 4; ++ks) { const bf16x8_t b = *(const bf16x8_t*)(kb + (size_t)nt * 16 * 128 + 32 * ks); acc[nt] = __builtin_amdgcn_mfma_f32_16x16x32_bf16(a[ks], b, acc[nt], 0, 0, 0); }
                unsigned pk[8][4];
#pragma unroll
                for (int nt = 0; nt < 8; ++nt)
#pragma unroll
                    for (int i = 0; i < 4; ++i) pk[nt][i] = (f2ord(acc[nt][i]) & ~127u) | (127u - (unsigned)(16 * nt + fr));
#pragma unroll
                for (int i = 0; i < 4; ++i) {
                    CE_DESC(pk[0][i], pk[1][i]); CE_DESC(pk[2][i], pk[3][i]); CE_DESC(pk[4][i], pk[5][i]); CE_DESC(pk[6][i], pk[7][i]);
                    CE_DESC(pk[0][i], pk[2][i]); CE_DESC(pk[1][i], pk[3][i]); CE_DESC(pk[4][i], pk[6][i]); CE_DESC(pk[5][i], pk[7][i]);
                    CE_DESC(pk[1][i], pk[2][i]); CE_DESC(pk[5][i], pk[6][i]);
                    CE_DESC(pk[0][i], pk[4][i]); CE_DESC(pk[1][i], pk[5][i]); CE_DESC(pk[2][i], pk[6][i]); CE_DESC(pk[3][i], pk[7][i]);
                    CE_DESC(pk[2][i], pk[4][i]); CE_DESC(pk[3][i], pk[5][i]);
                    CE_DESC(pk[1][i], pk[2][i]); CE_DESC(pk[3][i], pk[4][i]); CE_DESC(pk[5][i], pk[6][i]);
                }
#pragma unroll
                for (int r = 0; r < 16; ++r)
#pragma unroll
                    for (int i = 0; i < 4; ++i) {
                        const unsigned m = row_max_u(pk[0][i]);
                        if (fr == r) win[c][i] = m;
                        const bool w = pk[0][i] == m;
#pragma unroll
                        for (int nt = 0; nt < 7; ++nt) if (nt <= 14 - r) pk[nt][i] = w ? pk[nt + 1][i] : pk[nt][i];
                        if (7 <= 14 - r) pk[7][i] = w ? 0u : pk[7][i];
                    }
            }
#pragma unroll
            for (int i = 0; i < 4; ++i) {
                unsigned ck[4];
#pragma unroll
                for (int s = 0; s < 4; ++s) {
                    const int ab = hab[s] < 0 ? 0 : hab[s];
                    const unsigned wa = (unsigned)__shfl((int)win[0][i], (lane & 48) + (ab >> 4)), wb = (unsigned)__shfl((int)win[1][i], (lane & 48) + (ab & 15));
                    const float v = ord2f(wa & ~127u) + ord2f(wb & ~127u);
                    ck[s] = hab[s] < 0 ? 0u : ((f2ord(v) & ~255u) | (255u - (unsigned)ab));
                }
                CE_DESC(ck[0], ck[1]); CE_DESC(ck[2], ck[3]); CE_DESC(ck[0], ck[2]); CE_DESC(ck[1], ck[3]); CE_DESC(ck[1], ck[2]);
                unsigned mywin = 0u;
#pragma unroll
                for (int r = 0; r < 16; ++r) {
                    const unsigned m = row_max_u(ck[0]);
                    if (fr == r) mywin = m;
                    const bool w = ck[0] == m;
                    if (r < 15) { ck[0] = w ? ck[1] : ck[0]; ck[1] = w ? ck[2] : ck[1]; ck[2] = w ? ck[3] : ck[2]; ck[3] = w ? 0u : ck[3]; }
                }
                const unsigned ci = 255u - (mywin & 255u);
                const unsigned w0 = (unsigned)__shfl((int)win[0][i], (lane & 48) + (int)(ci >> 4)), w1 = (unsigned)__shfl((int)win[1][i], (lane & 48) + (int)(ci & 15u));
                const int e = (int)(127u - (w0 & 127u)) * 128 + (int)(127u - (w1 & 127u));
                const float s = ord2f(w0 & ~127u) + ord2f(w1 & ~127u);
                const float mx = row_max_f(s);
                const float ex = __expf(s - mx);
                const float sum = row_sum_f(ex);
                const int t = t0 + 4 * fq + i;
                eidx[(size_t)t * 128 + h * 16 + fr] = (unsigned short)e;
                gate[(size_t)t * 128 + h * 16 + fr] = ex / sum;
            }
        }
    }
}

__device__ __forceinline__ float wave_total_dpp(float x) {
    x = row_sum_f(x);
    return __builtin_bit_cast(float, __builtin_amdgcn_readlane(__builtin_bit_cast(int, x), 0)) + __builtin_bit_cast(float, __builtin_amdgcn_readlane(__builtin_bit_cast(int, x), 16)) +
           __builtin_bit_cast(float, __builtin_amdgcn_readlane(__builtin_bit_cast(int, x), 32)) + __builtin_bit_cast(float, __builtin_amdgcn_readlane(__builtin_bit_cast(int, x), 48));
}
__device__ __forceinline__ float gelu_erf(float x) { return 0.5f * x * (1.f + erff(x * 0.70710678118654752f)); }
__device__ __forceinline__ void ph_peer_gather(const Params& p, const bf16* hn2, const unsigned short* eidx, const float* gate, const unsigned char* tab, const float* scales, const float* mod, const float* xin, float* xout) {
    const int tid = opaque_tid();
    const int lane = tid & 63, gw = blockIdx.x * NWAVES + __builtin_amdgcn_readfirstlane(tid >> 6), ngw = gridDim.x * NWAVES;
    const unsigned char* utab = tab; const unsigned char* vtab = tab + (size_t)16384 * 1024;
    for (int t = gw; t < T; t += ngw) {
        const int b = t / S;
        float hv[16]; float hs = 0.f;
#pragma unroll
        for (int i = 0; i < 4; ++i) { const uint2 w = ((const uint2*)(hn2 + (size_t)t * D))[lane + 64 * i];
            hv[4 * i + 0] = __uint_as_float(w.x << 16); hv[4 * i + 1] = __uint_as_float(w.x & 0xffff0000u); hv[4 * i + 2] = __uint_as_float(w.y << 16); hv[4 * i + 3] = __uint_as_float(w.y & 0xffff0000u);
            hs += (hv[4 * i] + hv[4 * i + 1]) + (hv[4 * i + 2] + hv[4 * i + 3]); }
        hs = wave_total_dpp(hs);
        const int e0 = eidx[(size_t)t * 128 + lane], e1 = eidx[(size_t)t * 128 + 64 + lane];
        const float g0 = gate[(size_t)t * 128 + lane], g1 = gate[(size_t)t * 128 + 64 + lane];
        float pre0 = 0.f, pre1 = 0.f;
#pragma unroll
        for (int half = 0; half < 2; ++half) {
            const int ev = half ? e1 : e0;
            float pre = 0.f;
#pragma unroll 8
            for (int j = 0; j < 64; ++j) {
                const int e = __builtin_amdgcn_readlane(ev, j);
                const uint4 w = ((const uint4*)(utab + (size_t)e * 1024))[lane];
                const unsigned ww[4] = {w.x, w.y, w.z, w.w};
                float d = 0.f;
#pragma unroll
                for (int i = 0; i < 4; ++i) {
                    d += hv[4 * i + 0] * (float)(ww[i] & 0xffu); d += hv[4 * i + 1] * (float)((ww[i] >> 8) & 0xffu);
                    d += hv[4 * i + 2] * (float)((ww[i] >> 16) & 0xffu); d += hv[4 * i + 3] * (float)(ww[i] >> 24);
                }
                d = wave_total_dpp(d);
                pre = (lane == j) ? d : pre;
            }
            if (half) pre1 = pre; else pre0 = pre;
        }
        const float c0 = g0 * gelu_erf(scales[e0] * (pre0 - 128.f * hs)) * scales[16384 + e0];
        const float c1 = g1 * gelu_erf(scales[e1] * (pre1 - 128.f * hs)) * scales[16384 + e1];
        const float corr = 128.f * wave_total_dpp(c0 + c1);
        float acc[16];
#pragma unroll
        for (int i = 0; i < 16; ++i) acc[i] = 0.f;
#pragma unroll
        for (int half = 0; half < 2; ++half) {
            const int ev = half ? e1 : e0; const float cv = half ? c1 : c0;
#pragma unroll 8
            for (int j = 0; j < 64; ++j) {
                const int e = __builtin_amdgcn_readlane(ev, j);
                const float cf = __builtin_bit_cast(float, __builtin_amdgcn_readlane(__builtin_bit_cast(int, cv), j));
                const uint4 w = ((const uint4*)(vtab + (size_t)e * 1024))[lane];
                const unsigned ww[4] = {w.x, w.y, w.z, w.w};
#pragma unroll
                for (int i = 0; i < 4; ++i) {
                    acc[4 * i + 0] += cf * (float)(ww[i] & 0xffu); acc[4 * i + 1] += cf * (float)((ww[i] >> 8) & 0xffu);
                    acc[4 * i + 2] += cf * (float)((ww[i] >> 16) & 0xffu); acc[4 * i + 3] += cf * (float)(ww[i] >> 24);
                }
            }
        }
        float xv[16]; float ss = 0.f;
#pragma unroll
        for (int i = 0; i < 4; ++i) {
            const float4 g2 = ((const float4*)(mod + b * 6144 + 5 * D))[lane + 64 * i];
            const float4 x = ((const float4*)(xin + (size_t)t * D))[lane + 64 * i];
            xv[4 * i + 0] = x.x + g2.x * (acc[4 * i + 0] - corr); xv[4 * i + 1] = x.y + g2.y * (acc[4 * i + 1] - corr);
            xv[4 * i + 2] = x.z + g2.z * (acc[4 * i + 2] - corr); xv[4 * i + 3] = x.w + g2.w * (acc[4 * i + 3] - corr);
            ss += (xv[4 * i] * xv[4 * i] + xv[4 * i + 1] * xv[4 * i + 1]) + (xv[4 * i + 2] * xv[4 * i + 2] + xv[4 * i + 3] * xv[4 * i + 3]);
        }
        ss = wave_total_dpp(ss);
        const float r = rsqrtf(ss * (1.f / D) + EPS);
#pragma unroll
        for (int i = 0; i < 4; ++i) {
            const float4 gg = ((const float4*)p.fg)[lane + 64 * i];
            float4 o; o.x = xv[4 * i + 0] * r * gg.x; o.y = xv[4 * i + 1] * r * gg.y; o.z = xv[4 * i + 2] * r * gg.z; o.w = xv[4 * i + 3] * r * gg.w;
            ((float4*)(xout + (size_t)t * D))[lane + 64 * i] = o;
        }
    }
}

__device__ __forceinline__ void ph_vt(const bf16* proj, int voff, bf16* VT) {
    const int lane = threadIdx.x & 63, gw = blockIdx.x * NWAVES + __builtin_amdgcn_readfirstlane(threadIdx.x >> 6), ngw = gridDim.x * NWAVES;
    for (int u = gw; u < NB * 8 * (S / 64); u += ngw) {
        const int sb = u & 127, h = (u >> 7) & 7, b = u >> 10;
        const bf16* src = proj + (size_t)(b * S + sb * 64) * PW + voff + h * 64 + lane;
        bf16* dst = VT + (((size_t)(b * 8 + h) * (S / 32) + 2 * sb) * 64 + lane) * 32;
        unsigned short e[64];
#pragma unroll
        for (int j = 0; j < 64; ++j) e[j] = src[(size_t)j * PW];
#pragma unroll
        for (int blk = 0; blk < 2; ++blk)
#pragma unroll
            for (int q4 = 0; q4 < 4; ++q4) {
                const int a = 32 * blk + 4 * q4, c = a + 16;
                v4u o; o.x = e[a] | ((unsigned)e[a + 1] << 16); o.y = e[a + 2] | ((unsigned)e[a + 3] << 16); o.z = e[c] | ((unsigned)e[c + 1] << 16); o.w = e[c + 2] | ((unsigned)e[c + 3] << 16);
                *(v4u*)(dst + blk * 64 * 32 + 8 * q4) = o;
            }
    }
}
__device__ __forceinline__ void ph_stick2(const bf16* proj, const bf16* KC, const bf16* VT, bf16* yb) {
    const int tid = opaque_tid();
    const int lane = tid & 63, fr = lane & 15, fq = lane >> 4;
    const int gw = blockIdx.x * NWAVES + __builtin_amdgcn_readfirstlane(tid >> 6), ngw = gridDim.x * NWAVES;
    for (int u = gw; u < (T / 16) * 8; u += ngw) {
        const int h = (u >> 3) & 7, t0 = ((((u >> 6) << 3) | (u & 7))) * 16, b = t0 / S, tl0 = t0 % S;
        const int qpos = tl0 + fr;
        bf16x8_t bq[2];
        { const bf16* qrow = proj + (size_t)(t0 + fr) * PW + OFF_QB + 64 * h + 8 * fq; bq[0] = *(const bf16x8_t*)qrow; bq[1] = *(const bf16x8_t*)(qrow + 32); }
        f32x4_t acc[4];
#pragma unroll
        for (int dt = 0; dt < 4; ++dt) acc[dt] = (f32x4_t){0.f, 0.f, 0.f, 0.f};
        float carry = 0.f;
        const bf16* vtb = VT + ((size_t)(b * 8 + h) * (S / 32) * 64 + fr) * 32 + 8 * fq;
        const bf16* kbase = KC + ((size_t)(b * 8 + h) * S + fr) * 64 + 8 * fq;
        int kb = (tl0 + 15) >> 5;
        bf16x8_t nk[2][2]; v4u nv[4];
#pragma unroll
        for (int tile = 0; tile < 2; ++tile) { const bf16* kr = kbase + (size_t)(32 * kb + 16 * tile) * 64; nk[tile][0] = *(const bf16x8_t*)kr; nk[tile][1] = *(const bf16x8_t*)(kr + 32); }
#pragma unroll
        for (int dt = 0; dt < 4; ++dt) { const bf16* vr = vtb + (size_t)kb * 2048 + (16 * dt) * 32; nv[dt] = *(const v4u*)vr; }
        for (; kb >= 0; --kb) {
            bf16x8_t ck[2][2]; v4u cv[4];
#pragma unroll
            for (int tile = 0; tile < 2; ++tile) { ck[tile][0] = nk[tile][0]; ck[tile][1] = nk[tile][1]; }
#pragma unroll
            for (int dt = 0; dt < 4; ++dt) cv[dt] = nv[dt];
            { const int kbn = kb > 0 ? kb - 1 : 0;
#pragma unroll
              for (int tile = 0; tile < 2; ++tile) { const bf16* kr = kbase + (size_t)(32 * kbn + 16 * tile) * 64; nk[tile][0] = *(const bf16x8_t*)kr; nk[tile][1] = *(const bf16x8_t*)(kr + 32); }
#pragma unroll
              for (int dt = 0; dt < 4; ++dt) { const bf16* vr = vtb + (size_t)kbn * 2048 + (16 * dt) * 32; nv[dt] = *(const v4u*)vr; } }
            unsigned pw[4] = {0u, 0u, 0u, 0u};
#pragma unroll
            for (int tile = 1; tile >= 0; --tile) {
                const int k0 = 32 * kb + 16 * tile;
                if (k0 > tl0 + 14) continue;
                f32x4_t st = (f32x4_t){0.f, 0.f, 0.f, 0.f};
                st = __builtin_amdgcn_mfma_f32_16x16x32_bf16(ck[tile][0], bq[0], st, 0, 0, 0);
                st = __builtin_amdgcn_mfma_f32_16x16x32_bf16(ck[tile][1], bq[1], st, 0, 0, 0);
                float lb[4], l1m[4];
#pragma unroll
                for (int i = 0; i < 4; ++i) {
                    const float z = st[i] * 0.18033688011112042f;
                    const bool valid = (k0 + 4 * fq + i) < qpos;
                    const float sp = fmaxf(-z, 0.f) + __builtin_amdgcn_logf(1.f + __builtin_amdgcn_exp2f(-fabsf(z)));
                    lb[i] = valid ? -sp : -INFINITY;
                    l1m[i] = valid ? (-sp - z) : 0.f;
                }
                const float e2 = l1m[3], e1 = e2 + l1m[2], e0 = e1 + l1m[1], gsum = e0 + l1m[0];
                const float a1 = __shfl(gsum, (lane + 16) & 63), a2 = __shfl(gsum, (lane + 32) & 63), a3 = __shfl(gsum, (lane + 48) & 63);
                const float above = (fq < 3 ? a1 : 0.f) + (fq < 2 ? a2 : 0.f) + (fq < 1 ? a3 : 0.f);
                const float base = carry + above;
                const float w0 = __builtin_amdgcn_exp2f(lb[0] + base + e0), w1 = __builtin_amdgcn_exp2f(lb[1] + base + e1), w2 = __builtin_amdgcn_exp2f(lb[2] + base + e2), w3 = __builtin_amdgcn_exp2f(lb[3] + base);
                carry += (gsum + a1) + (a2 + a3);
                pw[2 * tile] = pk2(w0, w1); pw[2 * tile + 1] = pk2(w2, w3);
            }
            bf16x8_t pb;
            { v4u t; t.x = pw[0]; t.y = pw[1]; t.z = pw[2]; t.w = pw[3]; pb = __builtin_bit_cast(bf16x8_t, t); }
#pragma unroll
            for (int dt = 0; dt < 4; ++dt) {
                acc[dt] = __builtin_amdgcn_mfma_f32_16x16x32_bf16(__builtin_bit_cast(bf16x8_t, cv[dt]), pb, acc[dt], 0, 0, 0);
            }
            if (__all(carry < -173.2f)) break;
        }
#pragma unroll
        for (int dt = 0; dt < 4; ++dt) {
            uint2 o; o.x = pk2(acc[dt][0], acc[dt][1]); o.y = pk2(acc[dt][2], acc[dt][3]);
            *(uint2*)(yb + (size_t)(t0 + fr) * 512 + 64 * h + 16 * dt + 4 * fq) = o;
        }
    }
}

constexpr int IQB = 32, ICAPN = 704, ICAP = 705  , ITRIG = ICAPN - 128, ILOW = 352;
constexpr int LDS_IKEY = 0, LDS_IIDX = IQB * ICAP * 4, LDS_ICNT = ((LDS_IIDX + IQB * ICAP * 2 + 15) / 16) * 16, LDS_ITHR = LDS_ICNT + IQB * 4, LDS_IROW = LDS_ITHR + IQB * 4;
static_assert(LDS_IROW + NWAVES * 1024 <= LDS_BYTES - 16, "indexer LDS map");
__device__ __forceinline__ int wave_count(bool pred) { return __popcll(__ballot(pred)); }
__device__ __forceinline__ int index_keep(int nseen, int ntot) {
    const float f = (float)nseen / (float)ntot, a = (float)(ntot - nseen) / (float)nseen;
    const float s = 2.25f * sqrtf(a) + sqrtf(5.0625f * a + 256.f);
    return (int)ceilf(fmaxf(s * s, 272.f) * f);
}
template <int NE> __device__ __forceinline__ void index_load(LAS unsigned* keyb, LAS unsigned short* idxb, int q, int n, int lane, unsigned (&kv)[NE], unsigned (&iv)[NE]) {
#pragma unroll
    for (int j = 0; j < NE; ++j) { const int pos = lane + 64 * j; const bool in = pos < n; kv[j] = in ? keyb[q * ICAP + pos] : 0u; iv[j] = in ? (unsigned)idxb[q * ICAP + pos] : 0xFFFFu; }
}
template <int NE> __device__ __forceinline__ int index_count_ge(const unsigned (&kv)[NE], unsigned c) {
    int k = 0;
#pragma unroll
    for (int j = 0; j < NE; ++j) k += __popcll(__builtin_amdgcn_uicmp(kv[j], c, 35));
    return k;
}
template <int NE> __device__ __forceinline__ unsigned index_kth(const unsigned (&kv)[NE], int need) {
    unsigned tau = 0u;
#pragma unroll 1
    for (int bit = 31; bit >= 0; --bit) { const unsigned c = tau | (1u << bit); if (index_count_ge<NE>(kv, c) >= need) tau = c; }
    return tau;
}
template <int NE> __device__ __forceinline__ unsigned index_kth_range(const unsigned (&kv)[NE], int lo, int hi, int& cout) {
    unsigned tau = 0u;
#pragma unroll 1
    for (int bit = 31; bit >= 0; --bit) {
        const unsigned c = tau | (1u << bit); const int cc = index_count_ge<NE>(kv, c);
        if (cc >= lo) { tau = c; cout = cc; if (cc <= hi) break; }
    }
    return tau;
}
template <int NE> __device__ __forceinline__ unsigned index_bisect(const unsigned (&kv)[NE], unsigned lo, int K, int Khi, int& cout) {
    unsigned m = kv[0];
#pragma unroll
    for (int j = 1; j < NE; ++j) m = max(m, kv[j]);
    m = row_max_u(m);
    unsigned hi = max(max((unsigned)__builtin_amdgcn_readlane((int)m, 0), (unsigned)__builtin_amdgcn_readlane((int)m, 16)), max((unsigned)__builtin_amdgcn_readlane((int)m, 32), (unsigned)__builtin_amdgcn_readlane((int)m, 48)));
    if (hi > lo && hi - lo > (4u << 23)) {
        const unsigned g = hi - (3u << 23); const int cc = index_count_ge<NE>(kv, g);
        if (cc >= K) { lo = g; cout = cc; if (cc <= Khi) return lo; } else hi = g - 1u;
    }
#pragma unroll 1
    while (lo < hi) {
        const unsigned mid = lo + ((hi - lo + 1u) >> 1); const int cc = index_count_ge<NE>(kv, mid);
        if (cc >= K) { lo = mid; cout = cc; if (cc <= Khi) break; } else hi = mid - 1u;
    }
    return lo;
}
__device__ __forceinline__ void index_cut(LAS unsigned* keyb, LAS unsigned short* idxb, LAS unsigned* cnt, LAS unsigned* thr, int q, int lane, int K) {
    const int n = (int)cnt[q];
    if (n <= K) return;
    unsigned kv[11], iv[11];
    index_load<11>(keyb, idxb, q, n, lane, kv, iv);
    int c = n;
    const unsigned p = index_bisect<11>(kv, thr[q], K, K + (K >> 3), c);
    unsigned tau = p - 1u, iota = 0xFFFFu;
    if (c > 448 || p == 0u) {
        tau = index_kth<11>(kv, TOPK);
        int ngt = 0, neq = 0;
#pragma unroll
        for (int j = 0; j < 11; ++j) { ngt += __popcll(__builtin_amdgcn_uicmp(kv[j], tau, 34)); neq += __popcll(__builtin_amdgcn_uicmp(kv[j], tau, 32)); }
        const int need = TOPK - ngt;
        if (neq > need) {
            unsigned x = 0u;
#pragma unroll 1
            for (int bit = 15; bit >= 0; --bit) {
                const unsigned cc = x | (1u << bit);
                int k = 0;
#pragma unroll
                for (int j = 0; j < 11; ++j) k += wave_count(kv[j] == tau && iv[j] < cc);
                if (k < need) x = cc;
            }
            iota = x;
        }
    }
    int base = 0;
    const unsigned long long lt = (1ull << lane) - 1ull;
#pragma unroll
    for (int j = 0; j < 11; ++j) {
        const bool keep = kv[j] > tau || (kv[j] == tau && iv[j] <= iota);
        const unsigned long long m = __ballot(keep);
        const int pos = base + __popcll(m & lt);
        if (keep) { keyb[q * ICAP + pos] = kv[j]; idxb[q * ICAP + pos] = (unsigned short)iv[j]; }
        base += __popcll(m);
    }
    if (lane == 0) { cnt[q] = (unsigned)base; thr[q] = tau; }
    asm volatile("s_waitcnt lgkmcnt(0)" ::: "memory");
}
template <int NE> __device__ __forceinline__ void index_bits(LAS unsigned* keyb, LAS unsigned short* idxb, int q, int n, int lane, unsigned lo0) {
    unsigned kv[NE], iv[NE];
    index_load<NE>(keyb, idxb, q, n, lane, kv, iv);
    unsigned tau = 0u, iota = 0xFFFFu;
    if (n > TOPK) {
        int cdummy = n; tau = index_bisect<NE>(kv, lo0, TOPK, TOPK, cdummy);
        int ngt = 0, neq = 0;
#pragma unroll
        for (int j = 0; j < NE; ++j) { ngt += __popcll(__builtin_amdgcn_uicmp(kv[j], tau, 34)); neq += __popcll(__builtin_amdgcn_uicmp(kv[j], tau, 32)); }
        const int need = TOPK - ngt;
        if (neq > need) {
            unsigned x = 0u;
#pragma unroll 1
            for (int bit = 15; bit >= 0; --bit) {
                const unsigned c = x | (1u << bit);
                int k = 0;
#pragma unroll
                for (int j = 0; j < NE; ++j) k += wave_count(kv[j] == tau && iv[j] < c);
                if (k < need) x = c;
            }
            iota = x;
        }
    }
    LAS unsigned* rowl = keyb + q * ICAP;
    asm volatile("s_waitcnt lgkmcnt(0)" ::: "memory");
#pragma unroll
    for (int i = 0; i < 4; ++i) rowl[lane + 64 * i] = 0u;
    asm volatile("s_waitcnt lgkmcnt(0)" ::: "memory");
#pragma unroll
    for (int j = 0; j < NE; ++j) {
        const bool keep = (n > TOPK) ? (kv[j] > tau || (kv[j] == tau && iv[j] <= iota)) : (lane + 64 * j < n);
        if (keep) (void)__hip_atomic_fetch_or(rowl + (iv[j] >> 5), 1u << (iv[j] & 31u), __ATOMIC_RELAXED, __HIP_MEMORY_SCOPE_WORKGROUP);
    }
    asm volatile("s_waitcnt lgkmcnt(0)" ::: "memory");
}
__device__ __forceinline__ void index_final(LAS unsigned* keyb, LAS unsigned short* idxb, LAS unsigned* cnt, LAS unsigned* thr, int q, int lane) {
    const int n = (int)cnt[q]; const unsigned lo0 = thr[q];
    if (n <= 384) index_bits<6>(keyb, idxb, q, n, lane, lo0); else if (n <= 448) index_bits<7>(keyb, idxb, q, n, lane, lo0); else if (n <= 576) index_bits<9>(keyb, idxb, q, n, lane, lo0); else index_bits<11>(keyb, idxb, q, n, lane, lo0);
}
template <int ABL> __device__ __forceinline__ void ph_dsa_index(const bf16* proj, const bf16* KI, const bf16* WI, unsigned* selbits, LAS unsigned char* lds) {
    LAS unsigned* keyb = (LAS unsigned*)(lds + LDS_IKEY); LAS unsigned short* idxb = (LAS unsigned short*)(lds + LDS_IIDX);
    LAS unsigned* cnt = (LAS unsigned*)(lds + LDS_ICNT); LAS unsigned* thr = (LAS unsigned*)(lds + LDS_ITHR);
    const int tid = opaque_tid(), wave = __builtin_amdgcn_readfirstlane(tid >> 6), lane = tid & 63, fr = lane & 15, fq = lane >> 4;
    LAS unsigned* rowl = (LAS unsigned*)(lds + LDS_IROW + wave * 1024);
    constexpr int NQB = S / IQB;
    for (int pr = blockIdx.x; pr < NB * NQB / 2; pr += gridDim.x) {
        const int b = pr / (NQB / 2), pp = pr % (NQB / 2);
#pragma unroll 1
        for (int ui = 0; ui < 2; ++ui) {
            const int qb = ui ? pp : (NQB - 1 - pp);
            const int q0 = qb * IQB, t0 = b * S + q0;
            bf16x8_t bqf[2][8][2]; unsigned wvp[2][4];
#pragma unroll
            for (int qg = 0; qg < 2; ++qg) {
                const bf16* qrow = proj + (size_t)(t0 + 16 * qg + fr) * PW;
#pragma unroll
                for (int h = 0; h < 8; ++h) { bqf[qg][h][0] = *(const bf16x8_t*)(qrow + OFF_QI + 64 * h + 8 * fq); bqf[qg][h][1] = *(const bf16x8_t*)(qrow + OFF_QI + 64 * h + 8 * fq + 32); }
                { const uint4 w4 = *(const uint4*)(WI + (size_t)(t0 + 16 * qg + fr) * 8); wvp[qg][0] = w4.x; wvp[qg][1] = w4.y; wvp[qg][2] = w4.z; wvp[qg][3] = w4.w; }
            }
            bf16x8_t bql[2][1][2];
#pragma unroll
            for (int qg = 0; qg < 2; ++qg) {
#pragma unroll
                for (int ks = 0; ks < 2; ++ks) {
                    float ql[8] = {0.f, 0.f, 0.f, 0.f, 0.f, 0.f, 0.f, 0.f};
#pragma unroll
                    for (int h = 0; h < 8; ++h) {
                        const float wh = (h & 1) ? __uint_as_float(wvp[qg][h >> 1] & 0xffff0000u) : __uint_as_float(wvp[qg][h >> 1] << 16);
#pragma unroll
                        for (int j = 0; j < 8; ++j) ql[j] = __builtin_fmaf(wh, __uint_as_float((unsigned)(unsigned short)bqf[qg][h][ks][j] << 16), ql[j]);
                    }
                    v4u hi, lo; unsigned hw[4], lw[4];
#pragma unroll
                    for (int j = 0; j < 4; ++j) {
                        hw[j] = pk2(ql[2 * j], ql[2 * j + 1]);
                        lw[j] = pk2(ql[2 * j] - __uint_as_float(hw[j] << 16), ql[2 * j + 1] - __uint_as_float(hw[j] & 0xffff0000u));
                    }
                    hi.x = hw[0]; hi.y = hw[1]; hi.z = hw[2]; hi.w = hw[3]; (void)lw; (void)lo;
                    bql[qg][0][ks] = __builtin_bit_cast(bf16x8_t, hi);
                }
            }
            const int ntiles = (q0 + IQB - 1) / 128 + 1;
            const bf16* kwave = KI + (size_t)(b * S + 16 * wave + fr) * 64 + 8 * fq;
#pragma unroll 1
            for (int cons = 0; cons < 2; ++cons) {
            __syncthreads();
            if (tid < IQB) { cnt[tid] = 0u; thr[tid] = 0u; }
            bf16x8_t ak0 = *(const bf16x8_t*)kwave, ak1 = *(const bf16x8_t*)(kwave + 32);
#pragma unroll 1
            for (int kt = 0; kt < ntiles; ++kt) {
                asm volatile("s_waitcnt lgkmcnt(0)" ::: "memory"); __builtin_amdgcn_s_barrier(); asm volatile("" ::: "memory");
                if (__any((int)cnt[lane & 31] > ITRIG)) {
#pragma unroll 1
                    for (int qq = 0; qq < 4; ++qq) { const int q = 4 * wave + qq; if ((int)cnt[q] > ILOW) { if (ABL == 2) { if (lane == 0) cnt[q] = 256u; } else {
                        const int ntot = q0 + q + 1, nseen = min(128 * kt, ntot);
                        const int K = cons ? TOPK : __builtin_amdgcn_readfirstlane(max(index_keep(nseen, ntot), 32));
                        index_cut(keyb, idxb, cnt, thr, q, lane, K); } } }
                    asm volatile("s_waitcnt lgkmcnt(0)" ::: "memory"); __builtin_amdgcn_s_barrier(); asm volatile("" ::: "memory");
                }
                const unsigned th0 = thr[fr], th1 = thr[16 + fr];
                const int k0 = 128 * kt + 16 * wave;
                const bf16x8_t a0 = ak0, a1 = ak1;
                { const bf16* kn = kwave + (size_t)(128 * ((kt + 1 < ntiles) ? kt + 1 : kt)) * 64; ak0 = *(const bf16x8_t*)kn; ak1 = *(const bf16x8_t*)(kn + 32); }
#pragma unroll
                for (int qg = 0; qg < 2; ++qg) {
                    float sc[4]; f32x4_t pa[3];
#define IDX_STAGE(SLOT, B0, B1) { pa[SLOT] = (f32x4_t){0.f, 0.f, 0.f, 0.f}; pa[SLOT] = __builtin_amdgcn_mfma_f32_16x16x32_bf16(a0, B0, pa[SLOT], 0, 0, 0); pa[SLOT] = __builtin_amdgcn_mfma_f32_16x16x32_bf16(a1, B1, pa[SLOT], 0, 0, 0); }
                    IDX_STAGE(0, bql[qg][0][0], bql[qg][0][1])
                    IDX_STAGE(1, bqf[qg][0][0], bqf[qg][0][1])
                    IDX_STAGE(2, bqf[qg][1][0], bqf[qg][1][1])
                    __builtin_amdgcn_sched_barrier(0);
#pragma unroll
                    for (int i = 0; i < 4; ++i) sc[i] = pa[0][i];
#pragma unroll
                    for (int h = 0; h < 8; ++h) {
                        if (h + 2 < 8) IDX_STAGE(h % 3, bqf[qg][h + 2][0], bqf[qg][h + 2][1])
                        const float wh = (h & 1) ? __uint_as_float(wvp[qg][h >> 1] & 0xffff0000u) : __uint_as_float(wvp[qg][h >> 1] << 16);
#pragma unroll
                        for (int i = 0; i < 4; ++i) { sc[i] = __builtin_fmaf(__builtin_fabsf(pa[(h + 1) % 3][i]), wh, sc[i]); asm("" : "+v"(sc[i])); }
                        __builtin_amdgcn_sched_barrier(0);
                    }
#undef IDX_STAGE
                    const int qi = 16 * qg + fr, qpos = q0 + qi;
                    const unsigned th = qg ? th1 : th0;
                    unsigned keyv[4], slot[4]; bool prd[4];
#pragma unroll
                    for (int i = 0; i < 4; ++i) {
                        float s = sc[i]; if (s == 0.f) s = 0.f;
                        keyv[i] = f2ord(s);
                        prd[i] = (ABL != 1) && (k0 + 4 * fq + i <= qpos) && (keyv[i] > th);
                    }
#pragma unroll
                    for (int i = 0; i < 4; ++i) slot[i] = prd[i] ? __hip_atomic_fetch_add(cnt + qi, 1u, __ATOMIC_RELAXED, __HIP_MEMORY_SCOPE_WORKGROUP) : 0u;
#pragma unroll
                    for (int i = 0; i < 4; ++i) if (prd[i]) { keyb[qi * ICAP + slot[i]] = keyv[i]; idxb[qi * ICAP + slot[i]] = (unsigned short)(k0 + 4 * fq + i); }
                }
            }
            __syncthreads();
            if (!__any((int)cnt[lane & 31] < min(TOPK, q0 + (lane & 31) + 1))) break;
            }
#pragma unroll 1
            for (int qq = 0; qq < (ABL == 0 ? 4 : 0); ++qq) { const int q = 4 * wave + qq; index_final(keyb, idxb, cnt, thr, q, lane); }
            if (ABL == 0) {
                __syncthreads();
                unsigned* dst = selbits + ((size_t)(b * (S / 32) + qb) * 128) * 64;
                for (int idx = tid; idx < 128 * 32; idx += NTHR) { const int kt = idx >> 5, qq = idx & 31;
                    uint2 w; w.x = keyb[qq * ICAP + 2 * kt]; w.y = keyb[qq * ICAP + 2 * kt + 1];
                    *(uint2*)(dst + (size_t)idx * 2) = w; }
            }
        }
    }
    __syncthreads();
}

constexpr int AQB = 256, AKT = 64, AROW = 144;
constexpr int LDS_AK = 0, LDS_AV = AKT * AROW, LDS_ABUF = 2 * AKT * AROW, LDS_ABLUT = 2 * LDS_ABUF;
__device__ __forceinline__ float max3_f(float a, float b, float c) { float r_; asm("v_max3_f32 %0, %1, %2, %3" : "=v"(r_) : "v"(a), "v"(b), "v"(c)); return r_; }
__device__ __forceinline__ float max2_f(float a, float b) { float r_; asm("v_max_f32 %0, %1, %2" : "=v"(r_) : "v"(a), "v"(b)); return r_; }
__device__ __forceinline__ float bfi_f(unsigned mask, unsigned a, unsigned b) { unsigned r_; asm("v_bfi_b32 %0, %1, %2, %3" : "=v"(r_) : "v"(mask), "v"(a), "v"(b)); return __uint_as_float(r_); }
template <bool NEAR> __device__ __forceinline__ void attn_tile(LAS unsigned char* buf, LAS float* blut, const bf16x8_t (&bq)[2][2], const uint2 cb0, const uint2 cb1, int qw, int k0, int fr, int fq,
                                                               const bf16x8_t ones, f32x4_t (&acc)[2][4], f32x4_t (&accl)[2], const float (&mref_)[2], float (&mlane)[2]) {
    const float cfar = blut[128];
    bf16x8_t kf[4][2];
#pragma unroll
    for (int tile = 0; tile < 4; ++tile)
#pragma unroll
        for (int ks = 0; ks < 2; ++ks) kf[tile][ks] = *(const LAS bf16x8_t*)(buf + LDS_AK + (16 * tile + fr) * AROW + (8 * fq + 32 * ks) * 2);
    const LAS f32x4_t* mlut = (const LAS f32x4_t*)((LAS unsigned char*)blut + 2048);
    f32x4_t sx[2][4];
#pragma unroll
    for (int qg = 0; qg < 2; ++qg) {
        const uint2 cb = qg ? cb1 : cb0;
#pragma unroll
        for (int tile = 0; tile < 4; ++tile) sx[qg][tile] = mlut[__builtin_amdgcn_ubfe((tile & 2) ? cb.y : cb.x, 16 * (tile & 1) + 4 * fq, 4)];
    }
#pragma unroll
    for (int qg = 0; qg < 2; ++qg)
#pragma unroll
        for (int tile = 0; tile < 4; ++tile) {
            sx[qg][tile] = __builtin_amdgcn_mfma_f32_16x16x32_bf16(kf[tile][0], bq[qg][0], sx[qg][tile], 0, 0, 0); sx[qg][tile] = __builtin_amdgcn_mfma_f32_16x16x32_bf16(kf[tile][1], bq[qg][1], sx[qg][tile], 0, 0, 0); }
    float x[2][16];
#pragma unroll
    for (int qg = 0; qg < 2; ++qg) {
        const int dist0 = (qw + 16 * qg + fr) - (k0 + 4 * fq);
        const float mref = mref_[qg];
        const float cfm = cfar - mref;
#pragma unroll
        for (int tile = 0; tile < 4; ++tile) {
#pragma unroll
            for (int i = 0; i < 4; ++i) {
                float bias = cfm;
                if (NEAR) { int n = dist0 - (16 * tile + i); n = n < 0 ? 0 : (n > 128 ? 128 : n); bias = blut[n] - mref; }
                x[qg][4 * tile + i] = __builtin_fmaf(sx[qg][tile][i], 0.18033688011112042f, bias);
                asm("" : "+v"(x[qg][4 * tile + i]));
            }
        }
        mlane[qg] = max3_f(max3_f(max3_f(x[qg][0], x[qg][1], x[qg][2]), max3_f(x[qg][3], x[qg][4], x[qg][5]), x[qg][15]), max3_f(x[qg][6], x[qg][7], x[qg][8]), max3_f(max3_f(x[qg][9], x[qg][10], x[qg][11]), max3_f(x[qg][12], x[qg][13], x[qg][14]), mlane[qg]));
    }
#pragma unroll
    for (int blk = 0; blk < 2; ++blk) {
        bf16x8_t vf[4];
#pragma unroll
        for (int dt = 0; dt < 4; ++dt) vf[dt] = *(const LAS bf16x8_t*)(buf + LDS_AV + (16 * dt + fr) * AROW + (32 * blk + 8 * fq) * 2);
#pragma unroll
        for (int qg = 0; qg < 2; ++qg) {
            v4u t;
            t.x = pk2(__builtin_amdgcn_exp2f(x[qg][8 * blk + 0]), __builtin_amdgcn_exp2f(x[qg][8 * blk + 1])); t.y = pk2(__builtin_amdgcn_exp2f(x[qg][8 * blk + 2]), __builtin_amdgcn_exp2f(x[qg][8 * blk + 3]));
            t.z = pk2(__builtin_amdgcn_exp2f(x[qg][8 * blk + 4]), __builtin_amdgcn_exp2f(x[qg][8 * blk + 5])); t.w = pk2(__builtin_amdgcn_exp2f(x[qg][8 * blk + 6]), __builtin_amdgcn_exp2f(x[qg][8 * blk + 7]));
            const bf16x8_t pb = __builtin_bit_cast(bf16x8_t, t);
            accl[qg] = __builtin_amdgcn_mfma_f32_16x16x32_bf16(ones, pb, accl[qg], 0, 0, 0);
#pragma unroll
            for (int dt = 0; dt < 4; ++dt) acc[qg][dt] = __builtin_amdgcn_mfma_f32_16x16x32_bf16(vf[dt], pb, acc[qg][dt], 0, 0, 0);
        }
    }
}
__device__ __forceinline__ void ph_dsa_attn2(const Params& p, const bf16* proj, const bf16* KC, const bf16* VTa, const unsigned* selbits, bf16* ya, LAS unsigned char* lds) {
    const int tid = opaque_tid(), wave = __builtin_amdgcn_readfirstlane(tid >> 6), lane = tid & 63, fr = lane & 15, fq = lane >> 4;
    LAS float* blut = (LAS float*)(lds + LDS_ABLUT);
    LAS unsigned* aflag = (LAS unsigned*)(lds + LDS_ABLUT + 1024);
    constexpr int NQBA = S / AQB;
    const int ldr = tid >> 3, ldc = tid & 7;
    for (int pr = blockIdx.x; pr < NB * 8 * NQBA / 2; pr += gridDim.x) {
        const int bh = pr / (NQBA / 2), pp = pr % (NQBA / 2), b = bh >> 3, h = bh & 7;
        __syncthreads();
        if (tid <= 128) blut[tid] = p.rel_bias[(tid >= 128 ? 31 : t5_bucket(tid)) * 8 + h] * 1.4426950408889634f;
        if (tid >= 192 && tid < 256) ((LAS float*)((LAS unsigned char*)blut + 2048))[tid - 192] = ((((tid - 192) >> 2) >> (tid & 3)) & 1) ? 0.f : -1e30f;
        const bf16* kg = KC + ((size_t)(b * 8 + h) * S + ldr) * 64 + 8 * ldc;
        const bf16* vg = VTa + ((size_t)(b * 8 + h) * (S / 32) * 64 + (ldc >> 2) * 64 + ldr) * 32 + 8 * (ldc & 3);
#pragma unroll 1
        for (int ui = 0; ui < 2; ++ui) {
            const int qb = ui ? pp : (NQBA - 1 - pp);
            const int q0 = qb * AQB, qw = q0 + 32 * wave;
            const int ntiles = (q0 + AQB) / AKT;
            bf16x8_t bq[2][2];
#pragma unroll
            for (int qg = 0; qg < 2; ++qg) { const bf16* qrow = proj + (size_t)(b * S + qw + 16 * qg + fr) * PW + OFF_QA + 64 * h + 8 * fq; bq[qg][0] = *(const bf16x8_t*)qrow; bq[qg][1] = *(const bf16x8_t*)(qrow + 32); }
            const unsigned* brow0 = selbits + ((size_t)(b * (S / 32) + (qw >> 5)) * 128) * 64 + 2 * fr;
            const unsigned* brow1 = brow0 + 32;
            f32x4_t acc[2][4], accl[2]; float mref[2] = {0.f, 0.f}, mlane[2];
            const bf16x8_t ones = __builtin_bit_cast(bf16x8_t, (v4u){0x3f803f80u, 0x3f803f80u, 0x3f803f80u, 0x3f803f80u});
#pragma unroll 1
            for (int pass = 0; pass < 2; ++pass) {
#pragma unroll
            for (int qg = 0; qg < 2; ++qg) { mlane[qg] = -INFINITY; accl[qg] = (f32x4_t){0.f, 0.f, 0.f, 0.f};
#pragma unroll
                for (int dt = 0; dt < 4; ++dt) acc[qg][dt] = (f32x4_t){0.f, 0.f, 0.f, 0.f}; }
            __syncthreads();
            if (tid == 0) aflag[0] = 0u;
            { const v4u kk = *(const v4u*)kg, vv = *(const v4u*)vg;
              *(LAS v4u*)(lds + LDS_AK + ldr * AROW + 16 * ldc) = kk; *(LAS v4u*)(lds + LDS_AV + ldr * AROW + 16 * ldc) = vv; }
            uint2 wb0 = *(const uint2*)brow0, wb1 = *(const uint2*)brow1;
            __syncthreads();
            const int nfar = min(ntiles, max(0, (qw - 191 + 64) >> 6));
            const int nact = min(ntiles, (qw + 31) / AKT + 1);
#define ATTN_TILE_LOOP(KT_BEGIN, KT_END, BODY) \
            _Pragma("unroll 1") for (int kt = (KT_BEGIN); kt < (KT_END); ++kt) { \
                const int k0 = kt * AKT; \
                LAS unsigned char* buf = lds + (kt & 1) * LDS_ABUF; \
                const int ktn = (kt + 1 < ntiles) ? kt + 1 : kt;             \
                const uint2 cb0 = wb0, cb1 = wb1; \
                const v4u nk = *(const v4u*)(kg + (size_t)(ktn * AKT) * 64), nvv = *(const v4u*)(vg + (size_t)(ktn * AKT / 32) * 2048); \
                wb0 = *(const uint2*)(brow0 + 64 * ktn); wb1 = *(const uint2*)(brow1 + 64 * ktn); \
                BODY \
                { LAS unsigned char* nb = lds + ((kt + 1) & 1) * LDS_ABUF; \
                    *(LAS v4u*)(nb + LDS_AK + ldr * AROW + 16 * ldc) = nk; *(LAS v4u*)(nb + LDS_AV + ldr * AROW + 16 * ldc) = nvv; } \
                asm volatile("s_waitcnt lgkmcnt(0)" ::: "memory"); __builtin_amdgcn_s_barrier(); asm volatile("" ::: "memory");     \
            }
            ATTN_TILE_LOOP(0, nfar, attn_tile<false>(buf, blut, bq, cb0, cb1, qw, k0, fr, fq, ones, acc, accl, mref, mlane);)
            ATTN_TILE_LOOP(nfar, nact, attn_tile<true>(buf, blut, bq, cb0, cb1, qw, k0, fr, fq, ones, acc, accl, mref, mlane);)
            ATTN_TILE_LOOP(nact, ntiles, (void)buf; (void)k0; (void)cb0; (void)cb1;)
#undef ATTN_TILE_LOOP
            if (pass == 1) break;
            float mq[2];
#pragma unroll
            for (int qg = 0; qg < 2; ++qg) { float m_ = mlane[qg]; m_ = fmaxf(m_, __shfl_xor(m_, 16)); mq[qg] = fmaxf(m_, __shfl_xor(m_, 32)); }
            const bool bad = (mq[0] > 60.f) || (mq[0] < -60.f && mq[0] > -1e20f) || (mq[1] > 60.f) || (mq[1] < -60.f && mq[1] > -1e20f);
            if (__any(bad) && lane == 0) aflag[0] = 1u;
            __syncthreads();
            if (aflag[0] == 0u) break;
            mref[0] = (mq[0] > -1e20f) ? mq[0] : 0.f; mref[1] = (mq[1] > -1e20f) ? mq[1] : 0.f;
            }
#pragma unroll
            for (int qg = 0; qg < 2; ++qg) {
                const float inv = 1.f / accl[qg][0];
#pragma unroll
                for (int dt = 0; dt < 4; ++dt) { uint2 o; o.x = pk2(acc[qg][dt][0] * inv, acc[qg][dt][1] * inv); o.y = pk2(acc[qg][dt][2] * inv, acc[qg][dt][3] * inv);
                    *(uint2*)(ya + (size_t)(b * S + qw + 16 * qg + fr) * 512 + 64 * h + 16 * dt + 4 * fq) = o; }
            }
        }
    }
    __syncthreads();
}

__global__ void __launch_bounds__(NTHR, 2) mega_fwd(Params p) {
    extern __shared__ __attribute__((aligned(16))) unsigned char lds[];
    float* sm = (float*)lds;
    LAS unsigned char* ldsl = (LAS unsigned char*)lds;
    volatile LAS unsigned* bst = (volatile LAS unsigned*)(ldsl + LDS_BYTES - 16);
    if (threadIdx.x == 0) { bst[0] = 0u; bst[1] = 0u; bst[2] = 0u; bst[3] = 0u; }
    __syncthreads();
    XcdBarrier bar = xcd_barrier_post((unsigned*)(p.ws + WS_BAR), bst);
    unsigned char* ws = p.ws;
    float* mod = (float*)(ws + WS_MOD);
    bf16* proj = (bf16*)(ws + WS_PROJ);
    bf16* G = (bf16*)(ws + WS_G);
    bf16* ya = (bf16*)(ws + WS_YA); bf16* yb = (bf16*)(ws + WS_YB);
    bf16* hn2 = (bf16*)(ws + WS_HN2); bf16* qh = (bf16*)(ws + WS_QH);
    bf16* hn = (bf16*)p.out;
    const int G_ = gridDim.x, c_ = blockIdx.x;

    ph_mod(p, mod, (float*)(lds + LDS_SC_OFF));
    ph_weights(p, ldsl);
    xcd_barrier(bar);
    ph_norm<true>(p.x, p.g1, mod, 0, 1, hn);
    xcd_barrier(bar);
    {
        pg8::Gemm g{hn, (const bf16*)(ws + WS_WIN), T, NPROJ, D, D, D}; pg8::StaticOrder So; So.init(T, NPROJ, G_, c_);
        pg8::EpiX<1> E{proj, G, nullptr, nullptr, nullptr, PW, 0, (bf16*)(ws + WS_KCA), (bf16*)(ws + WS_KCB), (bf16*)(ws + WS_KI), (bf16*)(ws + WS_WI)};
        pg8::gemm_phase<pg8::EpiX<1>, pg8::StaticOrder, true, true>(ldsl, g, So, E);
    }
    xcd_barrier(bar);
    unsigned* selbits = (unsigned*)((unsigned char*)p.out + 32 * MiB); bf16* VTa = (bf16*)p.out;
    ph_vt(proj, OFF_VB, (bf16*)(ws + WS_VT));
    ph_vt(proj, OFF_VA, VTa);
    ph_dsa_index<0>(proj, (const bf16*)(ws + WS_KI), (const bf16*)(ws + WS_WI), selbits, ldsl);
    xcd_barrier(bar);
    ph_dsa_attn2(p, proj, (const bf16*)(ws + WS_KCA), VTa, selbits, ya, ldsl);
    ph_stick2(proj, (const bf16*)(ws + WS_KCB), (const bf16*)(ws + WS_VT), yb);
    xcd_barrier(bar);
    {
        pg8::Gemm g{ya, (const bf16*)(ws + WS_WPA), T, D, 512, 512, 512}; pg8::StaticOrder So; So.init(T, D, G_, c_);
        pg8::EpiX<2> E{nullptr, G, nullptr, nullptr, nullptr, 0, 0, nullptr, nullptr, nullptr, nullptr};
        pg8::gemm_phase<pg8::EpiX<2>, pg8::StaticOrder, true, true>(ldsl, g, So, E);
    }
    {
        pg8::Gemm g{yb, (const bf16*)(ws + WS_WPB), T, D, 512, 512, 512}; pg8::StaticOrder So; So.init(T, D, G_, c_);
        pg8::EpiX<3> E{nullptr, G, nullptr, nullptr, nullptr, 0, 0, nullptr, nullptr, nullptr, nullptr};
        pg8::gemm_phase<pg8::EpiX<3>, pg8::StaticOrder, true, true>(ldsl, g, So, E);
    }
    xcd_barrier(bar);
    {
        pg8::Gemm g{G, (const bf16*)(ws + WS_WOUT), T, D, D, GW, D}; pg8::StaticOrder So; So.init(T, D, G_, c_);
        pg8::EpiX<4> E{nullptr, nullptr, p.x, mod + 2 * D, p.out, 0, 0, nullptr, nullptr, nullptr, nullptr};
        pg8::gemm_phase<pg8::EpiX<4>, pg8::StaticOrder, true, true>(ldsl, g, So, E);
    }
    xcd_barrier(bar);
    ph_norm<false>(p.out, p.g2, mod, 3, 4, hn2);
    ph_quant(p, ws + WS_TAB, (float*)(ws + WS_SCALES));
    xcd_barrier(bar);
    {
        pg8::Gemm g{hn2, (const bf16*)(ws + WS_WQ), T, 2048, D, D, D}; pg8::StaticOrder So; So.init(T, 2048, G_, c_);
        pg8::EpiX<0> E{qh, nullptr, nullptr, nullptr, nullptr, 2048, 0, nullptr, nullptr, nullptr, nullptr};
        pg8::gemm_phase<pg8::EpiX<0>, pg8::StaticOrder, true, true>(ldsl, g, So, E);
    }
    xcd_barrier(bar);
    ph_peer_select(qh, (const bf16*)(ws + WS_SKB), (unsigned short*)(ws + WS_EIDX), (float*)(ws + WS_GATE));
    xcd_barrier(bar);
    ph_peer_gather(p, hn2, (const unsigned short*)(ws + WS_EIDX), (const float*)(ws + WS_GATE), ws + WS_TAB, (const float*)(ws + WS_SCALES), mod, p.out, p.out);
}

extern "C" void kernel_launch(void* const* d_in, const int* in_sizes, int n_in, void* d_out, int out_size, void* d_ws, size_t ws_size, hipStream_t stream) {
    static int grid = 0;
    if (grid == 0) {
        if (n_in != 16 || out_size != T * D || ws_size < WS_NEED) { fprintf(stderr, "kernel_launch: unexpected shapes (n_in %d out %d ws %zu)\n", n_in, out_size, ws_size); grid = -1; return; }
        int dev = 0, cus = 0, per_cu = 0;
        if (hipGetDevice(&dev) != hipSuccess || hipDeviceGetAttribute(&cus, hipDeviceAttributeMultiprocessorCount, dev) != hipSuccess) { grid = -1; return; }
        if (hipFuncSetAttribute((const void*)mega_fwd, hipFuncAttributeMaxDynamicSharedMemorySize, LDS_BYTES) != hipSuccess) { fprintf(stderr, "kernel_launch: hipFuncSetAttribute failed\n"); grid = -1; return; }
        if (hipOccupancyMaxActiveBlocksPerMultiprocessor(&per_cu, (const void*)mega_fwd, NTHR, LDS_BYTES) != hipSuccess || per_cu < 1) { fprintf(stderr, "kernel_launch: occupancy query says %d\n", per_cu); per_cu = 1; }
        (void)hipGetLastError();
        grid = cus;
    }
    if (grid < 0) return;
    (void)hipMemsetAsync((char*)d_ws + WS_BAR, 0, CTL_ZERO_BYTES, stream);
    Params p; memset(&p, 0, sizeof(p));
    p.x = (const float*)d_in[0]; p.c = (const float*)d_in[1]; p.w_ada = (const float*)d_in[2]; p.b_ada = (const float*)d_in[3];
    p.g1 = (const float*)d_in[4]; p.g2 = (const float*)d_in[5]; p.w_in = (const float*)d_in[6]; p.rel_bias = (const float*)d_in[7];
    p.wpa = (const float*)d_in[8]; p.wpb = (const float*)d_in[9]; p.wout = (const float*)d_in[10]; p.wq = (const float*)d_in[11];
    p.sk = (const float*)d_in[12]; p.pu = (const float*)d_in[13]; p.pv = (const float*)d_in[14]; p.fg = (const float*)d_in[15];
    p.out = (float*)d_out; p.ws = (unsigned char*)d_ws;
    hipLaunchKernelGGL(mega_fwd, dim3(grid), dim3(NTHR), LDS_BYTES, stream, p);
}
```

```cpp
#include <hip/hip_runtime.h>
#include <stdint.h>
#include <math.h>
#include <string.h>
#include <stdio.h>

typedef unsigned short bf16;
constexpr int D = 1024, NB = 2, S = 8192, T = NB * S;
constexpr int INW = 5704;
constexpr int OFF_QA = 0, OFF_VA = 512, OFF_QI = 1024, OFF_QB = 1536, OFF_VB = 2048;
constexpr int PW = 2560;
constexpr int NPROJ = 3840 + 2048;
constexpr int GW = 2048;
constexpr int TOPK = 256;
constexpr float EPS = 1e-6f;
constexpr size_t MiB = 1u << 20;
constexpr int NTHR = 512, NWAVES = 8;
constexpr int LDS_BYTES = 147456;

#define LAS __attribute__((address_space(3)))

__device__ __forceinline__ bf16 f2bf(float f) { unsigned u = __float_as_uint(f); return (bf16)((u + 0x7fffu + ((u >> 16) & 1u)) >> 16); }
__device__ __forceinline__ float bf2f(bf16 h) { return __uint_as_float(((unsigned)h) << 16); }
typedef __bf16 bf16x2_hw __attribute__((ext_vector_type(2)));
__device__ __forceinline__ unsigned pk2(float lo, float hi) { bf16x2_hw v; v[0] = (__bf16)lo; v[1] = (__bf16)hi; return __builtin_bit_cast(unsigned, v); }

__device__ __forceinline__ float wave_sum(float v) {
#pragma unroll
    for (int o = 1; o < 64; o <<= 1) v += __shfl_xor(v, o);
    return v;
}
__device__ __forceinline__ float block_sum(float v, float* red) {
    v = wave_sum(v);
    __syncthreads();
    if ((threadIdx.x & 63) == 0) red[threadIdx.x >> 6] = v;
    __syncthreads();
    float s = 0.f;
#pragma unroll
    for (int i = 0; i < NWAVES; ++i) s += red[i];
    return s;
}
typedef float f32x4_t __attribute__((ext_vector_type(4)));
#define XB_TMO      128
#define XB_XCNT(j)  (256  + 64 * (j))
#define XB_XSUB(j)  (1280 + 64 * (j))
#define XB_XGEN(j)  (2304 + 64 * (j))
#define XB_TOP      3328
#define XB_TOPGEN   3392
#define XCD_BAR_WORDS 3456
#define XB_SPIN_CAP (1u << 22)

__device__ __forceinline__ unsigned xb_ld(unsigned* p)              { return __hip_atomic_load(p, __ATOMIC_RELAXED, __HIP_MEMORY_SCOPE_AGENT); }
__device__ __forceinline__ unsigned xb_add(unsigned* p, unsigned v) { return __hip_atomic_fetch_add(p, v, __ATOMIC_RELAXED, __HIP_MEMORY_SCOPE_AGENT); }
__device__ __forceinline__ unsigned xb_xcc_id() { return (unsigned)__builtin_amdgcn_s_getreg((3 << 11) | 20) & 0xFu; }
#define XB_SPIN(cond, bar) do { unsigned _sp = 0; while (cond) { __builtin_amdgcn_s_sleep(1); \
    if ((++_sp & 255u) == 0u) { if (xb_ld(&(bar)[XB_TMO])) break; if (_sp > XB_SPIN_CAP) { atomicAdd(&(bar)[XB_TMO], 1u); break; } } } } while (0)

struct XcdBarrier {
    unsigned* bar; unsigned x;
    volatile LAS unsigned* st;
};

__device__ __forceinline__ XcdBarrier xcd_barrier_post(unsigned* bar, volatile LAS unsigned* st) {
    XcdBarrier b; b.bar = bar; b.x = xb_xcc_id(); b.st = st;
    if (threadIdx.x == 0) (void)xb_add(&bar[XB_XCNT(b.x)], 1u);
    return b;
}
__device__ __forceinline__ void xcd_barrier_complete(unsigned* bar, unsigned x, unsigned& nloc, unsigned& nx) {
    const unsigned G = gridDim.x * gridDim.y * gridDim.z;
    unsigned sum, cnt, mine, sp = 0u;
    for (;;) {
        sum = 0u; cnt = 0u; mine = 0u;
#pragma unroll
        for (unsigned j = 0; j < 16; ++j) { const unsigned c = xb_ld(&bar[XB_XCNT(j)]); sum += c; cnt += (c > 0u) ? 1u : 0u; mine = (j == x) ? c : mine; }
        if (sum == G) break;
        __builtin_amdgcn_s_sleep(1);
        if ((++sp & 255u) == 0u) { if (xb_ld(&bar[XB_TMO])) break; if (sp > XB_SPIN_CAP) { atomicAdd(&bar[XB_TMO], 1u); break; } }
    }
    nloc = mine > 0u ? mine : 1u; nx = cnt > 0u ? cnt : 1u;
}

__device__ __forceinline__ void xcd_barrier(const XcdBarrier& b) {
    asm volatile("s_waitcnt vmcnt(0)" ::: "memory");
    __syncthreads();
    if (threadIdx.x == 0) {
        unsigned* bar = b.bar;
        __builtin_amdgcn_s_waitcnt(0);
        unsigned nloc = b.st[0], nx = b.st[1];
        if (nloc == 0u) { xcd_barrier_complete(bar, b.x, nloc, nx); b.st[0] = nloc; b.st[1] = nx; }
        const unsigned old = xb_add(&bar[XB_XSUB(b.x)], 1u);
        const unsigned gen = old / nloc;
        if (old + 1u == (gen + 1u) * nloc) {
            __builtin_amdgcn_fence(__ATOMIC_RELEASE, "agent");
            asm volatile("s_waitcnt vmcnt(0)" ::: "memory");
            const unsigned og = xb_add(&bar[XB_TOP], 1u);
            const unsigned tg = og / nx;
            if (og + 1u == (tg + 1u) * nx) xb_add(&bar[XB_TOPGEN], 1u);
            else XB_SPIN(xb_ld(&bar[XB_TOPGEN]) == tg, bar);
            __builtin_amdgcn_fence(__ATOMIC_ACQUIRE, "agent");
            xb_add(&bar[XB_XGEN(b.x)], 1u);
            asm volatile("s_waitcnt vmcnt(0)" ::: "memory");
        } else {
            XB_SPIN(xb_ld(&bar[XB_XGEN(b.x)]) == gen, bar);
            __builtin_amdgcn_fence(__ATOMIC_ACQUIRE, "agent");
            asm volatile("s_waitcnt vmcnt(0)" ::: "memory");
        }
    }
    __syncthreads();
}


namespace pg8 {
#define PG8_LAS __attribute__((address_space(3)))
typedef unsigned short bf16_t;
typedef short bf16x8 __attribute__((ext_vector_type(8)));
typedef float f32x4 __attribute__((ext_vector_type(4)));
typedef unsigned u32x4 __attribute__((ext_vector_type(4)));
constexpr int BM = 256, BK = 64, HALF = 128, HTB = HALF * BK * 2  , STAGE_BYTES = 8 * HTB, NXCD = 8, WGM = 8;

__host__ __device__ __forceinline__ int lds_byte(int r, int c) { const int st = (r >> 4) * 2 + (c >> 5), rr = r & 15, cc = c & 31, ob = rr * 64 + cc * 2; return st * 1024 + (ob ^ (((ob >> 9) & 1) << 5)); }
__host__ __device__ __forceinline__ void stage_rc(int b, int& R, int& C) { const int st = b / 1024, sb = b % 1024, swz = sb ^ (((sb >> 9) & 1) << 5); R = (st >> 1) * 16 + swz / 64; C = (st & 1) * 32 + (swz % 64) / 2; }
__host__ __device__ __forceinline__ int perm32(int rho) { const int n = rho >> 4, i = rho & 15; return 8 * (i >> 2) + 4 * n + (i & 3); }

struct Unit { int pm, pn; };
struct Gemm { const bf16_t* A; const bf16_t* Bt; int M, N, K, lda, ldb; };

struct StaticOrder {
    int nM, nN, nwg, G, c;
    __host__ __device__ void init(int M, int N, int G_, int c_) { nM = M / BM; nN = N / BM; nwg = nM * nN; G = G_; c = c_; }
    __host__ __device__ bool next(int i, Unit& u) const {
        const long L = (long)i * G + c; if (L >= nwg) return false;
        int wgid = (int)L; { const int q = nwg / NXCD, r = nwg % NXCD, xcd = wgid % NXCD, off = wgid / NXCD; wgid = (xcd < r ? xcd * (q + 1) : r * (q + 1) + (xcd - r) * q) + off; }
        const int nig = WGM * nN, gid = wgid / nig, fm = gid * WGM, gsz = (nM - fm) < WGM ? (nM - fm) : WGM;
        u.pm = fm + ((wgid % nig) % gsz); u.pn = (wgid % nig) / gsz; return true;
    }
    __device__ __forceinline__ void a_ready(const Unit&) const {}
    __device__ __forceinline__ void done(const Unit&) const {}
};
__device__ __forceinline__ unsigned cvt_pk_bf16(float lo, float hi) { return ::pk2(lo, hi); }
template <class Epi, class Sched, bool ALIGN_EPI = false, bool SP2 = false>
__device__ __forceinline__ void gemm_phase(PG8_LAS unsigned char* lds, const Gemm g, const Sched& S, const Epi& E) {
    int tid_ = threadIdx.x; asm volatile("" : "+v"(tid_));
    const int tid = tid_, wid = __builtin_amdgcn_readfirstlane(tid >> 6), lane = tid & 63, wr = wid >> 2, wc = wid & 3, fr = lane & 15, fq = lane >> 4;
    const int K = g.K, nt = K / BK;
    unsigned voffA[2], voffB[2];
#pragma unroll
    for (int i = 0; i < 2; ++i) { int R, C; stage_rc(tid * 16 + i * 8192, R, C); const int Rb = Epi::PERM ? ((R & ~31) + perm32(R & 31)) : R;
        voffA[i] = (unsigned)(R * g.lda + C) * 2u; voffB[i] = (unsigned)(Rb * g.ldb + C) * 2u; }
    const size_t kstep = (size_t)(BK * 2);
    const size_t hstepA = (size_t)HALF * g.lda * 2, hstepB = (size_t)HALF * g.ldb * 2;
    const size_t tstepA = 2 * hstepA, tstepB = 2 * hstepB;
    const unsigned ldsw = (unsigned)wid * 1024u;
    const int aoff = lds_byte(wr * 64 + fr, fq * 8), boff = lds_byte(wc * 32 + fr, fq * 8);
#define PG8_SA(b, h) (((b) * 2 + (h)) * HTB)
#define PG8_SB(b, h) ((4 + (b) * 2 + (h)) * HTB)
#define PG8_STAGE(bufoff, gbase, voff) do { _Pragma("unroll") for (int _i = 0; _i < 2; ++_i) \
        __builtin_amdgcn_global_load_lds((const unsigned*)((const char*)(gbase) + (voff)[_i]), (PG8_LAS unsigned*)(lds + (bufoff) + ldsw + _i * 8192), 16, 0, 0); } while (0)
#define PG8_LDA(dst, b, h) do { _Pragma("unroll") for (int m = 0; m < 4; ++m) _Pragma("unroll") for (int k = 0; k < 2; ++k) dst[m][k] = *(const PG8_LAS bf16x8*)(lds + PG8_SA(b, h) + aoff + m * 2048 + k * 1024); } while (0)
#define PG8_LDB(dst, b, h) do { _Pragma("unroll") for (int n = 0; n < 2; ++n) _Pragma("unroll") for (int k = 0; k < 2; ++k) dst[n][k] = *(const PG8_LAS bf16x8*)(lds + PG8_SB(b, h) + boff + n * 2048 + k * 1024); } while (0)
#define PG8_MMA(ai, bj, At, Bt) do { __builtin_amdgcn_s_setprio(1); _Pragma("unroll") for (int m = 0; m < 4; ++m) _Pragma("unroll") for (int n = 0; n < 2; ++n) _Pragma("unroll") for (int k = 0; k < 2; ++k) \
        acc[ai][bj][m][n] = __builtin_amdgcn_mfma_f32_16x16x32_bf16(Bt[n][k], At[m][k], acc[ai][bj][m][n], 0, 0, 0); __builtin_amdgcn_s_setprio(0); } while (0)
#define PG8_WAIT_V(n) asm volatile("s_waitcnt vmcnt(" #n ")" ::: "memory")
#define PG8_WAIT_L(n) asm volatile("s_waitcnt lgkmcnt(" #n ")" ::: "memory")
#define PG8_BAR __builtin_amdgcn_s_barrier()
#define PG8_SCHED __builtin_amdgcn_sched_barrier(0)
    Unit cur, nxt; int ui = 0;
    if (!S.next(0, cur)) return;
    f32x4 acc[2][2][4][2];
#pragma unroll
    for (int a = 0; a < 2; ++a)
#pragma unroll
        for (int b = 0; b < 2; ++b)
#pragma unroll
            for (int m = 0; m < 4; ++m)
#pragma unroll
                for (int n = 0; n < 2; ++n) acc[a][b][m][n] = (f32x4){0.f, 0.f, 0.f, 0.f};
    bf16x8 At[4][2], B0[2][2], B1[2][2];
    const char* cA = (const char*)g.A + (size_t)cur.pm * tstepA; const char* cB = (const char*)g.Bt + (size_t)cur.pn * tstepB;
    S.a_ready(cur);
    if constexpr (SP2) {
        PG8_STAGE(PG8_SB(0, 0), cB, voffB); PG8_STAGE(PG8_SB(0, 1), cB + hstepB, voffB); PG8_STAGE(PG8_SA(0, 0), cA, voffA); PG8_STAGE(PG8_SA(0, 1), cA + hstepA, voffA);
        if (wr == 1) PG8_BAR;
        PG8_WAIT_V(2); PG8_BAR;
        PG8_STAGE(PG8_SB(1, 0), cB + kstep, voffB); PG8_STAGE(PG8_SA(1, 0), cA + kstep, voffA); PG8_STAGE(PG8_SB(1, 1), cB + hstepB + kstep, voffB);
        PG8_WAIT_V(6); PG8_BAR;
    } else {
        PG8_STAGE(PG8_SB(0, 0), cB, voffB); PG8_STAGE(PG8_SA(0, 0), cA, voffA); PG8_STAGE(PG8_SB(0, 1), cB + hstepB, voffB); PG8_STAGE(PG8_SA(0, 1), cA + hstepA, voffA);
        if (wr == 1) PG8_BAR;
        PG8_WAIT_V(4); PG8_BAR;
        PG8_STAGE(PG8_SB(1, 0), cB + kstep, voffB); PG8_STAGE(PG8_SA(1, 0), cA + kstep, voffA); PG8_STAGE(PG8_SB(1, 1), cB + hstepB + kstep, voffB);
        PG8_WAIT_V(6); PG8_BAR;
    }
    for (;;) {
        const bool has_next = S.next(ui + 1, nxt);
        const char* nA = has_next ? (const char*)g.A + (size_t)nxt.pm * tstepA : cA; const char* nB = has_next ? (const char*)g.Bt + (size_t)nxt.pn * tstepB : cB;
        for (int t = 0; t < nt; t += 2) {
            const bool last = (t == nt - 2);
            const char* a1 = cA + (size_t)(t + 1) * kstep;
            const char* a2 = last ? nA : cA + (size_t)(t + 2) * kstep; const char* b2 = last ? nB : cB + (size_t)(t + 2) * kstep;
            const char* a3 = a2 + kstep; const char* b3 = b2 + kstep;
            if (last && has_next) S.a_ready(nxt);
            if constexpr (SP2) {
            PG8_LDB(B0, 0, 0); PG8_LDB(B1, 0, 1); PG8_SCHED; PG8_LDA(At, 0, 0); PG8_STAGE(PG8_SA(1, 1), a1 + hstepA, voffA);
            PG8_WAIT_V(8); PG8_WAIT_L(0); PG8_BAR; PG8_MMA(0, 0, At, B0); PG8_MMA(0, 1, At, B1); PG8_BAR; PG8_SCHED;
            PG8_LDA(At, 0, 1); PG8_STAGE(PG8_SB(0, 0), b2, voffB); PG8_STAGE(PG8_SB(0, 1), b2 + hstepB, voffB); PG8_STAGE(PG8_SA(0, 0), a2, voffA);
            PG8_WAIT_V(8); PG8_WAIT_L(0); PG8_BAR; PG8_MMA(1, 0, At, B0); PG8_MMA(1, 1, At, B1); PG8_BAR; PG8_SCHED;
            PG8_LDB(B0, 1, 0); PG8_LDB(B1, 1, 1); PG8_SCHED; PG8_LDA(At, 1, 0); PG8_STAGE(PG8_SA(0, 1), a2 + hstepA, voffA);
            PG8_WAIT_V(8); PG8_WAIT_L(0); PG8_BAR; PG8_MMA(0, 0, At, B0); PG8_MMA(0, 1, At, B1); PG8_BAR; PG8_SCHED;
            PG8_LDA(At, 1, 1); PG8_STAGE(PG8_SB(1, 0), b3, voffB); PG8_STAGE(PG8_SB(1, 1), b3 + hstepB, voffB); PG8_STAGE(PG8_SA(1, 0), a3, voffA);
            PG8_WAIT_V(8); PG8_WAIT_L(0); PG8_BAR; PG8_MMA(1, 0, At, B0); PG8_MMA(1, 1, At, B1); PG8_BAR; PG8_SCHED;
            } else {
            PG8_LDB(B0, 0, 0); PG8_SCHED; PG8_LDA(At, 0, 0); PG8_STAGE(PG8_SA(1, 1), a1 + hstepA, voffA);
            PG8_WAIT_L(8); PG8_BAR; PG8_WAIT_L(0); PG8_MMA(0, 0, At, B0); PG8_BAR; PG8_SCHED;
            PG8_LDB(B1, 0, 1); PG8_STAGE(PG8_SB(0, 0), b2, voffB);
            PG8_BAR; PG8_WAIT_L(0); PG8_MMA(0, 1, At, B1); PG8_BAR;
            PG8_LDA(At, 0, 1); PG8_STAGE(PG8_SA(0, 0), a2, voffA);
            PG8_BAR; PG8_WAIT_L(0); PG8_MMA(1, 0, At, B0); PG8_BAR; PG8_SCHED;
            PG8_STAGE(PG8_SB(0, 1), b2 + hstepB, voffB);
            PG8_WAIT_V(6); PG8_BAR; PG8_MMA(1, 1, At, B1); PG8_BAR;
            PG8_LDB(B0, 1, 0); PG8_SCHED; PG8_LDA(At, 1, 0); PG8_STAGE(PG8_SA(0, 1), a2 + hstepA, voffA);
            PG8_WAIT_L(8); PG8_BAR; PG8_WAIT_L(0); PG8_MMA(0, 0, At, B0); PG8_BAR; PG8_SCHED;
            PG8_LDB(B1, 1, 1); PG8_STAGE(PG8_SB(1, 0), b3, voffB);
            PG8_BAR; PG8_WAIT_L(0); PG8_MMA(0, 1, At, B1); PG8_BAR;
            PG8_LDA(At, 1, 1); PG8_STAGE(PG8_SA(1, 0), a3, voffA);
            PG8_BAR; PG8_WAIT_L(0); PG8_MMA(1, 0, At, B0); PG8_BAR; PG8_SCHED;
            PG8_STAGE(PG8_SB(1, 1), b3 + hstepB, voffB);
            PG8_WAIT_V(6); PG8_BAR; PG8_MMA(1, 1, At, B1); PG8_BAR;
            }
        }
        if constexpr (ALIGN_EPI) { if (wr == 0) PG8_BAR; }
        if constexpr (!Epi::AFTER_DRAIN) { E(acc, cur, wr, wc, fr, fq); S.done(cur); }
        if (!has_next) break;
#pragma unroll
        for (int a = 0; a < 2; ++a)
#pragma unroll
            for (int b = 0; b < 2; ++b)
#pragma unroll
                for (int m = 0; m < 4; ++m)
#pragma unroll
                    for (int n = 0; n < 2; ++n) acc[a][b][m][n] = (f32x4){0.f, 0.f, 0.f, 0.f};
        cur = nxt; cA = nA; cB = nB; ++ui;
        if constexpr (ALIGN_EPI) { if (wr == 1) PG8_BAR; }
    }
    PG8_WAIT_V(0);
    if constexpr (!ALIGN_EPI) { if (wr == 0) PG8_BAR; }
    PG8_BAR;
    if constexpr (Epi::AFTER_DRAIN) { E.fused(acc, cur, wr, wc, fr, fq, lds, wid, lane); S.done(cur); }
#undef PG8_SA
#undef PG8_SB
#undef PG8_STAGE
#undef PG8_LDA
#undef PG8_LDB
#undef PG8_MMA
#undef PG8_WAIT_V
#undef PG8_WAIT_L
#undef PG8_BAR
#undef PG8_SCHED
}
}

namespace pg8 {
__device__ __forceinline__ float sigmoidf_(float v) { return 1.f / (1.f + __expf(-v)); }
__device__ __forceinline__ void unpack8(const u32x4 w, float (&f)[8]) {
    f[0] = __uint_as_float(w.x << 16); f[1] = __uint_as_float(w.x & 0xffff0000u); f[2] = __uint_as_float(w.y << 16); f[3] = __uint_as_float(w.y & 0xffff0000u);
    f[4] = __uint_as_float(w.z << 16); f[5] = __uint_as_float(w.z & 0xffff0000u); f[6] = __uint_as_float(w.w << 16); f[7] = __uint_as_float(w.w & 0xffff0000u);
}
template <int MODE> struct EpiX {
    static constexpr bool PERM = true, AFTER_DRAIN = false;
    bf16_t* O; bf16_t* G; const float* xres; const float* gate; float* outf; int ldc; int pad; bf16_t* KCa; bf16_t* KCb; bf16_t* KI; bf16_t* WI;
    __device__ __forceinline__ void operator()(const f32x4 (&acc)[2][2][4][2], const Unit& u, int wr, int wc, int fr, int fq) const {
        const int row0 = u.pm * BM + wr * 64 + fr;
        int colt = u.pn * BM; bf16_t* base = O; int ld = ldc; bool sig = false;
        if (MODE == 1) { if (u.pn >= 15) { colt -= 15 * BM; base = G; ld = GW; sig = true; }
            else if (u.pn >= 10) {
#pragma unroll
                for (int ai = 0; ai < 2; ++ai)
#pragma unroll
                    for (int m = 0; m < 4; ++m) {
                        const int row = row0 + ai * HALF + m * 16, bb = row / S, ss = row % S;
#pragma unroll
                        for (int bj = 0; bj < 2; ++bj) {
                            const int c = wc * 32 + 8 * fq + bj * HALF;
                            const f32x4 v0 = acc[ai][bj][m][0], v1 = acc[ai][bj][m][1];
                            u32x4 w; w.x = cvt_pk_bf16(v0[0], v0[1]); w.y = cvt_pk_bf16(v0[2], v0[3]); w.z = cvt_pk_bf16(v1[0], v1[1]); w.w = cvt_pk_bf16(v1[2], v1[3]);
                            if (u.pn < 14) { const int cc = ((u.pn - 10) & 1) * BM + c; bf16_t* kc = (u.pn < 12) ? KCa : KCb;
                                *(u32x4*)(kc + ((size_t)(bb * 8 + (cc >> 6)) * S + ss) * 64 + (cc & 63)) = w; }
                            else if (c < 64) *(u32x4*)(KI + (size_t)row * 64 + c) = w;
                            else if (c == 64) *(u32x4*)(WI + (size_t)row * 8) = w;
                        }
                    }
                return;
            } }
        if (MODE == 2 || MODE == 3) { base = G; ld = GW; }
        const int col0 = colt + wc * 32 + 8 * fq;
#pragma unroll
        for (int ai = 0; ai < 2; ++ai)
#pragma unroll
            for (int m = 0; m < 4; ++m) {
                const int row = row0 + ai * HALF + m * 16;
#pragma unroll
                for (int bj = 0; bj < 2; ++bj) {
                    const int col = col0 + bj * HALF;
                    f32x4 v0 = acc[ai][bj][m][0], v1 = acc[ai][bj][m][1];
                    if (MODE == 4) {
                        const size_t o = (size_t)row * 1024 + col;
                        const f32x4 x0 = __builtin_nontemporal_load((const f32x4*)(xres + o)), x1 = __builtin_nontemporal_load((const f32x4*)(xres + o + 4));
                        const float* gp = gate + (row / S) * 6144 + col;
                        const f32x4 g0 = *(const f32x4*)gp, g1 = *(const f32x4*)(gp + 4);
                        *(f32x4*)(outf + o) = x0 + g0 * v0; *(f32x4*)(outf + o + 4) = x1 + g1 * v1;
                    } else {
                        bf16_t* pp = base + (size_t)row * ld + col;
                        if (MODE == 1) { if (sig) {
#pragma unroll
                            for (int e = 0; e < 4; ++e) { v0[e] = sigmoidf_(v0[e]); v1[e] = sigmoidf_(v1[e]); } } }
                        if (MODE == 2) { float t[8]; unpack8(*(const u32x4*)pp, t);
#pragma unroll
                            for (int e = 0; e < 4; ++e) { v0[e] *= t[e]; v1[e] *= t[4 + e]; } }
                        if (MODE == 3) { float t[8], gg[8]; unpack8(*(const u32x4*)pp, t); unpack8(*(const u32x4*)(pp + 1024), gg);
#pragma unroll
                            for (int e = 0; e < 4; ++e) { v0[e] = t[e] + gg[e] * v0[e]; v1[e] = t[4 + e] + gg[4 + e] * v1[e]; } }
                        u32x4 w; w.x = cvt_pk_bf16(v0[0], v0[1]); w.y = cvt_pk_bf16(v0[2], v0[3]); w.z = cvt_pk_bf16(v1[0], v1[1]); w.w = cvt_pk_bf16(v1[2], v1[3]);
                        *(u32x4*)pp = w;
                    }
                }
            }
    }
};
}
struct Params {
    const float *x, *c, *w_ada, *b_ada, *g1, *g2, *w_in, *rel_bias, *wpa, *wpb, *wout, *wq, *sk, *pu, *pv, *fg;
    float* out; unsigned char* ws;
};
__device__ __forceinline__ int opaque_tid() { int t = threadIdx.x; asm volatile("" : "+v"(t)); return t; }
typedef unsigned v4u __attribute__((ext_vector_type(4)));
#define LDS_WAIT() asm volatile("s_waitcnt lgkmcnt(0)" ::: "memory")

constexpr size_t WS_BAR = 0;
constexpr size_t CTL_ZERO_BYTES = 16384;
constexpr size_t WS_MOD = 64 * 1024;
constexpr size_t WS_WIN = 1 * MiB;
constexpr size_t WS_WPA = 13 * MiB, WS_WPB = 14 * MiB;
constexpr size_t WS_WOUT = 15 * MiB;
constexpr size_t WS_WQ = 17 * MiB;
constexpr size_t WS_PROJ = 22 * MiB;
constexpr size_t WS_KCA = 102 * MiB, WS_KCB = 118 * MiB;
constexpr size_t WS_KI = 134 * MiB, WS_WI = 136 * MiB;
constexpr size_t WS_G = 142 * MiB;
constexpr size_t WS_YA = 206 * MiB, WS_YB = 222 * MiB;
constexpr size_t WS_HN2 = 22 * MiB;
constexpr size_t WS_QH = 54 * MiB;
constexpr size_t WS_SKB = 21 * MiB;
constexpr size_t WS_EIDX = 118 * MiB;
constexpr size_t WS_GATE = 122 * MiB;
constexpr size_t WS_TAB = 130 * MiB;
constexpr size_t WS_SCALES = 162 * MiB;
constexpr size_t WS_VT = 238 * MiB;
constexpr size_t WS_NEED = 254 * MiB;
constexpr int LDS_SC_OFF = 7 * 16384 + 8448;

__device__ __forceinline__ void ph_mod(const Params& p, float* mod, float* sc) {
    float* part = sc + 2048;
    const int tid = threadIdx.x, kk = tid >> 3, cc = tid & 7;
    for (int i = tid; i < 2048; i += NTHR) { float v = p.c[i]; sc[i] = v / (1.f + expf(-v)); }
    __syncthreads();
    for (int unit = blockIdx.x; unit < 6144 / 24; unit += gridDim.x) {
        const int col = unit * 24 + 3 * cc;
        float a[2][3] = {{0.f, 0.f, 0.f}, {0.f, 0.f, 0.f}};
#pragma unroll 4
        for (int k = kk; k < 1024; k += 64) {
            const float* w = p.w_ada + (size_t)k * 6144 + col;
            const float w0 = __builtin_nontemporal_load(w), w1 = __builtin_nontemporal_load(w + 1), w2 = __builtin_nontemporal_load(w + 2), s0 = sc[k], s1 = sc[1024 + k];
            a[0][0] += s0 * w0; a[0][1] += s0 * w1; a[0][2] += s0 * w2; a[1][0] += s1 * w0; a[1][1] += s1 * w1; a[1][2] += s1 * w2;
        }
#pragma unroll
        for (int b = 0; b < 2; ++b)
#pragma unroll
            for (int j = 0; j < 3; ++j) part[kk * 48 + b * 24 + 3 * cc + j] = a[b][j];
        __syncthreads();
        if (tid < 48) { float s = 0.f; for (int q = 0; q < 64; ++q) s += part[q * 48 + tid]; const int b = tid / 24, j = unit * 24 + tid % 24; mod[b * 6144 + j] = s + p.b_ada[j]; }
        __syncthreads();
    }
}

template <class CM> __device__ __forceinline__ void transpose_item(const float* W, int ldw, int K, bf16* WT, LAS float* scr, int item, int nblk, int lane, const CM& cm) {
    const int kb = item / nblk, nb = item % nblk, k0 = 64 * kb, n0 = 32 * nb;
    const int sc = cm(n0 + (lane & 31));
#pragma unroll 8
    for (int i = 0; i < 32; ++i) { const int kk = 2 * i + (lane >> 5); scr[kk * 33 + (lane & 31)] = (sc >= 0) ? __builtin_nontemporal_load(W + (size_t)(k0 + kk) * ldw + sc) : 0.f; }
    LDS_WAIT(); asm volatile("" ::: "memory");
    const int c = lane & 7;
#pragma unroll
    for (int j = 0; j < 4; ++j) { const int n = (lane >> 3) + 8 * j; const LAS float* s = scr + (8 * c) * 33 + n;
        v4u o; o.x = pk2(s[0 * 33], s[1 * 33]); o.y = pk2(s[2 * 33], s[3 * 33]); o.z = pk2(s[4 * 33], s[5 * 33]); o.w = pk2(s[6 * 33], s[7 * 33]);
        *(v4u*)(WT + (size_t)(n0 + n) * K + k0 + 8 * c) = o; }
    LDS_WAIT(); asm volatile("" ::: "memory");
}
struct CmIdent { __device__ __forceinline__ int operator()(int n) const { return n; } };
struct CmWin {
    __device__ __forceinline__ int operator()(int n) const {
        if (n < 512) return n;
        if (n < 1024) return 1024 + (n - 512);
        if (n < 1536) return 1536 + (n - 1024);
        if (n < 2048) return 2120 + (n - 1536);
        if (n < 2560) return 3144 + (n - 2048);
        if (n < 3072) return 512 + (n - 2560);
        if (n < 3584) return 2632 + (n - 3072);
        if (n < 3648) return 2048 + (n - 3584);
        if (n < 3656) return 2112 + (n - 3648);
        if (n < 3840) return -1;
        return 3656 + (n - 3840);
    }
};
__device__ __forceinline__ void ph_weights(const Params& p, LAS unsigned char* lds) {
    unsigned char* ws = p.ws;
    const int wave = __builtin_amdgcn_readfirstlane(threadIdx.x >> 6), lane = threadIdx.x & 63;
    LAS float* scr = (LAS float*)(lds + wave * 16384);
    const int gw = blockIdx.x * NWAVES + wave, NGW = gridDim.x * NWAVES;
    constexpr int I_IN = 16 * (NPROJ / 32), I_PA = 8 * 32, I_PB = 8 * 32, I_OUT = 16 * 32, I_Q = 16 * 64;
    constexpr int NITEMS = I_IN + I_PA + I_PB + I_OUT + I_Q;
    for (int it = gw; it < NITEMS; it += NGW) {
        int r = it;
        if (r < I_IN) { transpose_item(p.w_in, INW, 1024, (bf16*)(ws + WS_WIN), scr, r, NPROJ / 32, lane, CmWin()); continue; } r -= I_IN;
        if (r < I_PA) { transpose_item(p.wpa, 1024, 512, (bf16*)(ws + WS_WPA), scr, r, 32, lane, CmIdent()); continue; } r -= I_PA;
        if (r < I_PB) { transpose_item(p.wpb, 1024, 512, (bf16*)(ws + WS_WPB), scr, r, 32, lane, CmIdent()); continue; } r -= I_PB;
        if (r < I_OUT) { transpose_item(p.wout, 1024, 1024, (bf16*)(ws + WS_WOUT), scr, r, 32, lane, CmIdent()); continue; } r -= I_OUT;
        transpose_item(p.wq, 2048, 1024, (bf16*)(ws + WS_WQ), scr, r, 64, lane, CmIdent());
    }
    for (int i = gw * 64 + lane; i < 8 * 2 * 128 * 128 / 4; i += NGW * 64) {
        const float4 v = ((const float4*)p.sk)[i]; uint2 w; w.x = pk2(v.x, v.y); w.y = pk2(v.z, v.w); ((uint2*)(ws + WS_SKB))[i] = w;
    }
}

template <bool NT> __device__ __forceinline__ void ph_norm(const float* src, const float* g, const float* mod, int shift_i, int scale_i, bf16* dst) {
    const int lane = threadIdx.x & 63, gw = blockIdx.x * NWAVES + __builtin_amdgcn_readfirstlane(threadIdx.x >> 6), ngw = gridDim.x * NWAVES;
    for (int t = gw; t < T; t += ngw) {
        const int b = t / S;
        float4 v[4]; float ss = 0.f;
#pragma unroll
        for (int i = 0; i < 4; ++i) { const f32x4_t t_ = NT ? __builtin_nontemporal_load((const f32x4_t*)(src + (size_t)t * D) + lane + 64 * i) : *((const f32x4_t*)(src + (size_t)t * D) + lane + 64 * i); v[i] = make_float4(t_.x, t_.y, t_.z, t_.w); ss += v[i].x * v[i].x + v[i].y * v[i].y + v[i].z * v[i].z + v[i].w * v[i].w; }
        ss = wave_sum(ss);
        const float r = rsqrtf(ss * (1.f / D) + EPS);
#pragma unroll
        for (int i = 0; i < 4; ++i) {
            const float4 gg = ((const float4*)g)[lane + 64 * i];
            const float4 sh = ((const float4*)(mod + b * 6144 + shift_i * D))[lane + 64 * i];
            const float4 sc = ((const float4*)(mod + b * 6144 + scale_i * D))[lane + 64 * i];
            float4 o;
            o.x = v[i].x * r * gg.x * (1.f + sc.x) + sh.x; o.y = v[i].y * r * gg.y * (1.f + sc.y) + sh.y;
            o.z = v[i].z * r * gg.z * (1.f + sc.z) + sh.z; o.w = v[i].w * r * gg.w * (1.f + sc.w) + sh.w;
            uint2 w; w.x = pk2(o.x, o.y); w.y = pk2(o.z, o.w);
            ((uint2*)(dst + (size_t)t * D))[lane + 64 * i] = w;
        }
    }
}
__device__ __forceinline__ unsigned f2ord(float f) { unsigned u = __float_as_uint(f); return (u & 0x80000000u) ? ~u : (u | 0x80000000u); }
__device__ __forceinline__ int t5_bucket(int n) {
    if (n < 16) return n;
    int large = 16 + (int)(logf((float)n * (1.f / 16.f)) / 2.0794415416798357f * 16.f);
    return large < 31 ? large : 31;
}

typedef short bf16x8_t __attribute__((ext_vector_type(8)));
template <int CTRL> __device__ __forceinline__ unsigned dppu(unsigned x) { return (unsigned)__builtin_amdgcn_mov_dpp((int)x, CTRL, 0xf, 0xf, true); }
template <int CTRL> __device__ __forceinline__ float dppf(float x) { return __builtin_bit_cast(float, __builtin_amdgcn_mov_dpp(__builtin_bit_cast(int, x), CTRL, 0xf, 0xf, true)); }
__device__ __forceinline__ unsigned row_max_u(unsigned x) { x = max(x, dppu<0xB1>(x)); x = max(x, dppu<0x4E>(x)); x = max(x, dppu<0x141>(x)); x = max(x, dppu<0x128>(x)); return x; }
__device__ __forceinline__ float row_max_f(float x) { x = fmaxf(x, dppf<0xB1>(x)); x = fmaxf(x, dppf<0x4E>(x)); x = fmaxf(x, dppf<0x141>(x)); x = fmaxf(x, dppf<0x128>(x)); return x; }
__device__ __forceinline__ float row_sum_f(float x) { x += dppf<0xB1>(x); x += dppf<0x4E>(x); x += dppf<0x141>(x); x += dppf<0x128>(x); return x; }
__device__ __forceinline__ float ord2f(unsigned k) { return __uint_as_float((k & 0x80000000u) ? (k & 0x7fffffffu) : ~k); }
__device__ __forceinline__ unsigned max3u(unsigned a, unsigned b, unsigned c) { return max(max(a, b), c); }

__device__ __forceinline__ void ph_quant(const Params& p, unsigned char* tab, float* scales) {
    const int lane = threadIdx.x & 63, gw = blockIdx.x * NWAVES + __builtin_amdgcn_readfirstlane(threadIdx.x >> 6), ngw = gridDim.x * NWAVES;
    for (int r = gw; r < 32768; r += ngw) {
        const float* src = (r < 16384) ? p.pu + (size_t)r * D : p.pv + (size_t)(r - 16384) * D;
        float4 v[4]; float am = 0.f;
#pragma unroll
        for (int i = 0; i < 4; ++i) { const f32x4_t t_ = __builtin_nontemporal_load((const f32x4_t*)src + lane + 64 * i); v[i] = make_float4(t_.x, t_.y, t_.z, t_.w);     am = fmaxf(am, fmaxf(fmaxf(fabsf(v[i].x), fabsf(v[i].y)), fmaxf(fabsf(v[i].z), fabsf(v[i].w)))); }
#pragma unroll
        for (int o = 1; o < 64; o <<= 1) am = fmaxf(am, __shfl_xor(am, o));
        const float inv = am > 0.f ? 127.f / am : 0.f;
        uint4 w; unsigned* wp = (unsigned*)&w;
#pragma unroll
        for (int i = 0; i < 4; ++i) {
            const int q0 = (int)rintf(v[i].x * inv) + 128, q1 = (int)rintf(v[i].y * inv) + 128, q2 = (int)rintf(v[i].z * inv) + 128, q3 = (int)rintf(v[i].w * inv) + 128;
            wp[i] = (unsigned)q0 | ((unsigned)q1 << 8) | ((unsigned)q2 << 16) | ((unsigned)q3 << 24);
        }
        ((uint4*)(tab + (size_t)r * 1024))[lane] = w;
        if (lane == 0) scales[r] = am * (1.f / 127.f);
    }
}

#define CE_DESC(x, y) do { const unsigned hi_ = max(x, y), lo_ = min(x, y); x = hi_; y = lo_; } while (0)
__device__ __forceinline__ int hull_ab(int c) {
    int a = 0, base = 0; bool done = false;
#pragma unroll
    for (int aa = 0; aa < 16; ++aa) { const int nb = 16 / (aa + 1); if (!done) { if (c >= base + nb) { base += nb; a = aa + 1; } else done = true; } }
    return (c < 50) ? ((a << 4) | (c - base)) : -1;
}
__device__ __forceinline__ void ph_peer_select(const bf16* qh, const bf16* skb, unsigned short* eidx, float* gate) {
    const int tid = opaque_tid();
    const int lane = tid & 63, fr = lane & 15, fq = lane >> 4;
    const int gw = blockIdx.x * NWAVES + __builtin_amdgcn_readfirstlane(tid >> 6), ngw = gridDim.x * NWAVES;
    int hab[4];
#pragma unroll
    for (int s = 0; s < 4; ++s) hab[s] = hull_ab(16 * s + fr);
    for (int unit = gw; unit < (T / 16) * 2; unit += ngw) {
        const int t0 = (unit >> 1) * 16, hh = unit & 1;
#pragma unroll 1
        for (int hi = 0; hi < 4; ++hi) {
            const int h = hh * 4 + hi;
            unsigned win[2][4];
#pragma unroll
            for (int c = 0; c < 2; ++c) {
                f32x4_t acc[8];
#pragma unroll
                for (int nt = 0; nt < 8; ++nt) acc[nt] = (f32x4_t){0.f, 0.f, 0.f, 0.f};
                const bf16* qrow = qh + (size_t)(t0 + fr) * 2048 + h * 256 + c * 128 + 8 * fq;
                bf16x8_t a[4];
#pragma unroll
                for (int ks = 0; ks < 4; ++ks) a[ks] = *(const bf16x8_t*)(qrow + 32 * ks);
                const bf16* kb = skb + ((size_t)(h * 2 + c) * 128 + fr) * 128 + 8 * fq;
#pragma unroll
                for (int nt = 0; nt < 8; ++nt)
#pragma unroll
                    for (int ks = 0; ks < 4; ++ks) { const bf16x8_t b = *(const bf16x8_t*)(kb + (size_t)nt * 16 * 128 + 32 * ks); acc[nt] = __builtin_amdgcn_mfma_f32_16x16x32_bf16(a[ks], b, acc[nt], 0, 0, 0); }
                unsigned pk[8][4];
#pragma unroll
                for (int nt = 0; nt < 8; ++nt)
#pragma unroll
                    for (int i = 0; i < 4; ++i) pk[nt][i] = (f2ord(acc[nt][i]) & ~127u) | (127u - (unsigned)(16 * nt + fr));
#pragma unroll
                for (int i = 0; i < 4; ++i) {
                    CE_DESC(pk[0][i], pk[1][i]); CE_DESC(pk[2][i], pk[3][i]); CE_DESC(pk[4][i], pk[5][i]); CE_DESC(pk[6][i], pk[7][i]);
                    CE_DESC(pk[0][i], pk[2][i]); CE_DESC(pk[1][i], pk[3][i]); CE_DESC(pk[4][i], pk[6][i]); CE_DESC(pk[5][i], pk[7][i]);
                    CE_DESC(pk[1][i], pk[2][i]); CE_DESC(pk[5][i], pk[6][i]);
                    CE_DESC(pk[0][i], pk[4][i]); CE_DESC(pk[1][i], pk[5][i]); CE_DESC(pk[2][i], pk[6][i]); CE_DESC(pk[3][i], pk[7][i]);
                    CE_DESC(pk[2][i], pk[4][i]); CE_DESC(pk[3][i], pk[5][i]);
                    CE_DESC(pk[1][i], pk[2][i]); CE_DESC(pk[3][i], pk[4][i]); CE_DESC(pk[5][i], pk[6][i]);
                }
#pragma unroll
                for (int r = 0; r < 16; ++r)
#pragma unroll
                    for (int i = 0; i < 4; ++i) {
                        const unsigned m = row_max_u(pk[0][i]);
                        if (fr == r) win[c][i] = m;
                        const bool w = pk[0][i] == m;
#pragma unroll
                        for (int nt = 0; nt < 7; ++nt) if (nt <= 14 - r) pk[nt][i] = w ? pk[nt + 1][i] : pk[nt][i];
                        if (7 <= 14 - r) pk[7][i] = w ? 0u : pk[7][i];
                    }
            }
#pragma unroll
            for (int i = 0; i < 4; ++i) {
                unsigned ck[4];
#pragma unroll
                for (int s = 0; s < 4; ++s) {
                    const int ab = hab[s] < 0 ? 0 : hab[s];
                    const unsigned wa = (unsigned)__shfl((int)win[0][i], (lane & 48) + (ab >> 4)), wb = (unsigned)__shfl((int)win[1][i], (lane & 48) + (ab & 15));
                    const float v = ord2f(wa & ~127u) + ord2f(wb & ~127u);
                    ck[s] = hab[s] < 0 ? 0u : ((f2ord(v) & ~255u) | (255u - (unsigned)ab));
                }
                CE_DESC(ck[0], ck[1]); CE_DESC(ck[2], ck[3]); CE_DESC(ck[0], ck[2]); CE_DESC(ck[1], ck[3]); CE_DESC(ck[1], ck[2]);
                unsigned mywin = 0u;
#pragma unroll
                for (int r = 0; r < 16; ++r) {
                    const unsigned m = row_max_u(ck[0]);
                    if (fr == r) mywin = m;
                    const bool w = ck[0] == m;
                    if (r < 15) { ck[0] = w ? ck[1] : ck[0]; ck[1] = w ? ck[2] : ck[1]; ck[2] = w ? ck[3] : ck[2]; ck[3] = w ? 0u : ck[3]; }
                }
                const unsigned ci = 255u - (mywin & 255u);
                const unsigned w0 = (unsigned)__shfl((int)win[0][i], (lane & 48) + (int)(ci >> 4)), w1 = (unsigned)__shfl((int)win[1][i], (lane & 48) + (int)(ci & 15u));
                const int e = (int)(127u - (w0 & 127u)) * 128 + (int)(127u - (w1 & 127u));
                const float s = ord2f(w0 & ~127u) + ord2f(w1 & ~127u);
                const float mx = row_max_f(s);
                const float ex = __expf(s - mx);
                const float sum = row_sum_f(ex);
                const int t = t0 + 4 * fq + i;
                eidx[(size_t)t * 128 + h * 16 + fr] = (unsigned short)e;
                gate[(size_t)t * 128 + h * 16 + fr] = ex / sum;
            }
        }
    }
}

__device__ __forceinline__ float wave_total_dpp(float x) {
    x = row_sum_f(x);
    return __builtin_bit_cast(float, __builtin_amdgcn_readlane(__builtin_bit_cast(int, x), 0)) + __builtin_bit_cast(float, __builtin_amdgcn_readlane(__builtin_bit_cast(int, x), 16)) +
           __builtin_bit_cast(float, __builtin_amdgcn_readlane(__builtin_bit_cast(int, x), 32)) + __builtin_bit_cast(float, __builtin_amdgcn_readlane(__builtin_bit_cast(int, x), 48));
}
__device__ __forceinline__ float gelu_erf(float x) { return 0.5f * x * (1.f + erff(x * 0.70710678118654752f)); }
__device__ __forceinline__ void ph_peer_gather(const Params& p, const bf16* hn2, const unsigned short* eidx, const float* gate, const unsigned char* tab, const float* scales, const float* mod, const float* xin, float* xout) {
    const int tid = opaque_tid();
    const int lane = tid & 63, gw = blockIdx.x * NWAVES + __builtin_amdgcn_readfirstlane(tid >> 6), ngw = gridDim.x * NWAVES;
    const unsigned char* utab = tab; const unsigned char* vtab = tab + (size_t)16384 * 1024;
    for (int t = gw; t < T; t += ngw) {
        const int b = t / S;
        float hv[16]; float hs = 0.f;
#pragma unroll
        for (int i = 0; i < 4; ++i) { const uint2 w = ((const uint2*)(hn2 + (size_t)t * D))[lane + 64 * i];
            hv[4 * i + 0] = __uint_as_float(w.x << 16); hv[4 * i + 1] = __uint_as_float(w.x & 0xffff0000u); hv[4 * i + 2] = __uint_as_float(w.y << 16); hv[4 * i + 3] = __uint_as_float(w.y & 0xffff0000u);
            hs += (hv[4 * i] + hv[4 * i + 1]) + (hv[4 * i + 2] + hv[4 * i + 3]); }
        hs = wave_total_dpp(hs);
        const int e0 = eidx[(size_t)t * 128 + lane], e1 = eidx[(size_t)t * 128 + 64 + lane];
        const float g0 = gate[(size_t)t * 128 + lane], g1 = gate[(size_t)t * 128 + 64 + lane];
        float pre0 = 0.f, pre1 = 0.f;
#pragma unroll
        for (int half = 0; half < 2; ++half) {
            const int ev = half ? e1 : e0;
            float pre = 0.f;
#pragma unroll 8
            for (int j = 0; j < 64; ++j) {
                const int e = __builtin_amdgcn_readlane(ev, j);
                const uint4 w = ((const uint4*)(utab + (size_t)e * 1024))[lane];
                const unsigned ww[4] = {w.x, w.y, w.z, w.w};
                float d = 0.f;
#pragma unroll
                for (int i = 0; i < 4; ++i) {
                    d += hv[4 * i + 0] * (float)(ww[i] & 0xffu); d += hv[4 * i + 1] * (float)((ww[i] >> 8) & 0xffu);
                    d += hv[4 * i + 2] * (float)((ww[i] >> 16) & 0xffu); d += hv[4 * i + 3] * (float)(ww[i] >> 24);
                }
                d = wave_total_dpp(d);
                pre = (lane == j) ? d : pre;
            }
            if (half) pre1 = pre; else pre0 = pre;
        }
        const float c0 = g0 * gelu_erf(scales[e0] * (pre0 - 128.f * hs)) * scales[16384 + e0];
        const float c1 = g1 * gelu_erf(scales[e1] * (pre1 - 128.f * hs)) * scales[16384 + e1];
        const float corr = 128.f * wave_total_dpp(c0 + c1);
        float acc[16];
#pragma unroll
        for (int i = 0; i < 16; ++i) acc[i] = 0.f;
#pragma unroll
        for (int half = 0; half < 2; ++half) {
            const int ev = half ? e1 : e0; const float cv = half ? c1 : c0;
#pragma unroll 8
            for (int j = 0; j < 64; ++j) {
                const int e = __builtin_amdgcn_readlane(ev, j);
                const float cf = __builtin_bit_cast(float, __builtin_amdgcn_readlane(__builtin_bit_cast(int, cv), j));
                const uint4 w = ((const uint4*)(vtab + (size_t)e * 1024))[lane];
                const unsigned ww[4] = {w.x, w.y, w.z, w.w};
#pragma unroll
                for (int i = 0; i < 4; ++i) {
                    acc[4 * i + 0] += cf * (float)(ww[i] & 0xffu); acc[4 * i + 1] += cf * (float)((ww[i] >> 8) & 0xffu);
                    acc[4 * i + 2] += cf * (float)((ww[i] >> 16) & 0xffu); acc[4 * i + 3] += cf * (float)(ww[i] >> 24);
                }
            }
        }
        float xv[16]; float ss = 0.f;
#pragma unroll
        for (int i = 0; i < 4; ++i) {
            const float4 g2 = ((const float4*)(mod + b * 6144 + 5 * D))[lane + 64 * i];
            const float4 x = ((const float4*)(xin + (size_t)t * D))[lane + 64 * i];
            xv[4 * i + 0] = x.x + g2.x * (acc[4 * i + 0] - corr); xv[4 * i + 1] = x.y + g2.y * (acc[4 * i + 1] - corr);
            xv[4 * i + 2] = x.z + g2.z * (acc[4 * i + 2] - corr); xv[4 * i + 3] = x.w + g2.w * (acc[4 * i + 3] - corr);
            ss += (xv[4 * i] * xv[4 * i] + xv[4 * i + 1] * xv[4 * i + 1]) + (xv[4 * i + 2] * xv[4 * i + 2] + xv[4 * i + 3] * xv[4 * i + 3]);
        }
        ss = wave_total_dpp(ss);
        const float r = rsqrtf(ss * (1.f / D) + EPS);
#pragma unroll
        for (int i = 0; i < 4; ++i) {
            const float4 gg = ((const float4*)p.fg)[lane + 64 * i];
            float4 o; o.x = xv[4 * i + 0] * r * gg.x; o.y = xv[4 * i + 1] * r * gg.y; o.z = xv[4 * i + 2] * r * gg.z; o.w = xv[4 * i + 3] * r * gg.w;
            ((float4*)(xout + (size_t)t * D))[lane + 64 * i] = o;
        }
    }
}

__device__ __forceinline__ void ph_vt(const bf16* proj, int voff, bf16* VT) {
    const int lane = threadIdx.x & 63, gw = blockIdx.x * NWAVES + __builtin_amdgcn_readfirstlane(threadIdx.x >> 6), ngw = gridDim.x * NWAVES;
    for (int u = gw; u < NB * 8 * (S / 64); u += ngw) {
        const int sb = u & 127, h = (u >> 7) & 7, b = u >> 10;
        const bf16* src = proj + (size_t)(b * S + sb * 64) * PW + voff + h * 64 + lane;
        bf16* dst = VT + (((size_t)(b * 8 + h) * (S / 32) + 2 * sb) * 64 + lane) * 32;
        unsigned short e[64];
#pragma unroll
        for (int j = 0; j < 64; ++j) e[j] = src[(size_t)j * PW];
#pragma unroll
        for (int blk = 0; blk < 2; ++blk)
#pragma unroll
            for (int q4 = 0; q4 < 4; ++q4) {
                const int a = 32 * blk + 4 * q4, c = a + 16;
                v4u o; o.x = e[a] | ((unsigned)e[a + 1] << 16); o.y = e[a + 2] | ((unsigned)e[a + 3] << 16); o.z = e[c] | ((unsigned)e[c + 1] << 16); o.w = e[c + 2] | ((unsigned)e[c + 3] << 16);
                *(v4u*)(dst + blk * 64 * 32 + 8 * q4) = o;
            }
    }
}
__device__ __forceinline__ void ph_stick2(const bf16* proj, const bf16* KC, const bf16* VT, bf16* yb) {
    const int tid = opaque_tid();
    const int lane = tid & 63, fr = lane & 15, fq = lane >> 4;
    const int gw = blockIdx.x * NWAVES + __builtin_amdgcn_readfirstlane(tid >> 6), ngw = gridDim.x * NWAVES;
    for (int u = gw; u < (T / 16) * 8; u += ngw) {
        const int h = (u >> 3) & 7, t0 = ((((u >> 6) << 3) | (u & 7))) * 16, b = t0 / S, tl0 = t0 % S;
        const int qpos = tl0 + fr;
        bf16x8_t bq[2];
        { const bf16* qrow = proj + (size_t)(t0 + fr) * PW + OFF_QB + 64 * h + 8 * fq; bq[0] = *(const bf16x8_t*)qrow; bq[1] = *(const bf16x8_t*)(qrow + 32); }
        f32x4_t acc[4];
#pragma unroll
        for (int dt = 0; dt < 4; ++dt) acc[dt] = (f32x4_t){0.f, 0.f, 0.f, 0.f};
        float carry = 0.f;
        const bf16* vtb = VT + ((size_t)(b * 8 + h) * (S / 32) * 64 + fr) * 32 + 8 * fq;
        const bf16* kbase = KC + ((size_t)(b * 8 + h) * S + fr) * 64 + 8 * fq;
        int kb = (tl0 + 15) >> 5;
        bf16x8_t ka[2][2], kbf[2][2]; v4u va[4], vb[4];
#pragma unroll
        for (int tile = 0; tile < 2; ++tile) { const bf16* kr = kbase + (size_t)(32 * kb + 16 * tile) * 64; ka[tile][0] = *(const bf16x8_t*)kr; ka[tile][1] = *(const bf16x8_t*)(kr + 32); }
#pragma unroll
        for (int dt = 0; dt < 4; ++dt) { const bf16* vr = vtb + (size_t)kb * 2048 + (16 * dt) * 32; va[dt] = *(const v4u*)vr; }
        auto stick_step = [&](const bf16x8_t (&ck)[2][2], const v4u (&cv)[4], bf16x8_t (&nk)[2][2], v4u (&nv)[4], const int kbv) -> bool {
            { const int kbn = kbv > 0 ? kbv - 1 : 0;
#pragma unroll
              for (int tile = 0; tile < 2; ++tile) { const bf16* kr = kbase + (size_t)(32 * kbn + 16 * tile) * 64; nk[tile][0] = *(const bf16x8_t*)kr; nk[tile][1] = *(const bf16x8_t*)(kr + 32); }
#pragma unroll
              for (int dt = 0; dt < 4; ++dt) { const bf16* vr = vtb + (size_t)kbn * 2048 + (16 * dt) * 32; nv[dt] = *(const v4u*)vr; } }
            unsigned pw[4] = {0u, 0u, 0u, 0u};
#pragma unroll
            for (int tile = 1; tile >= 0; --tile) {
                const int k0 = 32 * kbv + 16 * tile;
                if (k0 > tl0 + 14) continue;
                f32x4_t st = (f32x4_t){0.f, 0.f, 0.f, 0.f};
                st = __builtin_amdgcn_mfma_f32_16x16x32_bf16(ck[tile][0], bq[0], st, 0, 0, 0);
                st = __builtin_amdgcn_mfma_f32_16x16x32_bf16(ck[tile][1], bq[1], st, 0, 0, 0);
                float lb[4], l1m[4];
#pragma unroll
                for (int i = 0; i < 4; ++i) {
                    const float z = st[i] * 0.18033688011112042f;
                    const bool valid = (k0 + 4 * fq + i) < qpos;
                    const float sp = fmaxf(-z, 0.f) + __builtin_amdgcn_logf(1.f + __builtin_amdgcn_exp2f(-fabsf(z)));
                    lb[i] = valid ? -sp : -INFINITY;
                    l1m[i] = valid ? (-sp - z) : 0.f;
                }
                const float e2 = l1m[3], e1 = e2 + l1m[2], e0 = e1 + l1m[1], gsum = e0 + l1m[0];
                const float a1 = __shfl(gsum, (lane + 16) & 63), a2 = __shfl(gsum, (lane + 32) & 63), a3 = __shfl(gsum, (lane + 48) & 63);
                const float above = (fq < 3 ? a1 : 0.f) + (fq < 2 ? a2 : 0.f) + (fq < 1 ? a3 : 0.f);
                const float base = carry + above;
                const float w0 = __builtin_amdgcn_exp2f(lb[0] + base + e0), w1 = __builtin_amdgcn_exp2f(lb[1] + base + e1), w2 = __builtin_amdgcn_exp2f(lb[2] + base + e2), w3 = __builtin_amdgcn_exp2f(lb[3] + base);
                carry += (gsum + a1) + (a2 + a3);
                pw[2 * tile] = pk2(w0, w1); pw[2 * tile + 1] = pk2(w2, w3);
            }
            bf16x8_t pb;
            { v4u t; t.x = pw[0]; t.y = pw[1]; t.z = pw[2]; t.w = pw[3]; pb = __builtin_bit_cast(bf16x8_t, t); }
#pragma unroll
            for (int dt = 0; dt < 4; ++dt) {
                acc[dt] = __builtin_amdgcn_mfma_f32_16x16x32_bf16(__builtin_bit_cast(bf16x8_t, cv[dt]), pb, acc[dt], 0, 0, 0);
            }
            return __all(carry < -173.2f);
        };
        for (; kb >= 0; kb -= 2) {
            if (stick_step(ka, va, kbf, vb, kb)) break;
            if (kb == 0) break;
            if (stick_step(kbf, vb, ka, va, kb - 1)) break;
        }
#pragma unroll
        for (int dt = 0; dt < 4; ++dt) {
            uint2 o; o.x = pk2(acc[dt][0], acc[dt][1]); o.y = pk2(acc[dt][2], acc[dt][3]);
            *(uint2*)(yb + (size_t)(t0 + fr) * 512 + 64 * h + 16 * dt + 4 * fq) = o;
        }
    }
}

constexpr int IQB = 32, ICAPN = 704, ICAP = 705  , ITRIG = ICAPN - 128, ILOW = 352;
constexpr int LDS_IKEY = 0, LDS_IIDX = IQB * ICAP * 4, LDS_ICNT = ((LDS_IIDX + IQB * ICAP * 2 + 15) / 16) * 16, LDS_ITHR = LDS_ICNT + IQB * 4, LDS_IROW = LDS_ITHR + IQB * 4;
static_assert(LDS_IROW + NWAVES * 1024 <= LDS_BYTES - 16, "indexer LDS map");
__device__ __forceinline__ int wave_count(bool pred) { return __popcll(__ballot(pred)); }
__device__ __forceinline__ int index_keep(int nseen, int ntot) {
    const float f = (float)nseen / (float)ntot, a = (float)(ntot - nseen) / (float)nseen;
    const float s = 2.25f * sqrtf(a) + sqrtf(5.0625f * a + 256.f);
    return (int)ceilf(fmaxf(s * s, 272.f) * f);
}
template <int NE> __device__ __forceinline__ void index_load(LAS unsigned* keyb, LAS unsigned short* idxb, int q, int n, int lane, unsigned (&kv)[NE], unsigned (&iv)[NE]) {
#pragma unroll
    for (int j = 0; j < NE; ++j) { const int pos = lane + 64 * j; const bool in = pos < n; kv[j] = in ? keyb[q * ICAP + pos] : 0u; iv[j] = in ? (unsigned)idxb[q * ICAP + pos] : 0xFFFFu; }
}
template <int NE> __device__ __forceinline__ int index_count_ge(const unsigned (&kv)[NE], unsigned c) {
    int k = 0;
#pragma unroll
    for (int j = 0; j < NE; ++j) k += __popcll(__builtin_amdgcn_uicmp(kv[j], c, 35));
    return k;
}
template <int NE> __device__ __forceinline__ unsigned index_kth(const unsigned (&kv)[NE], int need) {
    unsigned tau = 0u;
#pragma unroll 1
    for (int bit = 31; bit >= 0; --bit) { const unsigned c = tau | (1u << bit); if (index_count_ge<NE>(kv, c) >= need) tau = c; }
    return tau;
}
template <int NE> __device__ __forceinline__ unsigned index_kth_range(const unsigned (&kv)[NE], int lo, int hi, int& cout) {
    unsigned tau = 0u;
#pragma unroll 1
    for (int bit = 31; bit >= 0; --bit) {
        const unsigned c = tau | (1u << bit); const int cc = index_count_ge<NE>(kv, c);
        if (cc >= lo) { tau = c; cout = cc; if (cc <= hi) break; }
    }
    return tau;
}
template <int NE> __device__ __forceinline__ unsigned index_bisect(const unsigned (&kv)[NE], unsigned lo, int K, int Khi, int& cout) {
    unsigned m = kv[0];
#pragma unroll
    for (int j = 1; j < NE; ++j) m = max(m, kv[j]);
    m = row_max_u(m);
    unsigned hi = max(max((unsigned)__builtin_amdgcn_readlane((int)m, 0), (unsigned)__builtin_amdgcn_readlane((int)m, 16)), max((unsigned)__builtin_amdgcn_readlane((int)m, 32), (unsigned)__builtin_amdgcn_readlane((int)m, 48)));
    if (hi > lo && hi - lo > (4u << 23)) {
        const unsigned g = hi - (3u << 23); const int cc = index_count_ge<NE>(kv, g);
        if (cc >= K) { lo = g; cout = cc; if (cc <= Khi) return lo; } else hi = g - 1u;
    }
#pragma unroll 1
    while (lo < hi) {
        const unsigned mid = lo + ((hi - lo + 1u) >> 1); const int cc = index_count_ge<NE>(kv, mid);
        if (cc >= K) { lo = mid; cout = cc; if (cc <= Khi) break; } else hi = mid - 1u;
    }
    return lo;
}
__device__ __forceinline__ void index_cut(LAS unsigned* keyb, LAS unsigned short* idxb, LAS unsigned* cnt, LAS unsigned* thr, int q, int lane, int K) {
    const int n = (int)cnt[q];
    if (n <= K) return;
    unsigned kv[11], iv[11];
    index_load<11>(keyb, idxb, q, n, lane, kv, iv);
    int c = n;
    const unsigned p = index_bisect<11>(kv, thr[q], K, K + (K >> 3), c);
    unsigned tau = p - 1u, iota = 0xFFFFu;
    if (c > 448 || p == 0u) {
        tau = index_kth<11>(kv, TOPK);
        int ngt = 0, neq = 0;
#pragma unroll
        for (int j = 0; j < 11; ++j) { ngt += __popcll(__builtin_amdgcn_uicmp(kv[j], tau, 34)); neq += __popcll(__builtin_amdgcn_uicmp(kv[j], tau, 32)); }
        const int need = TOPK - ngt;
        if (neq > need) {
            unsigned x = 0u;
#pragma unroll 1
            for (int bit = 15; bit >= 0; --bit) {
                const unsigned cc = x | (1u << bit);
                int k = 0;
#pragma unroll
                for (int j = 0; j < 11; ++j) k += wave_count(kv[j] == tau && iv[j] < cc);
                if (k < need) x = cc;
            }
            iota = x;
        }
    }
    int base = 0;
    const unsigned long long lt = (1ull << lane) - 1ull;
#pragma unroll
    for (int j = 0; j < 11; ++j) {
        const bool keep = kv[j] > tau || (kv[j] == tau && iv[j] <= iota);
        const unsigned long long m = __ballot(keep);
        const int pos = base + __popcll(m & lt);
        if (keep) { keyb[q * ICAP + pos] = kv[j]; idxb[q * ICAP + pos] = (unsigned short)iv[j]; }
        base += __popcll(m);
    }
    if (lane == 0) { cnt[q] = (unsigned)base; thr[q] = tau; }
    asm volatile("s_waitcnt lgkmcnt(0)" ::: "memory");
}
template <int NE> __device__ __forceinline__ void index_bits(LAS unsigned* keyb, LAS unsigned short* idxb, int q, int n, int lane, unsigned lo0) {
    unsigned kv[NE], iv[NE];
    index_load<NE>(keyb, idxb, q, n, lane, kv, iv);
    unsigned tau = 0u, iota = 0xFFFFu;
    if (n > TOPK) {
        int cdummy = n; tau = index_bisect<NE>(kv, lo0, TOPK, TOPK, cdummy);
        int ngt = 0, neq = 0;
#pragma unroll
        for (int j = 0; j < NE; ++j) { ngt += __popcll(__builtin_amdgcn_uicmp(kv[j], tau, 34)); neq += __popcll(__builtin_amdgcn_uicmp(kv[j], tau, 32)); }
        const int need = TOPK - ngt;
        if (neq > need) {
            unsigned x = 0u;
#pragma unroll 1
            for (int bit = 15; bit >= 0; --bit) {
                const unsigned c = x | (1u << bit);
                int k = 0;
#pragma unroll
                for (int j = 0; j < NE; ++j) k += wave_count(kv[j] == tau && iv[j] < c);
                if (k < need) x = c;
            }
            iota = x;
        }
    }
    LAS unsigned* rowl = keyb + q * ICAP;
    asm volatile("s_waitcnt lgkmcnt(0)" ::: "memory");
#pragma unroll
    for (int i = 0; i < 4; ++i) rowl[lane + 64 * i] = 0u;
    asm volatile("s_waitcnt lgkmcnt(0)" ::: "memory");
#pragma unroll
    for (int j = 0; j < NE; ++j) {
        const bool keep = (n > TOPK) ? (kv[j] > tau || (kv[j] == tau && iv[j] <= iota)) : (lane + 64 * j < n);
        if (keep) (void)__hip_atomic_fetch_or(rowl + (iv[j] >> 5), 1u << (iv[j] & 31u), __ATOMIC_RELAXED, __HIP_MEMORY_SCOPE_WORKGROUP);
    }
    asm volatile("s_waitcnt lgkmcnt(0)" ::: "memory");
}
__device__ __forceinline__ void index_final(LAS unsigned* keyb, LAS unsigned short* idxb, LAS unsigned* cnt, LAS unsigned* thr, int q, int lane) {
    const int n = (int)cnt[q]; const unsigned lo0 = thr[q];
    if (n <= 384) index_bits<6>(keyb, idxb, q, n, lane, lo0); else if (n <= 448) index_bits<7>(keyb, idxb, q, n, lane, lo0); else if (n <= 576) index_bits<9>(keyb, idxb, q, n, lane, lo0); else index_bits<11>(keyb, idxb, q, n, lane, lo0);
}
template <int ABL> __device__ __forceinline__ void ph_dsa_index(const bf16* proj, const bf16* KI, const bf16* WI, unsigned* selbits, LAS unsigned char* lds) {
    LAS unsigned* keyb = (LAS unsigned*)(lds + LDS_IKEY); LAS unsigned short* idxb = (LAS unsigned short*)(lds + LDS_IIDX);
    LAS unsigned* cnt = (LAS unsigned*)(lds + LDS_ICNT); LAS unsigned* thr = (LAS unsigned*)(lds + LDS_ITHR);
    const int tid = opaque_tid(), wave = __builtin_amdgcn_readfirstlane(tid >> 6), lane = tid & 63, fr = lane & 15, fq = lane >> 4;
    LAS unsigned* rowl = (LAS unsigned*)(lds + LDS_IROW + wave * 1024);
    constexpr int NQB = S / IQB;
    for (int pr = blockIdx.x; pr < NB * NQB / 2; pr += gridDim.x) {
        const int b = pr / (NQB / 2), pp = pr % (NQB / 2);
#pragma unroll 1
        for (int ui = 0; ui < 2; ++ui) {
            const int qb = ui ? pp : (NQB - 1 - pp);
            const int q0 = qb * IQB, t0 = b * S + q0;
            bf16x8_t bqf[2][8][2]; unsigned wvp[2][4];
#pragma unroll
            for (int qg = 0; qg < 2; ++qg) {
                const bf16* qrow = proj + (size_t)(t0 + 16 * qg + fr) * PW;
#pragma unroll
                for (int h = 0; h < 8; ++h) { bqf[qg][h][0] = *(const bf16x8_t*)(qrow + OFF_QI + 64 * h + 8 * fq); bqf[qg][h][1] = *(const bf16x8_t*)(qrow + OFF_QI + 64 * h + 8 * fq + 32); }
                { const uint4 w4 = *(const uint4*)(WI + (size_t)(t0 + 16 * qg + fr) * 8); wvp[qg][0] = w4.x; wvp[qg][1] = w4.y; wvp[qg][2] = w4.z; wvp[qg][3] = w4.w; }
            }
            bf16x8_t bql[2][1][2];
#pragma unroll
            for (int qg = 0; qg < 2; ++qg) {
#pragma unroll
                for (int ks = 0; ks < 2; ++ks) {
                    float ql[8] = {0.f, 0.f, 0.f, 0.f, 0.f, 0.f, 0.f, 0.f};
#pragma unroll
                    for (int h = 0; h < 8; ++h) {
                        const float wh = (h & 1) ? __uint_as_float(wvp[qg][h >> 1] & 0xffff0000u) : __uint_as_float(wvp[qg][h >> 1] << 16);
#pragma unroll
                        for (int j = 0; j < 8; ++j) ql[j] = __builtin_fmaf(wh, __uint_as_float((unsigned)(unsigned short)bqf[qg][h][ks][j] << 16), ql[j]);
                    }
                    v4u hi, lo; unsigned hw[4], lw[4];
#pragma unroll
                    for (int j = 0; j < 4; ++j) {
                        hw[j] = pk2(ql[2 * j], ql[2 * j + 1]);
                        lw[j] = pk2(ql[2 * j] - __uint_as_float(hw[j] << 16), ql[2 * j + 1] - __uint_as_float(hw[j] & 0xffff0000u));
                    }
                    hi.x = hw[0]; hi.y = hw[1]; hi.z = hw[2]; hi.w = hw[3]; (void)lw; (void)lo;
                    bql[qg][0][ks] = __builtin_bit_cast(bf16x8_t, hi);
                }
            }
            const int ntiles = (q0 + IQB - 1) / 128 + 1;
            const bf16* kwave = KI + (size_t)(b * S + 16 * wave + fr) * 64 + 8 * fq;
#pragma unroll 1
            for (int cons = 0; cons < 2; ++cons) {
            __syncthreads();
            if (tid < IQB) { cnt[tid] = 0u; thr[tid] = 0u; }
            bf16x8_t ak0 = *(const bf16x8_t*)kwave, ak1 = *(const bf16x8_t*)(kwave + 32);
#pragma unroll 1
            for (int kt = 0; kt < ntiles; ++kt) {
                asm volatile("s_waitcnt lgkmcnt(0)" ::: "memory"); __builtin_amdgcn_s_barrier(); asm volatile("" ::: "memory");
                if (__any((int)cnt[lane & 31] > ITRIG)) {
#pragma unroll 1
                    for (int qq = 0; qq < 4; ++qq) { const int q = 4 * wave + qq; if ((int)cnt[q] > ILOW) { if (ABL == 2) { if (lane == 0) cnt[q] = 256u; } else {
                        const int ntot = q0 + q + 1, nseen = min(128 * kt, ntot);
                        const int K = cons ? TOPK : __builtin_amdgcn_readfirstlane(max(index_keep(nseen, ntot), 32));
                        index_cut(keyb, idxb, cnt, thr, q, lane, K); } } }
                    asm volatile("s_waitcnt lgkmcnt(0)" ::: "memory"); __builtin_amdgcn_s_barrier(); asm volatile("" ::: "memory");
                }
                const unsigned th0 = thr[fr], th1 = thr[16 + fr];
                const int k0 = 128 * kt + 16 * wave;
                const bf16x8_t a0 = ak0, a1 = ak1;
                { const bf16* kn = kwave + (size_t)(128 * ((kt + 1 < ntiles) ? kt + 1 : kt)) * 64; ak0 = *(const bf16x8_t*)kn; ak1 = *(const bf16x8_t*)(kn + 32); }
#pragma unroll
                for (int qg = 0; qg < 2; ++qg) {
                    float sc[4]; f32x4_t pa[3];
#define IDX_STAGE(SLOT, B0, B1) { pa[SLOT] = (f32x4_t){0.f, 0.f, 0.f, 0.f}; pa[SLOT] = __builtin_amdgcn_mfma_f32_16x16x32_bf16(a0, B0, pa[SLOT], 0, 0, 0); pa[SLOT] = __builtin_amdgcn_mfma_f32_16x16x32_bf16(a1, B1, pa[SLOT], 0, 0, 0); }
                    IDX_STAGE(0, bql[qg][0][0], bql[qg][0][1])
                    IDX_STAGE(1, bqf[qg][0][0], bqf[qg][0][1])
                    IDX_STAGE(2, bqf[qg][1][0], bqf[qg][1][1])
                    __builtin_amdgcn_sched_barrier(0);
#pragma unroll
                    for (int i = 0; i < 4; ++i) sc[i] = pa[0][i];
#pragma unroll
                    for (int h = 0; h < 8; ++h) {
                        if (h + 2 < 8) IDX_STAGE(h % 3, bqf[qg][h + 2][0], bqf[qg][h + 2][1])
                        const float wh = (h & 1) ? __uint_as_float(wvp[qg][h >> 1] & 0xffff0000u) : __uint_as_float(wvp[qg][h >> 1] << 16);
#pragma unroll
                        for (int i = 0; i < 4; ++i) { sc[i] = __builtin_fmaf(__builtin_fabsf(pa[(h + 1) % 3][i]), wh, sc[i]); asm("" : "+v"(sc[i])); }
                        __builtin_amdgcn_sched_barrier(0);
                    }
#undef IDX_STAGE
                    const int qi = 16 * qg + fr, qpos = q0 + qi;
                    const unsigned th = qg ? th1 : th0;
                    unsigned keyv[4], slot[4]; bool prd[4];
#pragma unroll
                    for (int i = 0; i < 4; ++i) {
                        float s = sc[i]; if (s == 0.f) s = 0.f;
                        keyv[i] = f2ord(s);
                        prd[i] = (ABL != 1) && (k0 + 4 * fq + i <= qpos) && (keyv[i] > th);
                    }
#pragma unroll
                    for (int i = 0; i < 4; ++i) slot[i] = prd[i] ? __hip_atomic_fetch_add(cnt + qi, 1u, __ATOMIC_RELAXED, __HIP_MEMORY_SCOPE_WORKGROUP) : 0u;
#pragma unroll
                    for (int i = 0; i < 4; ++i) if (prd[i]) { keyb[qi * ICAP + slot[i]] = keyv[i]; idxb[qi * ICAP + slot[i]] = (unsigned short)(k0 + 4 * fq + i); }
                }
            }
            __syncthreads();
            if (!__any((int)cnt[lane & 31] < min(TOPK, q0 + (lane & 31) + 1))) break;
            }
#pragma unroll 1
            for (int qq = 0; qq < (ABL == 0 ? 4 : 0); ++qq) { const int q = 4 * wave + qq; index_final(keyb, idxb, cnt, thr, q, lane); }
            if (ABL == 0) {
                __syncthreads();
                unsigned* dst = selbits + ((size_t)(b * (S / 32) + qb) * 128) * 64;
                for (int idx = tid; idx < 128 * 32; idx += NTHR) { const int kt = idx >> 5, qq = idx & 31;
                    uint2 w; w.x = keyb[qq * ICAP + 2 * kt]; w.y = keyb[qq * ICAP + 2 * kt + 1];
                    *(uint2*)(dst + (size_t)idx * 2) = w; }
            }
        }
    }
    __syncthreads();
}

constexpr int AQB = 256, AKT = 64, AROW = 144;
constexpr int LDS_AK = 0, LDS_AV = AKT * AROW, LDS_ABUF = 2 * AKT * AROW, LDS_ABLUT = 2 * LDS_ABUF;
__device__ __forceinline__ float max3_f(float a, float b, float c) { float r_; asm("v_max3_f32 %0, %1, %2, %3" : "=v"(r_) : "v"(a), "v"(b), "v"(c)); return r_; }
__device__ __forceinline__ float max2_f(float a, float b) { float r_; asm("v_max_f32 %0, %1, %2" : "=v"(r_) : "v"(a), "v"(b)); return r_; }
__device__ __forceinline__ float bfi_f(unsigned mask, unsigned a, unsigned b) { unsigned r_; asm("v_bfi_b32 %0, %1, %2, %3" : "=v"(r_) : "v"(mask), "v"(a), "v"(b)); return __uint_as_float(r_); }
template <bool NEAR> __device__ __forceinline__ void attn_tile(LAS unsigned char* buf, LAS float* blut, const bf16x8_t (&bq)[2][2], const uint2 cb0, const uint2 cb1, int qw, int k0, int fr, int fq,
                                                               const bf16x8_t ones, f32x4_t (&acc)[2][4], f32x4_t (&accl)[2], const float (&mref_)[2], float (&mlane)[2]) {
    const float cfar = blut[128];
    bf16x8_t kf[4][2];
#pragma unroll
    for (int tile = 0; tile < 4; ++tile)
#pragma unroll
        for (int ks = 0; ks < 2; ++ks) kf[tile][ks] = *(const LAS bf16x8_t*)(buf + LDS_AK + (16 * tile + fr) * AROW + (8 * fq + 32 * ks) * 2);
    const LAS f32x4_t* mlut = (const LAS f32x4_t*)((LAS unsigned char*)blut + 2048);
    f32x4_t sx[2][4];
#pragma unroll
    for (int qg = 0; qg < 2; ++qg) {
        const uint2 cb = qg ? cb1 : cb0;
#pragma unroll
        for (int tile = 0; tile < 4; ++tile) sx[qg][tile] = mlut[__builtin_amdgcn_ubfe((tile & 2) ? cb.y : cb.x, 16 * (tile & 1) + 4 * fq, 4)];
    }
#pragma unroll
    for (int qg = 0; qg < 2; ++qg)
#pragma unroll
        for (int tile = 0; tile < 4; ++tile) {
            sx[qg][tile] = __builtin_amdgcn_mfma_f32_16x16x32_bf16(kf[tile][0], bq[qg][0], sx[qg][tile], 0, 0, 0); sx[qg][tile] = __builtin_amdgcn_mfma_f32_16x16x32_bf16(kf[tile][1], bq[qg][1], sx[qg][tile], 0, 0, 0); }
    float x[2][16];
#pragma unroll
    for (int qg = 0; qg < 2; ++qg) {
        const int dist0 = (qw + 16 * qg + fr) - (k0 + 4 * fq);
        const float mref = mref_[qg];
        const float cfm = cfar - mref;
#pragma unroll
        for (int tile = 0; tile < 4; ++tile) {
#pragma unroll
            for (int i = 0; i < 4; ++i) {
                float bias = cfm;
                if (NEAR) { int n = dist0 - (16 * tile + i); n = n < 0 ? 0 : (n > 128 ? 128 : n); bias = blut[n] - mref; }
                x[qg][4 * tile + i] = __builtin_fmaf(sx[qg][tile][i], 0.18033688011112042f, bias);
                asm("" : "+v"(x[qg][4 * tile + i]));
            }
        }
        mlane[qg] = max3_f(max3_f(max3_f(x[qg][0], x[qg][1], x[qg][2]), max3_f(x[qg][3], x[qg][4], x[qg][5]), x[qg][15]), max3_f(x[qg][6], x[qg][7], x[qg][8]), max3_f(max3_f(x[qg][9], x[qg][10], x[qg][11]), max3_f(x[qg][12], x[qg][13], x[qg][14]), mlane[qg]));
    }
#pragma unroll
    for (int blk = 0; blk < 2; ++blk) {
        bf16x8_t vf[4];
#pragma unroll
        for (int dt = 0; dt < 4; ++dt) vf[dt] = *(const LAS bf16x8_t*)(buf + LDS_AV + (16 * dt + fr) * AROW + (32 * blk + 8 * fq) * 2);
#pragma unroll
        for (int qg = 0; qg < 2; ++qg) {
            v4u t;
            t.x = pk2(__builtin_amdgcn_exp2f(x[qg][8 * blk + 0]), __builtin_amdgcn_exp2f(x[qg][8 * blk + 1])); t.y = pk2(__builtin_amdgcn_exp2f(x[qg][8 * blk + 2]), __builtin_amdgcn_exp2f(x[qg][8 * blk + 3]));
            t.z = pk2(__builtin_amdgcn_exp2f(x[qg][8 * blk + 4]), __builtin_amdgcn_exp2f(x[qg][8 * blk + 5])); t.w = pk2(__builtin_amdgcn_exp2f(x[qg][8 * blk + 6]), __builtin_amdgcn_exp2f(x[qg][8 * blk + 7]));
            const bf16x8_t pb = __builtin_bit_cast(bf16x8_t, t);
            accl[qg] = __builtin_amdgcn_mfma_f32_16x16x32_bf16(ones, pb, accl[qg], 0, 0, 0);
#pragma unroll
            for (int dt = 0; dt < 4; ++dt) acc[qg][dt] = __builtin_amdgcn_mfma_f32_16x16x32_bf16(vf[dt], pb, acc[qg][dt], 0, 0, 0);
        }
    }
}
__device__ __forceinline__ void ph_dsa_attn2(const Params& p, const bf16* proj, const bf16* KC, const bf16* VTa, const unsigned* selbits, bf16* ya, LAS unsigned char* lds) {
    const int tid = opaque_tid(), wave = __builtin_amdgcn_readfirstlane(tid >> 6), lane = tid & 63, fr = lane & 15, fq = lane >> 4;
    LAS float* blut = (LAS float*)(lds + LDS_ABLUT);
    LAS unsigned* aflag = (LAS unsigned*)(lds + LDS_ABLUT + 1024);
    constexpr int NQBA = S / AQB;
    const int ldr = tid >> 3, ldc = tid & 7;
    for (int pr = blockIdx.x; pr < NB * 8 * NQBA / 2; pr += gridDim.x) {
        const int bh = pr / (NQBA / 2), pp = pr % (NQBA / 2), b = bh >> 3, h = bh & 7;
        __syncthreads();
        if (tid <= 128) blut[tid] = p.rel_bias[(tid >= 128 ? 31 : t5_bucket(tid)) * 8 + h] * 1.4426950408889634f;
        if (tid >= 192 && tid < 256) ((LAS float*)((LAS unsigned char*)blut + 2048))[tid - 192] = ((((tid - 192) >> 2) >> (tid & 3)) & 1) ? 0.f : -1e30f;
        const bf16* kg = KC + ((size_t)(b * 8 + h) * S + ldr) * 64 + 8 * ldc;
        const bf16* vg = VTa + ((size_t)(b * 8 + h) * (S / 32) * 64 + (ldc >> 2) * 64 + ldr) * 32 + 8 * (ldc & 3);
#pragma unroll 1
        for (int ui = 0; ui < 2; ++ui) {
            const int qb = ui ? pp : (NQBA - 1 - pp);
            const int q0 = qb * AQB, qw = q0 + 32 * wave;
            const int ntiles = (q0 + AQB) / AKT;
            bf16x8_t bq[2][2];
#pragma unroll
            for (int qg = 0; qg < 2; ++qg) { const bf16* qrow = proj + (size_t)(b * S + qw + 16 * qg + fr) * PW + OFF_QA + 64 * h + 8 * fq; bq[qg][0] = *(const bf16x8_t*)qrow; bq[qg][1] = *(const bf16x8_t*)(qrow + 32); }
            const unsigned* brow0 = selbits + ((size_t)(b * (S / 32) + (qw >> 5)) * 128) * 64 + 2 * fr;
            const unsigned* brow1 = brow0 + 32;
            f32x4_t acc[2][4], accl[2]; float mref[2] = {0.f, 0.f}, mlane[2];
            const bf16x8_t ones = __builtin_bit_cast(bf16x8_t, (v4u){0x3f803f80u, 0x3f803f80u, 0x3f803f80u, 0x3f803f80u});
#pragma unroll 1
            for (int pass = 0; pass < 2; ++pass) {
#pragma unroll
            for (int qg = 0; qg < 2; ++qg) { mlane[qg] = -INFINITY; accl[qg] = (f32x4_t){0.f, 0.f, 0.f, 0.f};
#pragma unroll
                for (int dt = 0; dt < 4; ++dt) acc[qg][dt] = (f32x4_t){0.f, 0.f, 0.f, 0.f}; }
            __syncthreads();
            if (tid == 0) aflag[0] = 0u;
            { const v4u kk = *(const v4u*)kg, vv = *(const v4u*)vg;
              *(LAS v4u*)(lds + LDS_AK + ldr * AROW + 16 * ldc) = kk; *(LAS v4u*)(lds + LDS_AV + ldr * AROW + 16 * ldc) = vv; }
            uint2 wb0 = *(const uint2*)brow0, wb1 = *(const uint2*)brow1;
            __syncthreads();
            const int nfar = min(ntiles, max(0, (qw - 191 + 64) >> 6));
            const int nact = min(ntiles, (qw + 31) / AKT + 1);
#define ATTN_TILE_LOOP(KT_BEGIN, KT_END, BODY) \
            _Pragma("unroll 1") for (int kt = (KT_BEGIN); kt < (KT_END); ++kt) { \
                const int k0 = kt * AKT; \
                LAS unsigned char* buf = lds + (kt & 1) * LDS_ABUF; \
                const int ktn = (kt + 1 < ntiles) ? kt + 1 : kt;             \
                const uint2 cb0 = wb0, cb1 = wb1; \
                const v4u nk = *(const v4u*)(kg + (size_t)(ktn * AKT) * 64), nvv = *(const v4u*)(vg + (size_t)(ktn * AKT / 32) * 2048); \
                wb0 = *(const uint2*)(brow0 + 64 * ktn); wb1 = *(const uint2*)(brow1 + 64 * ktn); \
                BODY \
                { LAS unsigned char* nb = lds + ((kt + 1) & 1) * LDS_ABUF; \
                    *(LAS v4u*)(nb + LDS_AK + ldr * AROW + 16 * ldc) = nk; *(LAS v4u*)(nb + LDS_AV + ldr * AROW + 16 * ldc) = nvv; } \
                asm volatile("s_waitcnt lgkmcnt(0)" ::: "memory"); __builtin_amdgcn_s_barrier(); asm volatile("" ::: "memory");     \
            }
            ATTN_TILE_LOOP(0, nfar, attn_tile<false>(buf, blut, bq, cb0, cb1, qw, k0, fr, fq, ones, acc, accl, mref, mlane);)
            ATTN_TILE_LOOP(nfar, nact, attn_tile<true>(buf, blut, bq, cb0, cb1, qw, k0, fr, fq, ones, acc, accl, mref, mlane);)
            ATTN_TILE_LOOP(nact, ntiles, (void)buf; (void)k0; (void)cb0; (void)cb1;)
#undef ATTN_TILE_LOOP
            if (pass == 1) break;
            float mq[2];
#pragma unroll
            for (int qg = 0; qg < 2; ++qg) { float m_ = mlane[qg]; m_ = fmaxf(m_, __shfl_xor(m_, 16)); mq[qg] = fmaxf(m_, __shfl_xor(m_, 32)); }
            const bool bad = (mq[0] > 60.f) || (mq[0] < -60.f && mq[0] > -1e20f) || (mq[1] > 60.f) || (mq[1] < -60.f && mq[1] > -1e20f);
            if (__any(bad) && lane == 0) aflag[0] = 1u;
            __syncthreads();
            if (aflag[0] == 0u) break;
            mref[0] = (mq[0] > -1e20f) ? mq[0] : 0.f; mref[1] = (mq[1] > -1e20f) ? mq[1] : 0.f;
            }
#pragma unroll
            for (int qg = 0; qg < 2; ++qg) {
                const float inv = 1.f / accl[qg][0];
#pragma unroll
                for (int dt = 0; dt < 4; ++dt) { uint2 o; o.x = pk2(acc[qg][dt][0] * inv, acc[qg][dt][1] * inv); o.y = pk2(acc[qg][dt][2] * inv, acc[qg][dt][3] * inv);
                    *(uint2*)(ya + (size_t)(b * S + qw + 16 * qg + fr) * 512 + 64 * h + 16 * dt + 4 * fq) = o; }
            }
        }
    }
    __syncthreads();
}

__global__ void __launch_bounds__(NTHR, 2) mega_fwd(Params p) {
    extern __shared__ __attribute__((aligned(16))) unsigned char lds[];
    float* sm = (float*)lds;
    LAS unsigned char* ldsl = (LAS unsigned char*)lds;
    volatile LAS unsigned* bst = (volatile LAS unsigned*)(ldsl + LDS_BYTES - 16);
    if (threadIdx.x == 0) { bst[0] = 0u; bst[1] = 0u; bst[2] = 0u; bst[3] = 0u; }
    __syncthreads();
    XcdBarrier bar = xcd_barrier_post((unsigned*)(p.ws + WS_BAR), bst);
    unsigned char* ws = p.ws;
    float* mod = (float*)(ws + WS_MOD);
    bf16* proj = (bf16*)(ws + WS_PROJ);
    bf16* G = (bf16*)(ws + WS_G);
    bf16* ya = (bf16*)(ws + WS_YA); bf16* yb = (bf16*)(ws + WS_YB);
    bf16* hn2 = (bf16*)(ws + WS_HN2); bf16* qh = (bf16*)(ws + WS_QH);
    bf16* hn = (bf16*)p.out;
    const int G_ = gridDim.x, c_ = blockIdx.x;

    ph_mod(p, mod, (float*)(lds + LDS_SC_OFF));
    ph_weights(p, ldsl);
    xcd_barrier(bar);
    ph_norm<true>(p.x, p.g1, mod, 0, 1, hn);
    xcd_barrier(bar);
    {
        pg8::Gemm g{hn, (const bf16*)(ws + WS_WIN), T, NPROJ, D, D, D}; pg8::StaticOrder So; So.init(T, NPROJ, G_, c_);
        pg8::EpiX<1> E{proj, G, nullptr, nullptr, nullptr, PW, 0, (bf16*)(ws + WS_KCA), (bf16*)(ws + WS_KCB), (bf16*)(ws + WS_KI), (bf16*)(ws + WS_WI)};
        pg8::gemm_phase<pg8::EpiX<1>, pg8::StaticOrder, true, true>(ldsl, g, So, E);
    }
    xcd_barrier(bar);
    unsigned* selbits = (unsigned*)((unsigned char*)p.out + 32 * MiB); bf16* VTa = (bf16*)p.out;
    ph_vt(proj, OFF_VB, (bf16*)(ws + WS_VT));
    ph_vt(proj, OFF_VA, VTa);
    ph_dsa_index<0>(proj, (const bf16*)(ws + WS_KI), (const bf16*)(ws + WS_WI), selbits, ldsl);
    xcd_barrier(bar);
    ph_dsa_attn2(p, proj, (const bf16*)(ws + WS_KCA), VTa, selbits, ya, ldsl);
    ph_stick2(proj, (const bf16*)(ws + WS_KCB), (const bf16*)(ws + WS_VT), yb);
    xcd_barrier(bar);
    {
        pg8::Gemm g{ya, (const bf16*)(ws + WS_WPA), T, D, 512, 512, 512}; pg8::StaticOrder So; So.init(T, D, G_, c_);
        pg8::EpiX<2> E{nullptr, G, nullptr, nullptr, nullptr, 0, 0, nullptr, nullptr, nullptr, nullptr};
        pg8::gemm_phase<pg8::EpiX<2>, pg8::StaticOrder, true, true>(ldsl, g, So, E);
    }
    {
        pg8::Gemm g{yb, (const bf16*)(ws + WS_WPB), T, D, 512, 512, 512}; pg8::StaticOrder So; So.init(T, D, G_, c_);
        pg8::EpiX<3> E{nullptr, G, nullptr, nullptr, nullptr, 0, 0, nullptr, nullptr, nullptr, nullptr};
        pg8::gemm_phase<pg8::EpiX<3>, pg8::StaticOrder, true, true>(ldsl, g, So, E);
    }
    xcd_barrier(bar);
    {
        pg8::Gemm g{G, (const bf16*)(ws + WS_WOUT), T, D, D, GW, D}; pg8::StaticOrder So; So.init(T, D, G_, c_);
        pg8::EpiX<4> E{nullptr, nullptr, p.x, mod + 2 * D, p.out, 0, 0, nullptr, nullptr, nullptr, nullptr};
        pg8::gemm_phase<pg8::EpiX<4>, pg8::StaticOrder, true, true>(ldsl, g, So, E);
    }
    xcd_barrier(bar);
    ph_norm<false>(p.out, p.g2, mod, 3, 4, hn2);
    ph_quant(p, ws + WS_TAB, (float*)(ws + WS_SCALES));
    xcd_barrier(bar);
    {
        pg8::Gemm g{hn2, (const bf16*)(ws + WS_WQ), T, 2048, D, D, D}; pg8::StaticOrder So; So.init(T, 2048, G_, c_);
        pg8::EpiX<0> E{qh, nullptr, nullptr, nullptr, nullptr, 2048, 0, nullptr, nullptr, nullptr, nullptr};
        pg8::gemm_phase<pg8::EpiX<0>, pg8::StaticOrder, true, true>(ldsl, g, So, E);
    }
    xcd_barrier(bar);
    ph_peer_select(qh, (const bf16*)(ws + WS_SKB), (unsigned short*)(ws + WS_EIDX), (float*)(ws + WS_GATE));
    xcd_barrier(bar);
    ph_peer_gather(p, hn2, (const unsigned short*)(ws + WS_EIDX), (const float*)(ws + WS_GATE), ws + WS_TAB, (const float*)(ws + WS_SCALES), mod, p.out, p.out);
}

extern "C" void kernel_launch(void* const* d_in, const int* in_sizes, int n_in, void* d_out, int out_size, void* d_ws, size_t ws_size, hipStream_t stream) {
    static int grid = 0;
    if (grid == 0) {
        if (n_in != 16 || out_size != T * D || ws_size < WS_NEED) { fprintf(stderr, "kernel_launch: unexpected shapes (n_in %d out %d ws %zu)\n", n_in, out_size, ws_size); grid = -1; return; }
        int dev = 0, cus = 0, per_cu = 0;
        if (hipGetDevice(&dev) != hipSuccess || hipDeviceGetAttribute(&cus, hipDeviceAttributeMultiprocessorCount, dev) != hipSuccess) { grid = -1; return; }
        if (hipFuncSetAttribute((const void*)mega_fwd, hipFuncAttributeMaxDynamicSharedMemorySize, LDS_BYTES) != hipSuccess) { fprintf(stderr, "kernel_launch: hipFuncSetAttribute failed\n"); grid = -1; return; }
        if (hipOccupancyMaxActiveBlocksPerMultiprocessor(&per_cu, (const void*)mega_fwd, NTHR, LDS_BYTES) != hipSuccess || per_cu < 1) { fprintf(stderr, "kernel_launch: occupancy query says %d\n", per_cu); per_cu = 1; }
        (void)hipGetLastError();
        grid = cus;
    }
    if (grid < 0) return;
    (void)hipMemsetAsync((char*)d_ws + WS_BAR, 0, CTL_ZERO_BYTES, stream);
    Params p; memset(&p, 0, sizeof(p));
    p.x = (const float*)d_in[0]; p.c = (const float*)d_in[1]; p.w_ada = (const float*)d_in[2]; p.b_ada = (const float*)d_in[3];
    p.g1 = (const float*)d_in[4]; p.g2 = (const float*)d_in[5]; p.w_in = (const float*)d_in[6]; p.rel_bias = (const float*)d_in[7];
    p.wpa = (const float*)d_in[8]; p.wpb = (const float*)d_in[9]; p.wout = (const float*)d_in[10]; p.wq = (const float*)d_in[11];
    p.sk = (const float*)d_in[12]; p.pu = (const float*)d_in[13]; p.pv = (const float*)d_in[14]; p.fg = (const float*)d_in[15];
    p.out = (float*)d_out; p.ws = (unsigned char*)d_ws;
    hipLaunchKernelGGL(mega_fwd, dim3(grid), dim3(NTHR), LDS_BYTES, stream, p);
}
```
